# Optimizing an MI355X kernel written in HIP

```python
import jax
import jax.numpy as jnp
from jax import lax
import numpy as np

D_MODEL = 1024
BATCH = 4
SEQ = 8192
DEPTH = 1

CHUNK = 64
D_MIX = D_MODEL
HEAD_DIM = 64
D_A = D_MIX // 2
D_B = D_MIX - D_A
N_HEADS_A = D_A // HEAD_DIM
N_HEADS_B = D_B // HEAD_DIM
N_IDX_HEADS = 16
IDX_DIM = 64
TOPK_MAX = 256
ROPE_THETA = 500000.0
ROT_DIM = HEAD_DIM // 4
IDX_ROT_DIM = IDX_DIM // 4
RET_THETA = 10000.0
Q_BLOCK = 128
N_GROUPS = 4
EXPERTS_PER_GROUP = 8
N_EXPERTS = N_GROUPS * EXPERTS_PER_GROUP
TOP_K_FINE = 2
D_EXPERT = D_MODEL // 2
MOE_BLOCK = 128
EPS = 1e-6
SPLITS = (D_A, D_A, D_A, N_IDX_HEADS * IDX_DIM, IDX_DIM, N_IDX_HEADS, D_B, D_B, D_B, D_B)
D_IN = sum(SPLITS)

kernel_name = 'hybrid_dsa_retention_hmoe_block'


def rmsnorm(x, g):
    xf = x.astype(jnp.float32)
    xf = xf * lax.rsqrt(jnp.mean(xf * xf, axis=-1, keepdims=True) + EPS)
    return xf.astype(x.dtype) * g


def rope(x, pos, rot_dim, theta):
    half = rot_dim // 2
    inv_freq = theta ** (-jnp.arange(half, dtype=jnp.float32) / half)
    ang = pos.astype(jnp.float32)[:, :, None, None] * inv_freq
    cos, sin = jnp.cos(ang), jnp.sin(ang)
    xr = x[..., :rot_dim].astype(jnp.float32)
    x1, x2 = xr[..., :half], xr[..., half:]
    rot = jnp.concatenate([x1 * cos - x2 * sin, x2 * cos + x1 * sin], axis=-1).astype(x.dtype)
    return jnp.concatenate([rot, x[..., rot_dim:]], axis=-1)


def dsa_attention(q, k, v, q_idx, k_idx, w_idx):
    B, S = q.shape[0], q.shape[1]
    k_top = min(TOPK_MAX, S // 4)
    n_blk = S // Q_BLOCK
    key_chunk = jnp.arange(S) // CHUNK

    def to_blocks(t):
        return t.reshape((B, n_blk, Q_BLOCK) + t.shape[2:]).swapaxes(0, 1)

    def block(xs):
        i, qb, qib, wb = xs
        q_chunk = (i * Q_BLOCK + jnp.arange(Q_BLOCK)) // CHUNK
        dots = jnp.einsum('bqhe,bse->bqhs', qib, k_idx, preferred_element_type=jnp.float32)
        score = jnp.einsum('bqh,bqhs->bqs', wb.astype(jnp.float32), jax.nn.relu(dots * IDX_DIM ** -0.5))
        admissible = key_chunk[None, :] <= q_chunk[:, None]
        score = jnp.where(admissible[None], score, -jnp.inf)
        _, sel = lax.top_k(score, k_top)
        k_sel = jax.vmap(lambda kk, ii: kk[ii])(k, sel)
        v_sel = jax.vmap(lambda vv, ii: vv[ii])(v, sel)
        valid = key_chunk[sel] <= q_chunk[None, :, None]
        logits = jnp.einsum('bqhd,bqkhd->bqhk', qb, k_sel, preferred_element_type=jnp.float32) * HEAD_DIM ** -0.5
        logits = jnp.where(valid[:, :, None, :], logits, -1e30)
        p = jax.nn.softmax(logits, axis=-1).astype(v.dtype)
        return jnp.einsum('bqhk,bqkhd->bqhd', p, v_sel)

    out = lax.map(block, (jnp.arange(n_blk), to_blocks(q), to_blocks(q_idx), to_blocks(w_idx)))
    return out.swapaxes(0, 1).reshape(B, S, -1)


def retention(q, k, v, g, pos):
    B, S, H, d = q.shape
    n_c = S // CHUNK
    dt = v.dtype
    log_gamma = jnp.log1p(-jnp.exp2(-5.0 - jnp.arange(H, dtype=jnp.float32)))
    q = rope(q, pos, d, RET_THETA).astype(jnp.float32).reshape(B, n_c, CHUNK, H, d)
    k = (rope(k, pos, d, RET_THETA).astype(jnp.float32) * d ** -0.5).reshape(B, n_c, CHUNK, H, d)
    v = v.astype(jnp.float32).reshape(B, n_c, CHUNK, H, d)
    n = jnp.arange(CHUNK, dtype=jnp.float32)
    diff = n[:, None] - n[None, :]
    decay = jnp.where(diff[None] >= 0, jnp.exp(jnp.maximum(diff, 0.0)[None] * log_gamma[:, None, None]), 0.0)
    scores = jnp.einsum('bcnhd,bcmhd->bchnm', q, k) * decay
    inner = jnp.einsum('bchnm,bcmhe->bcnhe', scores, v)
    zeta = jnp.exp((CHUNK - 1.0 - n)[:, None] * log_gamma[None, :])
    kv = jnp.einsum('bcmhd,bcmhe->bchde', k * zeta[None, None, :, :, None], v)
    g_chunk = jnp.exp(CHUNK * log_gamma)[None, :, None, None]

    def step(state, kv_c):
        return state * g_chunk + kv_c, state

    _, prev = lax.scan(step, jnp.zeros((B, H, d, d), jnp.float32), kv.swapaxes(0, 1))
    prev = prev.swapaxes(0, 1)
    xi = jnp.exp((n + 1.0)[:, None] * log_gamma[None, :])
    cross = jnp.einsum('bcnhd,bchde->bcnhe', q, prev) * xi[None, None, :, :, None]
    y = (inner + cross).reshape(B, S, H, d)
    mu = jnp.mean(y, axis=-1, keepdims=True)
    var = jnp.mean(jnp.square(y - mu), axis=-1, keepdims=True)
    y = (y - mu) * lax.rsqrt(var + EPS)
    return (jax.nn.silu(g.astype(jnp.float32)) * y).astype(dt).reshape(B, S, H * d)


def hybrid_mixer(h, positions, w_in, w_o):
    B, S, _ = h.shape
    proj = jnp.einsum('bsd,de->bse', h, w_in)
    cuts = [int(i) for i in np.cumsum(SPLITS)[:-1]]
    qa, ka, va, qi, ki, wi, qb, kb, vb, gb = jnp.split(proj, cuts, axis=-1)
    qa = rope(qa.reshape(B, S, N_HEADS_A, HEAD_DIM), positions, ROT_DIM, ROPE_THETA)
    ka = rope(ka.reshape(B, S, N_HEADS_A, HEAD_DIM), positions, ROT_DIM, ROPE_THETA)
    va = va.reshape(B, S, N_HEADS_A, HEAD_DIM)
    qi = rope(qi.reshape(B, S, N_IDX_HEADS, IDX_DIM), positions, IDX_ROT_DIM, ROPE_THETA)
    ki = rope(ki.reshape(B, S, 1, IDX_DIM), positions, IDX_ROT_DIM, ROPE_THETA)[:, :, 0]
    wi = wi * N_IDX_HEADS ** -0.5
    y_a = dsa_attention(qa, ka, va, qi, ki, wi)
    shp = (B, S, N_HEADS_B, HEAD_DIM)
    y_b = retention(qb.reshape(shp), kb.reshape(shp), vb.reshape(shp), gb.reshape(shp), positions)
    y = jnp.concatenate([y_a, y_b], axis=-1)
    return jnp.einsum('bse,ed->bsd', y, w_o)


def hier_moe(h, w_router_group, w_router_expert, w_up, w_gate, w_down):
    B, S, D = h.shape
    tok = h.reshape(-1, D)
    N = tok.shape[0]
    pg = jax.nn.softmax(jnp.einsum('nd,dg->ng', tok, w_router_group).astype(jnp.float32), axis=-1)
    grp = jnp.argmax(pg, axis=-1)
    p_grp = jnp.max(pg, axis=-1)
    fine = jnp.einsum('nd,gde->nge', tok, w_router_expert).astype(jnp.float32)
    fine = jnp.take_along_axis(fine, grp[:, None, None], axis=1)[:, 0]
    pe = jax.nn.softmax(fine, axis=-1)
    top_p, top_i = lax.top_k(pe, TOP_K_FINE)
    weights = p_grp[:, None] * top_p / jnp.sum(top_p, axis=-1, keepdims=True)
    experts = grp[:, None] * EXPERTS_PER_GROUP + top_i
    A = N * TOP_K_FINE
    e_flat = experts.reshape(-1)
    w_flat = weights.reshape(-1)
    t_flat = jnp.repeat(jnp.arange(N), TOP_K_FINE)
    order = jnp.argsort(e_flat)
    e_s, t_s, w_s = e_flat[order], t_flat[order], w_flat[order]
    counts = jnp.bincount(e_flat, length=N_EXPERTS)
    starts = jnp.cumsum(counts) - counts
    padded = (counts + MOE_BLOCK - 1) // MOE_BLOCK * MOE_BLOCK
    pends = jnp.cumsum(padded)
    pstarts = pends - padded
    dest = pstarts[e_s] + (jnp.arange(A) - starts[e_s])
    P = A + N_EXPERTS * MOE_BLOCK
    n_blocks = P // MOE_BLOCK
    x_buf = jnp.zeros((P, D), h.dtype).at[dest].set(tok[t_s])
    w_buf = jnp.zeros((P,), jnp.float32).at[dest].set(w_s)
    t_buf = jnp.zeros((P,), jnp.int32).at[dest].set(t_s.astype(jnp.int32))
    blk_expert = jnp.minimum(jnp.searchsorted(pends, jnp.arange(n_blocks) * MOE_BLOCK, side='right'), N_EXPERTS - 1)

    def run(xs):
        xb, e = xs
        return (jax.nn.silu(xb @ w_gate[e]) * (xb @ w_up[e])) @ w_down[e]

    y_buf = lax.map(run, (x_buf.reshape(n_blocks, MOE_BLOCK, D), blk_expert)).reshape(P, D)
    out = jnp.zeros((N, D), h.dtype).at[t_buf].add(y_buf * w_buf[:, None].astype(h.dtype))
    return out.reshape(B, S, D)


def setup_inputs(seed: int = 0) -> dict:
    key = jax.random.key(seed)
    ks = jax.random.split(key, 16)
    nrm = jax.random.normal
    D = D_MODEL
    x = nrm(ks[0], (BATCH, SEQ, D), jnp.float32)
    c = nrm(ks[1], (BATCH, D), jnp.float32)
    offs = jax.random.randint(ks[2], (BATCH, 1), 0, 4096)
    positions = (offs + jnp.arange(SEQ)[None, :]).astype(jnp.int32)
    w_ada = nrm(ks[3], (DEPTH, D, 6 * D), jnp.float32) * (0.5 * D ** -0.5)
    b_ada = 0.01 * nrm(ks[4], (DEPTH, 6 * D), jnp.float32)
    g_norm_mix = 1.0 + 0.01 * nrm(ks[5], (DEPTH, D), jnp.float32)
    w_in = nrm(ks[6], (DEPTH, D, D_IN), jnp.float32) * D ** -0.5
    w_o = nrm(ks[7], (DEPTH, D_MIX, D), jnp.float32) * D_MIX ** -0.5
    g_norm_ffn = 1.0 + 0.01 * nrm(ks[8], (DEPTH, D), jnp.float32)
    w_router_group = nrm(ks[9], (DEPTH, D, N_GROUPS), jnp.float32) * D ** -0.5
    w_router_expert = nrm(ks[10], (DEPTH, N_GROUPS, D, EXPERTS_PER_GROUP), jnp.float32) * D ** -0.5
    w_up = nrm(ks[11], (DEPTH, N_EXPERTS, D, D_EXPERT), jnp.float32) * D ** -0.5
    w_gate = nrm(ks[12], (DEPTH, N_EXPERTS, D, D_EXPERT), jnp.float32) * D ** -0.5
    w_down = nrm(ks[13], (DEPTH, N_EXPERTS, D_EXPERT, D), jnp.float32) * D_EXPERT ** -0.5
    g_norm_final = 1.0 + 0.01 * nrm(ks[14], (D,), jnp.float32)
    return {'x': x, 'c': c, 'positions': positions, 'w_ada': w_ada, 'b_ada': b_ada,
            'g_norm_mix': g_norm_mix, 'w_in': w_in, 'w_o': w_o, 'g_norm_ffn': g_norm_ffn,
            'w_router_group': w_router_group, 'w_router_expert': w_router_expert,
            'w_up': w_up, 'w_gate': w_gate, 'w_down': w_down, 'g_norm_final': g_norm_final}


def reference(x, c, positions, w_ada, b_ada, g_norm_mix, w_in, w_o, g_norm_ffn,
              w_router_group, w_router_expert, w_up, w_gate, w_down, g_norm_final):
    for l in range(DEPTH):
        mod = jnp.einsum('bd,de->be', c, w_ada[l]) + b_ada[l]
        sh1, sc1, gt1, sh2, sc2, gt2 = jnp.split(mod, 6, axis=-1)
        h = rmsnorm(x, g_norm_mix[l]) * (1.0 + sc1[:, None, :]) + sh1[:, None, :]
        x = x + gt1[:, None, :] * hybrid_mixer(h, positions, w_in[l], w_o[l])
        h = rmsnorm(x, g_norm_ffn[l]) * (1.0 + sc2[:, None, :]) + sh2[:, None, :]
        x = x + gt2[:, None, :] * hier_moe(h, w_router_group[l], w_router_expert[l], w_up[l], w_gate[l], w_down[l])
    return rmsnorm(x, g_norm_final)
```

```cpp
#include <hip/hip_runtime.h>
#include <cstdio>
#include <cstdint>

#ifndef REP_MASK
#define REP_MASK 0u
#endif
#define SUBREPS(k) (1 + (int)((REP_MASK >> (k)) & 1u))
#ifndef MK_N_LAUNCHES
#define MK_N_LAUNCHES 1
#endif

#define GAS __attribute__((address_space(1)))
#define LAS __attribute__((address_space(3)))
typedef unsigned short bf16;
typedef unsigned v4u __attribute__((ext_vector_type(4)));
typedef unsigned v2u __attribute__((ext_vector_type(2)));
typedef float f32x4 __attribute__((ext_vector_type(4)));
typedef float f32x16 __attribute__((ext_vector_type(16)));
typedef short bf16x8 __attribute__((ext_vector_type(8)));
typedef GAS unsigned gu32;
#define RLX_AGENT __ATOMIC_RELAXED, __HIP_MEMORY_SCOPE_AGENT
#define LDS_WAIT() asm volatile("s_waitcnt lgkmcnt(0)" ::: "memory")
#define VM_WAIT() asm volatile("s_waitcnt vmcnt(0)" ::: "memory")

constexpr int NB = 4, SEQ = 8192, M = NB * SEQ, D = 1024;
constexpr int DIN = 4688, NPAD = 4864;
constexpr int NEXP = 32, DEXP = 512;
constexpr float EPS = 1e-6f;
constexpr float C2 = 0.125f * 1.4426950408889634f;

constexpr size_t MiB = 1u << 20;
constexpr size_t WS_CTL = 0, CTL_ZERO_BYTES = 1 * MiB;
constexpr size_t WS_MODP = 1 * MiB;
constexpr size_t WS_MOD = 3 * MiB;
constexpr size_t WS_WIN = 4 * MiB;
constexpr size_t WS_WO = 14 * MiB;
constexpr size_t WS_H = 16 * MiB;
constexpr size_t WS_ST = 16 * MiB;
constexpr size_t WS_MIX = 16 * MiB;
constexpr size_t WS_QA = 80 * MiB, WS_KA = 112 * MiB, WS_VA = 144 * MiB;
constexpr size_t WS_ROUTE = 144 * MiB;
constexpr size_t WS_QI = 176 * MiB;
constexpr size_t WS_H2 = 176 * MiB;
constexpr size_t WS_C0 = 176 * MiB;
constexpr size_t WS_KI = 240 * MiB;
constexpr size_t WS_WI = 244 * MiB;
constexpr size_t WS_QB = 248 * MiB, WS_KB = 280 * MiB, WS_VB = 312 * MiB, WS_GB = 344 * MiB;
constexpr size_t WS_SCR = 248 * MiB;
constexpr size_t WS_WGU = 248 * MiB;
constexpr size_t WS_C1 = 248 * MiB;
constexpr size_t WS_WD = 312 * MiB;
constexpr size_t WS_Y = 376 * MiB;
constexpr size_t WS_ACT = 376 * MiB;
constexpr size_t WS_MASK = 440 * MiB;
constexpr size_t WS_ROPE1 = 474 * MiB;
constexpr size_t WS_ROPE2 = 476 * MiB;
constexpr size_t WS_END = 512 * MiB;

constexpr int CW_BAR = 4096;
constexpr int CW_ECNT = 16384;

constexpr int NWAVES = 8;
constexpr int RING_BYTES = 131072;
constexpr int AUX_OFF = RING_BYTES, AUX_BYTES = 20480;
constexpr int LDSCTL_OFF = AUX_OFF + AUX_BYTES;
constexpr int LDS_BYTES = LDSCTL_OFF + 256;

__device__ __forceinline__ unsigned f2bf(float f) { unsigned u = __builtin_bit_cast(unsigned, f); return (u + 0x7fffu + ((u >> 16) & 1u)) >> 16; }
__device__ __forceinline__ unsigned pk2(float lo, float hi) { return f2bf(lo) | (f2bf(hi) << 16); }
__device__ __forceinline__ float bf2f(unsigned short b) { return __builtin_bit_cast(float, (unsigned)b << 16); }
__device__ __forceinline__ float wave_sum(float v) {
#pragma unroll
    for (int o = 1; o < 64; o <<= 1) v += __shfl_xor(v, o);
    return v;
}

#define XB_TMO      128
#define XB_XCNT(j)  (256  + 64 * (j))
#define XB_XSUB(j)  (1280 + 64 * (j))
#define XB_XGEN(j)  (2304 + 64 * (j))
#define XB_TOP      3328
#define XB_TOPGEN   3392
#define XCD_BAR_WORDS 3456
#define XB_SPIN_CAP (1u << 18)
__device__ __forceinline__ unsigned xb_ld(unsigned* p)              { return __hip_atomic_load(p, __ATOMIC_RELAXED, __HIP_MEMORY_SCOPE_AGENT); }
__device__ __forceinline__ unsigned xb_add(unsigned* p, unsigned v) { return __hip_atomic_fetch_add(p, v, __ATOMIC_RELAXED, __HIP_MEMORY_SCOPE_AGENT); }
__device__ __forceinline__ unsigned xb_xcc_id() { return (unsigned)__builtin_amdgcn_s_getreg((3 << 11) | 20) & 0xFu; }
#define XB_SPIN(cond, bar) do { unsigned _sp = 0; while (cond) { __builtin_amdgcn_s_sleep(1); \
    if ((++_sp & 255u) == 0u) { if (xb_ld(&(bar)[XB_TMO])) break; if (_sp > XB_SPIN_CAP) { atomicAdd(&(bar)[XB_TMO], 1u); break; } } } } while (0)
struct XcdBarrier { unsigned* bar; unsigned x; volatile LAS unsigned* st; };
__device__ __forceinline__ XcdBarrier xcd_barrier_post(unsigned* bar, volatile LAS unsigned* st) {
    XcdBarrier b; b.bar = bar; b.x = xb_xcc_id(); b.st = st;
    if (threadIdx.x == 0) (void)xb_add(&bar[XB_XCNT(b.x)], 1u);
    return b;
}
__device__ __forceinline__ void xcd_barrier_complete(unsigned* bar, unsigned x, unsigned& nloc, unsigned& nx) {
    const unsigned G = gridDim.x * gridDim.y * gridDim.z;
    unsigned sum, cnt, mine, sp = 0u;
    for (;;) {
        sum = 0u; cnt = 0u; mine = 0u;
#pragma unroll
        for (unsigned j = 0; j < 16; ++j) { const unsigned c = xb_ld(&bar[XB_XCNT(j)]); sum += c; cnt += (c > 0u) ? 1u : 0u; mine = (j == x) ? c : mine; }
        if (sum == G) break;
        __builtin_amdgcn_s_sleep(1);
        if ((++sp & 255u) == 0u) { if (xb_ld(&bar[XB_TMO])) break; if (sp > XB_SPIN_CAP) { atomicAdd(&bar[XB_TMO], 1u); break; } }
    }
    nloc = mine > 0u ? mine : 1u; nx = cnt > 0u ? cnt : 1u;
}
__device__ __forceinline__ void xcd_barrier(const XcdBarrier& b) {
    asm volatile("s_waitcnt vmcnt(0)" ::: "memory");
    __syncthreads();
    if (threadIdx.x == 0) {
        unsigned* bar = b.bar;
        __builtin_amdgcn_s_waitcnt(0);
        unsigned nloc = b.st[0], nx = b.st[1];
        if (nloc == 0u) { xcd_barrier_complete(bar, b.x, nloc, nx); b.st[0] = nloc; b.st[1] = nx; }
        const unsigned old = xb_add(&bar[XB_XSUB(b.x)], 1u);
        const unsigned gen = old / nloc;
        if (old + 1u == (gen + 1u) * nloc) {
            __builtin_amdgcn_fence(__ATOMIC_RELEASE, "agent");
            asm volatile("s_waitcnt vmcnt(0)" ::: "memory");
            const unsigned og = xb_add(&bar[XB_TOP], 1u);
            const unsigned tg = og / nx;
            if (og + 1u == (tg + 1u) * nx) xb_add(&bar[XB_TOPGEN], 1u);
            else XB_SPIN(xb_ld(&bar[XB_TOPGEN]) == tg, bar);
            __builtin_amdgcn_fence(__ATOMIC_ACQUIRE, "agent");
            xb_add(&bar[XB_XGEN(b.x)], 1u);
            asm volatile("s_waitcnt vmcnt(0)" ::: "memory");
        } else {
            XB_SPIN(xb_ld(&bar[XB_XGEN(b.x)]) == gen, bar);
            __builtin_amdgcn_fence(__ATOMIC_ACQUIRE, "agent");
            asm volatile("s_waitcnt vmcnt(0)" ::: "memory");
        }
    }
    __syncthreads();
}

namespace pg8 {
typedef unsigned short bf16_t;
constexpr int BM = 256, BK = 64, HALF = 128, HTB = HALF * BK * 2, STAGE_BYTES = 8 * HTB;
__host__ __device__ __forceinline__ int lds_byte(int r, int c) { const int st = (r >> 4) * 2 + (c >> 5), rr = r & 15, cc = c & 31, ob = rr * 64 + cc * 2; return st * 1024 + (ob ^ (((ob >> 9) & 1) << 5)); }
__host__ __device__ __forceinline__ void stage_rc(int b, int& R, int& C) { const int st = b / 1024, sb = b % 1024, swz = sb ^ (((sb >> 9) & 1) << 5); R = (st >> 1) * 16 + swz / 64; C = (st & 1) * 32 + (swz % 64) / 2; }
__host__ __device__ __forceinline__ int perm32(int rho) { const int n = rho >> 4, i = rho & 15; return 8 * (i >> 2) + 4 * n + (i & 3); }
struct Unit { int pm, pn; };
struct Gemm { const bf16_t* A; const bf16_t* Bt; int K; };
__device__ __forceinline__ unsigned cvt_pk_bf16(float lo, float hi) { unsigned r; asm volatile("v_cvt_pk_bf16_f32 %0, %1, %2" : "=v"(r) : "v"(lo), "v"(hi)); return r; }

template <class Epi, class Sched, bool ALIGN_EPI>
__device__ __forceinline__ void gemm_phase(LAS unsigned char* lds, const Gemm g, const Sched& S, const Epi& E) {
    const int tid = threadIdx.x, wid = __builtin_amdgcn_readfirstlane(tid >> 6), lane = tid & 63, wr = wid >> 2, wc = wid & 3, fr = lane & 15, fq = lane >> 4;
    const int K = g.K, nt = K / BK;
    int Rs[2], Cs[2]; unsigned voffB[2];
#pragma unroll
    for (int i = 0; i < 2; ++i) { int R, C; stage_rc(tid * 16 + i * 8192, R, C); const int Rb = Epi::PERM ? ((R & ~31) + perm32(R & 31)) : R;
        Rs[i] = R; Cs[i] = C * 2; voffB[i] = (unsigned)(Rb * K + C) * 2u; }
    const size_t kstep = (size_t)(BK * 2);
    const size_t hstep = (size_t)HALF * K * 2;
    const unsigned ldsw = (unsigned)wid * 1024u;
    const int aoff = lds_byte(wr * 64 + fr, fq * 8), boff = lds_byte(wc * 32 + fr, fq * 8);
#define PG8_SA(b, h) (((b) * 2 + (h)) * HTB)
#define PG8_SB(b, h) ((4 + (b) * 2 + (h)) * HTB)
#define PG8_STAGE(bufoff, gbase, v0, v1) do { \
        __builtin_amdgcn_global_load_lds((const unsigned*)((const char*)(gbase) + (v0)), (LAS unsigned*)(lds + (bufoff) + ldsw), 16, 0, 0); \
        __builtin_amdgcn_global_load_lds((const unsigned*)((const char*)(gbase) + (v1)), (LAS unsigned*)(lds + (bufoff) + ldsw + 8192), 16, 0, 0); } while (0)
#define PG8_STAGEB(bufoff, gbase) PG8_STAGE(bufoff, gbase, voffB[0], voffB[1])
#define PG8_LDA(dst, b, h) do { _Pragma("unroll") for (int m = 0; m < 4; ++m) _Pragma("unroll") for (int k = 0; k < 2; ++k) dst[m][k] = *(const LAS bf16x8*)(lds + PG8_SA(b, h) + aoff + m * 2048 + k * 1024); } while (0)
#define PG8_LDB(dst, b, h) do { _Pragma("unroll") for (int n = 0; n < 2; ++n) _Pragma("unroll") for (int k = 0; k < 2; ++k) dst[n][k] = *(const LAS bf16x8*)(lds + PG8_SB(b, h) + boff + n * 2048 + k * 1024); } while (0)
#define PG8_MMA(ai, bj, At, Bt) do { __builtin_amdgcn_s_setprio(1); _Pragma("unroll") for (int m = 0; m < 4; ++m) _Pragma("unroll") for (int n = 0; n < 2; ++n) _Pragma("unroll") for (int k = 0; k < 2; ++k) \
        acc[ai][bj][m][n] = __builtin_amdgcn_mfma_f32_16x16x32_bf16(Bt[n][k], At[m][k], acc[ai][bj][m][n], 0, 0, 0); __builtin_amdgcn_s_setprio(0); } while (0)
#define PG8_WAIT_V(n) asm volatile("s_waitcnt vmcnt(" #n ")" ::: "memory")
#define PG8_WAIT_L(n) asm volatile("s_waitcnt lgkmcnt(" #n ")" ::: "memory")
#define PG8_BAR __builtin_amdgcn_s_barrier()
#define PG8_SCHED __builtin_amdgcn_sched_barrier(0)
    Unit cur, nxt; int ui = 0;
    if (!S.next(0, cur)) return;
    f32x4 acc[2][2][4][2];
#pragma unroll
    for (int a = 0; a < 2; ++a)
#pragma unroll
        for (int b = 0; b < 2; ++b)
#pragma unroll
            for (int m = 0; m < 4; ++m)
#pragma unroll
                for (int n = 0; n < 2; ++n) acc[a][b][m][n] = (f32x4){0.f, 0.f, 0.f, 0.f};
    bf16x8 At[4][2], B0[2][2], B1[2][2];
    unsigned vc[2][2], vn[2][2];
#pragma unroll
    for (int h = 0; h < 2; ++h)
#pragma unroll
        for (int i = 0; i < 2; ++i) vc[h][i] = (unsigned)S.arow(cur, h * HALF + Rs[i]) * (unsigned)(K * 2) + (unsigned)Cs[i];
    const char* cA = (const char*)g.A;
    const char* cB = (const char*)g.Bt + (size_t)S.brow0(cur) * K * 2;
    PG8_STAGEB(PG8_SB(0, 0), cB); PG8_STAGEB(PG8_SB(0, 1), cB + hstep); PG8_STAGE(PG8_SA(0, 0), cA, vc[0][0], vc[0][1]); PG8_STAGE(PG8_SA(0, 1), cA, vc[1][0], vc[1][1]);
    if (wr == 1) PG8_BAR;
    PG8_WAIT_V(2); PG8_BAR;
    PG8_STAGEB(PG8_SB(1, 0), cB + kstep); PG8_STAGE(PG8_SA(1, 0), cA + kstep, vc[0][0], vc[0][1]); PG8_STAGEB(PG8_SB(1, 1), cB + hstep + kstep);
    PG8_WAIT_V(6); PG8_BAR;
    for (;;) {
        const bool has_next = S.next(ui + 1, nxt);
        const char* nB = cB;
        if (has_next) {
            nB = (const char*)g.Bt + (size_t)S.brow0(nxt) * K * 2;
#pragma unroll
            for (int h = 0; h < 2; ++h)
#pragma unroll
                for (int i = 0; i < 2; ++i) vn[h][i] = (unsigned)S.arow(nxt, h * HALF + Rs[i]) * (unsigned)(K * 2) + (unsigned)Cs[i];
        } else {
#pragma unroll
            for (int h = 0; h < 2; ++h)
#pragma unroll
                for (int i = 0; i < 2; ++i) vn[h][i] = vc[h][i];
        }
        for (int t = 0; t < nt; t += 2) {
            const bool last = (t == nt - 2);
            const char* a1 = cA + (size_t)(t + 1) * kstep;
            const char* a2 = last ? cA : cA + (size_t)(t + 2) * kstep; const char* b2 = last ? nB : cB + (size_t)(t + 2) * kstep;
            const char* a3 = a2 + kstep; const char* b3 = b2 + kstep;
            const unsigned w00 = last ? vn[0][0] : vc[0][0], w01 = last ? vn[0][1] : vc[0][1], w10 = last ? vn[1][0] : vc[1][0], w11 = last ? vn[1][1] : vc[1][1];
            PG8_LDB(B0, 0, 0); PG8_LDB(B1, 0, 1); PG8_SCHED; PG8_LDA(At, 0, 0); PG8_STAGE(PG8_SA(1, 1), a1, vc[1][0], vc[1][1]);
            PG8_WAIT_V(8); PG8_WAIT_L(0); PG8_BAR; PG8_MMA(0, 0, At, B0); PG8_MMA(0, 1, At, B1); PG8_BAR; PG8_SCHED;
            PG8_LDA(At, 0, 1); PG8_STAGEB(PG8_SB(0, 0), b2); PG8_STAGEB(PG8_SB(0, 1), b2 + hstep); PG8_STAGE(PG8_SA(0, 0), a2, w00, w01);
            PG8_WAIT_V(8); PG8_WAIT_L(0); PG8_BAR; PG8_MMA(1, 0, At, B0); PG8_MMA(1, 1, At, B1); PG8_BAR; PG8_SCHED;
            PG8_LDB(B0, 1, 0); PG8_LDB(B1, 1, 1); PG8_SCHED; PG8_LDA(At, 1, 0); PG8_STAGE(PG8_SA(0, 1), a2, w10, w11);
            PG8_WAIT_V(8); PG8_WAIT_L(0); PG8_BAR; PG8_MMA(0, 0, At, B0); PG8_MMA(0, 1, At, B1); PG8_BAR; PG8_SCHED;
            PG8_LDA(At, 1, 1); PG8_STAGEB(PG8_SB(1, 0), b3); PG8_STAGEB(PG8_SB(1, 1), b3 + hstep); PG8_STAGE(PG8_SA(1, 0), a3, w00, w01);
            PG8_WAIT_V(8); PG8_WAIT_L(0); PG8_BAR; PG8_MMA(1, 0, At, B0); PG8_MMA(1, 1, At, B1); PG8_BAR; PG8_SCHED;
        }
        if constexpr (ALIGN_EPI) { if (wr == 0) PG8_BAR; }
        E(acc, cur, wr, wc, fr, fq);
        if (!has_next) break;
#pragma unroll
        for (int a = 0; a < 2; ++a)
#pragma unroll
            for (int b = 0; b < 2; ++b)
#pragma unroll
                for (int m = 0; m < 4; ++m)
#pragma unroll
                    for (int n = 0; n < 2; ++n) acc[a][b][m][n] = (f32x4){0.f, 0.f, 0.f, 0.f};
        cur = nxt; cB = nB; ++ui;
#pragma unroll
        for (int h = 0; h < 2; ++h)
#pragma unroll
            for (int i = 0; i < 2; ++i) vc[h][i] = vn[h][i];
        if constexpr (ALIGN_EPI) { if (wr == 1) PG8_BAR; }
    }
    PG8_WAIT_V(0);
    if constexpr (!ALIGN_EPI) { if (wr == 0) PG8_BAR; }
    PG8_BAR;
#undef PG8_SA
#undef PG8_SB
#undef PG8_STAGE
#undef PG8_STAGEB
#undef PG8_LDA
#undef PG8_LDB
#undef PG8_MMA
#undef PG8_WAIT_V
#undef PG8_WAIT_L
#undef PG8_BAR
#undef PG8_SCHED
}

struct StaticOrder {
    int nM, nN, nwg, G, c;
    __device__ void init(int Mrows, int N, int G_, int c_) { nM = Mrows / BM; nN = N / BM; nwg = nM * nN; G = G_; c = c_; }
    __device__ bool next(int i, Unit& u) const {
        const long L = (long)i * G + c; if (L >= nwg) return false;
        int wgid = (int)L; { const int q = nwg / 8, r = nwg % 8, xcd = wgid % 8, off = wgid / 8; wgid = (xcd < r ? xcd * (q + 1) : r * (q + 1) + (xcd - r) * q) + off; }
        const int nig = 8 * nN, gid = wgid / nig, fm = gid * 8, gsz = (nM - fm) < 8 ? (nM - fm) : 8;
        u.pm = fm + ((wgid % nig) % gsz); u.pn = (wgid % nig) / gsz; return true;
    }
    __device__ __forceinline__ int arow(const Unit& u, int rt) const { return u.pm * BM + rt; }
    __device__ __forceinline__ int brow0(const Unit& u) const { return u.pn * BM; }
};
}

#include <cmath>
namespace attn_body {
using bf16=unsigned short;
using bf16x8=__attribute__((ext_vector_type(8)))short;
using s16x4=__attribute__((ext_vector_type(4)))short;
using f32x16=__attribute__((ext_vector_type(16)))float;
using u32x4=__attribute__((ext_vector_type(4)))unsigned;
using u32x2=__attribute__((ext_vector_type(2)))unsigned;
constexpr int BATCH=4,NHEAD=8,SEQ=8192,D=64,DM=NHEAD*D,OPITCH=1024,MPITCH=1024;
constexpr int NW=8,QBLK=32,QB=QBLK*NW,KVBLK=64,NQB=SEQ/QB;
constexpr int ATTN_PITCH=DM, ATTN_UNIT_ROWS=QB;
__device__ __forceinline__ int crow(int r,int hi){return (r&3)+8*(r>>2)+4*hi;}
#define SBAR() __builtin_amdgcn_sched_barrier(0)
constexpr int NSLOT=3, SLOTB=8192;
constexpr int LDS_K=0, LDS_V=NSLOT*SLOTB, LDS_WS=2*NSLOT*SLOTB, LDS_OST=LDS_WS+NW*64*4, LDS_MK=LDS_OST+NW*4096, LDS_BYTES=LDS_MK+NW*1024;
__device__ __forceinline__ void glds16(const void*gsrc,unsigned lds_dst){unsigned keep;
  asm volatile("s_mov_b32 %0, m0\n\ts_mov_b32 m0, %2\n\ts_nop 0\n\tglobal_load_lds_dwordx4 %1, off\n\ts_mov_b32 m0, %0":"=&s"(keep):"v"(gsrc),"s"(lds_dst):"memory");}
__device__ __forceinline__ void glds4(const void*gsrc,unsigned lds_dst){unsigned keep;
  asm volatile("s_mov_b32 %0, m0\n\ts_mov_b32 m0, %2\n\ts_nop 0\n\tglobal_load_lds_dword %1, off\n\ts_mov_b32 m0, %0":"=&s"(keep):"v"(gsrc),"s"(lds_dst):"memory");}
__device__ __forceinline__ float mskf(float x,unsigned w,int pos){ unsigned m; asm("v_bfe_i32 %0, %1, %2, 1":"=v"(m):"v"(w),"n"(pos)); return __uint_as_float(__float_as_uint(x) & m); }
__device__ __forceinline__ float max3f(float a,float b,float c){float r;asm("v_max3_f32 %0, %1, %2, %3":"=v"(r):"v"(a),"v"(b),"v"(c));return r;}
__device__ __forceinline__ float max2f(float a,float b){float r;asm("v_max_f32_e32 %0, %1, %2":"=v"(r):"v"(a),"v"(b));return r;}
__device__ __forceinline__ float fadd_s(float a,float b){float r;asm("v_add_f32_e32 %0, %1, %2":"=v"(r):"v"(a),"v"(b));return r;}
__device__ __forceinline__ float fsub_s(float a,float b){float r;asm("v_sub_f32_e32 %0, %1, %2":"=v"(r):"v"(a),"v"(b));return r;}
typedef float f32x2_t __attribute__((ext_vector_type(2))); typedef __bf16 bf16x2_t __attribute__((ext_vector_type(2)));
__device__ __forceinline__ unsigned cvtpk_s(float lo,float hi){f32x2_t v={lo,hi};bf16x2_t b=__builtin_convertvector(v,bf16x2_t);return __builtin_bit_cast(unsigned,b);}
#define WAIT_BAR(N) asm volatile("s_waitcnt vmcnt(" #N ") lgkmcnt(0)\n\ts_barrier":::"memory")

__device__ __forceinline__ void qkt(f32x16&p0,f32x16&p1,const char*Kslot,const bf16x8*qr,const f32x16&negm,int r32,int hi){
  const char*kb=Kslot+hi*1024+r32*16;
  #pragma unroll
  for(int d0=0;d0<4;++d0){
    const bf16x8 b0=*reinterpret_cast<const bf16x8*>(kb+d0*2048);
    const bf16x8 b1=*reinterpret_cast<const bf16x8*>(kb+d0*2048+512);
    if(d0==0){p0=__builtin_amdgcn_mfma_f32_32x32x16_bf16(b0,qr[0],negm,0,0,0);p1=__builtin_amdgcn_mfma_f32_32x32x16_bf16(b1,qr[0],negm,0,0,0);}
    else{p0=__builtin_amdgcn_mfma_f32_32x32x16_bf16(b0,qr[d0],p0,0,0,0);p1=__builtin_amdgcn_mfma_f32_32x32x16_bf16(b1,qr[d0],p1,0,0,0);}}
}
typedef __attribute__((address_space(3))) const char* lds_cptr;
typedef short v4i16_t __attribute__((ext_vector_type(4)));
__device__ __forceinline__ void kload8(bf16x8*kf,lds_cptr kp){
  kf[0]=*(const __attribute__((address_space(3))) bf16x8*)(kp);      kf[1]=*(const __attribute__((address_space(3))) bf16x8*)(kp+512);
  kf[2]=*(const __attribute__((address_space(3))) bf16x8*)(kp+2048); kf[3]=*(const __attribute__((address_space(3))) bf16x8*)(kp+2560);
  kf[4]=*(const __attribute__((address_space(3))) bf16x8*)(kp+4096); kf[5]=*(const __attribute__((address_space(3))) bf16x8*)(kp+4608);
  kf[6]=*(const __attribute__((address_space(3))) bf16x8*)(kp+6144); kf[7]=*(const __attribute__((address_space(3))) bf16x8*)(kp+6656);
}
__device__ __forceinline__ void kload2(bf16x8*kf,lds_cptr kp,int j){ kf[2*j]=*(const __attribute__((address_space(3))) bf16x8*)(kp+j*2048); kf[2*j+1]=*(const __attribute__((address_space(3))) bf16x8*)(kp+j*2048+512); }
__device__ __forceinline__ s16x4 vtr(lds_cptr p){ return __builtin_bit_cast(s16x4,__builtin_amdgcn_ds_read_tr16_b64_v4i16((__attribute__((address_space(3))) v4i16_t*)p)); }
__device__ __forceinline__ float rowmax(const f32x16&p0,const f32x16&p1){
  float a=max3f(p0[0],p0[1],p1[0]),b=max3f(p0[2],p0[3],p1[1]);a=max3f(a,p1[2],p1[3]);
  #pragma unroll
  for(int r=4;r<16;r+=4){a=max3f(a,p0[r],p0[r+1]);b=max3f(b,p0[r+2],p0[r+3]);a=max3f(a,p1[r],p1[r+1]);b=max3f(b,p1[r+2],p1[r+3]);}
  const float m=max2f(a,b);
  auto rr=__builtin_amdgcn_permlane32_swap(__float_as_uint(m),__float_as_uint(m),false,false);
  return max2f(__uint_as_float(rr[0]),__uint_as_float(rr[1]));
}
__device__ __forceinline__ void pv(f32x16*o,int vb,bf16x8 pa0,bf16x8 pa1,bf16x8 pa2,bf16x8 pa3){
  #pragma unroll
  for(int d0=0;d0<2;++d0){s16x4 lo[4],hi[4];
    #pragma unroll
    for(int ks=0;ks<4;++ks){
      asm volatile("ds_read_b64_tr_b16 %0,%1 offset:%c2":"=&v"(lo[ks]):"v"(vb),"i"(d0*4096+ks*1024):"memory");
      asm volatile("ds_read_b64_tr_b16 %0,%1 offset:%c2":"=&v"(hi[ks]):"v"(vb),"i"(d0*4096+ks*1024+512):"memory");}
    asm volatile("s_waitcnt lgkmcnt(0)":::"memory");SBAR();
    #define PK(k) (bf16x8){lo[k][0],lo[k][1],lo[k][2],lo[k][3],hi[k][0],hi[k][1],hi[k][2],hi[k][3]}
    o[d0]=__builtin_amdgcn_mfma_f32_32x32x16_bf16(pa0,PK(0),o[d0],0,0,0);
    o[d0]=__builtin_amdgcn_mfma_f32_32x32x16_bf16(pa1,PK(1),o[d0],0,0,0);
    o[d0]=__builtin_amdgcn_mfma_f32_32x32x16_bf16(pa2,PK(2),o[d0],0,0,0);
    o[d0]=__builtin_amdgcn_mfma_f32_32x32x16_bf16(pa3,PK(3),o[d0],0,0,0);
    #undef PK
  }
}

#ifndef ATTN_STORE16
#define ATTN_STORE16(p,v) (*(u32x4*)(p)=(v))
#endif
template<int THRL> __device__ __forceinline__ void attn_unit(int b,int h,int qb,const bf16*Q,const bf16*__restrict__ K,const bf16*__restrict__ V,bf16*O,const unsigned char*__restrict__ MK,char*shm){
  const int tid=threadIdx.x,lane=tid&63,r32=lane&31,hi=lane>>5; const int wid=__builtin_amdgcn_readfirstlane(tid>>6);
  const long rowbase=(long)b*SEQ; const int q0=qb*QB;
  const bf16*Qw=Q+(rowbase+q0+wid*QBLK)*DM+h*D;
  const bf16*Kh=K+rowbase*DM+h*D,*Vh=V+rowbase*DM+h*D;
  const unsigned lds0=(unsigned)(uintptr_t)shm;
  float*wsf=(float*)(shm+LDS_WS)+wid*64;
  const bf16*ksrc=Kh+(long)lane*DM+wid*8;
  const bf16*vsrc=Vh+(long)(16*(wid&3)+(lane>>2))*DM+(wid>>2)*32+(lane&3)*8;
  const unsigned kdst=lds0+LDS_K+wid*1024, vdst=lds0+LDS_V+wid*1024;
  #define DMA_K(t,slot) glds16(ksrc+(long)(t)*KVBLK*DM,(unsigned)__builtin_amdgcn_readfirstlane(kdst+(slot)))
  #define DMA_V(t,slot) glds16(vsrc+(long)(t)*KVBLK*DM,(unsigned)__builtin_amdgcn_readfirstlane(vdst+(slot)))
  const unsigned char*msrc=MK+(rowbase+q0+wid*QBLK+(lane>>1))*(long)MPITCH+4*(lane&1);
  const unsigned mdst=lds0+LDS_MK+wid*1024;
  #define DMA_M(t) glds4(msrc+8*(long)(t),(unsigned)__builtin_amdgcn_readfirstlane(mdst+(((t)&3)<<8)))
  const lds_cptr mp0=(lds_cptr)shm+LDS_MK+wid*1024+r32*8;
  #define MLOAD(t) do{ const u32x2 mw_=*(const __attribute__((address_space(3))) u32x2*)(mp0+(((t)&3)<<8)); ml=mw_[0]>>(4*hi); mh=mw_[1]>>(4*hi); }while(0)
  const int vb0=(int)(lds0+LDS_V)+((lane>>4)&1)*32+(lane&3)*8+(4*hi+((lane&15)>>2))*64;
  const char*Kbase=shm+LDS_K; bf16x8 kf[8];
  const lds_cptr shm3=(lds_cptr)shm; const lds_cptr kp0=shm3+LDS_K+hi*1024+r32*16; const lds_cptr vp0=shm3+LDS_V+((lane>>4)&1)*32+(lane&3)*8+(4*hi+((lane&15)>>2))*64;
  const int NT=(q0+QB)/KVBLK;
  DMA_K(0,0);DMA_M(0);DMA_V(0,0);DMA_K(1,SLOTB);
  bf16x8 qr[4];
  #pragma unroll
  for(int d0=0;d0<4;++d0)qr[d0]=*reinterpret_cast<const bf16x8*>(&Qw[(long)r32*DM+d0*16+hi*8]);
  float mhat=0.f,l_reg=0.f;f32x16 o[2];o[0]=f32x16{};o[1]=f32x16{};f32x16 negm=f32x16{};asm volatile("":"+v"(negm));
  const int qrel=wid*QBLK+r32;
  #define CMASK(P0,P1,t) do{}while(0)
  unsigned ml=0u,mh=0u;
  bool resc=false;
  #define START(P0,P1) do{ const float rm=rowmax(P0,P1); resc=false; \
    { const float dl=rm; mhat=fadd_s(mhat,dl); \
      _Pragma("unroll") for(int r=0;r<16;++r){P0[r]=fsub_s(P0[r],dl);P1[r]=fsub_s(P1[r],dl);} \
      _Pragma("unroll") for(int r=0;r<16;++r)negm[r]=-mhat; asm volatile("":"+v"(negm)); } \
    _Pragma("unroll") for(int r=0;r<16;++r)P0[r]=__builtin_amdgcn_exp2f(P0[r]); }while(0)
  #define RESC() do{ if(resc){ asm volatile("s_waitcnt lgkmcnt(0)":::"memory"); \
      _Pragma("unroll") for(int d_=0;d_<2;++d_) _Pragma("unroll") for(int r=0;r<16;++r)o[d_][r]*=wsf[crow(r,hi)]; } }while(0)
  f32x16 pA0,pA1,pB0,pB1;
  int sl_prev=0,sl_cur=0,sl_next=SLOTB;
  #define ROT() do{sl_prev=sl_cur;sl_cur=sl_next;sl_next=(sl_next==(NSLOT-1)*SLOTB)?0:sl_next+SLOTB;}while(0)
  DMA_K(2,2*SLOTB);DMA_M(1);
  WAIT_BAR(4);
  qkt(pA0,pA1,Kbase,qr,negm,r32,hi);asm volatile("s_nop 15\n\ts_nop 7":"+v"(pA0),"+v"(pA1));CMASK(pA0,pA1,0);
  START(pA0,pA1);
  _Pragma("unroll") for(int r=0;r<16;++r)pA1[r]=__builtin_amdgcn_exp2f(pA1[r]);
  MLOAD(0);
  _Pragma("unroll") for(int r=0;r<16;++r){pA0[r]=mskf(pA0[r],ml,(r&3)+8*(r>>2));pA1[r]=mskf(pA1[r],mh,(r&3)+8*(r>>2));}
  WAIT_BAR(0);
  DMA_K(3,0);DMA_V(1,SLOTB);DMA_M(2);
  ROT();
  kload8(kf,kp0+sl_cur);
  WAIT_BAR(3);
  s16x4 vlo[8],vhi[8]; u32x4 pw0,pw1,pw2,pw3;
  #define PKW(P,B) cvtpk_s(P[B],P[B+1])
  #define PAF(k) __builtin_bit_cast(bf16x8,pw##k)
  #define VFR(i) (bf16x8){vlo[i][0],vlo[i][1],vlo[i][2],vlo[i][3],vhi[i][0],vhi[i][1],vhi[i][2],vhi[i][3]}
  #define PIN(x) asm volatile("":"+v"(x))
  #define MX3(a,b,c) __builtin_fmaxf(__builtin_fmaxf((a),(b)),(c))
  #define GAPA(MF,A0,A1,A2,A3,W0,W1,PW) do{ MF; sacc+=A0; sacc+=A1; sacc+=A2; sacc+=A3; PIN(sacc); W0; W1; PIN(PW); SBAR(); }while(0)
  #define EX(v) __builtin_amdgcn_exp2f(v)
  #define GAPB(MF,X,B,W) do{ MF; X[B]=mskf(EX(X[B]),W,2*(B)); X[B+1]=mskf(EX(X[B+1]),W,2*(B)+1); X[B+2]=mskf(EX(X[B+2]),W,2*(B)+2); X[B+3]=mskf(EX(X[B+3]),W,2*(B)+3); PIN(X); SBAR(); }while(0)
  #define VRD(i) do{ vlo[i]=vtr(vp_+(((i)>>2)*4096+((i)&3)*1024)); vhi[i]=vtr(vp_+(((i)>>2)*4096+((i)&3)*1024+512)); }while(0)
  #define KRD(G,j) do{ if(G){ kload2(kf,kp0+sl_next,j); SBAR(); } }while(0)
  #define STEP(C0,C1,P0,P1,t,GK,GV,GL,GM) do{ SBAR(); \
    const lds_cptr vp_=vp0+sl_prev; \
    VRD(0); SBAR(); float sacc=(P0[0]+P0[1]); \
    GAPA(C0=__builtin_amdgcn_mfma_f32_32x32x16_bf16(kf[0],qr[0],negm,0,0,0), P0[2],P0[3],P0[4],P0[5],     pw0[0]=PKW(P0,0), pw0[1]=PKW(P0,2), pw0); \
    VRD(4); SBAR(); GAPA(C1=__builtin_amdgcn_mfma_f32_32x32x16_bf16(kf[1],qr[0],negm,0,0,0), P0[6],P0[7],P0[8],P0[9],     pw0[2]=PKW(P0,4), pw0[3]=PKW(P0,6), pw0); \
    VRD(1); SBAR(); GAPA(C0=__builtin_amdgcn_mfma_f32_32x32x16_bf16(kf[2],qr[1],C0,0,0,0),   P0[10],P0[11],P0[12],P0[13], pw1[0]=PKW(P0,8), pw1[1]=PKW(P0,10), pw1); \
    VRD(5); SBAR(); GAPA(C1=__builtin_amdgcn_mfma_f32_32x32x16_bf16(kf[3],qr[1],C1,0,0,0),   P0[14],P0[15],P1[0],P1[1],   pw1[2]=PKW(P0,12),pw1[3]=PKW(P0,14), pw1); \
    VRD(2); SBAR(); GAPA(C0=__builtin_amdgcn_mfma_f32_32x32x16_bf16(kf[4],qr[2],C0,0,0,0),   P1[2],P1[3],P1[4],P1[5],     pw2[0]=PKW(P1,0), pw2[1]=PKW(P1,2), pw2); \
    VRD(6); SBAR(); GAPA(C1=__builtin_amdgcn_mfma_f32_32x32x16_bf16(kf[5],qr[2],C1,0,0,0),   P1[6],P1[7],P1[8],P1[9],     pw2[2]=PKW(P1,4), pw2[3]=PKW(P1,6), pw2); \
    VRD(3); SBAR(); GAPA(C0=__builtin_amdgcn_mfma_f32_32x32x16_bf16(kf[6],qr[3],C0,0,0,0),   P1[10],P1[11],P1[12],P1[13], pw3[0]=PKW(P1,8), pw3[1]=PKW(P1,10), pw3); \
    VRD(7); SBAR(); GAPA(C1=__builtin_amdgcn_mfma_f32_32x32x16_bf16(kf[7],qr[3],C1,0,0,0),   P1[14],P1[15],0.f,0.f,       pw3[2]=PKW(P1,12),pw3[3]=PKW(P1,14), pw3); \
    l_reg+=sacc; \
    if(GK){DMA_K((t)+3,sl_cur);} if(GV){DMA_V((t)+1,sl_next);} if(GM){DMA_M((t)+2);} \
    CMASK(C0,C1,t); \
    { float a=MX3(C0[0],C0[1],C1[0]),b=MX3(C0[2],C0[3],C1[1]); a=MX3(a,C1[2],C1[3]); \
      _Pragma("unroll") for(int r=4;r<16;r+=4){a=MX3(a,C0[r],C0[r+1]);b=MX3(b,C0[r+2],C0[r+3]);a=MX3(a,C1[r],C1[r+1]);b=MX3(b,C1[r+2],C1[r+3]);} \
      float rm=__builtin_fmaxf(a,b); { auto rr=__builtin_amdgcn_permlane32_swap(__float_as_uint(rm),__float_as_uint(rm),false,false); rm=__builtin_fmaxf(__uint_as_float(rr[0]),__uint_as_float(rr[1])); } \
      resc=false; \
      if(__builtin_expect(__any(rm>(float)THRL),0)){ const float dl=__builtin_fmaxf(rm,0.f); mhat+=dl; \
        _Pragma("unroll") for(int r=0;r<16;++r){C0[r]-=dl;C1[r]-=dl;} \
        _Pragma("unroll") for(int r=0;r<16;++r)negm[r]=-mhat; asm volatile("":"+v"(negm)); \
        const float f=__builtin_amdgcn_exp2f(-dl); l_reg*=f; if(hi==0)wsf[r32]=f; resc=true; } } \
    MLOAD(t); SBAR(); \
    GAPB(o[0]=__builtin_amdgcn_mfma_f32_32x32x16_bf16(PAF(0),VFR(0),o[0],0,0,0), C0,0,ml); \
    GAPB(o[1]=__builtin_amdgcn_mfma_f32_32x32x16_bf16(PAF(0),VFR(4),o[1],0,0,0), C0,4,ml); \
    KRD(GL,0); GAPB(o[0]=__builtin_amdgcn_mfma_f32_32x32x16_bf16(PAF(1),VFR(1),o[0],0,0,0), C0,8,ml); \
    KRD(GL,1); GAPB(o[1]=__builtin_amdgcn_mfma_f32_32x32x16_bf16(PAF(1),VFR(5),o[1],0,0,0), C0,12,ml); \
    KRD(GL,2); GAPB(o[0]=__builtin_amdgcn_mfma_f32_32x32x16_bf16(PAF(2),VFR(2),o[0],0,0,0), C1,0,mh); \
    KRD(GL,3); GAPB(o[1]=__builtin_amdgcn_mfma_f32_32x32x16_bf16(PAF(2),VFR(6),o[1],0,0,0), C1,4,mh); \
    GAPB(o[0]=__builtin_amdgcn_mfma_f32_32x32x16_bf16(PAF(3),VFR(3),o[0],0,0,0), C1,8,mh); \
    GAPB(o[1]=__builtin_amdgcn_mfma_f32_32x32x16_bf16(PAF(3),VFR(7),o[1],0,0,0), C1,12,mh); \
    }while(0)
  int t=1;
  #undef CMASK
  #define CMASK(P0,P1,t) do{}while(0)
  for(;t+5<NT;t+=2){
    STEP(pB0,pB1,pA0,pA1,t,true,true,true,true);     WAIT_BAR(3); RESC(); ROT();
    STEP(pA0,pA1,pB0,pB1,t+1,true,true,true,true);   WAIT_BAR(3); RESC(); ROT();
  }
  #undef CMASK
  #define CMASK(P0,P1,t) do{}while(0)
  #define ENDW(tt) do{ if((tt)+3<NT){WAIT_BAR(3);} else if((tt)+2<NT){WAIT_BAR(2);} else {WAIT_BAR(0);} }while(0)
  for(;t+1<NT;t+=2){
    STEP(pB0,pB1,pA0,pA1,t,(t+3<NT),(t+1<NT),(t+1<NT),(t+2<NT));       ENDW(t);   RESC(); ROT();
    STEP(pA0,pA1,pB0,pB1,t+1,(t+4<NT),(t+2<NT),(t+2<NT),(t+3<NT));     ENDW(t+1); RESC(); ROT();
  }
  STEP(pB0,pB1,pA0,pA1,NT-1,false,false,false,false); RESC();
  { float sacc=pB0[0]+pB0[1]; _Pragma("unroll") for(int r=2;r<16;++r)sacc+=pB0[r]; _Pragma("unroll") for(int r=0;r<16;++r)sacc+=pB1[r]; l_reg+=sacc;
    pw0=(u32x4){PKW(pB0,0),PKW(pB0,2),PKW(pB0,4),PKW(pB0,6)};pw1=(u32x4){PKW(pB0,8),PKW(pB0,10),PKW(pB0,12),PKW(pB0,14)};pw2=(u32x4){PKW(pB1,0),PKW(pB1,2),PKW(pB1,4),PKW(pB1,6)};pw3=(u32x4){PKW(pB1,8),PKW(pB1,10),PKW(pB1,12),PKW(pB1,14)};
    SBAR(); pv(o,vb0+sl_cur,PAF(0),PAF(1),PAF(2),PAF(3)); }
  #undef PKW
  #undef PAF
  #undef VFR
  #undef PIN
  #undef MX3
  #undef GAPA
  #undef GAPB
  #undef EX
  #undef VRD
  #undef KRD
  #undef STEP
  #undef ENDW
  {auto rr=__builtin_amdgcn_permlane32_swap(__float_as_uint(l_reg),__float_as_uint(l_reg),false,false);l_reg=__uint_as_float(rr[0])+__uint_as_float(rr[1]);}
  if(hi==0)wsf[32+r32]=l_reg;asm volatile("s_waitcnt lgkmcnt(0)":::"memory");
  float rli[16];
  #pragma unroll
  for(int r=0;r<16;++r)rli[r]=__builtin_amdgcn_rcpf(wsf[32+crow(r,hi)]);
  bf16*Ow=O+(rowbase+q0+wid*QBLK)*OPITCH+h*D;
  { bf16*stg=(bf16*)(shm+LDS_OST)+wid*2048;
    #pragma unroll
    for(int r=0;r<16;++r){const int orow=crow(r,hi);
      #pragma unroll
      for(int d0=0;d0<2;++d0)stg[orow*64+d0*32+r32]=(bf16)f2bf(o[d0][r]*rli[r]);}
    asm volatile("s_waitcnt lgkmcnt(0)":::"memory");
    #pragma unroll
    for(int i=0;i<4;++i){const int row=i*8+(lane>>3),ch=lane&7; const u32x4 v=*(const u32x4*)(stg+row*64+ch*8); ATTN_STORE16(Ow+(long)row*OPITCH+ch*8,v);} }
  asm volatile("s_waitcnt lgkmcnt(0)\n\ts_barrier":::"memory");
  #undef DMA_K
  #undef DMA_V
  #undef DMA_M
  #undef MLOAD
  #undef CMASK
  #undef START
  #undef RESC
  #undef ROT
}
constexpr int ATTN_LDS_BYTES=LDS_BYTES;
struct AttnTensors { const bf16* Q; const bf16* K; const bf16* V; bf16* O; const unsigned char* MK; };
struct AttnUnit { int bh; int qb; };
struct StaticOrder {
  int vcu;
  __device__ __forceinline__ explicit StaticOrder(int grid,int block):vcu((block%8)*(grid/8)+block/8){}
  __device__ __forceinline__ bool next(int i,AttnUnit&u)const{ if(i>=4)return false; const int s=vcu&7; u.bh=vcu>>3; u.qb=(i==0)?s:(i==1)?15-s:(i==2)?16+s:31-s; return true; }
  __device__ __forceinline__ void a_ready(const AttnUnit&)const{}
  __device__ __forceinline__ void done(const AttnUnit&)const{}
};
template<class Sched,int THRL=8> __device__ __forceinline__ void attn_phase(char*lds,const AttnTensors&T,const Sched&S){
  AttnUnit u;
  for(int i=0;S.next(i,u);++i){ S.a_ready(u); attn_unit<THRL>(u.bh/NHEAD,u.bh%NHEAD,u.qb,T.Q,T.K,T.V,T.O,T.MK,lds); S.done(u); }
}
#undef SBAR
#undef WAIT_BAR
}

struct Args { const void* in[15]; float* out; unsigned char* ws; int ph_lo, ph_hi; };
#define CAS __attribute__((address_space(4)))
struct Frame {
    LAS unsigned char* lds;
    gu32* ctl;
    unsigned char* ws;
    int tid, lane, wave;
    int vcu, G;
    const CAS Args* ka;
    __device__ __forceinline__ const float* inp(int k) const { return (const float*)ka->in[k]; }
#define FDEF(name, k) __device__ __forceinline__ const float* name() const { return inp(k); }
    FDEF(x, 0) FDEF(c, 1) FDEF(w_ada, 3) FDEF(b_ada, 4) FDEF(g_mix, 5) FDEF(w_in, 6) FDEF(w_o, 7) FDEF(g_ffn, 8) FDEF(w_rg, 9) FDEF(w_re, 10) FDEF(w_up, 11) FDEF(w_gate, 12) FDEF(w_down, 13) FDEF(g_fin, 14)
#undef FDEF
    __device__ __forceinline__ const int* pos() const { return (const int*)ka->in[2]; }
    __device__ __forceinline__ float* out() const { return ka->out; }
};

__device__ __forceinline__ void tr_put(LAS unsigned* T, int nb, int ns, int p, const f32x4 a, const f32x4 b) {
    T[(nb) * 33 + p] = pg8::cvt_pk_bf16(a.x, b.x); T[(nb + ns) * 33 + p] = pg8::cvt_pk_bf16(a.y, b.y);
    T[(nb + 2 * ns) * 33 + p] = pg8::cvt_pk_bf16(a.z, b.z); T[(nb + 3 * ns) * 33 + p] = pg8::cvt_pk_bf16(a.w, b.w);
}
__device__ __forceinline__ void tr_store(LAS unsigned* T, bf16* WT, int K, int n0, int k0, int lane) {
    LDS_WAIT(); asm volatile("" ::: "memory");
#pragma unroll
    for (int i = 0; i < 8; ++i) { const int n = (lane >> 3) + 8 * i, kc = lane & 7; const LAS unsigned* t = T + n * 33 + 4 * kc;
        v4u o; o.x = t[0]; o.y = t[1]; o.z = t[2]; o.w = t[3];
        *(GAS v4u*)(WT + (size_t)(n0 + n) * K + k0 + 8 * kc) = o; }
    LDS_WAIT(); asm volatile("" ::: "memory");
}
__device__ __forceinline__ void tr_tile_gu(const float* gate, const float* up, bf16* WT, int n0, int k0, LAS unsigned* T, int lane) {
    const int pq = lane >> 3, cq = lane & 7, c0 = n0 >> 1;
    f32x4 g0[4], g1[4], u0[4], u1[4];
#pragma unroll
    for (int i = 0; i < 4; ++i) { const int p = pq + 8 * i; const size_t o = (size_t)(k0 + 2 * p) * DEXP + c0 + 4 * cq;
        g0[i] = *(const GAS f32x4*)(gate + o); g1[i] = *(const GAS f32x4*)(gate + o + DEXP); u0[i] = *(const GAS f32x4*)(up + o); u1[i] = *(const GAS f32x4*)(up + o + DEXP); }
#pragma unroll
    for (int i = 0; i < 4; ++i) { const int p = pq + 8 * i; tr_put(T, 8 * cq, 2, p, g0[i], g1[i]); tr_put(T, 8 * cq + 1, 2, p, u0[i], u1[i]); }
    tr_store(T, WT, 1024, n0, k0, lane);
}
__device__ __forceinline__ void tr_tile_d(const float* wd, bf16* WT, int n0, int k0, LAS unsigned* T, int lane) {
    const int pq = lane >> 4, cq = lane & 15;
    f32x4 a[8], b[8];
#pragma unroll
    for (int i = 0; i < 8; ++i) { const int p = pq + 4 * i; const size_t o = (size_t)(k0 + 2 * p) * D + n0 + 4 * cq; a[i] = *(const GAS f32x4*)(wd + o); b[i] = *(const GAS f32x4*)(wd + o + D); }
#pragma unroll
    for (int i = 0; i < 8; ++i) { const int p = pq + 4 * i; tr_put(T, 4 * cq, 1, p, a[i], b[i]); }
    tr_store(T, WT, 512, n0, k0, lane);
}

template <class SrcFn>
__device__ __forceinline__ void tr_tile_gen(const SrcFn& src, int ldw, bf16* WT, int K, int n0, int k0, LAS unsigned* T, int lane) {
    const int pq = lane >> 4, cq = lane & 15; const float* sp = src(n0 + 4 * cq);
    f32x4 a[8], b[8];
#pragma unroll
    for (int i = 0; i < 8; ++i) { const int p = pq + 4 * i;
        if (sp) { a[i] = *(const GAS f32x4*)(sp + (size_t)(k0 + 2 * p) * ldw); b[i] = *(const GAS f32x4*)(sp + (size_t)(k0 + 2 * p + 1) * ldw); }
        else { a[i] = (f32x4){0.f, 0.f, 0.f, 0.f}; b[i] = a[i]; } }
#pragma unroll
    for (int i = 0; i < 8; ++i) { const int p = pq + 4 * i; tr_put(T, 4 * cq, 1, p, a[i], b[i]); }
    tr_store(T, WT, K, n0, k0, lane);
}

__device__ __forceinline__ int win_src_col(int n) {
    if (n < 2560) return n;
    if (n < 3584) {
        const int q = n - 2560, sec = q >> 9, hd = (q >> 6) & 7, p = q & 63, gidx = p >> 3, blk = gidx >> 1, isx2 = gidx & 1;
        return (sec ? 3152 : 2640) + hd * 64 + isx2 * 32 + 8 * blk + (p & 7);
    }
    if (n < 4096) return 3664 + (n - 3584);
    if (n < 4608) return 4176 + (n - 4096);
    if (n < 4672) return 2560 + (n - 4608);
    if (n < 4688) return 2624 + (n - 4672);
    return -1;
}

__device__ __forceinline__ void p0_prologue(Frame& F) {
    const int gw = F.vcu * NWAVES + F.wave, NGW = F.G * NWAVES;
    float* modp = (float*)(F.ws + WS_MODP);
    for (int rp2 = 0; rp2 < SUBREPS(20); ++rp2)
    for (int task = gw; task < 24 * 16; task += NGW) {
        const int cg = task % 24, ks = task / 24, j0 = cg * 256 + F.lane * 4;
        f32x4 a0 = {0, 0, 0, 0}, a1 = a0, a2 = a0, a3 = a0;
#pragma unroll 8
        for (int kk = 0; kk < 64; ++kk) { const int k = ks * 64 + kk; const f32x4 w = *(const GAS f32x4*)(F.w_ada() + (size_t)k * 6144 + j0);
            a0 += w * F.c()[0 * D + k]; a1 += w * F.c()[1 * D + k]; a2 += w * F.c()[2 * D + k]; a3 += w * F.c()[3 * D + k]; }
        *(GAS f32x4*)(modp + ((size_t)(ks * 4 + 0) * 6144 + j0)) = a0; *(GAS f32x4*)(modp + ((size_t)(ks * 4 + 1) * 6144 + j0)) = a1;
        *(GAS f32x4*)(modp + ((size_t)(ks * 4 + 2) * 6144 + j0)) = a2; *(GAS f32x4*)(modp + ((size_t)(ks * 4 + 3) * 6144 + j0)) = a3;
    }
    {
        float* c1 = (float*)(F.ws + WS_ROPE1); float* s1 = c1 + (size_t)M * 8;
        float* c2 = (float*)(F.ws + WS_ROPE2); float* s2 = c2 + (size_t)M * 32;
        const int gt = (F.vcu * NWAVES + F.wave) * 64 + F.lane, NGT = NGW * 64;
        for (int rp2 = 0; rp2 < SUBREPS(18); ++rp2)
        for (int i = gt; i < M * 40; i += NGT) {
            const int m = i / 40, j = i % 40; const float p = (float)F.pos()[m];
            if (j < 8) { const float inv = powf(500000.0f, -(float)j / 8.0f); float sn, cs; sincosf(p * inv, &sn, &cs); c1[m * 8 + j] = cs; s1[m * 8 + j] = sn; }
            else { const int jj = j - 8; const float inv = powf(10000.0f, -(float)jj / 32.0f); float sn, cs; sincosf(p * inv, &sn, &cs); c2[m * 32 + jj] = cs; s2[m * 32 + jj] = sn; }
        }
    }
    {
        constexpr int I_IN = (NPAD / 64) * (D / 64), I_O = (D / 64) * (D / 64);
        bf16* wint = (bf16*)(F.ws + WS_WIN); bf16* wot = (bf16*)(F.ws + WS_WO);
        const float* w_in = F.w_in(); const float* w_o = F.w_o();
        LAS unsigned* T = (LAS unsigned*)(F.lds + F.wave * 16384);
        for (int rp2 = 0; rp2 < SUBREPS(19); ++rp2)
        for (int it = gw; it < I_IN + I_O; it += NGW) {
            if (it < I_IN) { const int nb = it / 16, kb = it % 16;
                tr_tile_gen([&](int n) -> const float* { const int sc = win_src_col(n); return sc < 0 ? nullptr : w_in + sc; }, DIN, wint, D, nb * 64, kb * 64, T, F.lane); }
            else { const int r = it - I_IN, nb = r / 16, kb = r % 16;
                tr_tile_gen([&](int n) -> const float* { return w_o + n; }, D, wot, D, nb * 64, kb * 64, T, F.lane); }
        }
    }
}

__device__ __forceinline__ float mod_value(const float* modp, const float* b_ada, int b, int j) {
    float s = 0.f;
#pragma unroll
    for (int ks = 0; ks < 16; ++ks) s += modp[(size_t)(ks * 4 + b) * 6144 + j];
    return s + b_ada[j];
}
__device__ __forceinline__ void p1_norm(Frame& F) {
    const float* modp = (const float*)(F.ws + WS_MODP);
    LAS float* G1 = (LAS float*)F.lds;
    LAS float* S1 = G1 + 4 * D;
    for (int i = F.tid; i < 4 * D; i += NWAVES * 64) { const int b = i >> 10, col = i & 1023;
        const float sh = mod_value(modp, F.b_ada(), b, col), sc = mod_value(modp, F.b_ada(), b, 1024 + col);
        G1[i] = F.g_mix()[col] * (1.f + sc); S1[i] = sh; }
    if (blockIdx.x < 4) { float* mod = (float*)(F.ws + WS_MOD); const int b = blockIdx.x;
        for (int j = F.tid; j < 6144; j += NWAVES * 64) mod[b * 6144 + j] = mod_value(modp, F.b_ada(), b, j); }
    __syncthreads();
    const int gw = F.vcu * NWAVES + F.wave, NGW = F.G * NWAVES;
    bf16* H = (bf16*)(F.ws + WS_H);
    f32x4 nv[4];
    if (gw < M) { const GAS f32x4* xr = (const GAS f32x4*)(F.x() + (size_t)gw * D) + F.lane;
#pragma unroll
        for (int j = 0; j < 4; ++j) nv[j] = xr[64 * j]; }
    for (int m = gw; m < M; m += NGW) {
        const int b = m >> 13;
        f32x4 v[4]; float s = 0.f;
#pragma unroll
        for (int j = 0; j < 4; ++j) v[j] = nv[j];
        if (m + NGW < M) { const GAS f32x4* xr = (const GAS f32x4*)(F.x() + (size_t)(m + NGW) * D) + F.lane;
#pragma unroll
            for (int j = 0; j < 4; ++j) nv[j] = xr[64 * j]; }
#pragma unroll
        for (int j = 0; j < 4; ++j) s += (v[j].x * v[j].x + v[j].y * v[j].y) + (v[j].z * v[j].z + v[j].w * v[j].w);
        const float r = 1.f / sqrtf(wave_sum(s) * (1.f / D) + EPS);
        GAS unsigned long long* o8 = (GAS unsigned long long*)(H + (size_t)m * D) + F.lane;
#pragma unroll
        for (int j = 0; j < 4; ++j) { const int col = 4 * F.lane + 256 * j; const f32x4 g = *(const LAS f32x4*)(G1 + b * D + col), sh = *(const LAS f32x4*)(S1 + b * D + col);
            const f32x4 h = v[j] * r * g + sh;
            o8[64 * j] = (unsigned long long)pk2(h.x, h.y) | ((unsigned long long)pk2(h.z, h.w) << 32); }
    }
    __syncthreads();
}

struct EpiInProj {
    static constexpr bool PERM = true;
    unsigned char* ws;
    __device__ __forceinline__ void operator()(f32x4 (&acc)[2][2][4][2], const pg8::Unit& u, int wr, int wc, int fr, int fq) const {
        const int pn = u.pn; const int row0 = u.pm * 256 + wr * 64 + fr;
        const bool prope = (pn < 4) || (pn >= 6 && pn < 10) || (pn == 18);
        const bool rrope = (pn >= 10 && pn < 14);
        const bool roped = rrope || (prope && (wc & 1) == 0);
        const float* ct = (const float*)(ws + (rrope ? WS_ROPE2 : WS_ROPE1)); const int tl = rrope ? 32 : 8; const float* stb = ct + (size_t)M * tl;
        const int toff = rrope ? 8 * (2 * (wc & 1) + (fq >> 1)) : 0;
        const float sgn = (fq & 1) ? 1.f : -1.f;
        const bool act = rrope || (fq < 2 && !(pn == 18 && wc != 0));
        bf16* base; int ld, colt; float sc = 1.f; bool remap = false;
        if (pn < 2) { base = (bf16*)(ws + WS_QA); ld = 512; colt = pn * 256; sc = C2; }
        else if (pn < 4) { base = (bf16*)(ws + WS_KA); ld = 512; colt = (pn - 2) * 256; }
        else if (pn < 6) { base = (bf16*)(ws + WS_VA); ld = 512; colt = (pn - 4) * 256; }
        else if (pn < 10) { base = (bf16*)(ws + WS_QI); ld = 1024; colt = (pn - 6) * 256; }
        else if (pn < 12) { base = (bf16*)(ws + WS_QB); ld = 512; colt = (pn - 10) * 256; remap = true; }
        else if (pn < 14) { base = (bf16*)(ws + WS_KB); ld = 512; colt = (pn - 12) * 256; remap = true; sc = 0.125f; }
        else if (pn < 16) { base = (bf16*)(ws + WS_VB); ld = 512; colt = (pn - 14) * 256; }
        else if (pn < 18) { base = (bf16*)(ws + WS_GB); ld = 512; colt = (pn - 16) * 256; }
        else { base = (bf16*)(ws + WS_KI); ld = 64; colt = 0; }
        int colb[2];
#pragma unroll
        for (int bj = 0; bj < 2; ++bj) { int col = bj * 128 + wc * 32 + 8 * fq;
            if (remap) { const int p = col & 63, gidx = p >> 3; col = (col & ~63) + (gidx & 1) * 32 + 8 * (gidx >> 1); }
            colb[bj] = col; }
        float* wi = (float*)(ws + WS_WI);
#pragma unroll
        for (int ai = 0; ai < 2; ++ai)
#pragma unroll
            for (int m = 0; m < 4; ++m) { const int row = row0 + ai * 128 + m * 16;
                if (roped) {
                    f32x4 cs[2], sn[2];
#pragma unroll
                    for (int n = 0; n < 2; ++n) { cs[n] = *(const GAS f32x4*)(ct + (size_t)row * tl + toff + 4 * n); sn[n] = *(const GAS f32x4*)(stb + (size_t)row * tl + toff + 4 * n) * sgn; }
#pragma unroll
                    for (int bj = 0; bj < 2; ++bj)
#pragma unroll
                        for (int n = 0; n < 2; ++n) { const f32x4 v = acc[ai][bj][m][n]; f32x4 p;
                            p.x = __shfl_xor(v.x, 16); p.y = __shfl_xor(v.y, 16); p.z = __shfl_xor(v.z, 16); p.w = __shfl_xor(v.w, 16);
                            if (act) acc[ai][bj][m][n] = v * cs[n] + p * sn[n]; }
                }
                if (pn < 18) {
#pragma unroll
                    for (int bj = 0; bj < 2; ++bj) {
                        const f32x4 v0 = acc[ai][bj][m][0] * sc, v1 = acc[ai][bj][m][1] * sc; v4u w;
                        w.x = pg8::cvt_pk_bf16(v0[0], v0[1]); w.y = pg8::cvt_pk_bf16(v0[2], v0[3]); w.z = pg8::cvt_pk_bf16(v1[0], v1[1]); w.w = pg8::cvt_pk_bf16(v1[2], v1[3]);
                        *(GAS v4u*)(base + (size_t)row * ld + colt + colb[bj]) = w; }
                } else {
                    const int col = colb[0];
                    const f32x4 v0 = acc[ai][0][m][0], v1 = acc[ai][0][m][1];
                    if (col < 64) { v4u w; w.x = pg8::cvt_pk_bf16(v0[0], v0[1]); w.y = pg8::cvt_pk_bf16(v0[2], v0[3]); w.z = pg8::cvt_pk_bf16(v1[0], v1[1]); w.w = pg8::cvt_pk_bf16(v1[2], v1[3]);
                        *(GAS v4u*)(base + (size_t)row * 64 + col) = w; }
                    else if (col < 80) { *(GAS f32x4*)(wi + (size_t)row * 16 + (col - 64)) = v0 * 0.25f; *(GAS f32x4*)(wi + (size_t)row * 16 + (col - 64) + 4) = v1 * 0.25f; }
                }
                asm volatile("" ::: "memory");
            }
    }
};

struct EpiOutProj {
    static constexpr bool PERM = true;
    bf16* mix; const float* mod;
    __device__ __forceinline__ void operator()(f32x4 (&acc)[2][2][4][2], const pg8::Unit& u, int wr, int wc, int fr, int fq) const {
        const int row0 = u.pm * 256 + wr * 64 + fr; const int b = (u.pm * 256) >> 13;
#pragma unroll
        for (int bj = 0; bj < 2; ++bj) { const int col = u.pn * 256 + bj * 128 + wc * 32 + 8 * fq;
            const f32x4 g0 = *(const GAS f32x4*)(mod + b * 6144 + 2048 + col), g1 = *(const GAS f32x4*)(mod + b * 6144 + 2048 + col + 4);
#pragma unroll
            for (int ai = 0; ai < 2; ++ai)
#pragma unroll
                for (int m = 0; m < 4; ++m) { const f32x4 v0 = acc[ai][bj][m][0] * g0, v1 = acc[ai][bj][m][1] * g1; v4u w;
                    w.x = pg8::cvt_pk_bf16(v0[0], v0[1]); w.y = pg8::cvt_pk_bf16(v0[2], v0[3]); w.z = pg8::cvt_pk_bf16(v1[0], v1[1]); w.w = pg8::cvt_pk_bf16(v1[2], v1[3]);
                    *(GAS v4u*)(mix + (size_t)(row0 + ai * 128 + m * 16) * D + col) = w; } }
    }
};

__device__ __forceinline__ float ret_log_gamma(int h) { return log1pf(-exp2f(-5.0f - (float)h)); }
__device__ __forceinline__ int crow(int r, int hi) { return (r & 3) + 8 * (r >> 2) + 4 * hi; }

typedef short v4i16_t __attribute__((ext_vector_type(4)));
constexpr size_t WS_TOT = WS_MASK;
constexpr size_t WS_CARRY = WS_MASK + 8 * MiB;
__device__ __forceinline__ void ra_states(Frame& F) {
    const bf16* KB = (const bf16*)(F.ws + WS_KB); const bf16* VB = (const bf16*)(F.ws + WS_VB);
    float* ST = (float*)(F.ws + WS_ST); float* TOT = (float*)(F.ws + WS_TOT);
    const int lane = F.lane, r32 = lane & 31, hi = lane >> 5, gi = lane & 15, gg = lane >> 4, wave = F.wave;
    const int half = wave >> 2, et = (wave >> 1) & 1, dt = wave & 1, ht = F.tid & 255;
    for (int unit = F.vcu; unit < 256; unit += F.G) {
        const int bh = unit >> 3, h = bh & 7, b = bh >> 3, c0 = (unit & 7) * 16 + half * 8;
        const float lg = ret_log_gamma(h), g = __expf(64.f * lg);
        f32x16 acc = f32x16{};
        const int offA = (((gi >> 2) + 8 * hi) * 64 + 32 * et + 16 * (gg & 1) + 4 * (gi & 3)) * 2;
        const int offB = (((gi >> 2) + 8 * hi) * 64 + 32 * dt + 16 * (gg & 1) + 4 * (gi & 3)) * 2;
        v4u nk[2], nvv[2];
#define RA_LOAD(cc) do { const size_t t0_ = (size_t)b * SEQ + (size_t)(cc) * 64; _Pragma("unroll") for (int p = 0; p < 2; ++p) { const int idx = ht + 256 * p, row = idx >> 3, q = idx & 7; \
            nk[p] = *(const GAS v4u*)(KB + (t0_ + row) * 512 + h * 64 + q * 8); nvv[p] = *(const GAS v4u*)(VB + (t0_ + row) * 512 + h * 64 + q * 8); } } while (0)
        RA_LOAD(c0);
#pragma unroll 1
        for (int i = 0; i < 8; ++i) {
            const int c = c0 + i;
            LAS unsigned short* Ks = (LAS unsigned short*)(F.lds + (half * 2 + (i & 1)) * 16384);
            LAS unsigned short* Vs = Ks + 4096;
#pragma unroll
            for (int p = 0; p < 2; ++p) { const int idx = ht + 256 * p, row = idx >> 3, q = idx & 7;
                v4u kk = nk[p]; const float z = __expf((63.f - (float)row) * lg); unsigned* kw = (unsigned*)&kk;
#pragma unroll
                for (int e = 0; e < 4; ++e) kw[e] = pg8::cvt_pk_bf16(bf2f((unsigned short)(kw[e] & 0xffff)) * z, bf2f((unsigned short)(kw[e] >> 16)) * z);
                *(LAS v4u*)(Ks + row * 64 + q * 8) = kk; *(LAS v4u*)(Vs + row * 64 + q * 8) = nvv[p]; }
            if (i < 7) RA_LOAD(c + 1);
            { float* st = ST + ((size_t)bh * 128 + c) * 4096;
#pragma unroll
                for (int r = 0; r < 16; ++r) st[(32 * et + crow(r, hi)) * 64 + 32 * dt + r32] = acc[r]; }
#pragma unroll
            for (int r = 0; r < 16; ++r) acc[r] *= g;
            __syncthreads();
#pragma unroll
            for (int ks = 0; ks < 4; ++ks) {
                const LAS unsigned char* va = (const LAS unsigned char*)Vs + offA + ks * 16 * 64 * 2; const LAS unsigned char* kb = (const LAS unsigned char*)Ks + offB + ks * 16 * 64 * 2;
                const v4i16_t a0 = __builtin_amdgcn_ds_read_tr16_b64_v4i16((LAS v4i16_t*)va), a1 = __builtin_amdgcn_ds_read_tr16_b64_v4i16((LAS v4i16_t*)(va + 4 * 64 * 2));
                const v4i16_t b0 = __builtin_amdgcn_ds_read_tr16_b64_v4i16((LAS v4i16_t*)kb), b1 = __builtin_amdgcn_ds_read_tr16_b64_v4i16((LAS v4i16_t*)(kb + 4 * 64 * 2));
                acc = __builtin_amdgcn_mfma_f32_32x32x16_bf16((bf16x8){a0[0], a0[1], a0[2], a0[3], a1[0], a1[1], a1[2], a1[3]}, (bf16x8){b0[0], b0[1], b0[2], b0[3], b1[0], b1[1], b1[2], b1[3]}, acc, 0, 0, 0); }
        }
#undef RA_LOAD
        { float* tt = TOT + ((size_t)bh * 16 + (unit & 7) * 2 + half) * 4096;
#pragma unroll
            for (int r = 0; r < 16; ++r) tt[(32 * et + crow(r, hi)) * 64 + 32 * dt + r32] = acc[r]; }
        __syncthreads();
    }
}
__device__ __forceinline__ void rb_carry(Frame& F) {
    const float* TOT = (const float*)(F.ws + WS_TOT); float* CAR = (float*)(F.ws + WS_CARRY);
    const int gt = (F.vcu * NWAVES + F.wave) * 64 + F.lane, NGT = F.G * NWAVES * 64;
    for (int i = gt; i < 32 * 4096; i += NGT) {
        const int bh = i >> 12, el = i & 4095, h = bh & 7;
        const float g8 = __expf(512.f * ret_log_gamma(h));
        const float* p = TOT + (size_t)bh * 16 * 4096 + el; float* q = CAR + (size_t)bh * 16 * 4096 + el; float run = 0.f;
#pragma unroll
        for (int gI = 0; gI < 16; ++gI) { const float t = p[(size_t)gI * 4096]; q[(size_t)gI * 4096] = run; run = run * g8 + t; }
    }
}
__device__ __forceinline__ void r3_out(Frame& F) {
    const int gw = F.vcu * NWAVES + F.wave, NGW = F.G * NWAVES;
    LAS unsigned short* Vs = (LAS unsigned short*)(F.lds + F.wave * 16384);
    const bf16* QB = (const bf16*)(F.ws + WS_QB); const bf16* KB = (const bf16*)(F.ws + WS_KB); const bf16* VB = (const bf16*)(F.ws + WS_VB); const bf16* GB = (const bf16*)(F.ws + WS_GB);
    const float* ST = (const float*)(F.ws + WS_ST); const float* CAR = (const float*)(F.ws + WS_CARRY); bf16* Y = (bf16*)(F.ws + WS_Y);
    const int lane = F.lane, r32 = lane & 31, hi = lane >> 5, gi = lane & 15, gg = lane >> 4;
    const int vtr_off = (((gi >> 2) + 4 * hi) * 64 + 16 * (gg & 1) + 4 * (gi & 3)) * 2;
    for (int u = gw; u < NB * 8 * 128; u += NGW) {
        const int c = u & 127, h = (u >> 7) & 7, b = u >> 10;
        const float lg = ret_log_gamma(h), gpc = __expf(64.f * (float)(c & 7) * lg);
        const size_t tok0 = (size_t)b * SEQ + (size_t)c * 64;
        { const GAS v4u* vp = (const GAS v4u*)(VB + (tok0 + lane) * 512 + h * 64);
#pragma unroll
            for (int q = 0; q < 8; ++q) *(LAS v4u*)(Vs + lane * 64 + q * 8) = vp[q]; }
        bf16x8 qf[2][4], pf[2][4];
#pragma unroll
        for (int t = 0; t < 2; ++t)
#pragma unroll
            for (int ks = 0; ks < 4; ++ks) {
                qf[t][ks] = *(const GAS bf16x8*)(QB + (tok0 + 32 * t + r32) * 512 + h * 64 + 16 * ks + 8 * hi);
                const float* sp = ST + (size_t)u * 4096 + (32 * t + r32) * 64 + 16 * ks + 8 * hi;
                const float* cp = CAR + ((size_t)(u >> 7) * 16 + (c >> 3)) * 4096 + (32 * t + r32) * 64 + 16 * ks + 8 * hi;
                const f32x4 s0 = *(const GAS f32x4*)sp + *(const GAS f32x4*)cp * gpc, s1 = *(const GAS f32x4*)(sp + 4) + *(const GAS f32x4*)(cp + 4) * gpc;
                v4u w; w.x = pg8::cvt_pk_bf16(s0.x, s0.y); w.y = pg8::cvt_pk_bf16(s0.z, s0.w); w.z = pg8::cvt_pk_bf16(s1.x, s1.y); w.w = pg8::cvt_pk_bf16(s1.z, s1.w);
                pf[t][ks] = __builtin_bit_cast(bf16x8, w); }
        float emr[16];
#pragma unroll
        for (int r = 0; r < 16; ++r) emr[r] = __expf(-(float)crow(r, hi) * lg);
        const float em32 = __expf(-32.f * lg);
        LDS_WAIT(); asm volatile("" ::: "memory");
#pragma unroll
        for (int nt = 0; nt < 2; ++nt) {
            const int n = 32 * nt + r32;
            const float en = __expf((float)n * lg), xi = __expf((float)(n + 1) * lg);
            f32x16 y[2]; y[0] = f32x16{}; y[1] = f32x16{};
#pragma unroll
            for (int et = 0; et < 2; ++et)
#pragma unroll
                for (int ks = 0; ks < 4; ++ks) y[et] = __builtin_amdgcn_mfma_f32_32x32x16_bf16(pf[et][ks], qf[nt][ks], y[et], 0, 0, 0);
#pragma unroll
            for (int r = 0; r < 16; ++r) { y[0][r] *= xi; y[1][r] *= xi; }
#pragma unroll
            for (int mt = 0; mt <= nt; ++mt) {
                f32x16 st = f32x16{};
#pragma unroll
                for (int ks = 0; ks < 4; ++ks) { const bf16x8 kf = *(const GAS bf16x8*)(KB + (tok0 + 32 * mt + r32) * 512 + h * 64 + 16 * ks + 8 * hi);
                    st = __builtin_amdgcn_mfma_f32_32x32x16_bf16(kf, qf[nt][ks], st, 0, 0, 0); }
                const float enm = mt ? en * em32 : en;
#pragma unroll
                for (int r = 0; r < 16; ++r) { const int m = 32 * mt + crow(r, hi); st[r] = (n >= m) ? st[r] * (enm * emr[r]) : 0.f; }
#pragma unroll
                for (int s2 = 0; s2 < 2; ++s2) {
                    v4u pw; pw.x = pg8::cvt_pk_bf16(st[8 * s2 + 0], st[8 * s2 + 1]); pw.y = pg8::cvt_pk_bf16(st[8 * s2 + 2], st[8 * s2 + 3]); pw.z = pg8::cvt_pk_bf16(st[8 * s2 + 4], st[8 * s2 + 5]); pw.w = pg8::cvt_pk_bf16(st[8 * s2 + 6], st[8 * s2 + 7]);
                    const bf16x8 pb = __builtin_bit_cast(bf16x8, pw);
#pragma unroll
                    for (int et = 0; et < 2; ++et) {
                        const LAS unsigned char* vb = (const LAS unsigned char*)Vs + vtr_off + ((32 * mt + 16 * s2) * 64 + 32 * et) * 2;
                        const v4i16_t lo = __builtin_amdgcn_ds_read_tr16_b64_v4i16((LAS v4i16_t*)vb), hh = __builtin_amdgcn_ds_read_tr16_b64_v4i16((LAS v4i16_t*)(vb + 8 * 64 * 2));
                        const bf16x8 va = (bf16x8){lo[0], lo[1], lo[2], lo[3], hh[0], hh[1], hh[2], hh[3]};
                        y[et] = __builtin_amdgcn_mfma_f32_32x32x16_bf16(va, pb, y[et], 0, 0, 0); }
                }
            }
            float sm = 0.f;
#pragma unroll
            for (int r = 0; r < 16; ++r) sm += y[0][r] + y[1][r];
            sm += __shfl_xor(sm, 32);
            const float mu = sm * (1.f / 64.f); float q = 0.f;
#pragma unroll
            for (int r = 0; r < 16; ++r) { y[0][r] -= mu; y[1][r] -= mu; q += y[0][r] * y[0][r] + y[1][r] * y[1][r]; }
            q += __shfl_xor(q, 32);
            const float rs = __builtin_amdgcn_rsqf(q * (1.f / 64.f) + EPS);
            const size_t tok = tok0 + n;
#pragma unroll
            for (int et = 0; et < 2; ++et)
#pragma unroll
                for (int g4 = 0; g4 < 4; ++g4) { const int e0 = 32 * et + 8 * g4 + 4 * hi;
                    const v2u gv = *(const GAS v2u*)(GB + tok * 512 + h * 64 + e0);
                    float o4[4];
#pragma unroll
                    for (int i = 0; i < 4; ++i) { const float g = bf2f((unsigned short)((i & 1) ? ((i & 2) ? gv.y : gv.x) >> 16 : ((i & 2) ? gv.y : gv.x) & 0xffff));
                        const float sg = g * __builtin_amdgcn_rcpf(1.f + __expf(-g)); o4[i] = sg * y[et][4 * g4 + i] * rs; }
                    v2u ov; ov.x = pg8::cvt_pk_bf16(o4[0], o4[1]); ov.y = pg8::cvt_pk_bf16(o4[2], o4[3]);
                    *(GAS v2u*)(Y + tok * D + 512 + h * 64 + e0) = ov; }
        }
        LDS_WAIT(); asm volatile("" ::: "memory");
    }
}

__device__ __forceinline__ void p_norm2_route(Frame& F) {
    const float* mod = (const float*)(F.ws + WS_MOD);
    LAS f32x4* RG = (LAS f32x4*)F.lds;
    LAS f32x4* RE = (LAS f32x4*)(F.lds + 16384);
    { const float* wrg = F.w_rg(); const float* wre = F.w_re();
        for (int i = F.tid; i < 1024; i += NWAVES * 64) { const int ln = (i & 255) >> 2, j = i >> 8, t = i & 3; RG[(j * 4 + t) * 64 + ln] = *(const GAS f32x4*)(wrg + (size_t)i * 4); }
        for (int i = F.tid; i < 4 * 1024 * 2; i += NWAVES * 64) { const int g = i >> 11, row = (i >> 1) & 1023, hf = i & 1, ln = (row & 255) >> 2, j = row >> 8, t = row & 3;
            RE[g * 2048 + ((j * 4 + t) * 2 + hf) * 64 + ln] = *(const GAS f32x4*)(wre + ((size_t)g * 1024 + row) * 8 + hf * 4); } }
    __syncthreads();
    const int gw = F.vcu * NWAVES + F.wave, NGW = F.G * NWAVES;
    const float* X = F.x(); const bf16* MIX = (const bf16*)(F.ws + WS_MIX); bf16* H2 = (bf16*)(F.ws + WS_H2);
    unsigned* ltok = (unsigned*)(F.ws + WS_ROUTE); float* lw = (float*)(F.ws + WS_ROUTE + 4 * MiB);
    f32x4 nv[4]; v2u nm[4];
#define N2_LOAD(mm) do { const GAS f32x4* xr = (const GAS f32x4*)(X + (size_t)(mm) * D) + F.lane; \
        _Pragma("unroll") for (int j = 0; j < 4; ++j) { nv[j] = xr[64 * j]; nm[j] = *(const GAS v2u*)(MIX + (size_t)(mm) * D + 4 * F.lane + 256 * j); } } while (0)
    if (gw < M) N2_LOAD(gw);
    for (int m = gw; m < M; m += NGW) {
        const int b = m >> 13;
        f32x4 v[4]; float s = 0.f;
#pragma unroll
        for (int j = 0; j < 4; ++j) { v[j] = nv[j]; v[j].x += bf2f((unsigned short)(nm[j].x & 0xffff)); v[j].y += bf2f((unsigned short)(nm[j].x >> 16)); v[j].z += bf2f((unsigned short)(nm[j].y & 0xffff)); v[j].w += bf2f((unsigned short)(nm[j].y >> 16)); }
        if (m + NGW < M) N2_LOAD(m + NGW);
#pragma unroll
        for (int j = 0; j < 4; ++j) s += (v[j].x * v[j].x + v[j].y * v[j].y) + (v[j].z * v[j].z + v[j].w * v[j].w);
        const float r = 1.f / sqrtf(wave_sum(s) * (1.f / D) + EPS);
        GAS unsigned long long* o8 = (GAS unsigned long long*)(H2 + (size_t)m * D) + F.lane;
        f32x4 lg = {0.f, 0.f, 0.f, 0.f};
#pragma unroll
        for (int j = 0; j < 4; ++j) { const int col = 4 * F.lane + 256 * j;
            const f32x4 g = *(const GAS f32x4*)(F.g_ffn() + col) * (*(const GAS f32x4*)(mod + b * 6144 + 4096 + col) + 1.f), sh = *(const GAS f32x4*)(mod + b * 6144 + 3072 + col);
            v[j] = v[j] * r * g + sh;
            o8[64 * j] = (unsigned long long)pk2(v[j].x, v[j].y) | ((unsigned long long)pk2(v[j].z, v[j].w) << 32);
            const LAS f32x4* wg = RG + (j * 4) * 64 + F.lane;
            lg += wg[0] * v[j].x; lg += wg[64] * v[j].y; lg += wg[128] * v[j].z; lg += wg[192] * v[j].w; }
        lg.x = wave_sum(lg.x); lg.y = wave_sum(lg.y); lg.z = wave_sum(lg.z); lg.w = wave_sum(lg.w);
        int grp = 0; float mx = lg.x;
        if (lg.y > mx) { mx = lg.y; grp = 1; } if (lg.z > mx) { mx = lg.z; grp = 2; } if (lg.w > mx) { mx = lg.w; grp = 3; }
        const float pgrp = 1.f / (expf(lg.x - mx) + expf(lg.y - mx) + expf(lg.z - mx) + expf(lg.w - mx));
        f32x4 f0 = {0.f, 0.f, 0.f, 0.f}, f1 = f0;
        const LAS f32x4* reg = RE + grp * 2048 + F.lane;
#pragma unroll
        for (int j = 0; j < 4; ++j) { const LAS f32x4* we = reg + (j * 8) * 64;
            f0 += we[0] * v[j].x; f1 += we[64] * v[j].x; f0 += we[128] * v[j].y; f1 += we[192] * v[j].y; f0 += we[256] * v[j].z; f1 += we[320] * v[j].z; f0 += we[384] * v[j].w; f1 += we[448] * v[j].w; }
        float fe[8];
        fe[0] = wave_sum(f0.x); fe[1] = wave_sum(f0.y); fe[2] = wave_sum(f0.z); fe[3] = wave_sum(f0.w); fe[4] = wave_sum(f1.x); fe[5] = wave_sum(f1.y); fe[6] = wave_sum(f1.z); fe[7] = wave_sum(f1.w);
        int i1 = 0; float m1 = fe[0];
#pragma unroll
        for (int e = 1; e < 8; ++e) if (fe[e] > m1) { m1 = fe[e]; i1 = e; }
        int i2 = -1; float m2 = -INFINITY;
#pragma unroll
        for (int e = 0; e < 8; ++e) if (e != i1 && fe[e] > m2) { m2 = fe[e]; i2 = e; }
        const float e2 = expf(m2 - m1); const float w1 = pgrp / (1.f + e2), w2 = pgrp * e2 / (1.f + e2);
        if (F.lane < 2) { const int e = grp * 8 + (F.lane ? i2 : i1); const float w = F.lane ? w2 : w1;
            const unsigned p = __hip_atomic_fetch_add((unsigned*)(F.ctl + CW_ECNT + 64 * e), 1u, RLX_AGENT);
            ltok[(size_t)e * M + p] = (unsigned)m | ((unsigned)F.lane << 31); lw[(size_t)e * M + p] = w; }
    }
    __syncthreads();
}
__device__ __forceinline__ void p_expert_convert(Frame& F, int part, int nparts) {
    const int gw = F.vcu * NWAVES + F.wave, NGW = F.G * NWAVES;
    int ln = F.lane; asm volatile("" : "+v"(ln));
    LAS unsigned* T = (LAS unsigned*)(F.lds + F.wave * 16384);
    bf16* wgu = (bf16*)(F.ws + WS_WGU); bf16* wd = (bf16*)(F.ws + WS_WD);
    constexpr int I_GU = NEXP * 16 * 16, I_D = NEXP * 16 * 8;
    int k = 0;
    for (int it = gw; it < I_GU + I_D; it += NGW, ++k) {
        if (k % nparts != part) continue;
        if (it < I_GU) { const int e = it >> 8, r = it & 255, nt = r >> 4, kt = r & 15;
            tr_tile_gu(F.w_gate() + (size_t)e * D * DEXP, F.w_up() + (size_t)e * D * DEXP, wgu + (size_t)e * 1024 * 1024, nt * 64, kt * 64, T, ln); }
        else { const int q = it - I_GU, e = q >> 7, r = q & 127, nt = r >> 3, kt = r & 7;
            tr_tile_d(F.w_down() + (size_t)e * DEXP * D, wd + (size_t)e * 1024 * 512, nt * 64, kt * 64, T, ln); }
    }
}

constexpr int MOE_MAXU = 5;
struct MoeSched {
    int G, c, nunits; LAS int* blkstart; LAS unsigned* tok; bool gather;
    __device__ __forceinline__ bool next(int i, pg8::Unit& u) const {
        const int L = i * G + c; if (L >= nunits || i >= MOE_MAXU) return false;
        const int blk = L >> 2, pnl = L & 3; int e = 0;
#pragma unroll 1
        for (int k = 1; k < NEXP; ++k) if (blkstart[k] <= blk) e = k;
        u.pm = i | (blk << 8); u.pn = e * 4 + pnl; return true;
    }
    __device__ __forceinline__ int arow(const pg8::Unit& u, int rt) const {
        if (gather) { const unsigned t = tok[(u.pm & 255) * 256 + rt]; return (int)(t == 0xffffffffu ? 0u : (t & 0x7fffffffu)); }
        return (u.pm >> 8) * 256 + rt;
    }
    __device__ __forceinline__ int brow0(const pg8::Unit& u) const { return u.pn * 256; }
};
__device__ __forceinline__ int moe_tables(Frame& F, LAS int* blkstart, LAS unsigned* tok, LAS float* wts) {
    if (F.tid == 0) { int acc = 0; for (int e = 0; e < NEXP; ++e) { blkstart[e] = acc; const unsigned cnt = __hip_atomic_load((unsigned*)(F.ctl + CW_ECNT + 64 * e), RLX_AGENT); acc += (int)((cnt + 255u) >> 8); } blkstart[NEXP] = acc; }
    __syncthreads();
    const int nunits = blkstart[NEXP] * 4;
    const unsigned* ltok = (const unsigned*)(F.ws + WS_ROUTE); const float* lw = (const float*)(F.ws + WS_ROUTE + 4 * MiB);
    for (int i = 0; i < MOE_MAXU; ++i) { const int L = i * F.G + F.vcu; if (L >= nunits) break;
        const int blk = L >> 2; int e = 0;
        for (int k = 1; k < NEXP; ++k) if (blkstart[k] <= blk) e = k;
        const unsigned cnt = __hip_atomic_load((unsigned*)(F.ctl + CW_ECNT + 64 * e), RLX_AGENT);
        for (int r = F.tid; r < 256; r += NWAVES * 64) { const unsigned p = (unsigned)(blk - blkstart[e]) * 256u + (unsigned)r;
            tok[i * 256 + r] = p < cnt ? ltok[(size_t)e * M + p] : 0xffffffffu; wts[i * 256 + r] = p < cnt ? lw[(size_t)e * M + p] : 0.f; } }
    __syncthreads();
    return nunits;
}
struct EpiMoe1 {
    static constexpr bool PERM = true;
    bf16* act;
    __device__ __forceinline__ void operator()(f32x4 (&acc)[2][2][4][2], const pg8::Unit& u, int wr, int wc, int fr, int fq) const {
        const int blk = u.pm >> 8, pnl = u.pn & 3; const int row0 = blk * 256 + wr * 64 + fr;
#pragma unroll
        for (int bj = 0; bj < 2; ++bj) { const int ac = pnl * 128 + (bj * 128 + wc * 32 + 8 * fq) / 2;
#pragma unroll
            for (int ai = 0; ai < 2; ++ai)
#pragma unroll
                for (int m = 0; m < 4; ++m) { const f32x4 v0 = acc[ai][bj][m][0], v1 = acc[ai][bj][m][1];
                    const float a0 = v0[0] / (1.f + __expf(-v0[0])) * v0[1], a1 = v0[2] / (1.f + __expf(-v0[2])) * v0[3];
                    const float a2 = v1[0] / (1.f + __expf(-v1[0])) * v1[1], a3 = v1[2] / (1.f + __expf(-v1[2])) * v1[3];
                    v2u w; w.x = pg8::cvt_pk_bf16(a0, a1); w.y = pg8::cvt_pk_bf16(a2, a3);
                    *(GAS v2u*)(act + (size_t)(row0 + ai * 128 + m * 16) * DEXP + ac) = w; } }
    }
};
struct EpiMoe2 {
    static constexpr bool PERM = true;
    bf16* c0; bf16* c1; LAS unsigned* tok; LAS float* wts;
    __device__ __forceinline__ void operator()(f32x4 (&acc)[2][2][4][2], const pg8::Unit& u, int wr, int wc, int fr, int fq) const {
        const int li = u.pm & 255, pnl = u.pn & 3;
#pragma unroll
        for (int ai = 0; ai < 2; ++ai)
#pragma unroll
            for (int m = 0; m < 4; ++m) { const int rt = ai * 128 + wr * 64 + m * 16 + fr; const unsigned en = tok[li * 256 + rt]; const float w = wts[li * 256 + rt];
                if (en != 0xffffffffu) { bf16* dst = ((en >> 31) ? c1 : c0) + (size_t)(en & 0x7fffffffu) * D + pnl * 256 + wc * 32 + 8 * fq;
#pragma unroll
                    for (int bj = 0; bj < 2; ++bj) { const f32x4 v0 = acc[ai][bj][m][0] * w, v1 = acc[ai][bj][m][1] * w; v4u o;
                        o.x = pg8::cvt_pk_bf16(v0[0], v0[1]); o.y = pg8::cvt_pk_bf16(v0[2], v0[3]); o.z = pg8::cvt_pk_bf16(v1[0], v1[1]); o.w = pg8::cvt_pk_bf16(v1[2], v1[3]);
                        *(GAS v4u*)(dst + bj * 128) = o; } } }
    }
};

typedef _Float16 h16x2 __attribute__((ext_vector_type(2)));
__device__ __forceinline__ unsigned pk_f16_rtz(float a, float b) { return __builtin_bit_cast(unsigned, __builtin_amdgcn_cvt_pkrtz(a, b)); }
__device__ __forceinline__ unsigned sortable16x2(unsigned x) { const unsigned m = ((x >> 15) & 0x00010001u) * 0xFFFFu; return x ^ (m | 0x80008000u); }
constexpr int IDX_HS = 257;
constexpr int IDX_WT_OFF = 68 * 1024, IDX_RH_OFF = 72 * 1024, IDX_P2_OFF = IDX_RH_OFF + 32 * IDX_HS * 4, IDX_P2_BYTES = 4480;
static_assert(IDX_P2_OFF + 8 * IDX_P2_BYTES <= RING_BYTES + AUX_BYTES, "indexer LDS map");
template <int NC>
__device__ __forceinline__ void hist_find(LAS unsigned* H, int lane, unsigned K, unsigned& bsel, unsigned& above, unsigned& atb) {
    unsigned t[4];
#pragma unroll
    for (int q = 0; q < 4; ++q) { unsigned a = 0;
#pragma unroll
        for (int c = 0; c < NC; ++c) a += H[c * IDX_HS + 4 * lane + q];
        t[q] = a; }
    const unsigned ls = (t[0] + t[1]) + (t[2] + t[3]);
    unsigned suf = ls;
#pragma unroll
    for (int o = 1; o < 64; o <<= 1) { const unsigned v = __shfl_down(suf, o); if (lane + o < 64) suf += v; }
    unsigned ab = suf - ls; bool found = false; unsigned fb = 0, fa = 0, ft = 0;
#pragma unroll
    for (int q = 3; q >= 0; --q) { if (!found && ab < K && ab + t[q] >= K) { found = true; fb = 4 * lane + q; fa = ab; ft = t[q]; } ab += t[q]; }
    const unsigned long long bal = __ballot(found);
    const int src = bal ? (int)__builtin_ctzll(bal) : 0;
    bsel = __shfl(fb, src); above = __shfl(fa, src); atb = __shfl(ft, src);
}
__device__ __forceinline__ void sel_load(v4u (&ch)[16], const unsigned short* srow, int n, int lane) {
    const int nchunks = n >> 3;
#pragma unroll
    for (int j = 0; j < 16; ++j) { const int c = lane + 64 * j;
        unsigned off = (unsigned)c * 16u; asm volatile("" : "+v"(off));
        if (c < nchunks) ch[j] = *(const GAS v4u*)((const char*)srow + off); else ch[j] = (v4u){0u, 0u, 0u, 0u}; }
}
__device__ __forceinline__ unsigned pk_max_u16(unsigned a, unsigned b) { unsigned r; asm("v_pk_max_u16 %0, %1, %2" : "=v"(r) : "v"(a), "v"(b)); return r; }
__device__ __forceinline__ unsigned pk_min_u16(unsigned a, unsigned b) { unsigned r; asm("v_pk_min_u16 %0, %1, %2" : "=v"(r) : "v"(a), "v"(b)); return r; }
__device__ __forceinline__ void sel_compute(const v4u (&ch)[16], const unsigned short* srow, int n, unsigned char* mrow, LAS unsigned* RH, LAS unsigned* P2, int lane) {
    const int nchunks = n >> 3;
    if (n <= 256) {
#pragma unroll 1
        for (int j = 0; j < 16; ++j) { const int c = lane + 64 * j; mrow[c] = (c < nchunks) ? (unsigned char)0xFF : (unsigned char)0; }
        return;
    }
    unsigned b1, above1, at1; hist_find<1>(RH, lane, 256u, b1, above1, at1);
    for (int i = lane; i < 4 * IDX_HS; i += 64) P2[i] = 0u;
    LAS unsigned* hb = P2 + (lane & 3) * IDX_HS;
    unsigned pat = (b1 << 8) | (b1 << 24), c256 = 0x01000100u, c1 = 0x00010001u;
    asm volatile("" : "+v"(pat), "+v"(c256), "+v"(c1));
#pragma unroll
    for (int j = 0; j < 16; ++j) { if (64 * j < nchunks) {
#pragma unroll
        for (int i = 0; i < 4; ++i) { const unsigned w = ch[j][i]; const unsigned m = pk_min_u16(w ^ pat, c256);
            __hip_atomic_fetch_add(hb + (w & 0xffu), ((m >> 8) & 1u) ^ 1u, __ATOMIC_RELAXED, __HIP_MEMORY_SCOPE_WORKGROUP);
            __hip_atomic_fetch_add(hb + ((w >> 16) & 0xffu), (m >> 24) ^ 1u, __ATOMIC_RELAXED, __HIP_MEMORY_SCOPE_WORKGROUP); } } __builtin_amdgcn_sched_barrier(0); }
    unsigned b2, above2, teq; hist_find<4>(P2, lane, 256u - above1, b2, above2, teq);
    const unsigned tau = (b1 << 8) | b2; const unsigned r = 256u - above1 - above2;
    if (r >= teq) {
        unsigned tt = tau | (tau << 16); asm volatile("" : "+v"(tt));
#pragma unroll
        for (int j = 0; j < 16; ++j) { const int c = lane + 64 * j; unsigned acc = 0u;
#pragma unroll
            for (int i = 0; i < 4; ++i) { const unsigned w = ch[j][i]; const unsigned ns = pk_min_u16(pk_max_u16(w, tt) ^ w, c1);
                acc |= ns << (2 * i); }
            const unsigned bits = ~(acc | (acc >> 15)) & 0xffu;
            { unsigned off = (unsigned)c; asm volatile("" : "+v"(off)); mrow[off] = (unsigned char)bits; } __builtin_amdgcn_sched_barrier(0); }
    } else {
        unsigned running = 0u;
#pragma unroll 1
        for (int j = 0; j < 16; ++j) { const int c = lane + 64 * j;
            v4u x = {0u, 0u, 0u, 0u};
            if (c < nchunks) x = *(const GAS v4u*)(srow + (size_t)c * 8);
            unsigned gt = 0u, eq = 0u;
#pragma unroll
            for (int i = 0; i < 4; ++i) { const unsigned w = x[i], k0 = w & 0xffffu, k1 = w >> 16;
                gt |= (k0 > tau ? 1u : 0u) << (2 * i); gt |= (k1 > tau ? 1u : 0u) << (2 * i + 1); eq |= (k0 == tau ? 1u : 0u) << (2 * i); eq |= (k1 == tau ? 1u : 0u) << (2 * i + 1); }
            const unsigned tc = (unsigned)__builtin_popcount(eq); unsigned inc = tc;
#pragma unroll
            for (int o = 1; o < 64; o <<= 1) { const unsigned v = __shfl_up(inc, o); if (lane >= o) inc += v; }
            const unsigned base = running + inc - tc;
            int take = (int)r - (int)base; take = take < 0 ? 0 : (take > 8 ? 8 : take);
            unsigned e2 = eq, kept = 0u;
#pragma unroll
            for (int t = 0; t < 8; ++t) { const unsigned low = e2 & (0u - e2); if (t < take) kept |= low; e2 &= e2 - 1u; }
            running += __shfl(inc, 63);
            mrow[c] = (unsigned char)(gt | kept); }
    }
}
__device__ __forceinline__ void p_indexer(Frame& F) {
    const bf16* QI = (const bf16*)(F.ws + WS_QI); const bf16* KI = (const bf16*)(F.ws + WS_KI); const float* WI = (const float*)(F.ws + WS_WI);
    unsigned short* scr = (unsigned short*)(F.ws + WS_SCR) + (size_t)blockIdx.x * 32 * 8192;
    unsigned char* MASK = (unsigned char*)(F.ws + WS_MASK);
    const int tid = F.tid, lane = F.lane, wave = F.wave, r32 = lane & 31, hi = lane >> 5;
    LAS unsigned char* lds = F.lds;
    const int b = F.vcu >> 6, wq = F.vcu & 63;
#pragma unroll 1
    for (int ui = 0; ui < 4; ++ui) {
        const int qb32 = (ui == 0) ? wq : (ui == 1) ? 127 - wq : (ui == 2) ? 128 + wq : 255 - wq;
        const int n = 64 * ((qb32 >> 1) + 1), ntiles = n >> 5;
        const size_t tokb = (size_t)b * SEQ, tok0 = tokb + (size_t)qb32 * 32;
#pragma unroll
        for (int i = 0; i < 8; ++i) { const int f = wave + 8 * i, hh = f >> 2, ks = f & 3;
            const v4u v = *(const GAS v4u*)(QI + (tok0 + r32) * 1024 + hh * 64 + 16 * ks + 8 * hi); *(LAS v4u*)(lds + f * 1024 + lane * 16) = v; }
        { LAS float* wt = (LAS float*)(lds + IDX_WT_OFF);
            const int q = tid & 31, hh = tid >> 5; wt[hh * 32 + q] = WI[(tok0 + q) * 16 + hh] * 0.125f;
            LAS unsigned* rh = (LAS unsigned*)(lds + IDX_RH_OFF); for (int i = tid; i < 32 * IDX_HS; i += NWAVES * 64) rh[i] = 0u; }
        { const int q = tid & 31, dg = tid >> 5; f32x4 a = {0.f, 0.f, 0.f, 0.f};
#pragma unroll
            for (int hh = 0; hh < 16; ++hh) { const float wv = WI[(tok0 + q) * 16 + hh] * 0.125f; const v2u qv = *(const GAS v2u*)(QI + (tok0 + q) * 1024 + hh * 64 + 4 * dg);
                a.x += wv * bf2f((unsigned short)(qv.x & 0xffff)); a.y += wv * bf2f((unsigned short)(qv.x >> 16)); a.z += wv * bf2f((unsigned short)(qv.y & 0xffff)); a.w += wv * bf2f((unsigned short)(qv.y >> 16)); }
            v2u o; o.x = pk2(a.x, a.y); o.y = pk2(a.z, a.w);
            *(LAS v2u*)(lds + (64 + (dg >> 2)) * 1024 + (q + 32 * ((dg >> 1) & 1)) * 16 + (dg & 1) * 8) = o; }
        __syncthreads();
        LAS unsigned* hrow = (LAS unsigned*)(lds + IDX_RH_OFF) + r32 * IDX_HS;
        bf16x8 kf[2][4];
#define IDX_KLOAD(TT) do { _Pragma("unroll") for (int j = 0; j < 2; ++j) { const int T = ((TT) + j < ntiles) ? (TT) + j : ntiles - 1; \
            _Pragma("unroll") for (int ks = 0; ks < 4; ++ks) kf[j][ks] = *(const GAS bf16x8*)(KI + (tokb + (size_t)T * 32 + r32) * 64 + 16 * ks + 8 * hi); } } while (0)
#define IDX_FMA4(S, P, B, W) do { asm volatile("v_fma_f32 %0, |%4|, %8, %0\n\tv_fma_f32 %1, |%5|, %8, %1\n\tv_fma_f32 %2, |%6|, %8, %2\n\tv_fma_f32 %3, |%7|, %8, %3" \
                : "+v"(S[B]), "+v"(S[B + 1]), "+v"(S[B + 2]), "+v"(S[B + 3]) : "v"(P[B]), "v"(P[B + 1]), "v"(P[B + 2]), "v"(P[B + 3]), "v"(W)); __builtin_amdgcn_sched_barrier(0); } while (0)
#define IDX_QF(base, ks) (*(const LAS bf16x8*)((base) + (ks) * 1024))
#define IDX_MF(N, K, Q, C) N = __builtin_amdgcn_mfma_f32_32x32x16_bf16(K, Q, C, 0, 0, 0); __builtin_amdgcn_sched_barrier(0)
#define IDX_PSTEP(N0, N1, P0, P1, W, CUR, NXT) do { \
                IDX_MF(N0, kf[0][0], qa, f32x16{}); IDX_FMA4(sc[0], P0, 0, W); \
                IDX_MF(N1, kf[1][0], qa, f32x16{}); IDX_FMA4(sc[0], P0, 4, W); qa = IDX_QF(CUR, 2); \
                IDX_MF(N0, kf[0][1], qb, N0); IDX_FMA4(sc[0], P0, 8, W); \
                IDX_MF(N1, kf[1][1], qb, N1); IDX_FMA4(sc[0], P0, 12, W); qb = IDX_QF(CUR, 3); \
                IDX_MF(N0, kf[0][2], qa, N0); IDX_FMA4(sc[1], P1, 0, W); \
                IDX_MF(N1, kf[1][2], qa, N1); IDX_FMA4(sc[1], P1, 4, W); qa = IDX_QF(NXT, 0); \
                IDX_MF(N0, kf[0][3], qb, N0); IDX_FMA4(sc[1], P1, 8, W); \
                IDX_MF(N1, kf[1][3], qb, N1); IDX_FMA4(sc[1], P1, 12, W); qb = IDX_QF(NXT, 1); } while (0)
        if (wave * 2 < ntiles) IDX_KLOAD(wave * 2);
#pragma unroll 1
        for (int T0 = wave * 2; T0 < ntiles; T0 += 16) {
            f32x16 sc[2];
            sc[0] = f32x16{}; sc[1] = f32x16{};
#pragma unroll
            for (int ks = 0; ks < 4; ++ks) { const bf16x8 qf = *(const LAS bf16x8*)(lds + (64 + ks) * 1024 + lane * 16);
                sc[0] = __builtin_amdgcn_mfma_f32_32x32x16_bf16(kf[0][ks], qf, sc[0], 0, 0, 0); sc[1] = __builtin_amdgcn_mfma_f32_32x32x16_bf16(kf[1][ks], qf, sc[1], 0, 0, 0); }
            {
                f32x16 dA0 = f32x16{}, dA1 = f32x16{}, dB0 = f32x16{}, dB1 = f32x16{};
                float wprev = 0.f;
                const LAS unsigned char* qbase = lds + lane * 16;
                const LAS unsigned char* wbase = lds + IDX_WT_OFF + r32 * 4;
                bf16x8 qa = IDX_QF(qbase, 0), qb = IDX_QF(qbase, 1);
#pragma unroll 1
                for (int hh = 0; hh < 16; hh += 2) {
                    const float wh0 = *(const LAS float*)(wbase + hh * 128), wh1 = *(const LAS float*)(wbase + hh * 128 + 128);
                    IDX_PSTEP(dA0, dA1, dB0, dB1, wprev, qbase, qbase + 4096);
                    IDX_PSTEP(dB0, dB1, dA0, dA1, wh0, qbase + 4096, qbase + 8192);
                    wprev = wh1; qbase += 8192;
                }
                asm volatile("s_nop 15\n\ts_nop 7" ::: "memory");
#pragma unroll
                for (int r = 0; r < 16; r += 4) { IDX_FMA4(sc[0], dB0, r, wprev); }
#pragma unroll
                for (int r = 0; r < 16; r += 4) { IDX_FMA4(sc[1], dB1, r, wprev); }
            }
            if (T0 + 16 < ntiles) IDX_KLOAD(T0 + 16);
#pragma unroll
            for (int j = 0; j < 2; ++j) { if (T0 + j < ntiles) { unsigned short* dst = scr + (size_t)r32 * 8192 + (size_t)(T0 + j) * 32 + 4 * hi;
#pragma unroll
                for (int g = 0; g < 4; ++g) { v2u o; o.x = sortable16x2(pk_f16_rtz(sc[j][4 * g], sc[j][4 * g + 1])); o.y = sortable16x2(pk_f16_rtz(sc[j][4 * g + 2], sc[j][4 * g + 3])); *(GAS v2u*)(dst + 8 * g) = o;
                    __hip_atomic_fetch_add(hrow + ((o.x >> 8) & 255u), 1u, __ATOMIC_RELAXED, __HIP_MEMORY_SCOPE_WORKGROUP); __hip_atomic_fetch_add(hrow + (o.x >> 24), 1u, __ATOMIC_RELAXED, __HIP_MEMORY_SCOPE_WORKGROUP);
                    __hip_atomic_fetch_add(hrow + ((o.y >> 8) & 255u), 1u, __ATOMIC_RELAXED, __HIP_MEMORY_SCOPE_WORKGROUP); __hip_atomic_fetch_add(hrow + (o.y >> 24), 1u, __ATOMIC_RELAXED, __HIP_MEMORY_SCOPE_WORKGROUP); } } }
        }
#undef IDX_QF
#undef IDX_MF
#undef IDX_PSTEP
#undef IDX_FMA4
        VM_WAIT(); __syncthreads();
        __builtin_amdgcn_fence(__ATOMIC_ACQUIRE, "agent");
        { LAS unsigned* P2 = (LAS unsigned*)(lds + IDX_P2_OFF + wave * IDX_P2_BYTES); LAS unsigned* RH = (LAS unsigned*)(lds + IDX_RH_OFF) + wave * 4 * IDX_HS;
            const unsigned short* sr = scr + (size_t)wave * 4 * 8192; unsigned char* mr = MASK + (tok0 + wave * 4) * 1024;
#pragma unroll 1
            for (int rp3 = 0; rp3 < SUBREPS(16); ++rp3) {
            { int ls = lane; asm volatile("" : "+v"(ls));
                v4u chA[16], chB[16];
                sel_load(chA, sr, n, ls); sel_load(chB, sr + 8192, n, ls);
                sel_compute(chA, sr, n, mr, RH, P2, ls);
                sel_load(chA, sr + 2 * 8192, n, ls);
                sel_compute(chB, sr + 8192, n, mr + 1024, RH + IDX_HS, P2, ls);
                sel_load(chB, sr + 3 * 8192, n, ls);
                sel_compute(chA, sr + 2 * 8192, n, mr + 2 * 1024, RH + 2 * IDX_HS, P2, ls);
                sel_compute(chB, sr + 3 * 8192, n, mr + 3 * 1024, RH + 3 * IDX_HS, P2, ls); } } }
        __syncthreads();
    }
}

template <bool WITH_MOE>
__device__ __forceinline__ void p_final(Frame& F) {
    const int gw = F.vcu * NWAVES + F.wave, NGW = F.G * NWAVES;
    const float* X = F.x(); const bf16* MIX = (const bf16*)(F.ws + WS_MIX); const float* mod = (const float*)(F.ws + WS_MOD);
    const bf16* C0 = (const bf16*)(F.ws + WS_C0); const bf16* C1 = (const bf16*)(F.ws + WS_C1);
    f32x4 nv[4]; v2u nm[4], na[4], nc[4];
#define FIN_LOAD(mm) do { const GAS f32x4* xr = (const GAS f32x4*)(X + (size_t)(mm) * D) + F.lane; \
        _Pragma("unroll") for (int j = 0; j < 4; ++j) { nv[j] = xr[64 * j]; nm[j] = *(const GAS v2u*)(MIX + (size_t)(mm) * D + 4 * F.lane + 256 * j); if (WITH_MOE) { const int col = 4 * F.lane + 256 * j; na[j] = *(const GAS v2u*)(C0 + (size_t)(mm) * D + col); nc[j] = *(const GAS v2u*)(C1 + (size_t)(mm) * D + col); } } } while (0)
    if (gw < M) FIN_LOAD(gw);
    for (int m = gw; m < M; m += NGW) {
        const int b = m >> 13;
        f32x4 v[4]; v2u ca[4], cc[4]; float s = 0.f;
#pragma unroll
        for (int j = 0; j < 4; ++j) { v[j] = nv[j]; ca[j] = na[j]; cc[j] = nc[j];
            v[j].x += bf2f((unsigned short)(nm[j].x & 0xffff)); v[j].y += bf2f((unsigned short)(nm[j].x >> 16)); v[j].z += bf2f((unsigned short)(nm[j].y & 0xffff)); v[j].w += bf2f((unsigned short)(nm[j].y >> 16)); }
        if (m + NGW < M) FIN_LOAD(m + NGW);
#pragma unroll
        for (int j = 0; j < 4; ++j) {
            if (WITH_MOE) { const int col = 4 * F.lane + 256 * j; const f32x4 gt = *(const GAS f32x4*)(mod + b * 6144 + 5120 + col);
                const v2u a = ca[j], c = cc[j];
                f32x4 mo; mo.x = bf2f((unsigned short)(a.x & 0xffff)) + bf2f((unsigned short)(c.x & 0xffff)); mo.y = bf2f((unsigned short)(a.x >> 16)) + bf2f((unsigned short)(c.x >> 16));
                mo.z = bf2f((unsigned short)(a.y & 0xffff)) + bf2f((unsigned short)(c.y & 0xffff)); mo.w = bf2f((unsigned short)(a.y >> 16)) + bf2f((unsigned short)(c.y >> 16));
                v[j] = v[j] + gt * mo; }
            s += (v[j].x * v[j].x + v[j].y * v[j].y) + (v[j].z * v[j].z + v[j].w * v[j].w); }
        const float r = 1.f / sqrtf(wave_sum(s) * (1.f / D) + EPS);
        GAS f32x4* o = (GAS f32x4*)(F.out() + (size_t)m * D) + F.lane;
#pragma unroll
        for (int j = 0; j < 4; ++j) { const f32x4 g = *(const GAS f32x4*)(F.g_fin() + 4 * F.lane + 256 * j); o[64 * j] = v[j] * r * g; }
    }
}

constexpr int N_PHASES = 16;
__global__ void __launch_bounds__(NWAVES * 64, 2) mk_fwd(Args args) {
    extern __shared__ __attribute__((aligned(16))) unsigned char lds[];
    Frame F;
    F.lds = (LAS unsigned char*)lds;
    F.tid = threadIdx.x; F.lane = F.tid & 63; F.wave = __builtin_amdgcn_readfirstlane(F.tid >> 6);
    F.G = gridDim.x; { const int bx = blockIdx.x; F.vcu = (F.G % 8 == 0) ? (bx % 8) * (F.G / 8) + bx / 8 : bx; }
    F.ws = args.ws; F.ctl = (gu32*)(args.ws + WS_CTL);
    F.ka = (const CAS Args*)__builtin_amdgcn_kernarg_segment_ptr();
    volatile LAS unsigned* LCTL = (volatile LAS unsigned*)(F.lds + LDSCTL_OFF);
    for (int u = F.tid; u < 64; u += NWAVES * 64) LCTL[u] = 0u;
    __syncthreads();
    const bool multi = (args.ph_hi - args.ph_lo) > 1;
    XcdBarrier bar; bar.bar = (unsigned*)(F.ctl + CW_BAR); bar.x = 0; bar.st = nullptr;
    if (multi) bar = xcd_barrier_post((unsigned*)(F.ctl + CW_BAR), LCTL + 8);
    const int lo = args.ph_lo, hi = args.ph_hi;
#ifndef PH_MASK
#define PH_MASK 0xffffffffu
#endif
#define IN(k) (((PH_MASK >> (k)) & 1u) && lo <= (k) && (k) < hi)
#define REPS(k) (1 + (int)((REP_MASK >> (k)) & 1u))
#define SEAM(k) do { if (IN(k) && IN((k) + 1)) xcd_barrier(bar); } while (0)

    if (IN(0)) _Pragma("unroll") for (int rp_ = 0; rp_ < REPS(0); ++rp_) { p0_prologue(F); } SEAM(0);
    if (multi && ((REP_MASK >> 21) & 1u)) { for (int q = 0; q < 8; ++q) xcd_barrier(bar); }
    if (IN(1)) _Pragma("unroll") for (int rp_ = 0; rp_ < REPS(1); ++rp_) { p1_norm(F); } SEAM(1);
    if (IN(2)) _Pragma("unroll") for (int rp_ = 0; rp_ < REPS(2); ++rp_) {
        pg8::Gemm g{(const bf16*)(F.ws + WS_H), (const bf16*)(F.ws + WS_WIN), D}; pg8::StaticOrder S; S.init(M, NPAD, F.G, (int)blockIdx.x);
        EpiInProj E{F.ws};
        pg8::gemm_phase<EpiInProj, pg8::StaticOrder, true>(F.lds, g, S, E);
    } SEAM(2);
    if (IN(3)) _Pragma("unroll") for (int rp_ = 0; rp_ < REPS(3); ++rp_) { ra_states(F); } SEAM(3);
    if (IN(4)) _Pragma("unroll") for (int rp_ = 0; rp_ < REPS(4); ++rp_) { rb_carry(F); } SEAM(4);
    if (IN(5)) _Pragma("unroll") for (int rp_ = 0; rp_ < REPS(5); ++rp_) { r3_out(F);
    } SEAM(5);
    if (IN(6)) _Pragma("unroll") for (int rp_ = 0; rp_ < REPS(6); ++rp_) { p_indexer(F); } SEAM(6);
    if (IN(7)) _Pragma("unroll") for (int rp_ = 0; rp_ < REPS(7); ++rp_) {
        const attn_body::AttnTensors AT{(const bf16*)(F.ws + WS_QA), (const bf16*)(F.ws + WS_KA), (const bf16*)(F.ws + WS_VA), (bf16*)(F.ws + WS_Y), (const unsigned char*)(F.ws + WS_MASK)};
        const attn_body::StaticOrder S((int)F.G, (int)blockIdx.x);
        { attn_body::AttnUnit u;
            for (int i = 0; S.next(i, u); ++i) { attn_body::attn_unit<8>(u.bh / attn_body::NHEAD, u.bh % attn_body::NHEAD, u.qb, AT.Q, AT.K, AT.V, AT.O, AT.MK, (char*)lds);
                p_expert_convert(F, i, 4); __syncthreads(); } }
    } SEAM(7);
    if (IN(8)) _Pragma("unroll") for (int rp_ = 0; rp_ < REPS(8); ++rp_) {
        pg8::Gemm g{(const bf16*)(F.ws + WS_Y), (const bf16*)(F.ws + WS_WO), D}; pg8::StaticOrder S; S.init(M, D, F.G, (int)blockIdx.x);
        EpiOutProj E{(bf16*)(F.ws + WS_MIX), (const float*)(F.ws + WS_MOD)};
        pg8::gemm_phase<EpiOutProj, pg8::StaticOrder, true>(F.lds, g, S, E);
    } SEAM(8);
    if (IN(9)) _Pragma("unroll") for (int rp_ = 0; rp_ < REPS(9); ++rp_) { p_norm2_route(F); } SEAM(9);
    if (IN(10)) _Pragma("unroll") for (int rp_ = 0; rp_ < REPS(10); ++rp_) {
        LAS int* blkstart = (LAS int*)(F.lds + AUX_OFF); LAS unsigned* tok = (LAS unsigned*)(F.lds + AUX_OFF + 256); LAS float* wts = (LAS float*)(F.lds + AUX_OFF + 256 + MOE_MAXU * 1024);
        const int nunits = moe_tables(F, blkstart, tok, wts);
        pg8::Gemm g{(const bf16*)(F.ws + WS_H2), (const bf16*)(F.ws + WS_WGU), D}; MoeSched S{F.G, F.vcu, nunits, blkstart, tok, true};
        EpiMoe1 E{(bf16*)(F.ws + WS_ACT)};
        pg8::gemm_phase<EpiMoe1, MoeSched, true>(F.lds, g, S, E);
    } SEAM(10);
    if (IN(11)) _Pragma("unroll") for (int rp_ = 0; rp_ < REPS(11); ++rp_) {
        LAS int* blkstart = (LAS int*)(F.lds + AUX_OFF); LAS unsigned* tok = (LAS unsigned*)(F.lds + AUX_OFF + 256); LAS float* wts = (LAS float*)(F.lds + AUX_OFF + 256 + MOE_MAXU * 1024);
        const int nunits = moe_tables(F, blkstart, tok, wts);
        pg8::Gemm g{(const bf16*)(F.ws + WS_ACT), (const bf16*)(F.ws + WS_WD), DEXP}; MoeSched S{F.G, F.vcu, nunits, blkstart, tok, false};
        EpiMoe2 E{(bf16*)(F.ws + WS_C0), (bf16*)(F.ws + WS_C1), tok, wts};
        pg8::gemm_phase<EpiMoe2, MoeSched, true>(F.lds, g, S, E);
    } SEAM(11);
    if (IN(12)) _Pragma("unroll") for (int rp_ = 0; rp_ < REPS(12); ++rp_) { p_final<true>(F); }
#undef IN
#undef SEAM
}

extern "C" void kernel_launch(void* const* d_in, const int* in_sizes, int n_in, void* d_out, int out_size, void* d_ws, size_t ws_size, hipStream_t stream) {
    static int grid = 0;
    if (grid == 0) {
        if (n_in != 15 || out_size != M * D || ws_size < WS_END) { fprintf(stderr, "kernel_launch: unexpected shapes (n_in %d out %d ws %zu)\n", n_in, out_size, ws_size); grid = -1; return; }
        int dev = 0, cus = 0, per_cu = 0;
        if (hipGetDevice(&dev) != hipSuccess || hipDeviceGetAttribute(&cus, hipDeviceAttributeMultiprocessorCount, dev) != hipSuccess) { grid = -1; return; }
        if (hipFuncSetAttribute((const void*)mk_fwd, hipFuncAttributeMaxDynamicSharedMemorySize, LDS_BYTES) != hipSuccess) { fprintf(stderr, "kernel_launch: hipFuncSetAttribute failed\n"); grid = -1; return; }
        if (hipOccupancyMaxActiveBlocksPerMultiprocessor(&per_cu, (const void*)mk_fwd, NWAVES * 64, LDS_BYTES) != hipSuccess || per_cu < 1) { fprintf(stderr, "kernel_launch: occupancy query says %d\n", per_cu); }
        (void)hipGetLastError();
        grid = cus;
    }
    if (grid < 0) return;
    (void)hipMemsetAsync((char*)d_ws + WS_CTL, 0, CTL_ZERO_BYTES, stream);
    Args a{};
    for (int i = 0; i < 15; ++i) a.in[i] = d_in[i];
    a.out = (float*)d_out; a.ws = (unsigned char*)d_ws;
#if MK_N_LAUNCHES == 1
    a.ph_lo = 0; a.ph_hi = N_PHASES;
    hipLaunchKernelGGL(mk_fwd, dim3(grid), dim3(NWAVES * 64), LDS_BYTES, stream, a);
#else
    for (int p = 0; p < N_PHASES; ++p) { a.ph_lo = p; a.ph_hi = p + 1; hipLaunchKernelGGL(mk_fwd, dim3(grid), dim3(NWAVES * 64), LDS_BYTES, stream, a); }
#endif
}
```

```cpp
#include <hip/hip_runtime.h>
#include <cstdio>
#include <cstdint>

#ifndef REP_MASK
#define REP_MASK 0u
#endif
#define SUBREPS(k) (1 + (int)((REP_MASK >> (k)) & 1u))
#ifndef MK_N_LAUNCHES
#define MK_N_LAUNCHES 1
#endif

#define GAS __attribute__((address_space(1)))
#define LAS __attribute__((address_space(3)))
typedef unsigned short bf16;
typedef unsigned v4u __attribute__((ext_vector_type(4)));
typedef unsigned v2u __attribute__((ext_vector_type(2)));
typedef float f32x4 __attribute__((ext_vector_type(4)));
typedef float f32x16 __attribute__((ext_vector_type(16)));
typedef short bf16x8 __attribute__((ext_vector_type(8)));
typedef GAS unsigned gu32;
#define RLX_AGENT __ATOMIC_RELAXED, __HIP_MEMORY_SCOPE_AGENT
#define LDS_WAIT() asm volatile("s_waitcnt lgkmcnt(0)" ::: "memory")
#define VM_WAIT() asm volatile("s_waitcnt vmcnt(0)" ::: "memory")

constexpr int NB = 4, SEQ = 8192, M = NB * SEQ, D = 1024;
constexpr int DIN = 4688, NPAD = 4864;
constexpr int NEXP = 32, DEXP = 512;
constexpr float EPS = 1e-6f;
constexpr float C2 = 0.125f * 1.4426950408889634f;

constexpr size_t MiB = 1u << 20;
constexpr size_t WS_CTL = 0, CTL_ZERO_BYTES = 1 * MiB;
constexpr size_t WS_MODP = 1 * MiB;
constexpr size_t WS_MOD = 3 * MiB;
constexpr size_t WS_WIN = 4 * MiB;
constexpr size_t WS_WO = 14 * MiB;
constexpr size_t WS_H = 16 * MiB;
constexpr size_t WS_ST = 16 * MiB;
constexpr size_t WS_MIX = 16 * MiB;
constexpr size_t WS_QA = 80 * MiB, WS_KA = 112 * MiB, WS_VA = 144 * MiB;
constexpr size_t WS_ROUTE = 144 * MiB;
constexpr size_t WS_QI = 176 * MiB;
constexpr size_t WS_H2 = 176 * MiB;
constexpr size_t WS_C0 = 176 * MiB;
constexpr size_t WS_KI = 240 * MiB;
constexpr size_t WS_WI = 244 * MiB;
constexpr size_t WS_QB = 248 * MiB, WS_KB = 280 * MiB, WS_VB = 312 * MiB, WS_GB = 344 * MiB;
constexpr size_t WS_SCR = 248 * MiB;
constexpr size_t WS_WGU = 248 * MiB;
constexpr size_t WS_C1 = 248 * MiB;
constexpr size_t WS_WD = 312 * MiB;
constexpr size_t WS_Y = 376 * MiB;
constexpr size_t WS_ACT = 376 * MiB;
constexpr size_t WS_MASK = 440 * MiB;
constexpr size_t WS_ROPE1 = 474 * MiB;
constexpr size_t WS_ROPE2 = 476 * MiB;
constexpr size_t WS_END = 512 * MiB;

constexpr int CW_BAR = 4096;
constexpr int CW_ECNT = 16384;

constexpr int NWAVES = 8;
constexpr int RING_BYTES = 131072;
constexpr int AUX_OFF = RING_BYTES, AUX_BYTES = 20480;
constexpr int LDSCTL_OFF = AUX_OFF + AUX_BYTES;
constexpr int LDS_BYTES = LDSCTL_OFF + 256;

__device__ __forceinline__ unsigned f2bf(float f) { unsigned u = __builtin_bit_cast(unsigned, f); return (u + 0x7fffu + ((u >> 16) & 1u)) >> 16; }
__device__ __forceinline__ unsigned pk2(float lo, float hi) { return f2bf(lo) | (f2bf(hi) << 16); }
__device__ __forceinline__ float bf2f(unsigned short b) { return __builtin_bit_cast(float, (unsigned)b << 16); }
__device__ __forceinline__ float wave_sum(float v) {
#pragma unroll
    for (int o = 1; o < 64; o <<= 1) v += __shfl_xor(v, o);
    return v;
}

#define XB_TMO      128
#define XB_XCNT(j)  (256  + 64 * (j))
#define XB_XSUB(j)  (1280 + 64 * (j))
#define XB_XGEN(j)  (2304 + 64 * (j))
#define XB_TOP      3328
#define XB_TOPGEN   3392
#define XCD_BAR_WORDS 3456
#define XB_SPIN_CAP (1u << 18)
__device__ __forceinline__ unsigned xb_ld(unsigned* p)              { return __hip_atomic_load(p, __ATOMIC_RELAXED, __HIP_MEMORY_SCOPE_AGENT); }
__device__ __forceinline__ unsigned xb_add(unsigned* p, unsigned v) { return __hip_atomic_fetch_add(p, v, __ATOMIC_RELAXED, __HIP_MEMORY_SCOPE_AGENT); }
__device__ __forceinline__ unsigned xb_xcc_id() { return (unsigned)__builtin_amdgcn_s_getreg((3 << 11) | 20) & 0xFu; }
#define XB_SPIN(cond, bar) do { unsigned _sp = 0; while (cond) { __builtin_amdgcn_s_sleep(1); \
    if ((++_sp & 255u) == 0u) { if (xb_ld(&(bar)[XB_TMO])) break; if (_sp > XB_SPIN_CAP) { atomicAdd(&(bar)[XB_TMO], 1u); break; } } } } while (0)
struct XcdBarrier { unsigned* bar; unsigned x; volatile LAS unsigned* st; };
__device__ __forceinline__ XcdBarrier xcd_barrier_post(unsigned* bar, volatile LAS unsigned* st) {
    XcdBarrier b; b.bar = bar; b.x = xb_xcc_id(); b.st = st;
    if (threadIdx.x == 0) (void)xb_add(&bar[XB_XCNT(b.x)], 1u);
    return b;
}
__device__ __forceinline__ void xcd_barrier_complete(unsigned* bar, unsigned x, unsigned& nloc, unsigned& nx) {
    const unsigned G = gridDim.x * gridDim.y * gridDim.z;
    unsigned sum, cnt, mine, sp = 0u;
    for (;;) {
        sum = 0u; cnt = 0u; mine = 0u;
#pragma unroll
        for (unsigned j = 0; j < 16; ++j) { const unsigned c = xb_ld(&bar[XB_XCNT(j)]); sum += c; cnt += (c > 0u) ? 1u : 0u; mine = (j == x) ? c : mine; }
        if (sum == G) break;
        __builtin_amdgcn_s_sleep(1);
        if ((++sp & 255u) == 0u) { if (xb_ld(&bar[XB_TMO])) break; if (sp > XB_SPIN_CAP) { atomicAdd(&bar[XB_TMO], 1u); break; } }
    }
    nloc = mine > 0u ? mine : 1u; nx = cnt > 0u ? cnt : 1u;
}
__device__ __forceinline__ void xcd_barrier(const XcdBarrier& b) {
    asm volatile("s_waitcnt vmcnt(0)" ::: "memory");
    __syncthreads();
    if (threadIdx.x == 0) {
        unsigned* bar = b.bar;
        __builtin_amdgcn_s_waitcnt(0);
        unsigned nloc = b.st[0], nx = b.st[1];
        if (nloc == 0u) { xcd_barrier_complete(bar, b.x, nloc, nx); b.st[0] = nloc; b.st[1] = nx; }
        const unsigned old = xb_add(&bar[XB_XSUB(b.x)], 1u);
        const unsigned gen = old / nloc;
        if (old + 1u == (gen + 1u) * nloc) {
            __builtin_amdgcn_fence(__ATOMIC_RELEASE, "agent");
            asm volatile("s_waitcnt vmcnt(0)" ::: "memory");
            const unsigned og = xb_add(&bar[XB_TOP], 1u);
            const unsigned tg = og / nx;
            if (og + 1u == (tg + 1u) * nx) xb_add(&bar[XB_TOPGEN], 1u);
            else XB_SPIN(xb_ld(&bar[XB_TOPGEN]) == tg, bar);
            __builtin_amdgcn_fence(__ATOMIC_ACQUIRE, "agent");
            xb_add(&bar[XB_XGEN(b.x)], 1u);
            asm volatile("s_waitcnt vmcnt(0)" ::: "memory");
        } else {
            XB_SPIN(xb_ld(&bar[XB_XGEN(b.x)]) == gen, bar);
            __builtin_amdgcn_fence(__ATOMIC_ACQUIRE, "agent");
            asm volatile("s_waitcnt vmcnt(0)" ::: "memory");
        }
    }
    __syncthreads();
}

namespace pg8 {
typedef unsigned short bf16_t;
constexpr int BM = 256, BK = 64, HALF = 128, HTB = HALF * BK * 2, STAGE_BYTES = 8 * HTB;
__host__ __device__ __forceinline__ int lds_byte(int r, int c) { const int st = (r >> 4) * 2 + (c >> 5), rr = r & 15, cc = c & 31, ob = rr * 64 + cc * 2; return st * 1024 + (ob ^ (((ob >> 9) & 1) << 5)); }
__host__ __device__ __forceinline__ void stage_rc(int b, int& R, int& C) { const int st = b / 1024, sb = b % 1024, swz = sb ^ (((sb >> 9) & 1) << 5); R = (st >> 1) * 16 + swz / 64; C = (st & 1) * 32 + (swz % 64) / 2; }
__host__ __device__ __forceinline__ int perm32(int rho) { const int n = rho >> 4, i = rho & 15; return 8 * (i >> 2) + 4 * n + (i & 3); }
struct Unit { int pm, pn; };
struct Gemm { const bf16_t* A; const bf16_t* Bt; int K; };
__device__ __forceinline__ unsigned cvt_pk_bf16(float lo, float hi) { unsigned r; asm volatile("v_cvt_pk_bf16_f32 %0, %1, %2" : "=v"(r) : "v"(lo), "v"(hi)); return r; }

template <class Epi, class Sched, bool ALIGN_EPI>
__device__ __forceinline__ void gemm_phase(LAS unsigned char* lds, const Gemm g, const Sched& S, const Epi& E) {
    const int tid = threadIdx.x, wid = __builtin_amdgcn_readfirstlane(tid >> 6), lane = tid & 63, wr = wid >> 2, wc = wid & 3, fr = lane & 15, fq = lane >> 4;
    const int K = g.K, nt = K / BK;
    int Rs[2], Cs[2]; unsigned voffB[2];
#pragma unroll
    for (int i = 0; i < 2; ++i) { int R, C; stage_rc(tid * 16 + i * 8192, R, C); const int Rb = Epi::PERM ? ((R & ~31) + perm32(R & 31)) : R;
        Rs[i] = R; Cs[i] = C * 2; voffB[i] = (unsigned)(Rb * K + C) * 2u; }
    const size_t kstep = (size_t)(BK * 2);
    const size_t hstep = (size_t)HALF * K * 2;
    const unsigned ldsw = (unsigned)wid * 1024u;
    const int aoff = lds_byte(wr * 64 + fr, fq * 8), boff = lds_byte(wc * 32 + fr, fq * 8);
#define PG8_SA(b, h) (((b) * 2 + (h)) * HTB)
#define PG8_SB(b, h) ((4 + (b) * 2 + (h)) * HTB)
#define PG8_STAGE(bufoff, gbase, v0, v1) do { \
        __builtin_amdgcn_global_load_lds((const unsigned*)((const char*)(gbase) + (v0)), (LAS unsigned*)(lds + (bufoff) + ldsw), 16, 0, 0); \
        __builtin_amdgcn_global_load_lds((const unsigned*)((const char*)(gbase) + (v1)), (LAS unsigned*)(lds + (bufoff) + ldsw + 8192), 16, 0, 0); } while (0)
#define PG8_STAGEB(bufoff, gbase) PG8_STAGE(bufoff, gbase, voffB[0], voffB[1])
#define PG8_LDA(dst, b, h) do { _Pragma("unroll") for (int m = 0; m < 4; ++m) _Pragma("unroll") for (int k = 0; k < 2; ++k) dst[m][k] = *(const LAS bf16x8*)(lds + PG8_SA(b, h) + aoff + m * 2048 + k * 1024); } while (0)
#define PG8_LDB(dst, b, h) do { _Pragma("unroll") for (int n = 0; n < 2; ++n) _Pragma("unroll") for (int k = 0; k < 2; ++k) dst[n][k] = *(const LAS bf16x8*)(lds + PG8_SB(b, h) + boff + n * 2048 + k * 1024); } while (0)
#define PG8_MMA(ai, bj, At, Bt) do { __builtin_amdgcn_s_setprio(1); _Pragma("unroll") for (int m = 0; m < 4; ++m) _Pragma("unroll") for (int n = 0; n < 2; ++n) _Pragma("unroll") for (int k = 0; k < 2; ++k) \
        acc[ai][bj][m][n] = __builtin_amdgcn_mfma_f32_16x16x32_bf16(Bt[n][k], At[m][k], acc[ai][bj][m][n], 0, 0, 0); __builtin_amdgcn_s_setprio(0); } while (0)
#define PG8_WAIT_V(n) asm volatile("s_waitcnt vmcnt(" #n ")" ::: "memory")
#define PG8_WAIT_L(n) asm volatile("s_waitcnt lgkmcnt(" #n ")" ::: "memory")
#define PG8_BAR __builtin_amdgcn_s_barrier()
#define PG8_SCHED __builtin_amdgcn_sched_barrier(0)
    Unit cur, nxt; int ui = 0;
    if (!S.next(0, cur)) return;
    f32x4 acc[2][2][4][2];
#pragma unroll
    for (int a = 0; a < 2; ++a)
#pragma unroll
        for (int b = 0; b < 2; ++b)
#pragma unroll
            for (int m = 0; m < 4; ++m)
#pragma unroll
                for (int n = 0; n < 2; ++n) acc[a][b][m][n] = (f32x4){0.f, 0.f, 0.f, 0.f};
    bf16x8 At[4][2], B0[2][2], B1[2][2];
    unsigned vc[2][2], vn[2][2];
#pragma unroll
    for (int h = 0; h < 2; ++h)
#pragma unroll
        for (int i = 0; i < 2; ++i) vc[h][i] = (unsigned)S.arow(cur, h * HALF + Rs[i]) * (unsigned)(K * 2) + (unsigned)Cs[i];
    const char* cA = (const char*)g.A;
    const char* cB = (const char*)g.Bt + (size_t)S.brow0(cur) * K * 2;
    PG8_STAGEB(PG8_SB(0, 0), cB); PG8_STAGEB(PG8_SB(0, 1), cB + hstep); PG8_STAGE(PG8_SA(0, 0), cA, vc[0][0], vc[0][1]); PG8_STAGE(PG8_SA(0, 1), cA, vc[1][0], vc[1][1]);
    if (wr == 1) PG8_BAR;
    PG8_WAIT_V(2); PG8_BAR;
    PG8_STAGEB(PG8_SB(1, 0), cB + kstep); PG8_STAGE(PG8_SA(1, 0), cA + kstep, vc[0][0], vc[0][1]); PG8_STAGEB(PG8_SB(1, 1), cB + hstep + kstep);
    PG8_WAIT_V(6); PG8_BAR;
    for (;;) {
        const bool has_next = S.next(ui + 1, nxt);
        const char* nB = cB;
        if (has_next) {
            nB = (const char*)g.Bt + (size_t)S.brow0(nxt) * K * 2;
#pragma unroll
            for (int h = 0; h < 2; ++h)
#pragma unroll
                for (int i = 0; i < 2; ++i) vn[h][i] = (unsigned)S.arow(nxt, h * HALF + Rs[i]) * (unsigned)(K * 2) + (unsigned)Cs[i];
        } else {
#pragma unroll
            for (int h = 0; h < 2; ++h)
#pragma unroll
                for (int i = 0; i < 2; ++i) vn[h][i] = vc[h][i];
        }
        for (int t = 0; t < nt; t += 2) {
            const bool last = (t == nt - 2);
            const char* a1 = cA + (size_t)(t + 1) * kstep;
            const char* a2 = last ? cA : cA + (size_t)(t + 2) * kstep; const char* b2 = last ? nB : cB + (size_t)(t + 2) * kstep;
            const char* a3 = a2 + kstep; const char* b3 = b2 + kstep;
            const unsigned w00 = last ? vn[0][0] : vc[0][0], w01 = last ? vn[0][1] : vc[0][1], w10 = last ? vn[1][0] : vc[1][0], w11 = last ? vn[1][1] : vc[1][1];
            PG8_LDB(B0, 0, 0); PG8_LDB(B1, 0, 1); PG8_SCHED; PG8_LDA(At, 0, 0); PG8_STAGE(PG8_SA(1, 1), a1, vc[1][0], vc[1][1]);
            PG8_WAIT_V(8); PG8_WAIT_L(0); PG8_BAR; PG8_MMA(0, 0, At, B0); PG8_MMA(0, 1, At, B1); PG8_BAR; PG8_SCHED;
            PG8_LDA(At, 0, 1); PG8_STAGEB(PG8_SB(0, 0), b2); PG8_STAGEB(PG8_SB(0, 1), b2 + hstep); PG8_STAGE(PG8_SA(0, 0), a2, w00, w01);
            PG8_WAIT_V(8); PG8_WAIT_L(0); PG8_BAR; PG8_MMA(1, 0, At, B0); PG8_MMA(1, 1, At, B1); PG8_BAR; PG8_SCHED;
            PG8_LDB(B0, 1, 0); PG8_LDB(B1, 1, 1); PG8_SCHED; PG8_LDA(At, 1, 0); PG8_STAGE(PG8_SA(0, 1), a2, w10, w11);
            PG8_WAIT_V(8); PG8_WAIT_L(0); PG8_BAR; PG8_MMA(0, 0, At, B0); PG8_MMA(0, 1, At, B1); PG8_BAR; PG8_SCHED;
            PG8_LDA(At, 1, 1); PG8_STAGEB(PG8_SB(1, 0), b3); PG8_STAGEB(PG8_SB(1, 1), b3 + hstep); PG8_STAGE(PG8_SA(1, 0), a3, w00, w01);
            PG8_WAIT_V(8); PG8_WAIT_L(0); PG8_BAR; PG8_MMA(1, 0, At, B0); PG8_MMA(1, 1, At, B1); PG8_BAR; PG8_SCHED;
        }
        if constexpr (ALIGN_EPI) { if (wr == 0) PG8_BAR; }
        E(acc, cur, wr, wc, fr, fq);
        if (!has_next) break;
#pragma unroll
        for (int a = 0; a < 2; ++a)
#pragma unroll
            for (int b = 0; b < 2; ++b)
#pragma unroll
                for (int m = 0; m < 4; ++m)
#pragma unroll
                    for (int n = 0; n < 2; ++n) acc[a][b][m][n] = (f32x4){0.f, 0.f, 0.f, 0.f};
        cur = nxt; cB = nB; ++ui;
#pragma unroll
        for (int h = 0; h < 2; ++h)
#pragma unroll
            for (int i = 0; i < 2; ++i) vc[h][i] = vn[h][i];
        if constexpr (ALIGN_EPI) { if (wr == 1) PG8_BAR; }
    }
    PG8_WAIT_V(0);
    if constexpr (!ALIGN_EPI) { if (wr == 0) PG8_BAR; }
    PG8_BAR;
#undef PG8_SA
#undef PG8_SB
#undef PG8_STAGE
#undef PG8_STAGEB
#undef PG8_LDA
#undef PG8_LDB
#undef PG8_MMA
#undef PG8_WAIT_V
#undef PG8_WAIT_L
#undef PG8_BAR
#undef PG8_SCHED
}

struct StaticOrder {
    int nM, nN, nwg, G, c;
    __device__ void init(int Mrows, int N, int G_, int c_) { nM = Mrows / BM; nN = N / BM; nwg = nM * nN; G = G_; c = c_; }
    __device__ bool next(int i, Unit& u) const {
        const long L = (long)i * G + c; if (L >= nwg) return false;
        int wgid = (int)L; { const int q = nwg / 8, r = nwg % 8, xcd = wgid % 8, off = wgid / 8; wgid = (xcd < r ? xcd * (q + 1) : r * (q + 1) + (xcd - r) * q) + off; }
        const int nig = 8 * nN, gid = wgid / nig, fm = gid * 8, gsz = (nM - fm) < 8 ? (nM - fm) : 8;
        u.pm = fm + ((wgid % nig) % gsz); u.pn = (wgid % nig) / gsz; return true;
    }
    __device__ __forceinline__ int arow(const Unit& u, int rt) const { return u.pm * BM + rt; }
    __device__ __forceinline__ int brow0(const Unit& u) const { return u.pn * BM; }
};
}

#include <cmath>
namespace attn_body {
using bf16=unsigned short;
using bf16x8=__attribute__((ext_vector_type(8)))short;
using s16x4=__attribute__((ext_vector_type(4)))short;
using f32x16=__attribute__((ext_vector_type(16)))float;
using u32x4=__attribute__((ext_vector_type(4)))unsigned;
using u32x2=__attribute__((ext_vector_type(2)))unsigned;
constexpr int BATCH=4,NHEAD=8,SEQ=8192,D=64,DM=NHEAD*D,OPITCH=1024,MPITCH=1024;
constexpr int NW=8,QBLK=32,QB=QBLK*NW,KVBLK=64,NQB=SEQ/QB;
constexpr int ATTN_PITCH=DM, ATTN_UNIT_ROWS=QB;
__device__ __forceinline__ int crow(int r,int hi){return (r&3)+8*(r>>2)+4*hi;}
#define SBAR() __builtin_amdgcn_sched_barrier(0)
constexpr int NSLOT=3, SLOTB=8192;
constexpr int LDS_K=0, LDS_V=NSLOT*SLOTB, LDS_WS=2*NSLOT*SLOTB, LDS_OST=LDS_WS+NW*64*4, LDS_MK=LDS_OST+NW*4096, LDS_BYTES=LDS_MK+NW*1024;
__device__ __forceinline__ void glds16(const void*gsrc,unsigned lds_dst){unsigned keep;
  asm volatile("s_mov_b32 %0, m0\n\ts_mov_b32 m0, %2\n\ts_nop 0\n\tglobal_load_lds_dwordx4 %1, off\n\ts_mov_b32 m0, %0":"=&s"(keep):"v"(gsrc),"s"(lds_dst):"memory");}
__device__ __forceinline__ void glds4(const void*gsrc,unsigned lds_dst){unsigned keep;
  asm volatile("s_mov_b32 %0, m0\n\ts_mov_b32 m0, %2\n\ts_nop 0\n\tglobal_load_lds_dword %1, off\n\ts_mov_b32 m0, %0":"=&s"(keep):"v"(gsrc),"s"(lds_dst):"memory");}
__device__ __forceinline__ float mskf(float x,unsigned w,int pos){ unsigned m; asm("v_bfe_i32 %0, %1, %2, 1":"=v"(m):"v"(w),"n"(pos)); return __uint_as_float(__float_as_uint(x) & m); }
__device__ __forceinline__ float max3f(float a,float b,float c){float r;asm("v_max3_f32 %0, %1, %2, %3":"=v"(r):"v"(a),"v"(b),"v"(c));return r;}
__device__ __forceinline__ float max2f(float a,float b){float r;asm("v_max_f32_e32 %0, %1, %2":"=v"(r):"v"(a),"v"(b));return r;}
__device__ __forceinline__ float fadd_s(float a,float b){float r;asm("v_add_f32_e32 %0, %1, %2":"=v"(r):"v"(a),"v"(b));return r;}
__device__ __forceinline__ float fsub_s(float a,float b){float r;asm("v_sub_f32_e32 %0, %1, %2":"=v"(r):"v"(a),"v"(b));return r;}
typedef float f32x2_t __attribute__((ext_vector_type(2))); typedef __bf16 bf16x2_t __attribute__((ext_vector_type(2)));
__device__ __forceinline__ unsigned cvtpk_s(float lo,float hi){f32x2_t v={lo,hi};bf16x2_t b=__builtin_convertvector(v,bf16x2_t);return __builtin_bit_cast(unsigned,b);}
#define WAIT_BAR(N) asm volatile("s_waitcnt vmcnt(" #N ") lgkmcnt(0)\n\ts_barrier":::"memory")

__device__ __forceinline__ void qkt(f32x16&p0,f32x16&p1,const char*Kslot,const bf16x8*qr,const f32x16&negm,int r32,int hi){
  const char*kb=Kslot+hi*1024+r32*16;
  #pragma unroll
  for(int d0=0;d0<4;++d0){
    const bf16x8 b0=*reinterpret_cast<const bf16x8*>(kb+d0*2048);
    const bf16x8 b1=*reinterpret_cast<const bf16x8*>(kb+d0*2048+512);
    if(d0==0){p0=__builtin_amdgcn_mfma_f32_32x32x16_bf16(b0,qr[0],negm,0,0,0);p1=__builtin_amdgcn_mfma_f32_32x32x16_bf16(b1,qr[0],negm,0,0,0);}
    else{p0=__builtin_amdgcn_mfma_f32_32x32x16_bf16(b0,qr[d0],p0,0,0,0);p1=__builtin_amdgcn_mfma_f32_32x32x16_bf16(b1,qr[d0],p1,0,0,0);}}
}
typedef __attribute__((address_space(3))) const char* lds_cptr;
typedef short v4i16_t __attribute__((ext_vector_type(4)));
__device__ __forceinline__ void kload8(bf16x8*kf,lds_cptr kp){
  kf[0]=*(const __attribute__((address_space(3))) bf16x8*)(kp);      kf[1]=*(const __attribute__((address_space(3))) bf16x8*)(kp+512);
  kf[2]=*(const __attribute__((address_space(3))) bf16x8*)(kp+2048); kf[3]=*(const __attribute__((address_space(3))) bf16x8*)(kp+2560);
  kf[4]=*(const __attribute__((address_space(3))) bf16x8*)(kp+4096); kf[5]=*(const __attribute__((address_space(3))) bf16x8*)(kp+4608);
  kf[6]=*(const __attribute__((address_space(3))) bf16x8*)(kp+6144); kf[7]=*(const __attribute__((address_space(3))) bf16x8*)(kp+6656);
}
__device__ __forceinline__ void kload2(bf16x8*kf,lds_cptr kp,int j){ kf[2*j]=*(const __attribute__((address_space(3))) bf16x8*)(kp+j*2048); kf[2*j+1]=*(const __attribute__((address_space(3))) bf16x8*)(kp+j*2048+512); }
__device__ __forceinline__ s16x4 vtr(lds_cptr p){ return __builtin_bit_cast(s16x4,__builtin_amdgcn_ds_read_tr16_b64_v4i16((__attribute__((address_space(3))) v4i16_t*)p)); }
__device__ __forceinline__ float rowmax(const f32x16&p0,const f32x16&p1){
  float a=max3f(p0[0],p0[1],p1[0]),b=max3f(p0[2],p0[3],p1[1]);a=max3f(a,p1[2],p1[3]);
  #pragma unroll
  for(int r=4;r<16;r+=4){a=max3f(a,p0[r],p0[r+1]);b=max3f(b,p0[r+2],p0[r+3]);a=max3f(a,p1[r],p1[r+1]);b=max3f(b,p1[r+2],p1[r+3]);}
  const float m=max2f(a,b);
  auto rr=__builtin_amdgcn_permlane32_swap(__float_as_uint(m),__float_as_uint(m),false,false);
  return max2f(__uint_as_float(rr[0]),__uint_as_float(rr[1]));
}
__device__ __forceinline__ void pv(f32x16*o,int vb,bf16x8 pa0,bf16x8 pa1,bf16x8 pa2,bf16x8 pa3){
  #pragma unroll
  for(int d0=0;d0<2;++d0){s16x4 lo[4],hi[4];
    #pragma unroll
    for(int ks=0;ks<4;++ks){
      asm volatile("ds_read_b64_tr_b16 %0,%1 offset:%c2":"=&v"(lo[ks]):"v"(vb),"i"(d0*4096+ks*1024):"memory");
      asm volatile("ds_read_b64_tr_b16 %0,%1 offset:%c2":"=&v"(hi[ks]):"v"(vb),"i"(d0*4096+ks*1024+512):"memory");}
    asm volatile("s_waitcnt lgkmcnt(0)":::"memory");SBAR();
    #define PK(k) (bf16x8){lo[k][0],lo[k][1],lo[k][2],lo[k][3],hi[k][0],hi[k][1],hi[k][2],hi[k][3]}
    o[d0]=__builtin_amdgcn_mfma_f32_32x32x16_bf16(pa0,PK(0),o[d0],0,0,0);
    o[d0]=__builtin_amdgcn_mfma_f32_32x32x16_bf16(pa1,PK(1),o[d0],0,0,0);
    o[d0]=__builtin_amdgcn_mfma_f32_32x32x16_bf16(pa2,PK(2),o[d0],0,0,0);
    o[d0]=__builtin_amdgcn_mfma_f32_32x32x16_bf16(pa3,PK(3),o[d0],0,0,0);
    #undef PK
  }
}

#ifndef ATTN_STORE16
#define ATTN_STORE16(p,v) (*(u32x4*)(p)=(v))
#endif
template<int THRL> __device__ __forceinline__ void attn_unit(int b,int h,int qb,const bf16*Q,const bf16*__restrict__ K,const bf16*__restrict__ V,bf16*O,const unsigned char*__restrict__ MK,char*shm){
  const int tid=threadIdx.x,lane=tid&63,r32=lane&31,hi=lane>>5; const int wid=__builtin_amdgcn_readfirstlane(tid>>6);
  const long rowbase=(long)b*SEQ; const int q0=qb*QB;
  const bf16*Qw=Q+(rowbase+q0+wid*QBLK)*DM+h*D;
  const bf16*Kh=K+rowbase*DM+h*D,*Vh=V+rowbase*DM+h*D;
  const unsigned lds0=(unsigned)(uintptr_t)shm;
  float*wsf=(float*)(shm+LDS_WS)+wid*64;
  const bf16*ksrc=Kh+(long)lane*DM+wid*8;
  const bf16*vsrc=Vh+(long)(16*(wid&3)+(lane>>2))*DM+(wid>>2)*32+(lane&3)*8;
  const unsigned kdst=lds0+LDS_K+wid*1024, vdst=lds0+LDS_V+wid*1024;
  #define DMA_K(t,slot) glds16(ksrc+(long)(t)*KVBLK*DM,(unsigned)__builtin_amdgcn_readfirstlane(kdst+(slot)))
  #define DMA_V(t,slot) glds16(vsrc+(long)(t)*KVBLK*DM,(unsigned)__builtin_amdgcn_readfirstlane(vdst+(slot)))
  const unsigned char*msrc=MK+(rowbase+q0+wid*QBLK+(lane>>1))*(long)MPITCH+4*(lane&1);
  const unsigned mdst=lds0+LDS_MK+wid*1024;
  #define DMA_M(t) glds4(msrc+8*(long)(t),(unsigned)__builtin_amdgcn_readfirstlane(mdst+(((t)&3)<<8)))
  const lds_cptr mp0=(lds_cptr)shm+LDS_MK+wid*1024+r32*8;
  #define MLOAD(t) do{ const u32x2 mw_=*(const __attribute__((address_space(3))) u32x2*)(mp0+(((t)&3)<<8)); ml=mw_[0]>>(4*hi); mh=mw_[1]>>(4*hi); }while(0)
  const int vb0=(int)(lds0+LDS_V)+((lane>>4)&1)*32+(lane&3)*8+(4*hi+((lane&15)>>2))*64;
  const char*Kbase=shm+LDS_K; bf16x8 kf[8];
  const lds_cptr shm3=(lds_cptr)shm; const lds_cptr kp0=shm3+LDS_K+hi*1024+r32*16; const lds_cptr vp0=shm3+LDS_V+((lane>>4)&1)*32+(lane&3)*8+(4*hi+((lane&15)>>2))*64;
  const int NT=(q0+QB)/KVBLK;
  DMA_K(0,0);DMA_M(0);DMA_V(0,0);DMA_K(1,SLOTB);
  bf16x8 qr[4];
  #pragma unroll
  for(int d0=0;d0<4;++d0)qr[d0]=*reinterpret_cast<const bf16x8*>(&Qw[(long)r32*DM+d0*16+hi*8]);
  float mhat=0.f,l_reg=0.f;f32x16 o[2];o[0]=f32x16{};o[1]=f32x16{};f32x16 negm=f32x16{};asm volatile("":"+v"(negm));
  const int qrel=wid*QBLK+r32;
  #define CMASK(P0,P1,t) do{}while(0)
  unsigned ml=0u,mh=0u;
  bool resc=false;
  #define START(P0,P1) do{ const float rm=rowmax(P0,P1); resc=false; \
    { const float dl=rm; mhat=fadd_s(mhat,dl); \
      _Pragma("unroll") for(int r=0;r<16;++r){P0[r]=fsub_s(P0[r],dl);P1[r]=fsub_s(P1[r],dl);} \
      _Pragma("unroll") for(int r=0;r<16;++r)negm[r]=-mhat; asm volatile("":"+v"(negm)); } \
    _Pragma("unroll") for(int r=0;r<16;++r)P0[r]=__builtin_amdgcn_exp2f(P0[r]); }while(0)
  #define RESC() do{ if(resc){ asm volatile("s_waitcnt lgkmcnt(0)":::"memory"); \
      _Pragma("unroll") for(int d_=0;d_<2;++d_) _Pragma("unroll") for(int r=0;r<16;++r)o[d_][r]*=wsf[crow(r,hi)]; } }while(0)
  f32x16 pA0,pA1,pB0,pB1;
  int sl_prev=0,sl_cur=0,sl_next=SLOTB;
  #define ROT() do{sl_prev=sl_cur;sl_cur=sl_next;sl_next=(sl_next==(NSLOT-1)*SLOTB)?0:sl_next+SLOTB;}while(0)
  DMA_K(2,2*SLOTB);DMA_M(1);
  WAIT_BAR(4);
  qkt(pA0,pA1,Kbase,qr,negm,r32,hi);asm volatile("s_nop 15\n\ts_nop 7":"+v"(pA0),"+v"(pA1));CMASK(pA0,pA1,0);
  START(pA0,pA1);
  _Pragma("unroll") for(int r=0;r<16;++r)pA1[r]=__builtin_amdgcn_exp2f(pA1[r]);
  MLOAD(0);
  _Pragma("unroll") for(int r=0;r<16;++r){pA0[r]=mskf(pA0[r],ml,(r&3)+8*(r>>2));pA1[r]=mskf(pA1[r],mh,(r&3)+8*(r>>2));}
  WAIT_BAR(0);
  DMA_K(3,0);DMA_V(1,SLOTB);DMA_M(2);
  ROT();
  kload8(kf,kp0+sl_cur);
  WAIT_BAR(3);
  s16x4 vlo[8],vhi[8]; u32x4 pw0,pw1,pw2,pw3;
  #define PKW(P,B) cvtpk_s(P[B],P[B+1])
  #define PAF(k) __builtin_bit_cast(bf16x8,pw##k)
  #define VFR(i) (bf16x8){vlo[i][0],vlo[i][1],vlo[i][2],vlo[i][3],vhi[i][0],vhi[i][1],vhi[i][2],vhi[i][3]}
  #define PIN(x) asm volatile("":"+v"(x))
  #define MX3(a,b,c) __builtin_fmaxf(__builtin_fmaxf((a),(b)),(c))
  #define GAPA(MF,A0,A1,A2,A3,W0,W1,PW) do{ MF; sacc+=A0; sacc+=A1; sacc+=A2; sacc+=A3; PIN(sacc); W0; W1; PIN(PW); SBAR(); }while(0)
  #define EX(v) __builtin_amdgcn_exp2f(v)
  #define GAPB(MF,X,B,W) do{ MF; X[B]=mskf(EX(X[B]),W,2*(B)); X[B+1]=mskf(EX(X[B+1]),W,2*(B)+1); X[B+2]=mskf(EX(X[B+2]),W,2*(B)+2); X[B+3]=mskf(EX(X[B+3]),W,2*(B)+3); PIN(X); SBAR(); }while(0)
  #define VRD(i) do{ vlo[i]=vtr(vp_+(((i)>>2)*4096+((i)&3)*1024)); vhi[i]=vtr(vp_+(((i)>>2)*4096+((i)&3)*1024+512)); }while(0)
  #define KRD(G,j) do{ if(G){ kload2(kf,kp0+sl_next,j); SBAR(); } }while(0)
  #define STEP(C0,C1,P0,P1,t,GK,GV,GL,GM) do{ SBAR(); \
    const lds_cptr vp_=vp0+sl_prev; \
    VRD(0); SBAR(); float sacc=(P0[0]+P0[1]); \
    GAPA(C0=__builtin_amdgcn_mfma_f32_32x32x16_bf16(kf[0],qr[0],negm,0,0,0), P0[2],P0[3],P0[4],P0[5],     pw0[0]=PKW(P0,0), pw0[1]=PKW(P0,2), pw0); \
    VRD(4); SBAR(); GAPA(C1=__builtin_amdgcn_mfma_f32_32x32x16_bf16(kf[1],qr[0],negm,0,0,0), P0[6],P0[7],P0[8],P0[9],     pw0[2]=PKW(P0,4), pw0[3]=PKW(P0,6), pw0); \
    VRD(1); SBAR(); GAPA(C0=__builtin_amdgcn_mfma_f32_32x32x16_bf16(kf[2],qr[1],C0,0,0,0),   P0[10],P0[11],P0[12],P0[13], pw1[0]=PKW(P0,8), pw1[1]=PKW(P0,10), pw1); \
    VRD(5); SBAR(); GAPA(C1=__builtin_amdgcn_mfma_f32_32x32x16_bf16(kf[3],qr[1],C1,0,0,0),   P0[14],P0[15],P1[0],P1[1],   pw1[2]=PKW(P0,12),pw1[3]=PKW(P0,14), pw1); \
    VRD(2); SBAR(); GAPA(C0=__builtin_amdgcn_mfma_f32_32x32x16_bf16(kf[4],qr[2],C0,0,0,0),   P1[2],P1[3],P1[4],P1[5],     pw2[0]=PKW(P1,0), pw2[1]=PKW(P1,2), pw2); \
    VRD(6); SBAR(); GAPA(C1=__builtin_amdgcn_mfma_f32_32x32x16_bf16(kf[5],qr[2],C1,0,0,0),   P1[6],P1[7],P1[8],P1[9],     pw2[2]=PKW(P1,4), pw2[3]=PKW(P1,6), pw2); \
    VRD(3); SBAR(); GAPA(C0=__builtin_amdgcn_mfma_f32_32x32x16_bf16(kf[6],qr[3],C0,0,0,0),   P1[10],P1[11],P1[12],P1[13], pw3[0]=PKW(P1,8), pw3[1]=PKW(P1,10), pw3); \
    VRD(7); SBAR(); GAPA(C1=__builtin_amdgcn_mfma_f32_32x32x16_bf16(kf[7],qr[3],C1,0,0,0),   P1[14],P1[15],0.f,0.f,       pw3[2]=PKW(P1,12),pw3[3]=PKW(P1,14), pw3); \
    l_reg+=sacc; \
    if(GK){DMA_K((t)+3,sl_cur);} if(GV){DMA_V((t)+1,sl_next);} if(GM){DMA_M((t)+2);} \
    CMASK(C0,C1,t); \
    { float a=MX3(C0[0],C0[1],C1[0]),b=MX3(C0[2],C0[3],C1[1]); a=MX3(a,C1[2],C1[3]); \
      _Pragma("unroll") for(int r=4;r<16;r+=4){a=MX3(a,C0[r],C0[r+1]);b=MX3(b,C0[r+2],C0[r+3]);a=MX3(a,C1[r],C1[r+1]);b=MX3(b,C1[r+2],C1[r+3]);} \
      float rm=__builtin_fmaxf(a,b); { auto rr=__builtin_amdgcn_permlane32_swap(__float_as_uint(rm),__float_as_uint(rm),false,false); rm=__builtin_fmaxf(__uint_as_float(rr[0]),__uint_as_float(rr[1])); } \
      resc=false; \
      if(__builtin_expect(__any(rm>(float)THRL),0)){ const float dl=__builtin_fmaxf(rm,0.f); mhat+=dl; \
        _Pragma("unroll") for(int r=0;r<16;++r){C0[r]-=dl;C1[r]-=dl;} \
        _Pragma("unroll") for(int r=0;r<16;++r)negm[r]=-mhat; asm volatile("":"+v"(negm)); \
        const float f=__builtin_amdgcn_exp2f(-dl); l_reg*=f; if(hi==0)wsf[r32]=f; resc=true; } } \
    MLOAD(t); SBAR(); \
    GAPB(o[0]=__builtin_amdgcn_mfma_f32_32x32x16_bf16(PAF(0),VFR(0),o[0],0,0,0), C0,0,ml); \
    GAPB(o[1]=__builtin_amdgcn_mfma_f32_32x32x16_bf16(PAF(0),VFR(4),o[1],0,0,0), C0,4,ml); \
    KRD(GL,0); GAPB(o[0]=__builtin_amdgcn_mfma_f32_32x32x16_bf16(PAF(1),VFR(1),o[0],0,0,0), C0,8,ml); \
    KRD(GL,1); GAPB(o[1]=__builtin_amdgcn_mfma_f32_32x32x16_bf16(PAF(1),VFR(5),o[1],0,0,0), C0,12,ml); \
    KRD(GL,2); GAPB(o[0]=__builtin_amdgcn_mfma_f32_32x32x16_bf16(PAF(2),VFR(2),o[0],0,0,0), C1,0,mh); \
    KRD(GL,3); GAPB(o[1]=__builtin_amdgcn_mfma_f32_32x32x16_bf16(PAF(2),VFR(6),o[1],0,0,0), C1,4,mh); \
    GAPB(o[0]=__builtin_amdgcn_mfma_f32_32x32x16_bf16(PAF(3),VFR(3),o[0],0,0,0), C1,8,mh); \
    GAPB(o[1]=__builtin_amdgcn_mfma_f32_32x32x16_bf16(PAF(3),VFR(7),o[1],0,0,0), C1,12,mh); \
    }while(0)
  int t=1;
  #undef CMASK
  #define CMASK(P0,P1,t) do{}while(0)
  for(;t+5<NT;t+=2){
    STEP(pB0,pB1,pA0,pA1,t,true,true,true,true);     WAIT_BAR(3); RESC(); ROT();
    STEP(pA0,pA1,pB0,pB1,t+1,true,true,true,true);   WAIT_BAR(3); RESC(); ROT();
  }
  #undef CMASK
  #define CMASK(P0,P1,t) do{}while(0)
  #define ENDW(tt) do{ if((tt)+3<NT){WAIT_BAR(3);} else if((tt)+2<NT){WAIT_BAR(2);} else {WAIT_BAR(0);} }while(0)
  for(;t+1<NT;t+=2){
    STEP(pB0,pB1,pA0,pA1,t,(t+3<NT),(t+1<NT),(t+1<NT),(t+2<NT));       ENDW(t);   RESC(); ROT();
    STEP(pA0,pA1,pB0,pB1,t+1,(t+4<NT),(t+2<NT),(t+2<NT),(t+3<NT));     ENDW(t+1); RESC(); ROT();
  }
  STEP(pB0,pB1,pA0,pA1,NT-1,false,false,false,false); RESC();
  { float sacc=pB0[0]+pB0[1]; _Pragma("unroll") for(int r=2;r<16;++r)sacc+=pB0[r]; _Pragma("unroll") for(int r=0;r<16;++r)sacc+=pB1[r]; l_reg+=sacc;
    pw0=(u32x4){PKW(pB0,0),PKW(pB0,2),PKW(pB0,4),PKW(pB0,6)};pw1=(u32x4){PKW(pB0,8),PKW(pB0,10),PKW(pB0,12),PKW(pB0,14)};pw2=(u32x4){PKW(pB1,0),PKW(pB1,2),PKW(pB1,4),PKW(pB1,6)};pw3=(u32x4){PKW(pB1,8),PKW(pB1,10),PKW(pB1,12),PKW(pB1,14)};
    SBAR(); pv(o,vb0+sl_cur,PAF(0),PAF(1),PAF(2),PAF(3)); }
  #undef PKW
  #undef PAF
  #undef VFR
  #undef PIN
  #undef MX3
  #undef GAPA
  #undef GAPB
  #undef EX
  #undef VRD
  #undef KRD
  #undef STEP
  #undef ENDW
  {auto rr=__builtin_amdgcn_permlane32_swap(__float_as_uint(l_reg),__float_as_uint(l_reg),false,false);l_reg=__uint_as_float(rr[0])+__uint_as_float(rr[1]);}
  if(hi==0)wsf[32+r32]=l_reg;asm volatile("s_waitcnt lgkmcnt(0)":::"memory");
  float rli[16];
  #pragma unroll
  for(int r=0;r<16;++r)rli[r]=__builtin_amdgcn_rcpf(wsf[32+crow(r,hi)]);
  bf16*Ow=O+(rowbase+q0+wid*QBLK)*OPITCH+h*D;
  { bf16*stg=(bf16*)(shm+LDS_OST)+wid*2048;
    #pragma unroll
    for(int r=0;r<16;++r){const int orow=crow(r,hi);
      #pragma unroll
      for(int d0=0;d0<2;++d0)stg[orow*64+d0*32+r32]=(bf16)f2bf(o[d0][r]*rli[r]);}
    asm volatile("s_waitcnt lgkmcnt(0)":::"memory");
    #pragma unroll
    for(int i=0;i<4;++i){const int row=i*8+(lane>>3),ch=lane&7; const u32x4 v=*(const u32x4*)(stg+row*64+ch*8); ATTN_STORE16(Ow+(long)row*OPITCH+ch*8,v);} }
  asm volatile("s_waitcnt lgkmcnt(0)\n\ts_barrier":::"memory");
  #undef DMA_K
  #undef DMA_V
  #undef DMA_M
  #undef MLOAD
  #undef CMASK
  #undef START
  #undef RESC
  #undef ROT
}
constexpr int ATTN_LDS_BYTES=LDS_BYTES;
struct AttnTensors { const bf16* Q; const bf16* K; const bf16* V; bf16* O; const unsigned char* MK; };
struct AttnUnit { int bh; int qb; };
struct StaticOrder {
  int vcu;
  __device__ __forceinline__ explicit StaticOrder(int grid,int block):vcu((block%8)*(grid/8)+block/8){}
  __device__ __forceinline__ bool next(int i,AttnUnit&u)const{ if(i>=4)return false; const int s=vcu&7; u.bh=vcu>>3; u.qb=(i==0)?s:(i==1)?15-s:(i==2)?16+s:31-s; return true; }
  __device__ __forceinline__ void a_ready(const AttnUnit&)const{}
  __device__ __forceinline__ void done(const AttnUnit&)const{}
};
template<class Sched,int THRL=8> __device__ __forceinline__ void attn_phase(char*lds,const AttnTensors&T,const Sched&S){
  AttnUnit u;
  for(int i=0;S.next(i,u);++i){ S.a_ready(u); attn_unit<THRL>(u.bh/NHEAD,u.bh%NHEAD,u.qb,T.Q,T.K,T.V,T.O,T.MK,lds); S.done(u); }
}
#undef SBAR
#undef WAIT_BAR
}

struct Args { const void* in[15]; float* out; unsigned char* ws; int ph_lo, ph_hi; };
#define CAS __attribute__((address_space(4)))
struct Frame {
    LAS unsigned char* lds;
    gu32* ctl;
    unsigned char* ws;
    int tid, lane, wave;
    int vcu, G;
    const CAS Args* ka;
    __device__ __forceinline__ const float* inp(int k) const { return (const float*)ka->in[k]; }
#define FDEF(name, k) __device__ __forceinline__ const float* name() const { return inp(k); }
    FDEF(x, 0) FDEF(c, 1) FDEF(w_ada, 3) FDEF(b_ada, 4) FDEF(g_mix, 5) FDEF(w_in, 6) FDEF(w_o, 7) FDEF(g_ffn, 8) FDEF(w_rg, 9) FDEF(w_re, 10) FDEF(w_up, 11) FDEF(w_gate, 12) FDEF(w_down, 13) FDEF(g_fin, 14)
#undef FDEF
    __device__ __forceinline__ const int* pos() const { return (const int*)ka->in[2]; }
    __device__ __forceinline__ float* out() const { return ka->out; }
};

__device__ __forceinline__ void tr_put(LAS unsigned* T, int nb, int ns, int p, const f32x4 a, const f32x4 b) {
    T[(nb) * 33 + p] = pg8::cvt_pk_bf16(a.x, b.x); T[(nb + ns) * 33 + p] = pg8::cvt_pk_bf16(a.y, b.y);
    T[(nb + 2 * ns) * 33 + p] = pg8::cvt_pk_bf16(a.z, b.z); T[(nb + 3 * ns) * 33 + p] = pg8::cvt_pk_bf16(a.w, b.w);
}
__device__ __forceinline__ void tr_store(LAS unsigned* T, bf16* WT, int K, int n0, int k0, int lane) {
    LDS_WAIT(); asm volatile("" ::: "memory");
#pragma unroll
    for (int i = 0; i < 8; ++i) { const int n = (lane >> 3) + 8 * i, kc = lane & 7; const LAS unsigned* t = T + n * 33 + 4 * kc;
        v4u o; o.x = t[0]; o.y = t[1]; o.z = t[2]; o.w = t[3];
        *(GAS v4u*)(WT + (size_t)(n0 + n) * K + k0 + 8 * kc) = o; }
    LDS_WAIT(); asm volatile("" ::: "memory");
}
__device__ __forceinline__ void tr_tile_gu(const float* gate, const float* up, bf16* WT, int n0, int k0, LAS unsigned* T, int lane) {
    const int pq = lane >> 3, cq = lane & 7, c0 = n0 >> 1;
    f32x4 g0[4], g1[4], u0[4], u1[4];
#pragma unroll
    for (int i = 0; i < 4; ++i) { const int p = pq + 8 * i; const size_t o = (size_t)(k0 + 2 * p) * DEXP + c0 + 4 * cq;
        g0[i] = *(const GAS f32x4*)(gate + o); g1[i] = *(const GAS f32x4*)(gate + o + DEXP); u0[i] = *(const GAS f32x4*)(up + o); u1[i] = *(const GAS f32x4*)(up + o + DEXP); }
#pragma unroll
    for (int i = 0; i < 4; ++i) { const int p = pq + 8 * i; tr_put(T, 8 * cq, 2, p, g0[i], g1[i]); tr_put(T, 8 * cq + 1, 2, p, u0[i], u1[i]); }
    tr_store(T, WT, 1024, n0, k0, lane);
}
__device__ __forceinline__ void tr_tile_d(const float* wd, bf16* WT, int n0, int k0, LAS unsigned* T, int lane) {
    const int pq = lane >> 4, cq = lane & 15;
    f32x4 a[8], b[8];
#pragma unroll
    for (int i = 0; i < 8; ++i) { const int p = pq + 4 * i; const size_t o = (size_t)(k0 + 2 * p) * D + n0 + 4 * cq; a[i] = *(const GAS f32x4*)(wd + o); b[i] = *(const GAS f32x4*)(wd + o + D); }
#pragma unroll
    for (int i = 0; i < 8; ++i) { const int p = pq + 4 * i; tr_put(T, 4 * cq, 1, p, a[i], b[i]); }
    tr_store(T, WT, 512, n0, k0, lane);
}

template <class SrcFn>
__device__ __forceinline__ void tr_tile_gen(const SrcFn& src, int ldw, bf16* WT, int K, int n0, int k0, LAS unsigned* T, int lane) {
    const int pq = lane >> 4, cq = lane & 15; const float* sp = src(n0 + 4 * cq);
    f32x4 a[8], b[8];
#pragma unroll
    for (int i = 0; i < 8; ++i) { const int p = pq + 4 * i;
        if (sp) { a[i] = *(const GAS f32x4*)(sp + (size_t)(k0 + 2 * p) * ldw); b[i] = *(const GAS f32x4*)(sp + (size_t)(k0 + 2 * p + 1) * ldw); }
        else { a[i] = (f32x4){0.f, 0.f, 0.f, 0.f}; b[i] = a[i]; } }
#pragma unroll
    for (int i = 0; i < 8; ++i) { const int p = pq + 4 * i; tr_put(T, 4 * cq, 1, p, a[i], b[i]); }
    tr_store(T, WT, K, n0, k0, lane);
}

__device__ __forceinline__ int prope_dim(int p) { return p < 16 ? 8 * ((p >> 2) & 1) + 4 * (p >> 3) + (p & 3) : p; }
__device__ __forceinline__ int rrope_dim(int p) { return 32 * ((p >> 2) & 1) + 4 * (p >> 3) + (p & 3); }
__device__ __forceinline__ int win_src_col(int n) {
    if (n < 1024) return (n & ~63) + prope_dim(n & 63);
    if (n < 1536) return n;
    if (n < 2560) return (n & ~63) + prope_dim(n & 63);
    if (n < 3584) { const int q = n - 2560, sec = q >> 9, hd = (q >> 6) & 7; return (sec ? 3152 : 2640) + hd * 64 + rrope_dim(q & 63); }
    if (n < 4096) return 3664 + (n - 3584);
    if (n < 4608) return 4176 + (n - 4096);
    if (n < 4672) return 2560 + prope_dim(n - 4608);
    if (n < 4688) return 2624 + (n - 4672);
    return -1;
}

__device__ __forceinline__ void p0_prologue(Frame& F) {
    const int gw = F.vcu * NWAVES + F.wave, NGW = F.G * NWAVES;
    float* modp = (float*)(F.ws + WS_MODP);
    for (int rp2 = 0; rp2 < SUBREPS(20); ++rp2)
    for (int task = gw; task < 24 * 16; task += NGW) {
        const int cg = task % 24, ks = task / 24, j0 = cg * 256 + F.lane * 4;
        f32x4 a0 = {0, 0, 0, 0}, a1 = a0, a2 = a0, a3 = a0;
#pragma unroll 8
        for (int kk = 0; kk < 64; ++kk) { const int k = ks * 64 + kk; const f32x4 w = *(const GAS f32x4*)(F.w_ada() + (size_t)k * 6144 + j0);
            a0 += w * F.c()[0 * D + k]; a1 += w * F.c()[1 * D + k]; a2 += w * F.c()[2 * D + k]; a3 += w * F.c()[3 * D + k]; }
        *(GAS f32x4*)(modp + ((size_t)(ks * 4 + 0) * 6144 + j0)) = a0; *(GAS f32x4*)(modp + ((size_t)(ks * 4 + 1) * 6144 + j0)) = a1;
        *(GAS f32x4*)(modp + ((size_t)(ks * 4 + 2) * 6144 + j0)) = a2; *(GAS f32x4*)(modp + ((size_t)(ks * 4 + 3) * 6144 + j0)) = a3;
    }
    {
        float* c1 = (float*)(F.ws + WS_ROPE1); float* s1 = c1 + (size_t)M * 8;
        float* c2 = (float*)(F.ws + WS_ROPE2); float* s2 = c2 + (size_t)M * 32;
        const int gt = (F.vcu * NWAVES + F.wave) * 64 + F.lane, NGT = NGW * 64;
        for (int rp2 = 0; rp2 < SUBREPS(18); ++rp2)
        for (int i = gt; i < M * 40; i += NGT) {
            const int m = i / 40, j = i % 40; const float p = (float)F.pos()[m];
            if (j < 8) { const float inv = powf(500000.0f, -(float)j / 8.0f); float sn, cs; sincosf(p * inv, &sn, &cs); c1[m * 8 + j] = cs; s1[m * 8 + j] = sn; }
            else { const int jj = j - 8; const float inv = powf(10000.0f, -(float)jj / 32.0f); float sn, cs; sincosf(p * inv, &sn, &cs); c2[m * 32 + jj] = cs; s2[m * 32 + jj] = sn; }
        }
    }
    {
        constexpr int I_IN = (NPAD / 64) * (D / 64), I_O = (D / 64) * (D / 64);
        bf16* wint = (bf16*)(F.ws + WS_WIN); bf16* wot = (bf16*)(F.ws + WS_WO);
        const float* w_in = F.w_in(); const float* w_o = F.w_o();
        LAS unsigned* T = (LAS unsigned*)(F.lds + F.wave * 16384);
        for (int rp2 = 0; rp2 < SUBREPS(19); ++rp2)
        for (int it = gw; it < I_IN + I_O; it += NGW) {
            if (it < I_IN) { const int nb = it / 16, kb = it % 16;
                tr_tile_gen([&](int n) -> const float* { const int sc = win_src_col(n); return sc < 0 ? nullptr : w_in + sc; }, DIN, wint, D, nb * 64, kb * 64, T, F.lane); }
            else { const int r = it - I_IN, nb = r / 16, kb = r % 16;
                tr_tile_gen([&](int n) -> const float* { return w_o + n; }, D, wot, D, nb * 64, kb * 64, T, F.lane); }
        }
    }
}

__device__ __forceinline__ float mod_value(const float* modp, const float* b_ada, int b, int j) {
    float s = 0.f;
#pragma unroll
    for (int ks = 0; ks < 16; ++ks) s += modp[(size_t)(ks * 4 + b) * 6144 + j];
    return s + b_ada[j];
}
__device__ __forceinline__ void p1_norm(Frame& F) {
    const float* modp = (const float*)(F.ws + WS_MODP);
    LAS float* G1 = (LAS float*)F.lds;
    LAS float* S1 = G1 + 4 * D;
    for (int i = F.tid; i < 4 * D; i += NWAVES * 64) { const int b = i >> 10, col = i & 1023;
        const float sh = mod_value(modp, F.b_ada(), b, col), sc = mod_value(modp, F.b_ada(), b, 1024 + col);
        G1[i] = F.g_mix()[col] * (1.f + sc); S1[i] = sh; }
    if (blockIdx.x < 4) { float* mod = (float*)(F.ws + WS_MOD); const int b = blockIdx.x;
        for (int j = F.tid; j < 6144; j += NWAVES * 64) mod[b * 6144 + j] = mod_value(modp, F.b_ada(), b, j); }
    __syncthreads();
    const int gw = F.vcu * NWAVES + F.wave, NGW = F.G * NWAVES;
    bf16* H = (bf16*)(F.ws + WS_H);
    f32x4 nv[4];
    if (gw < M) { const GAS f32x4* xr = (const GAS f32x4*)(F.x() + (size_t)gw * D) + F.lane;
#pragma unroll
        for (int j = 0; j < 4; ++j) nv[j] = xr[64 * j]; }
    for (int m = gw; m < M; m += NGW) {
        const int b = m >> 13;
        f32x4 v[4]; float s = 0.f;
#pragma unroll
        for (int j = 0; j < 4; ++j) v[j] = nv[j];
        if (m + NGW < M) { const GAS f32x4* xr = (const GAS f32x4*)(F.x() + (size_t)(m + NGW) * D) + F.lane;
#pragma unroll
            for (int j = 0; j < 4; ++j) nv[j] = xr[64 * j]; }
#pragma unroll
        for (int j = 0; j < 4; ++j) s += (v[j].x * v[j].x + v[j].y * v[j].y) + (v[j].z * v[j].z + v[j].w * v[j].w);
        const float r = 1.f / sqrtf(wave_sum(s) * (1.f / D) + EPS);
        GAS unsigned long long* o8 = (GAS unsigned long long*)(H + (size_t)m * D) + F.lane;
#pragma unroll
        for (int j = 0; j < 4; ++j) { const int col = 4 * F.lane + 256 * j; const f32x4 g = *(const LAS f32x4*)(G1 + b * D + col), sh = *(const LAS f32x4*)(S1 + b * D + col);
            const f32x4 h = v[j] * r * g + sh;
            o8[64 * j] = (unsigned long long)pk2(h.x, h.y) | ((unsigned long long)pk2(h.z, h.w) << 32); }
    }
    __syncthreads();
}

struct EpiInProj {
    static constexpr bool PERM = true;
    unsigned char* ws;
    __device__ __forceinline__ void operator()(f32x4 (&acc)[2][2][4][2], const pg8::Unit& u, int wr, int wc, int fr, int fq) const {
        const int pn = u.pn; const int row0 = u.pm * 256 + wr * 64 + fr;
        const bool prope = (pn < 4) || (pn >= 6 && pn < 10) || (pn == 18);
        const bool rrope = (pn >= 10 && pn < 14);
        const bool roped = rrope || (prope && (wc & 1) == 0 && !(pn == 18 && wc != 0));
        const int g = 4 * (wc & 1) + fq;
        const bool act = rrope || (fq < 2);
        const int tl = rrope ? 32 : 8;
        const float* ct = (const float*)(ws + (rrope ? WS_ROPE2 : WS_ROPE1)) + 4 * (act ? g : 0); const float* stb = ct + (size_t)M * tl;
        bf16* base; int ld, colt; float sc = 1.f;
        if (pn < 2) { base = (bf16*)(ws + WS_QA); ld = 512; colt = pn * 256; sc = C2; }
        else if (pn < 4) { base = (bf16*)(ws + WS_KA); ld = 512; colt = (pn - 2) * 256; }
        else if (pn < 6) { base = (bf16*)(ws + WS_VA); ld = 512; colt = (pn - 4) * 256; }
        else if (pn < 10) { base = (bf16*)(ws + WS_QI); ld = 1024; colt = (pn - 6) * 256; }
        else if (pn < 12) { base = (bf16*)(ws + WS_QB); ld = 512; colt = (pn - 10) * 256; }
        else if (pn < 14) { base = (bf16*)(ws + WS_KB); ld = 512; colt = (pn - 12) * 256; sc = 0.125f; }
        else if (pn < 16) { base = (bf16*)(ws + WS_VB); ld = 512; colt = (pn - 14) * 256; }
        else if (pn < 18) { base = (bf16*)(ws + WS_GB); ld = 512; colt = (pn - 16) * 256; }
        else { base = (bf16*)(ws + WS_KI); ld = 64; colt = 0; }
        int colA[2], colB[2];
#pragma unroll
        for (int bj = 0; bj < 2; ++bj) { const int col = bj * 128 + wc * 32 + 8 * fq, hb = col & ~63;
            if (rrope) { colA[bj] = hb + 4 * g; colB[bj] = hb + 32 + 4 * g; }
            else if (prope && (wc & 1) == 0 && fq < 2 && !(pn == 18 && wc != 0)) { colA[bj] = hb + 4 * g; colB[bj] = hb + 8 + 4 * g; }
            else { colA[bj] = col; colB[bj] = col + 4; } }
        float* wi = (float*)(ws + WS_WI);
        f32x4 cnx = {0.f, 0.f, 0.f, 0.f}, snx = cnx;
        if (roped) { cnx = *(const GAS f32x4*)(ct + (size_t)row0 * tl); snx = *(const GAS f32x4*)(stb + (size_t)row0 * tl); }
#pragma unroll
        for (int ai = 0; ai < 2; ++ai)
#pragma unroll
            for (int m = 0; m < 4; ++m) { const int row = row0 + ai * 128 + m * 16;
                if (roped) {
                    const f32x4 cs = cnx, sn = snx;
                    if (!(ai == 1 && m == 3)) { const int rn = row0 + ((m == 3) ? 128 : ai * 128 + (m + 1) * 16);
                        cnx = *(const GAS f32x4*)(ct + (size_t)rn * tl); snx = *(const GAS f32x4*)(stb + (size_t)rn * tl); }
#pragma unroll
                    for (int bj = 0; bj < 2; ++bj) { const f32x4 x1 = acc[ai][bj][m][0], x2 = acc[ai][bj][m][1];
                        if (act) { acc[ai][bj][m][0] = x1 * cs - x2 * sn; acc[ai][bj][m][1] = x2 * cs + x1 * sn; } }
                }
                if (pn < 18) {
#pragma unroll
                    for (int bj = 0; bj < 2; ++bj) {
                        const f32x4 v0 = acc[ai][bj][m][0] * sc, v1 = acc[ai][bj][m][1] * sc; v2u wa, wb;
                        wa.x = pg8::cvt_pk_bf16(v0[0], v0[1]); wa.y = pg8::cvt_pk_bf16(v0[2], v0[3]); wb.x = pg8::cvt_pk_bf16(v1[0], v1[1]); wb.y = pg8::cvt_pk_bf16(v1[2], v1[3]);
                        bf16* rp = base + (size_t)row * ld + colt;
                        *(GAS v2u*)(rp + colA[bj]) = wa; *(GAS v2u*)(rp + colB[bj]) = wb; }
                } else {
                    const int col = wc * 32 + 8 * fq;
                    const f32x4 v0 = acc[ai][0][m][0], v1 = acc[ai][0][m][1];
                    if (col < 64) { v2u wa, wb; wa.x = pg8::cvt_pk_bf16(v0[0], v0[1]); wa.y = pg8::cvt_pk_bf16(v0[2], v0[3]); wb.x = pg8::cvt_pk_bf16(v1[0], v1[1]); wb.y = pg8::cvt_pk_bf16(v1[2], v1[3]);
                        *(GAS v2u*)(base + (size_t)row * 64 + colA[0]) = wa; *(GAS v2u*)(base + (size_t)row * 64 + colB[0]) = wb; }
                    else if (col < 80) { *(GAS f32x4*)(wi + (size_t)row * 16 + (col - 64)) = v0 * 0.25f; *(GAS f32x4*)(wi + (size_t)row * 16 + (col - 64) + 4) = v1 * 0.25f; }
                }
                asm volatile("" ::: "memory");
            }
    }
};

struct EpiOutProj {
    static constexpr bool PERM = true;
    bf16* mix; const float* mod;
    __device__ __forceinline__ void operator()(f32x4 (&acc)[2][2][4][2], const pg8::Unit& u, int wr, int wc, int fr, int fq) const {
        const int row0 = u.pm * 256 + wr * 64 + fr; const int b = (u.pm * 256) >> 13;
#pragma unroll
        for (int bj = 0; bj < 2; ++bj) { const int col = u.pn * 256 + bj * 128 + wc * 32 + 8 * fq;
            const f32x4 g0 = *(const GAS f32x4*)(mod + b * 6144 + 2048 + col), g1 = *(const GAS f32x4*)(mod + b * 6144 + 2048 + col + 4);
#pragma unroll
            for (int ai = 0; ai < 2; ++ai)
#pragma unroll
                for (int m = 0; m < 4; ++m) { const f32x4 v0 = acc[ai][bj][m][0] * g0, v1 = acc[ai][bj][m][1] * g1; v4u w;
                    w.x = pg8::cvt_pk_bf16(v0[0], v0[1]); w.y = pg8::cvt_pk_bf16(v0[2], v0[3]); w.z = pg8::cvt_pk_bf16(v1[0], v1[1]); w.w = pg8::cvt_pk_bf16(v1[2], v1[3]);
                    *(GAS v4u*)(mix + (size_t)(row0 + ai * 128 + m * 16) * D + col) = w; } }
    }
};

__device__ __forceinline__ float ret_log_gamma(int h) { return log1pf(-exp2f(-5.0f - (float)h)); }
__device__ __forceinline__ int crow(int r, int hi) { return (r & 3) + 8 * (r >> 2) + 4 * hi; }

typedef short v4i16_t __attribute__((ext_vector_type(4)));
constexpr size_t WS_TOT = WS_MASK;
constexpr size_t WS_CARRY = WS_MASK + 8 * MiB;
__device__ __forceinline__ void ra_states(Frame& F) {
    const bf16* KB = (const bf16*)(F.ws + WS_KB); const bf16* VB = (const bf16*)(F.ws + WS_VB);
    float* ST = (float*)(F.ws + WS_ST); float* TOT = (float*)(F.ws + WS_TOT);
    const int lane = F.lane, r32 = lane & 31, hi = lane >> 5, gi = lane & 15, gg = lane >> 4, wave = F.wave;
    const int half = wave >> 2, et = (wave >> 1) & 1, dt = wave & 1, ht = F.tid & 255;
    for (int unit = F.vcu; unit < 256; unit += F.G) {
        const int bh = unit >> 3, h = bh & 7, b = bh >> 3, c0 = (unit & 7) * 16 + half * 8;
        const float lg = ret_log_gamma(h), g = __expf(64.f * lg);
        f32x16 acc = f32x16{};
        const int offA = (((gi >> 2) + 8 * hi) * 64 + 32 * et + 16 * (gg & 1) + 4 * (gi & 3)) * 2;
        const int offB = (((gi >> 2) + 8 * hi) * 64 + 32 * dt + 16 * (gg & 1) + 4 * (gi & 3)) * 2;
        v4u nk[2], nvv[2];
#define RA_LOAD(cc) do { const size_t t0_ = (size_t)b * SEQ + (size_t)(cc) * 64; _Pragma("unroll") for (int p = 0; p < 2; ++p) { const int idx = ht + 256 * p, row = idx >> 3, q = idx & 7; \
            nk[p] = *(const GAS v4u*)(KB + (t0_ + row) * 512 + h * 64 + q * 8); nvv[p] = *(const GAS v4u*)(VB + (t0_ + row) * 512 + h * 64 + q * 8); } } while (0)
        RA_LOAD(c0);
#pragma unroll 1
        for (int i = 0; i < 8; ++i) {
            const int c = c0 + i;
            LAS unsigned short* Ks = (LAS unsigned short*)(F.lds + (half * 2 + (i & 1)) * 16384);
            LAS unsigned short* Vs = Ks + 4096;
#pragma unroll
            for (int p = 0; p < 2; ++p) { const int idx = ht + 256 * p, row = idx >> 3, q = idx & 7;
                v4u kk = nk[p]; const float z = __expf((63.f - (float)row) * lg); unsigned* kw = (unsigned*)&kk;
#pragma unroll
                for (int e = 0; e < 4; ++e) kw[e] = pg8::cvt_pk_bf16(bf2f((unsigned short)(kw[e] & 0xffff)) * z, bf2f((unsigned short)(kw[e] >> 16)) * z);
                *(LAS v4u*)(Ks + row * 64 + q * 8) = kk; *(LAS v4u*)(Vs + row * 64 + q * 8) = nvv[p]; }
            if (i < 7) RA_LOAD(c + 1);
            { float* st = ST + ((size_t)bh * 128 + c) * 4096;
#pragma unroll
                for (int r = 0; r < 16; ++r) st[(32 * et + crow(r, hi)) * 64 + 32 * dt + r32] = acc[r]; }
#pragma unroll
            for (int r = 0; r < 16; ++r) acc[r] *= g;
            __syncthreads();
#pragma unroll
            for (int ks = 0; ks < 4; ++ks) {
                const LAS unsigned char* va = (const LAS unsigned char*)Vs + offA + ks * 16 * 64 * 2; const LAS unsigned char* kb = (const LAS unsigned char*)Ks + offB + ks * 16 * 64 * 2;
                const v4i16_t a0 = __builtin_amdgcn_ds_read_tr16_b64_v4i16((LAS v4i16_t*)va), a1 = __builtin_amdgcn_ds_read_tr16_b64_v4i16((LAS v4i16_t*)(va + 4 * 64 * 2));
                const v4i16_t b0 = __builtin_amdgcn_ds_read_tr16_b64_v4i16((LAS v4i16_t*)kb), b1 = __builtin_amdgcn_ds_read_tr16_b64_v4i16((LAS v4i16_t*)(kb + 4 * 64 * 2));
                acc = __builtin_amdgcn_mfma_f32_32x32x16_bf16((bf16x8){a0[0], a0[1], a0[2], a0[3], a1[0], a1[1], a1[2], a1[3]}, (bf16x8){b0[0], b0[1], b0[2], b0[3], b1[0], b1[1], b1[2], b1[3]}, acc, 0, 0, 0); }
        }
#undef RA_LOAD
        { float* tt = TOT + ((size_t)bh * 16 + (unit & 7) * 2 + half) * 4096;
#pragma unroll
            for (int r = 0; r < 16; ++r) tt[(32 * et + crow(r, hi)) * 64 + 32 * dt + r32] = acc[r]; }
        __syncthreads();
    }
}
__device__ __forceinline__ void rb_carry(Frame& F) {
    const float* TOT = (const float*)(F.ws + WS_TOT); float* CAR = (float*)(F.ws + WS_CARRY);
    const int gt = (F.vcu * NWAVES + F.wave) * 64 + F.lane, NGT = F.G * NWAVES * 64;
    for (int i = gt; i < 32 * 4096; i += NGT) {
        const int bh = i >> 12, el = i & 4095, h = bh & 7;
        const float g8 = __expf(512.f * ret_log_gamma(h));
        const float* p = TOT + (size_t)bh * 16 * 4096 + el; float* q = CAR + (size_t)bh * 16 * 4096 + el; float run = 0.f;
#pragma unroll
        for (int gI = 0; gI < 16; ++gI) { const float t = p[(size_t)gI * 4096]; q[(size_t)gI * 4096] = run; run = run * g8 + t; }
    }
}
__device__ __forceinline__ void r3_out(Frame& F) {
    const int gw = F.vcu * NWAVES + F.wave, NGW = F.G * NWAVES;
    LAS unsigned short* Vs = (LAS unsigned short*)(F.lds + F.wave * 16384);
    const bf16* QB = (const bf16*)(F.ws + WS_QB); const bf16* KB = (const bf16*)(F.ws + WS_KB); const bf16* VB = (const bf16*)(F.ws + WS_VB); const bf16* GB = (const bf16*)(F.ws + WS_GB);
    const float* ST = (const float*)(F.ws + WS_ST); const float* CAR = (const float*)(F.ws + WS_CARRY); bf16* Y = (bf16*)(F.ws + WS_Y);
    const int lane = F.lane, r32 = lane & 31, hi = lane >> 5, gi = lane & 15, gg = lane >> 4;
    const int vtr_off = (((gi >> 2) + 4 * hi) * 64 + 16 * (gg & 1) + 4 * (gi & 3)) * 2;
    for (int u = gw; u < NB * 8 * 128; u += NGW) {
        const int c = u & 127, h = (u >> 7) & 7, b = u >> 10;
        const float lg = ret_log_gamma(h), gpc = __expf(64.f * (float)(c & 7) * lg);
        const size_t tok0 = (size_t)b * SEQ + (size_t)c * 64;
        { const GAS v4u* vp = (const GAS v4u*)(VB + (tok0 + lane) * 512 + h * 64);
#pragma unroll
            for (int q = 0; q < 8; ++q) *(LAS v4u*)(Vs + lane * 64 + q * 8) = vp[q]; }
        bf16x8 qf[2][4], pf[2][4];
#pragma unroll
        for (int t = 0; t < 2; ++t)
#pragma unroll
            for (int ks = 0; ks < 4; ++ks) {
                qf[t][ks] = *(const GAS bf16x8*)(QB + (tok0 + 32 * t + r32) * 512 + h * 64 + 16 * ks + 8 * hi);
                const float* sp = ST + (size_t)u * 4096 + (32 * t + r32) * 64 + 16 * ks + 8 * hi;
                const float* cp = CAR + ((size_t)(u >> 7) * 16 + (c >> 3)) * 4096 + (32 * t + r32) * 64 + 16 * ks + 8 * hi;
                const f32x4 s0 = *(const GAS f32x4*)sp + *(const GAS f32x4*)cp * gpc, s1 = *(const GAS f32x4*)(sp + 4) + *(const GAS f32x4*)(cp + 4) * gpc;
                v4u w; w.x = pg8::cvt_pk_bf16(s0.x, s0.y); w.y = pg8::cvt_pk_bf16(s0.z, s0.w); w.z = pg8::cvt_pk_bf16(s1.x, s1.y); w.w = pg8::cvt_pk_bf16(s1.z, s1.w);
                pf[t][ks] = __builtin_bit_cast(bf16x8, w); }
        float emr[16];
#pragma unroll
        for (int r = 0; r < 16; ++r) emr[r] = __expf(-(float)crow(r, hi) * lg);
        const float em32 = __expf(-32.f * lg);
        LDS_WAIT(); asm volatile("" ::: "memory");
#pragma unroll
        for (int nt = 0; nt < 2; ++nt) {
            const int n = 32 * nt + r32;
            const float en = __expf((float)n * lg), xi = __expf((float)(n + 1) * lg);
            f32x16 y[2]; y[0] = f32x16{}; y[1] = f32x16{};
#pragma unroll
            for (int et = 0; et < 2; ++et)
#pragma unroll
                for (int ks = 0; ks < 4; ++ks) y[et] = __builtin_amdgcn_mfma_f32_32x32x16_bf16(pf[et][ks], qf[nt][ks], y[et], 0, 0, 0);
#pragma unroll
            for (int r = 0; r < 16; ++r) { y[0][r] *= xi; y[1][r] *= xi; }
#pragma unroll
            for (int mt = 0; mt <= nt; ++mt) {
                f32x16 st = f32x16{};
#pragma unroll
                for (int ks = 0; ks < 4; ++ks) { const bf16x8 kf = *(const GAS bf16x8*)(KB + (tok0 + 32 * mt + r32) * 512 + h * 64 + 16 * ks + 8 * hi);
                    st = __builtin_amdgcn_mfma_f32_32x32x16_bf16(kf, qf[nt][ks], st, 0, 0, 0); }
                const float enm = mt ? en * em32 : en;
#pragma unroll
                for (int r = 0; r < 16; ++r) { const int m = 32 * mt + crow(r, hi); st[r] = (n >= m) ? st[r] * (enm * emr[r]) : 0.f; }
#pragma unroll
                for (int s2 = 0; s2 < 2; ++s2) {
                    v4u pw; pw.x = pg8::cvt_pk_bf16(st[8 * s2 + 0], st[8 * s2 + 1]); pw.y = pg8::cvt_pk_bf16(st[8 * s2 + 2], st[8 * s2 + 3]); pw.z = pg8::cvt_pk_bf16(st[8 * s2 + 4], st[8 * s2 + 5]); pw.w = pg8::cvt_pk_bf16(st[8 * s2 + 6], st[8 * s2 + 7]);
                    const bf16x8 pb = __builtin_bit_cast(bf16x8, pw);
#pragma unroll
                    for (int et = 0; et < 2; ++et) {
                        const LAS unsigned char* vb = (const LAS unsigned char*)Vs + vtr_off + ((32 * mt + 16 * s2) * 64 + 32 * et) * 2;
                        const v4i16_t lo = __builtin_amdgcn_ds_read_tr16_b64_v4i16((LAS v4i16_t*)vb), hh = __builtin_amdgcn_ds_read_tr16_b64_v4i16((LAS v4i16_t*)(vb + 8 * 64 * 2));
                        const bf16x8 va = (bf16x8){lo[0], lo[1], lo[2], lo[3], hh[0], hh[1], hh[2], hh[3]};
                        y[et] = __builtin_amdgcn_mfma_f32_32x32x16_bf16(va, pb, y[et], 0, 0, 0); }
                }
            }
            float sm = 0.f;
#pragma unroll
            for (int r = 0; r < 16; ++r) sm += y[0][r] + y[1][r];
            sm += __shfl_xor(sm, 32);
            const float mu = sm * (1.f / 64.f); float q = 0.f;
#pragma unroll
            for (int r = 0; r < 16; ++r) { y[0][r] -= mu; y[1][r] -= mu; q += y[0][r] * y[0][r] + y[1][r] * y[1][r]; }
            q += __shfl_xor(q, 32);
            const float rs = __builtin_amdgcn_rsqf(q * (1.f / 64.f) + EPS);
            const size_t tok = tok0 + n;
#pragma unroll
            for (int et = 0; et < 2; ++et)
#pragma unroll
                for (int g4 = 0; g4 < 4; ++g4) { const int e0 = 32 * et + 8 * g4 + 4 * hi;
                    const v2u gv = *(const GAS v2u*)(GB + tok * 512 + h * 64 + e0);
                    float o4[4];
#pragma unroll
                    for (int i = 0; i < 4; ++i) { const float g = bf2f((unsigned short)((i & 1) ? ((i & 2) ? gv.y : gv.x) >> 16 : ((i & 2) ? gv.y : gv.x) & 0xffff));
                        const float sg = g * __builtin_amdgcn_rcpf(1.f + __expf(-g)); o4[i] = sg * y[et][4 * g4 + i] * rs; }
                    v2u ov; ov.x = pg8::cvt_pk_bf16(o4[0], o4[1]); ov.y = pg8::cvt_pk_bf16(o4[2], o4[3]);
                    *(GAS v2u*)(Y + tok * D + 512 + h * 64 + e0) = ov; }
        }
        LDS_WAIT(); asm volatile("" ::: "memory");
    }
}

__device__ __forceinline__ void p_norm2_route(Frame& F) {
    const float* mod = (const float*)(F.ws + WS_MOD);
    LAS f32x4* RG = (LAS f32x4*)F.lds;
    LAS f32x4* RE = (LAS f32x4*)(F.lds + 16384);
    { const float* wrg = F.w_rg(); const float* wre = F.w_re();
        for (int i = F.tid; i < 1024; i += NWAVES * 64) { const int ln = (i & 255) >> 2, j = i >> 8, t = i & 3; RG[(j * 4 + t) * 64 + ln] = *(const GAS f32x4*)(wrg + (size_t)i * 4); }
        for (int i = F.tid; i < 4 * 1024 * 2; i += NWAVES * 64) { const int g = i >> 11, row = (i >> 1) & 1023, hf = i & 1, ln = (row & 255) >> 2, j = row >> 8, t = row & 3;
            RE[g * 2048 + ((j * 4 + t) * 2 + hf) * 64 + ln] = *(const GAS f32x4*)(wre + ((size_t)g * 1024 + row) * 8 + hf * 4); } }
    __syncthreads();
    const int gw = F.vcu * NWAVES + F.wave, NGW = F.G * NWAVES;
    const float* X = F.x(); const bf16* MIX = (const bf16*)(F.ws + WS_MIX); bf16* H2 = (bf16*)(F.ws + WS_H2);
    unsigned* ltok = (unsigned*)(F.ws + WS_ROUTE); float* lw = (float*)(F.ws + WS_ROUTE + 4 * MiB);
    f32x4 nv[4]; v2u nm[4];
#define N2_LOAD(mm) do { const GAS f32x4* xr = (const GAS f32x4*)(X + (size_t)(mm) * D) + F.lane; \
        _Pragma("unroll") for (int j = 0; j < 4; ++j) { nv[j] = xr[64 * j]; nm[j] = *(const GAS v2u*)(MIX + (size_t)(mm) * D + 4 * F.lane + 256 * j); } } while (0)
    if (gw < M) N2_LOAD(gw);
    for (int m = gw; m < M; m += NGW) {
        const int b = m >> 13;
        f32x4 v[4]; float s = 0.f;
#pragma unroll
        for (int j = 0; j < 4; ++j) { v[j] = nv[j]; v[j].x += bf2f((unsigned short)(nm[j].x & 0xffff)); v[j].y += bf2f((unsigned short)(nm[j].x >> 16)); v[j].z += bf2f((unsigned short)(nm[j].y & 0xffff)); v[j].w += bf2f((unsigned short)(nm[j].y >> 16)); }
        if (m + NGW < M) N2_LOAD(m + NGW);
#pragma unroll
        for (int j = 0; j < 4; ++j) s += (v[j].x * v[j].x + v[j].y * v[j].y) + (v[j].z * v[j].z + v[j].w * v[j].w);
        const float r = 1.f / sqrtf(wave_sum(s) * (1.f / D) + EPS);
        GAS unsigned long long* o8 = (GAS unsigned long long*)(H2 + (size_t)m * D) + F.lane;
        f32x4 lg = {0.f, 0.f, 0.f, 0.f};
#pragma unroll
        for (int j = 0; j < 4; ++j) { const int col = 4 * F.lane + 256 * j;
            const f32x4 g = *(const GAS f32x4*)(F.g_ffn() + col) * (*(const GAS f32x4*)(mod + b * 6144 + 4096 + col) + 1.f), sh = *(const GAS f32x4*)(mod + b * 6144 + 3072 + col);
            v[j] = v[j] * r * g + sh;
            o8[64 * j] = (unsigned long long)pk2(v[j].x, v[j].y) | ((unsigned long long)pk2(v[j].z, v[j].w) << 32);
            const LAS f32x4* wg = RG + (j * 4) * 64 + F.lane;
            lg += wg[0] * v[j].x; lg += wg[64] * v[j].y; lg += wg[128] * v[j].z; lg += wg[192] * v[j].w; }
        lg.x = wave_sum(lg.x); lg.y = wave_sum(lg.y); lg.z = wave_sum(lg.z); lg.w = wave_sum(lg.w);
        int grp = 0; float mx = lg.x;
        if (lg.y > mx) { mx = lg.y; grp = 1; } if (lg.z > mx) { mx = lg.z; grp = 2; } if (lg.w > mx) { mx = lg.w; grp = 3; }
        const float pgrp = 1.f / (expf(lg.x - mx) + expf(lg.y - mx) + expf(lg.z - mx) + expf(lg.w - mx));
        f32x4 f0 = {0.f, 0.f, 0.f, 0.f}, f1 = f0;
        const LAS f32x4* reg = RE + grp * 2048 + F.lane;
#pragma unroll
        for (int j = 0; j < 4; ++j) { const LAS f32x4* we = reg + (j * 8) * 64;
            f0 += we[0] * v[j].x; f1 += we[64] * v[j].x; f0 += we[128] * v[j].y; f1 += we[192] * v[j].y; f0 += we[256] * v[j].z; f1 += we[320] * v[j].z; f0 += we[384] * v[j].w; f1 += we[448] * v[j].w; }
        float fe[8];
        fe[0] = wave_sum(f0.x); fe[1] = wave_sum(f0.y); fe[2] = wave_sum(f0.z); fe[3] = wave_sum(f0.w); fe[4] = wave_sum(f1.x); fe[5] = wave_sum(f1.y); fe[6] = wave_sum(f1.z); fe[7] = wave_sum(f1.w);
        int i1 = 0; float m1 = fe[0];
#pragma unroll
        for (int e = 1; e < 8; ++e) if (fe[e] > m1) { m1 = fe[e]; i1 = e; }
        int i2 = -1; float m2 = -INFINITY;
#pragma unroll
        for (int e = 0; e < 8; ++e) if (e != i1 && fe[e] > m2) { m2 = fe[e]; i2 = e; }
        const float e2 = expf(m2 - m1); const float w1 = pgrp / (1.f + e2), w2 = pgrp * e2 / (1.f + e2);
        if (F.lane < 2) { const int e = grp * 8 + (F.lane ? i2 : i1); const float w = F.lane ? w2 : w1;
            const unsigned p = __hip_atomic_fetch_add((unsigned*)(F.ctl + CW_ECNT + 64 * e), 1u, RLX_AGENT);
            ltok[(size_t)e * M + p] = (unsigned)m | ((unsigned)F.lane << 31); lw[(size_t)e * M + p] = w; }
    }
    __syncthreads();
}
__device__ __forceinline__ void p_expert_convert(Frame& F, int part, int nparts) {
    const int gw = F.vcu * NWAVES + F.wave, NGW = F.G * NWAVES;
    int ln = F.lane; asm volatile("" : "+v"(ln));
    LAS unsigned* T = (LAS unsigned*)(F.lds + F.wave * 16384);
    bf16* wgu = (bf16*)(F.ws + WS_WGU); bf16* wd = (bf16*)(F.ws + WS_WD);
    constexpr int I_GU = NEXP * 16 * 16, I_D = NEXP * 16 * 8;
    int k = 0;
    for (int it = gw; it < I_GU + I_D; it += NGW, ++k) {
        if (k % nparts != part) continue;
        if (it < I_GU) { const int e = it >> 8, r = it & 255, nt = r >> 4, kt = r & 15;
            tr_tile_gu(F.w_gate() + (size_t)e * D * DEXP, F.w_up() + (size_t)e * D * DEXP, wgu + (size_t)e * 1024 * 1024, nt * 64, kt * 64, T, ln); }
        else { const int q = it - I_GU, e = q >> 7, r = q & 127, nt = r >> 3, kt = r & 7;
            tr_tile_d(F.w_down() + (size_t)e * DEXP * D, wd + (size_t)e * 1024 * 512, nt * 64, kt * 64, T, ln); }
    }
}

constexpr int MOE_MAXU = 5;
struct MoeSched {
    int G, c, nunits; LAS int* blkstart; LAS unsigned* tok; bool gather;
    __device__ __forceinline__ bool next(int i, pg8::Unit& u) const {
        const int L = i * G + c; if (L >= nunits || i >= MOE_MAXU) return false;
        const int blk = L >> 2, pnl = L & 3; int e = 0;
#pragma unroll 1
        for (int k = 1; k < NEXP; ++k) if (blkstart[k] <= blk) e = k;
        u.pm = i | (blk << 8); u.pn = e * 4 + pnl; return true;
    }
    __device__ __forceinline__ int arow(const pg8::Unit& u, int rt) const {
        if (gather) { const unsigned t = tok[(u.pm & 255) * 256 + rt]; return (int)(t == 0xffffffffu ? 0u : (t & 0x7fffffffu)); }
        return (u.pm >> 8) * 256 + rt;
    }
    __device__ __forceinline__ int brow0(const pg8::Unit& u) const { return u.pn * 256; }
};
__device__ __forceinline__ int moe_tables(Frame& F, LAS int* blkstart, LAS unsigned* tok, LAS float* wts) {
    if (F.tid == 0) { int acc = 0; for (int e = 0; e < NEXP; ++e) { blkstart[e] = acc; const unsigned cnt = __hip_atomic_load((unsigned*)(F.ctl + CW_ECNT + 64 * e), RLX_AGENT); acc += (int)((cnt + 255u) >> 8); } blkstart[NEXP] = acc; }
    __syncthreads();
    const int nunits = blkstart[NEXP] * 4;
    const unsigned* ltok = (const unsigned*)(F.ws + WS_ROUTE); const float* lw = (const float*)(F.ws + WS_ROUTE + 4 * MiB);
    for (int i = 0; i < MOE_MAXU; ++i) { const int L = i * F.G + F.vcu; if (L >= nunits) break;
        const int blk = L >> 2; int e = 0;
        for (int k = 1; k < NEXP; ++k) if (blkstart[k] <= blk) e = k;
        const unsigned cnt = __hip_atomic_load((unsigned*)(F.ctl + CW_ECNT + 64 * e), RLX_AGENT);
        for (int r = F.tid; r < 256; r += NWAVES * 64) { const unsigned p = (unsigned)(blk - blkstart[e]) * 256u + (unsigned)r;
            tok[i * 256 + r] = p < cnt ? ltok[(size_t)e * M + p] : 0xffffffffu; wts[i * 256 + r] = p < cnt ? lw[(size_t)e * M + p] : 0.f; } }
    __syncthreads();
    return nunits;
}
struct EpiMoe1 {
    static constexpr bool PERM = true;
    bf16* act;
    __device__ __forceinline__ void operator()(f32x4 (&acc)[2][2][4][2], const pg8::Unit& u, int wr, int wc, int fr, int fq) const {
        const int blk = u.pm >> 8, pnl = u.pn & 3; const int row0 = blk * 256 + wr * 64 + fr;
#pragma unroll
        for (int bj = 0; bj < 2; ++bj) { const int ac = pnl * 128 + (bj * 128 + wc * 32 + 8 * fq) / 2;
#pragma unroll
            for (int ai = 0; ai < 2; ++ai)
#pragma unroll
                for (int m = 0; m < 4; ++m) { const f32x4 v0 = acc[ai][bj][m][0], v1 = acc[ai][bj][m][1];
                    const float a0 = v0[0] / (1.f + __expf(-v0[0])) * v0[1], a1 = v0[2] / (1.f + __expf(-v0[2])) * v0[3];
                    const float a2 = v1[0] / (1.f + __expf(-v1[0])) * v1[1], a3 = v1[2] / (1.f + __expf(-v1[2])) * v1[3];
                    v2u w; w.x = pg8::cvt_pk_bf16(a0, a1); w.y = pg8::cvt_pk_bf16(a2, a3);
                    *(GAS v2u*)(act + (size_t)(row0 + ai * 128 + m * 16) * DEXP + ac) = w; } }
    }
};
struct EpiMoe2 {
    static constexpr bool PERM = true;
    bf16* c0; bf16* c1; LAS unsigned* tok; LAS float* wts;
    __device__ __forceinline__ void operator()(f32x4 (&acc)[2][2][4][2], const pg8::Unit& u, int wr, int wc, int fr, int fq) const {
        const int li = u.pm & 255, pnl = u.pn & 3;
#pragma unroll
        for (int ai = 0; ai < 2; ++ai)
#pragma unroll
            for (int m = 0; m < 4; ++m) { const int rt = ai * 128 + wr * 64 + m * 16 + fr; const unsigned en = tok[li * 256 + rt]; const float w = wts[li * 256 + rt];
                if (en != 0xffffffffu) { bf16* dst = ((en >> 31) ? c1 : c0) + (size_t)(en & 0x7fffffffu) * D + pnl * 256 + wc * 32 + 8 * fq;
#pragma unroll
                    for (int bj = 0; bj < 2; ++bj) { const f32x4 v0 = acc[ai][bj][m][0] * w, v1 = acc[ai][bj][m][1] * w; v4u o;
                        o.x = pg8::cvt_pk_bf16(v0[0], v0[1]); o.y = pg8::cvt_pk_bf16(v0[2], v0[3]); o.z = pg8::cvt_pk_bf16(v1[0], v1[1]); o.w = pg8::cvt_pk_bf16(v1[2], v1[3]);
                        *(GAS v4u*)(dst + bj * 128) = o; } } }
    }
};

typedef _Float16 h16x2 __attribute__((ext_vector_type(2)));
__device__ __forceinline__ unsigned pk_f16_rtz(float a, float b) { return __builtin_bit_cast(unsigned, __builtin_amdgcn_cvt_pkrtz(a, b)); }
__device__ __forceinline__ unsigned sortable16x2(unsigned x) { const unsigned m = ((x >> 15) & 0x00010001u) * 0xFFFFu; return x ^ (m | 0x80008000u); }
constexpr int IDX_HS = 257;
constexpr int IDX_WT_OFF = 68 * 1024, IDX_RH_OFF = 72 * 1024, IDX_P2_OFF = IDX_RH_OFF + 32 * IDX_HS * 4, IDX_P2_BYTES = 4480;
static_assert(IDX_P2_OFF + 8 * IDX_P2_BYTES <= RING_BYTES + AUX_BYTES, "indexer LDS map");
template <int NC>
__device__ __forceinline__ void hist_find(LAS unsigned* H, int lane, unsigned K, unsigned& bsel, unsigned& above, unsigned& atb) {
    unsigned t[4];
#pragma unroll
    for (int q = 0; q < 4; ++q) { unsigned a = 0;
#pragma unroll
        for (int c = 0; c < NC; ++c) a += H[c * IDX_HS + 4 * lane + q];
        t[q] = a; }
    const unsigned ls = (t[0] + t[1]) + (t[2] + t[3]);
    unsigned suf = ls;
#pragma unroll
    for (int o = 1; o < 64; o <<= 1) { const unsigned v = __shfl_down(suf, o); if (lane + o < 64) suf += v; }
    unsigned ab = suf - ls; bool found = false; unsigned fb = 0, fa = 0, ft = 0;
#pragma unroll
    for (int q = 3; q >= 0; --q) { if (!found && ab < K && ab + t[q] >= K) { found = true; fb = 4 * lane + q; fa = ab; ft = t[q]; } ab += t[q]; }
    const unsigned long long bal = __ballot(found);
    const int src = bal ? (int)__builtin_ctzll(bal) : 0;
    bsel = __shfl(fb, src); above = __shfl(fa, src); atb = __shfl(ft, src);
}
__device__ __forceinline__ void sel_load(v4u (&ch)[16], const unsigned short* srow, int n, int lane) {
    const int nchunks = n >> 3;
#pragma unroll
    for (int j = 0; j < 16; ++j) { const int c = lane + 64 * j;
        unsigned off = (unsigned)c * 16u; asm volatile("" : "+v"(off));
        if (c < nchunks) ch[j] = *(const GAS v4u*)((const char*)srow + off); else ch[j] = (v4u){0u, 0u, 0u, 0u}; }
}
__device__ __forceinline__ unsigned pk_max_u16(unsigned a, unsigned b) { unsigned r; asm("v_pk_max_u16 %0, %1, %2" : "=v"(r) : "v"(a), "v"(b)); return r; }
__device__ __forceinline__ unsigned pk_min_u16(unsigned a, unsigned b) { unsigned r; asm("v_pk_min_u16 %0, %1, %2" : "=v"(r) : "v"(a), "v"(b)); return r; }
__device__ __forceinline__ void sel_compute(const v4u (&ch)[16], const unsigned short* srow, int n, unsigned char* mrow, LAS unsigned* RH, LAS unsigned* P2, int lane) {
    const int nchunks = n >> 3;
    if (n <= 256) {
#pragma unroll 1
        for (int j = 0; j < 16; ++j) { const int c = lane + 64 * j; mrow[c] = (c < nchunks) ? (unsigned char)0xFF : (unsigned char)0; }
        return;
    }
    unsigned b1, above1, at1; hist_find<1>(RH, lane, 256u, b1, above1, at1);
    for (int i = lane; i < 4 * IDX_HS; i += 64) P2[i] = 0u;
    LAS unsigned* hb = P2 + (lane & 3) * IDX_HS;
    unsigned pat = (b1 << 8) | (b1 << 24), c256 = 0x01000100u, c1 = 0x00010001u;
    asm volatile("" : "+v"(pat), "+v"(c256), "+v"(c1));
#pragma unroll
    for (int j = 0; j < 16; ++j) { if (64 * j < nchunks) {
#pragma unroll
        for (int i = 0; i < 4; ++i) { const unsigned w = ch[j][i]; const unsigned m = pk_min_u16(w ^ pat, c256);
            __hip_atomic_fetch_add(hb + (w & 0xffu), ((m >> 8) & 1u) ^ 1u, __ATOMIC_RELAXED, __HIP_MEMORY_SCOPE_WORKGROUP);
            __hip_atomic_fetch_add(hb + ((w >> 16) & 0xffu), (m >> 24) ^ 1u, __ATOMIC_RELAXED, __HIP_MEMORY_SCOPE_WORKGROUP); } } __builtin_amdgcn_sched_barrier(0); }
    unsigned b2, above2, teq; hist_find<4>(P2, lane, 256u - above1, b2, above2, teq);
    const unsigned tau = (b1 << 8) | b2; const unsigned r = 256u - above1 - above2;
    if (r >= teq) {
        unsigned tt = tau | (tau << 16); asm volatile("" : "+v"(tt));
#pragma unroll
        for (int j = 0; j < 16; ++j) { const int c = lane + 64 * j; unsigned acc = 0u;
#pragma unroll
            for (int i = 0; i < 4; ++i) { const unsigned w = ch[j][i]; const unsigned ns = pk_min_u16(pk_max_u16(w, tt) ^ w, c1);
                acc |= ns << (2 * i); }
            const unsigned bits = ~(acc | (acc >> 15)) & 0xffu;
            { unsigned off = (unsigned)c; asm volatile("" : "+v"(off)); mrow[off] = (unsigned char)bits; } __builtin_amdgcn_sched_barrier(0); }
    } else {
        unsigned running = 0u;
#pragma unroll 1
        for (int j = 0; j < 16; ++j) { const int c = lane + 64 * j;
            v4u x = {0u, 0u, 0u, 0u};
            if (c < nchunks) x = *(const GAS v4u*)(srow + (size_t)c * 8);
            unsigned gt = 0u, eq = 0u;
#pragma unroll
            for (int i = 0; i < 4; ++i) { const unsigned w = x[i], k0 = w & 0xffffu, k1 = w >> 16;
                gt |= (k0 > tau ? 1u : 0u) << (2 * i); gt |= (k1 > tau ? 1u : 0u) << (2 * i + 1); eq |= (k0 == tau ? 1u : 0u) << (2 * i); eq |= (k1 == tau ? 1u : 0u) << (2 * i + 1); }
            const unsigned tc = (unsigned)__builtin_popcount(eq); unsigned inc = tc;
#pragma unroll
            for (int o = 1; o < 64; o <<= 1) { const unsigned v = __shfl_up(inc, o); if (lane >= o) inc += v; }
            const unsigned base = running + inc - tc;
            int take = (int)r - (int)base; take = take < 0 ? 0 : (take > 8 ? 8 : take);
            unsigned e2 = eq, kept = 0u;
#pragma unroll
            for (int t = 0; t < 8; ++t) { const unsigned low = e2 & (0u - e2); if (t < take) kept |= low; e2 &= e2 - 1u; }
            running += __shfl(inc, 63);
            mrow[c] = (unsigned char)(gt | kept); }
    }
}
__device__ __forceinline__ void p_indexer(Frame& F) {
    const bf16* QI = (const bf16*)(F.ws + WS_QI); const bf16* KI = (const bf16*)(F.ws + WS_KI); const float* WI = (const float*)(F.ws + WS_WI);
    unsigned short* scr = (unsigned short*)(F.ws + WS_SCR) + (size_t)blockIdx.x * 32 * 8192;
    unsigned char* MASK = (unsigned char*)(F.ws + WS_MASK);
    const int tid = F.tid, lane = F.lane, wave = F.wave, r32 = lane & 31, hi = lane >> 5;
    LAS unsigned char* lds = F.lds;
    const int b = F.vcu >> 6, wq = F.vcu & 63;
#pragma unroll 1
    for (int ui = 0; ui < 4; ++ui) {
        const int qb32 = (ui == 0) ? wq : (ui == 1) ? 127 - wq : (ui == 2) ? 128 + wq : 255 - wq;
        const int n = 64 * ((qb32 >> 1) + 1), ntiles = n >> 5;
        const size_t tokb = (size_t)b * SEQ, tok0 = tokb + (size_t)qb32 * 32;
#pragma unroll
        for (int i = 0; i < 8; ++i) { const int f = wave + 8 * i, hh = f >> 2, ks = f & 3;
            const v4u v = *(const GAS v4u*)(QI + (tok0 + r32) * 1024 + hh * 64 + 16 * ks + 8 * hi); *(LAS v4u*)(lds + f * 1024 + lane * 16) = v; }
        { LAS float* wt = (LAS float*)(lds + IDX_WT_OFF);
            const int q = tid & 31, hh = tid >> 5; wt[hh * 32 + q] = WI[(tok0 + q) * 16 + hh] * 0.125f;
            LAS unsigned* rh = (LAS unsigned*)(lds + IDX_RH_OFF); for (int i = tid; i < 32 * IDX_HS; i += NWAVES * 64) rh[i] = 0u; }
        { const int q = tid & 31, dg = tid >> 5; f32x4 a = {0.f, 0.f, 0.f, 0.f};
#pragma unroll
            for (int hh = 0; hh < 16; ++hh) { const float wv = WI[(tok0 + q) * 16 + hh] * 0.125f; const v2u qv = *(const GAS v2u*)(QI + (tok0 + q) * 1024 + hh * 64 + 4 * dg);
                a.x += wv * bf2f((unsigned short)(qv.x & 0xffff)); a.y += wv * bf2f((unsigned short)(qv.x >> 16)); a.z += wv * bf2f((unsigned short)(qv.y & 0xffff)); a.w += wv * bf2f((unsigned short)(qv.y >> 16)); }
            v2u o; o.x = pk2(a.x, a.y); o.y = pk2(a.z, a.w);
            *(LAS v2u*)(lds + (64 + (dg >> 2)) * 1024 + (q + 32 * ((dg >> 1) & 1)) * 16 + (dg & 1) * 8) = o; }
        __syncthreads();
        LAS unsigned* hrow = (LAS unsigned*)(lds + IDX_RH_OFF) + r32 * IDX_HS;
        bf16x8 kf[2][4];
#define IDX_KLOAD(TT) do { _Pragma("unroll") for (int j = 0; j < 2; ++j) { const int T = ((TT) + j < ntiles) ? (TT) + j : ntiles - 1; \
            _Pragma("unroll") for (int ks = 0; ks < 4; ++ks) kf[j][ks] = *(const GAS bf16x8*)(KI + (tokb + (size_t)T * 32 + r32) * 64 + 16 * ks + 8 * hi); } } while (0)
#define IDX_FMA4(S, P, B, W) do { asm volatile("v_fma_f32 %0, |%4|, %8, %0\n\tv_fma_f32 %1, |%5|, %8, %1\n\tv_fma_f32 %2, |%6|, %8, %2\n\tv_fma_f32 %3, |%7|, %8, %3" \
                : "+v"(S[B]), "+v"(S[B + 1]), "+v"(S[B + 2]), "+v"(S[B + 3]) : "v"(P[B]), "v"(P[B + 1]), "v"(P[B + 2]), "v"(P[B + 3]), "v"(W)); __builtin_amdgcn_sched_barrier(0); } while (0)
#define IDX_QF(base, ks) (*(const LAS bf16x8*)((base) + (ks) * 1024))
#define IDX_MF(N, K, Q, C) N = __builtin_amdgcn_mfma_f32_32x32x16_bf16(K, Q, C, 0, 0, 0); __builtin_amdgcn_sched_barrier(0)
#define IDX_PSTEP(N0, N1, P0, P1, W, CUR, NXT) do { \
                IDX_MF(N0, kf[0][0], qa, f32x16{}); IDX_FMA4(sc[0], P0, 0, W); \
                IDX_MF(N1, kf[1][0], qa, f32x16{}); IDX_FMA4(sc[0], P0, 4, W); qa = IDX_QF(CUR, 2); \
                IDX_MF(N0, kf[0][1], qb, N0); IDX_FMA4(sc[0], P0, 8, W); \
                IDX_MF(N1, kf[1][1], qb, N1); IDX_FMA4(sc[0], P0, 12, W); qb = IDX_QF(CUR, 3); \
                IDX_MF(N0, kf[0][2], qa, N0); IDX_FMA4(sc[1], P1, 0, W); \
                IDX_MF(N1, kf[1][2], qa, N1); IDX_FMA4(sc[1], P1, 4, W); qa = IDX_QF(NXT, 0); \
                IDX_MF(N0, kf[0][3], qb, N0); IDX_FMA4(sc[1], P1, 8, W); \
                IDX_MF(N1, kf[1][3], qb, N1); IDX_FMA4(sc[1], P1, 12, W); qb = IDX_QF(NXT, 1); } while (0)
        if (wave * 2 < ntiles) IDX_KLOAD(wave * 2);
#pragma unroll 1
        for (int T0 = wave * 2; T0 < ntiles; T0 += 16) {
            f32x16 sc[2];
            sc[0] = f32x16{}; sc[1] = f32x16{};
#pragma unroll
            for (int ks = 0; ks < 4; ++ks) { const bf16x8 qf = *(const LAS bf16x8*)(lds + (64 + ks) * 1024 + lane * 16);
                sc[0] = __builtin_amdgcn_mfma_f32_32x32x16_bf16(kf[0][ks], qf, sc[0], 0, 0, 0); sc[1] = __builtin_amdgcn_mfma_f32_32x32x16_bf16(kf[1][ks], qf, sc[1], 0, 0, 0); }
            {
                f32x16 dA0 = f32x16{}, dA1 = f32x16{}, dB0 = f32x16{}, dB1 = f32x16{};
                float wprev = 0.f;
                const LAS unsigned char* qbase = lds + lane * 16;
                const LAS unsigned char* wbase = lds + IDX_WT_OFF + r32 * 4;
                bf16x8 qa = IDX_QF(qbase, 0), qb = IDX_QF(qbase, 1);
#pragma unroll 1
                for (int hh = 0; hh < 16; hh += 2) {
                    const float wh0 = *(const LAS float*)(wbase + hh * 128), wh1 = *(const LAS float*)(wbase + hh * 128 + 128);
                    IDX_PSTEP(dA0, dA1, dB0, dB1, wprev, qbase, qbase + 4096);
                    IDX_PSTEP(dB0, dB1, dA0, dA1, wh0, qbase + 4096, qbase + 8192);
                    wprev = wh1; qbase += 8192;
                }
                asm volatile("s_nop 15\n\ts_nop 7" ::: "memory");
#pragma unroll
                for (int r = 0; r < 16; r += 4) { IDX_FMA4(sc[0], dB0, r, wprev); }
#pragma unroll
                for (int r = 0; r < 16; r += 4) { IDX_FMA4(sc[1], dB1, r, wprev); }
            }
            if (T0 + 16 < ntiles) IDX_KLOAD(T0 + 16);
#pragma unroll
            for (int j = 0; j < 2; ++j) { if (T0 + j < ntiles) { unsigned short* dst = scr + (size_t)r32 * 8192 + (size_t)(T0 + j) * 32 + 4 * hi;
#pragma unroll
                for (int g = 0; g < 4; ++g) { v2u o; o.x = sortable16x2(pk_f16_rtz(sc[j][4 * g], sc[j][4 * g + 1])); o.y = sortable16x2(pk_f16_rtz(sc[j][4 * g + 2], sc[j][4 * g + 3])); *(GAS v2u*)(dst + 8 * g) = o;
                    __hip_atomic_fetch_add(hrow + ((o.x >> 8) & 255u), 1u, __ATOMIC_RELAXED, __HIP_MEMORY_SCOPE_WORKGROUP); __hip_atomic_fetch_add(hrow + (o.x >> 24), 1u, __ATOMIC_RELAXED, __HIP_MEMORY_SCOPE_WORKGROUP);
                    __hip_atomic_fetch_add(hrow + ((o.y >> 8) & 255u), 1u, __ATOMIC_RELAXED, __HIP_MEMORY_SCOPE_WORKGROUP); __hip_atomic_fetch_add(hrow + (o.y >> 24), 1u, __ATOMIC_RELAXED, __HIP_MEMORY_SCOPE_WORKGROUP); } } }
        }
#undef IDX_QF
#undef IDX_MF
#undef IDX_PSTEP
#undef IDX_FMA4
        VM_WAIT(); __syncthreads();
        __builtin_amdgcn_fence(__ATOMIC_ACQUIRE, "agent");
        { LAS unsigned* P2 = (LAS unsigned*)(lds + IDX_P2_OFF + wave * IDX_P2_BYTES); LAS unsigned* RH = (LAS unsigned*)(lds + IDX_RH_OFF) + wave * 4 * IDX_HS;
            const unsigned short* sr = scr + (size_t)wave * 4 * 8192; unsigned char* mr = MASK + (tok0 + wave * 4) * 1024;
#pragma unroll 1
            for (int rp3 = 0; rp3 < SUBREPS(16); ++rp3) {
            { int ls = lane; asm volatile("" : "+v"(ls));
                v4u chA[16], chB[16];
                sel_load(chA, sr, n, ls); sel_load(chB, sr + 8192, n, ls);
                sel_compute(chA, sr, n, mr, RH, P2, ls);
                sel_load(chA, sr + 2 * 8192, n, ls);
                sel_compute(chB, sr + 8192, n, mr + 1024, RH + IDX_HS, P2, ls);
                sel_load(chB, sr + 3 * 8192, n, ls);
                sel_compute(chA, sr + 2 * 8192, n, mr + 2 * 1024, RH + 2 * IDX_HS, P2, ls);
                sel_compute(chB, sr + 3 * 8192, n, mr + 3 * 1024, RH + 3 * IDX_HS, P2, ls); } } }
        __syncthreads();
    }
}

template <bool WITH_MOE>
__device__ __forceinline__ void p_final(Frame& F) {
    const int gw = F.vcu * NWAVES + F.wave, NGW = F.G * NWAVES;
    const float* X = F.x(); const bf16* MIX = (const bf16*)(F.ws + WS_MIX); const float* mod = (const float*)(F.ws + WS_MOD);
    const bf16* C0 = (const bf16*)(F.ws + WS_C0); const bf16* C1 = (const bf16*)(F.ws + WS_C1);
    f32x4 nv[4]; v2u nm[4], na[4], nc[4];
#define FIN_LOAD(mm) do { const GAS f32x4* xr = (const GAS f32x4*)(X + (size_t)(mm) * D) + F.lane; \
        _Pragma("unroll") for (int j = 0; j < 4; ++j) { nv[j] = xr[64 * j]; nm[j] = *(const GAS v2u*)(MIX + (size_t)(mm) * D + 4 * F.lane + 256 * j); if (WITH_MOE) { const int col = 4 * F.lane + 256 * j; na[j] = *(const GAS v2u*)(C0 + (size_t)(mm) * D + col); nc[j] = *(const GAS v2u*)(C1 + (size_t)(mm) * D + col); } } } while (0)
    if (gw < M) FIN_LOAD(gw);
    for (int m = gw; m < M; m += NGW) {
        const int b = m >> 13;
        f32x4 v[4]; v2u ca[4], cc[4]; float s = 0.f;
#pragma unroll
        for (int j = 0; j < 4; ++j) { v[j] = nv[j]; ca[j] = na[j]; cc[j] = nc[j];
            v[j].x += bf2f((unsigned short)(nm[j].x & 0xffff)); v[j].y += bf2f((unsigned short)(nm[j].x >> 16)); v[j].z += bf2f((unsigned short)(nm[j].y & 0xffff)); v[j].w += bf2f((unsigned short)(nm[j].y >> 16)); }
        if (m + NGW < M) FIN_LOAD(m + NGW);
#pragma unroll
        for (int j = 0; j < 4; ++j) {
            if (WITH_MOE) { const int col = 4 * F.lane + 256 * j; const f32x4 gt = *(const GAS f32x4*)(mod + b * 6144 + 5120 + col);
                const v2u a = ca[j], c = cc[j];
                f32x4 mo; mo.x = bf2f((unsigned short)(a.x & 0xffff)) + bf2f((unsigned short)(c.x & 0xffff)); mo.y = bf2f((unsigned short)(a.x >> 16)) + bf2f((unsigned short)(c.x >> 16));
                mo.z = bf2f((unsigned short)(a.y & 0xffff)) + bf2f((unsigned short)(c.y & 0xffff)); mo.w = bf2f((unsigned short)(a.y >> 16)) + bf2f((unsigned short)(c.y >> 16));
                v[j] = v[j] + gt * mo; }
            s += (v[j].x * v[j].x + v[j].y * v[j].y) + (v[j].z * v[j].z + v[j].w * v[j].w); }
        const float r = 1.f / sqrtf(wave_sum(s) * (1.f / D) + EPS);
        GAS f32x4* o = (GAS f32x4*)(F.out() + (size_t)m * D) + F.lane;
#pragma unroll
        for (int j = 0; j < 4; ++j) { const f32x4 g = *(const GAS f32x4*)(F.g_fin() + 4 * F.lane + 256 * j); o[64 * j] = v[j] * r * g; }
    }
}

constexpr int N_PHASES = 16;
__global__ void __launch_bounds__(NWAVES * 64, 2) mk_fwd(Args args) {
    extern __shared__ __attribute__((aligned(16))) unsigned char lds[];
    Frame F;
    F.lds = (LAS unsigned char*)lds;
    F.tid = threadIdx.x; F.lane = F.tid & 63; F.wave = __builtin_amdgcn_readfirstlane(F.tid >> 6);
    F.G = gridDim.x; { const int bx = blockIdx.x; F.vcu = (F.G % 8 == 0) ? (bx % 8) * (F.G / 8) + bx / 8 : bx; }
    F.ws = args.ws; F.ctl = (gu32*)(args.ws + WS_CTL);
    F.ka = (const CAS Args*)__builtin_amdgcn_kernarg_segment_ptr();
    volatile LAS unsigned* LCTL = (volatile LAS unsigned*)(F.lds + LDSCTL_OFF);
    for (int u = F.tid; u < 64; u += NWAVES * 64) LCTL[u] = 0u;
    __syncthreads();
    const bool multi = (args.ph_hi - args.ph_lo) > 1;
    XcdBarrier bar; bar.bar = (unsigned*)(F.ctl + CW_BAR); bar.x = 0; bar.st = nullptr;
    if (multi) bar = xcd_barrier_post((unsigned*)(F.ctl + CW_BAR), LCTL + 8);
    const int lo = args.ph_lo, hi = args.ph_hi;
#ifndef PH_MASK
#define PH_MASK 0xffffffffu
#endif
#define IN(k) (((PH_MASK >> (k)) & 1u) && lo <= (k) && (k) < hi)
#define REPS(k) (1 + (int)((REP_MASK >> (k)) & 1u))
#define SEAM(k) do { if (IN(k) && IN((k) + 1)) xcd_barrier(bar); } while (0)

    if (IN(0)) _Pragma("unroll") for (int rp_ = 0; rp_ < REPS(0); ++rp_) { p0_prologue(F); } SEAM(0);
    if (multi && ((REP_MASK >> 21) & 1u)) { for (int q = 0; q < 8; ++q) xcd_barrier(bar); }
    if (IN(1)) _Pragma("unroll") for (int rp_ = 0; rp_ < REPS(1); ++rp_) { p1_norm(F); } SEAM(1);
    if (IN(2)) _Pragma("unroll") for (int rp_ = 0; rp_ < REPS(2); ++rp_) {
        pg8::Gemm g{(const bf16*)(F.ws + WS_H), (const bf16*)(F.ws + WS_WIN), D}; pg8::StaticOrder S; S.init(M, NPAD, F.G, (int)blockIdx.x);
        EpiInProj E{F.ws};
        pg8::gemm_phase<EpiInProj, pg8::StaticOrder, true>(F.lds, g, S, E);
    } SEAM(2);
    if (IN(3)) _Pragma("unroll") for (int rp_ = 0; rp_ < REPS(3); ++rp_) { ra_states(F); } SEAM(3);
    if (IN(4)) _Pragma("unroll") for (int rp_ = 0; rp_ < REPS(4); ++rp_) { rb_carry(F); } SEAM(4);
    if (IN(5)) _Pragma("unroll") for (int rp_ = 0; rp_ < REPS(5); ++rp_) { r3_out(F);
    } SEAM(5);
    if (IN(6)) _Pragma("unroll") for (int rp_ = 0; rp_ < REPS(6); ++rp_) { p_indexer(F); } SEAM(6);
    if (IN(7)) _Pragma("unroll") for (int rp_ = 0; rp_ < REPS(7); ++rp_) {
        const attn_body::AttnTensors AT{(const bf16*)(F.ws + WS_QA), (const bf16*)(F.ws + WS_KA), (const bf16*)(F.ws + WS_VA), (bf16*)(F.ws + WS_Y), (const unsigned char*)(F.ws + WS_MASK)};
        const attn_body::StaticOrder S((int)F.G, (int)blockIdx.x);
        { attn_body::AttnUnit u;
            for (int i = 0; S.next(i, u); ++i) { attn_body::attn_unit<8>(u.bh / attn_body::NHEAD, u.bh % attn_body::NHEAD, u.qb, AT.Q, AT.K, AT.V, AT.O, AT.MK, (char*)lds);
                p_expert_convert(F, i, 4); __syncthreads(); } }
    } SEAM(7);
    if (IN(8)) _Pragma("unroll") for (int rp_ = 0; rp_ < REPS(8); ++rp_) {
        pg8::Gemm g{(const bf16*)(F.ws + WS_Y), (const bf16*)(F.ws + WS_WO), D}; pg8::StaticOrder S; S.init(M, D, F.G, (int)blockIdx.x);
        EpiOutProj E{(bf16*)(F.ws + WS_MIX), (const float*)(F.ws + WS_MOD)};
        pg8::gemm_phase<EpiOutProj, pg8::StaticOrder, true>(F.lds, g, S, E);
    } SEAM(8);
    if (IN(9)) _Pragma("unroll") for (int rp_ = 0; rp_ < REPS(9); ++rp_) { p_norm2_route(F); } SEAM(9);
    if (IN(10)) _Pragma("unroll") for (int rp_ = 0; rp_ < REPS(10); ++rp_) {
        LAS int* blkstart = (LAS int*)(F.lds + AUX_OFF); LAS unsigned* tok = (LAS unsigned*)(F.lds + AUX_OFF + 256); LAS float* wts = (LAS float*)(F.lds + AUX_OFF + 256 + MOE_MAXU * 1024);
        const int nunits = moe_tables(F, blkstart, tok, wts);
        pg8::Gemm g{(const bf16*)(F.ws + WS_H2), (const bf16*)(F.ws + WS_WGU), D}; MoeSched S{F.G, F.vcu, nunits, blkstart, tok, true};
        EpiMoe1 E{(bf16*)(F.ws + WS_ACT)};
        pg8::gemm_phase<EpiMoe1, MoeSched, true>(F.lds, g, S, E);
    } SEAM(10);
    if (IN(11)) _Pragma("unroll") for (int rp_ = 0; rp_ < REPS(11); ++rp_) {
        LAS int* blkstart = (LAS int*)(F.lds + AUX_OFF); LAS unsigned* tok = (LAS unsigned*)(F.lds + AUX_OFF + 256); LAS float* wts = (LAS float*)(F.lds + AUX_OFF + 256 + MOE_MAXU * 1024);
        const int nunits = moe_tables(F, blkstart, tok, wts);
        pg8::Gemm g{(const bf16*)(F.ws + WS_ACT), (const bf16*)(F.ws + WS_WD), DEXP}; MoeSched S{F.G, F.vcu, nunits, blkstart, tok, false};
        EpiMoe2 E{(bf16*)(F.ws + WS_C0), (bf16*)(F.ws + WS_C1), tok, wts};
        pg8::gemm_phase<EpiMoe2, MoeSched, true>(F.lds, g, S, E);
    } SEAM(11);
    if (IN(12)) _Pragma("unroll") for (int rp_ = 0; rp_ < REPS(12); ++rp_) { p_final<true>(F); }
#undef IN
#undef SEAM
}

extern "C" void kernel_launch(void* const* d_in, const int* in_sizes, int n_in, void* d_out, int out_size, void* d_ws, size_t ws_size, hipStream_t stream) {
    static int grid = 0;
    if (grid == 0) {
        if (n_in != 15 || out_size != M * D || ws_size < WS_END) { fprintf(stderr, "kernel_launch: unexpected shapes (n_in %d out %d ws %zu)\n", n_in, out_size, ws_size); grid = -1; return; }
        int dev = 0, cus = 0, per_cu = 0;
        if (hipGetDevice(&dev) != hipSuccess || hipDeviceGetAttribute(&cus, hipDeviceAttributeMultiprocessorCount, dev) != hipSuccess) { grid = -1; return; }
        if (hipFuncSetAttribute((const void*)mk_fwd, hipFuncAttributeMaxDynamicSharedMemorySize, LDS_BYTES) != hipSuccess) { fprintf(stderr, "kernel_launch: hipFuncSetAttribute failed\n"); grid = -1; return; }
        if (hipOccupancyMaxActiveBlocksPerMultiprocessor(&per_cu, (const void*)mk_fwd, NWAVES * 64, LDS_BYTES) != hipSuccess || per_cu < 1) { fprintf(stderr, "kernel_launch: occupancy query says %d\n", per_cu); }
        (void)hipGetLastError();
        grid = cus;
    }
    if (grid < 0) return;
    (void)hipMemsetAsync((char*)d_ws + WS_CTL, 0, CTL_ZERO_BYTES, stream);
    Args a{};
    for (int i = 0; i < 15; ++i) a.in[i] = d_in[i];
    a.out = (float*)d_out; a.ws = (unsigned char*)d_ws;
#if MK_N_LAUNCHES == 1
    a.ph_lo = 0; a.ph_hi = N_PHASES;
    hipLaunchKernelGGL(mk_fwd, dim3(grid), dim3(NWAVES * 64), LDS_BYTES, stream, a);
#else
    for (int p = 0; p < N_PHASES; ++p) { a.ph_lo = p; a.ph_hi = p + 1; hipLaunchKernelGGL(mk_fwd, dim3(grid), dim3(NWAVES * 64), LDS_BYTES, stream, a); }
#endif
}
```

```cpp
#include <hip/hip_runtime.h>
#include <cstdio>
#include <cstdint>

#ifndef REP_MASK
#define REP_MASK 0u
#endif
#define SUBREPS(k) (1 + (int)((REP_MASK >> (k)) & 1u))
#ifndef MK_N_LAUNCHES
#define MK_N_LAUNCHES 1
#endif

#define GAS __attribute__((address_space(1)))
#define LAS __attribute__((address_space(3)))
typedef unsigned short bf16;
typedef unsigned v4u __attribute__((ext_vector_type(4)));
typedef unsigned v2u __attribute__((ext_vector_type(2)));
typedef float f32x4 __attribute__((ext_vector_type(4)));
typedef float f32x16 __attribute__((ext_vector_type(16)));
typedef short bf16x8 __attribute__((ext_vector_type(8)));
typedef GAS unsigned gu32;
#define RLX_AGENT __ATOMIC_RELAXED, __HIP_MEMORY_SCOPE_AGENT
#define LDS_WAIT() asm volatile("s_waitcnt lgkmcnt(0)" ::: "memory")
#define VM_WAIT() asm volatile("s_waitcnt vmcnt(0)" ::: "memory")

constexpr int NB = 4, SEQ = 8192, M = NB * SEQ, D = 1024;
constexpr int DIN = 4688, NPAD = 4864;
constexpr int NEXP = 32, DEXP = 512;
constexpr float EPS = 1e-6f;
constexpr float C2 = 0.125f * 1.4426950408889634f;

constexpr size_t MiB = 1u << 20;
constexpr size_t WS_CTL = 0, CTL_ZERO_BYTES = 1 * MiB;
constexpr size_t WS_MODP = 1 * MiB;
constexpr size_t WS_MOD = 3 * MiB;
constexpr size_t WS_WIN = 4 * MiB;
constexpr size_t WS_WO = 14 * MiB;
constexpr size_t WS_H = 16 * MiB;
constexpr size_t WS_ST = 16 * MiB;
constexpr size_t WS_MIX = 16 * MiB;
constexpr size_t WS_QA = 80 * MiB, WS_KA = 112 * MiB, WS_VA = 144 * MiB;
constexpr size_t WS_ROUTE = 144 * MiB;
constexpr size_t WS_QI = 176 * MiB;
constexpr size_t WS_H2 = 176 * MiB;
constexpr size_t WS_C0 = 176 * MiB;
constexpr size_t WS_KI = 240 * MiB;
constexpr size_t WS_WI = 244 * MiB;
constexpr size_t WS_QB = 248 * MiB, WS_KB = 280 * MiB, WS_VB = 312 * MiB, WS_GB = 344 * MiB;
constexpr size_t WS_SCR = 248 * MiB;
constexpr size_t WS_WGU = 248 * MiB;
constexpr size_t WS_C1 = 248 * MiB;
constexpr size_t WS_WD = 312 * MiB;
constexpr size_t WS_Y = 376 * MiB;
constexpr size_t WS_ACT = 376 * MiB;
constexpr size_t WS_MASK = 440 * MiB;
constexpr size_t WS_ROPE1 = 474 * MiB;
constexpr size_t WS_ROPE2 = 476 * MiB;
constexpr size_t WS_END = 512 * MiB;

constexpr int CW_BAR = 4096;
constexpr int CW_ECNT = 16384;

constexpr int NWAVES = 8;
constexpr int RING_BYTES = 131072;
constexpr int AUX_OFF = RING_BYTES, AUX_BYTES = 20480;
constexpr int LDSCTL_OFF = AUX_OFF + AUX_BYTES;
constexpr int LDS_BYTES = LDSCTL_OFF + 256;

__device__ __forceinline__ unsigned f2bf(float f) { unsigned u = __builtin_bit_cast(unsigned, f); return (u + 0x7fffu + ((u >> 16) & 1u)) >> 16; }
__device__ __forceinline__ unsigned pk2(float lo, float hi) { return f2bf(lo) | (f2bf(hi) << 16); }
__device__ __forceinline__ float bf2f(unsigned short b) { return __builtin_bit_cast(float, (unsigned)b << 16); }
__device__ __forceinline__ float wave_sum(float v) {
#pragma unroll
    for (int o = 1; o < 64; o <<= 1) v += __shfl_xor(v, o);
    return v;
}

#define XB_TMO      128
#define XB_XCNT(j)  (256  + 64 * (j))
#define XB_XSUB(j)  (1280 + 64 * (j))
#define XB_XGEN(j)  (2304 + 64 * (j))
#define XB_TOP      3328
#define XB_TOPGEN   3392
#define XCD_BAR_WORDS 3456
#define XB_SPIN_CAP (1u << 18)
__device__ __forceinline__ unsigned xb_ld(unsigned* p)              { return __hip_atomic_load(p, __ATOMIC_RELAXED, __HIP_MEMORY_SCOPE_AGENT); }
__device__ __forceinline__ unsigned xb_add(unsigned* p, unsigned v) { return __hip_atomic_fetch_add(p, v, __ATOMIC_RELAXED, __HIP_MEMORY_SCOPE_AGENT); }
__device__ __forceinline__ unsigned xb_xcc_id() { return (unsigned)__builtin_amdgcn_s_getreg((3 << 11) | 20) & 0xFu; }
#define XB_SPIN(cond, bar) do { unsigned _sp = 0; while (cond) { __builtin_amdgcn_s_sleep(1); \
    if ((++_sp & 255u) == 0u) { if (xb_ld(&(bar)[XB_TMO])) break; if (_sp > XB_SPIN_CAP) { atomicAdd(&(bar)[XB_TMO], 1u); break; } } } } while (0)
struct XcdBarrier { unsigned* bar; unsigned x; volatile LAS unsigned* st; };
__device__ __forceinline__ XcdBarrier xcd_barrier_post(unsigned* bar, volatile LAS unsigned* st) {
    XcdBarrier b; b.bar = bar; b.x = xb_xcc_id(); b.st = st;
    if (threadIdx.x == 0) (void)xb_add(&bar[XB_XCNT(b.x)], 1u);
    return b;
}
__device__ __forceinline__ void xcd_barrier_complete(unsigned* bar, unsigned x, unsigned& nloc, unsigned& nx) {
    const unsigned G = gridDim.x * gridDim.y * gridDim.z;
    unsigned sum, cnt, mine, sp = 0u;
    for (;;) {
        sum = 0u; cnt = 0u; mine = 0u;
#pragma unroll
        for (unsigned j = 0; j < 16; ++j) { const unsigned c = xb_ld(&bar[XB_XCNT(j)]); sum += c; cnt += (c > 0u) ? 1u : 0u; mine = (j == x) ? c : mine; }
        if (sum == G) break;
        __builtin_amdgcn_s_sleep(1);
        if ((++sp & 255u) == 0u) { if (xb_ld(&bar[XB_TMO])) break; if (sp > XB_SPIN_CAP) { atomicAdd(&bar[XB_TMO], 1u); break; } }
    }
    nloc = mine > 0u ? mine : 1u; nx = cnt > 0u ? cnt : 1u;
}
__device__ __forceinline__ void xcd_barrier(const XcdBarrier& b) {
    asm volatile("s_waitcnt vmcnt(0)" ::: "memory");
    __syncthreads();
    if (threadIdx.x == 0) {
        unsigned* bar = b.bar;
        __builtin_amdgcn_s_waitcnt(0);
        unsigned nloc = b.st[0], nx = b.st[1];
        if (nloc == 0u) { xcd_barrier_complete(bar, b.x, nloc, nx); b.st[0] = nloc; b.st[1] = nx; }
        const unsigned old = xb_add(&bar[XB_XSUB(b.x)], 1u);
        const unsigned gen = old / nloc;
        if (old + 1u == (gen + 1u) * nloc) {
            __builtin_amdgcn_fence(__ATOMIC_RELEASE, "agent");
            asm volatile("s_waitcnt vmcnt(0)" ::: "memory");
            const unsigned og = xb_add(&bar[XB_TOP], 1u);
            const unsigned tg = og / nx;
            if (og + 1u == (tg + 1u) * nx) xb_add(&bar[XB_TOPGEN], 1u);
            else XB_SPIN(xb_ld(&bar[XB_TOPGEN]) == tg, bar);
            __builtin_amdgcn_fence(__ATOMIC_ACQUIRE, "agent");
            xb_add(&bar[XB_XGEN(b.x)], 1u);
            asm volatile("s_waitcnt vmcnt(0)" ::: "memory");
        } else {
            XB_SPIN(xb_ld(&bar[XB_XGEN(b.x)]) == gen, bar);
            __builtin_amdgcn_fence(__ATOMIC_ACQUIRE, "agent");
            asm volatile("s_waitcnt vmcnt(0)" ::: "memory");
        }
    }
    __syncthreads();
}

namespace pg8 {
typedef unsigned short bf16_t;
constexpr int BM = 256, BK = 64, HALF = 128, HTB = HALF * BK * 2, STAGE_BYTES = 8 * HTB;
__host__ __device__ __forceinline__ int lds_byte(int r, int c) { const int st = (r >> 4) * 2 + (c >> 5), rr = r & 15, cc = c & 31, ob = rr * 64 + cc * 2; return st * 1024 + (ob ^ (((ob >> 9) & 1) << 5)); }
__host__ __device__ __forceinline__ void stage_rc(int b, int& R, int& C) { const int st = b / 1024, sb = b % 1024, swz = sb ^ (((sb >> 9) & 1) << 5); R = (st >> 1) * 16 + swz / 64; C = (st & 1) * 32 + (swz % 64) / 2; }
__host__ __device__ __forceinline__ int perm32(int rho) { const int n = rho >> 4, i = rho & 15; return 8 * (i >> 2) + 4 * n + (i & 3); }
struct Unit { int pm, pn; };
struct Gemm { const bf16_t* A; const bf16_t* Bt; int K; };
__device__ __forceinline__ unsigned cvt_pk_bf16(float lo, float hi) { unsigned r; asm volatile("v_cvt_pk_bf16_f32 %0, %1, %2" : "=v"(r) : "v"(lo), "v"(hi)); return r; }

template <class Epi, class Sched, bool ALIGN_EPI>
__device__ __forceinline__ void gemm_phase(LAS unsigned char* lds, const Gemm g, const Sched& S, const Epi& E) {
    const int tid = threadIdx.x, wid = __builtin_amdgcn_readfirstlane(tid >> 6), lane = tid & 63, wr = wid >> 2, wc = wid & 3, fr = lane & 15, fq = lane >> 4;
    const int K = g.K, nt = K / BK;
    int Rs[2], Cs[2]; unsigned voffB[2];
#pragma unroll
    for (int i = 0; i < 2; ++i) { int R, C; stage_rc(tid * 16 + i * 8192, R, C); const int Rb = Epi::PERM ? ((R & ~31) + perm32(R & 31)) : R;
        Rs[i] = R; Cs[i] = C * 2; voffB[i] = (unsigned)(Rb * K + C) * 2u; }
    const size_t kstep = (size_t)(BK * 2);
    const size_t hstep = (size_t)HALF * K * 2;
    const unsigned ldsw = (unsigned)wid * 1024u;
    const int aoff = lds_byte(wr * 64 + fr, fq * 8), boff = lds_byte(wc * 32 + fr, fq * 8);
#define PG8_SA(b, h) (((b) * 2 + (h)) * HTB)
#define PG8_SB(b, h) ((4 + (b) * 2 + (h)) * HTB)
#define PG8_STAGE(bufoff, gbase, v0, v1) do { \
        __builtin_amdgcn_global_load_lds((const unsigned*)((const char*)(gbase) + (v0)), (LAS unsigned*)(lds + (bufoff) + ldsw), 16, 0, 0); \
        __builtin_amdgcn_global_load_lds((const unsigned*)((const char*)(gbase) + (v1)), (LAS unsigned*)(lds + (bufoff) + ldsw + 8192), 16, 0, 0); } while (0)
#define PG8_STAGEB(bufoff, gbase) PG8_STAGE(bufoff, gbase, voffB[0], voffB[1])
#define PG8_LDA(dst, b, h) do { _Pragma("unroll") for (int m = 0; m < 4; ++m) _Pragma("unroll") for (int k = 0; k < 2; ++k) dst[m][k] = *(const LAS bf16x8*)(lds + PG8_SA(b, h) + aoff + m * 2048 + k * 1024); } while (0)
#define PG8_LDB(dst, b, h) do { _Pragma("unroll") for (int n = 0; n < 2; ++n) _Pragma("unroll") for (int k = 0; k < 2; ++k) dst[n][k] = *(const LAS bf16x8*)(lds + PG8_SB(b, h) + boff + n * 2048 + k * 1024); } while (0)
#define PG8_MMA(ai, bj, At, Bt) do { __builtin_amdgcn_s_setprio(1); _Pragma("unroll") for (int m = 0; m < 4; ++m) _Pragma("unroll") for (int n = 0; n < 2; ++n) _Pragma("unroll") for (int k = 0; k < 2; ++k) \
        acc[ai][bj][m][n] = __builtin_amdgcn_mfma_f32_16x16x32_bf16(Bt[n][k], At[m][k], acc[ai][bj][m][n], 0, 0, 0); __builtin_amdgcn_s_setprio(0); } while (0)
#define PG8_WAIT_V(n) asm volatile("s_waitcnt vmcnt(" #n ")" ::: "memory")
#define PG8_WAIT_L(n) asm volatile("s_waitcnt lgkmcnt(" #n ")" ::: "memory")
#define PG8_BAR __builtin_amdgcn_s_barrier()
#define PG8_SCHED __builtin_amdgcn_sched_barrier(0)
    Unit cur, nxt; int ui = 0;
    if (!S.next(0, cur)) return;
    f32x4 acc[2][2][4][2];
#pragma unroll
    for (int a = 0; a < 2; ++a)
#pragma unroll
        for (int b = 0; b < 2; ++b)
#pragma unroll
            for (int m = 0; m < 4; ++m)
#pragma unroll
                for (int n = 0; n < 2; ++n) acc[a][b][m][n] = (f32x4){0.f, 0.f, 0.f, 0.f};
    bf16x8 At[4][2], B0[2][2], B1[2][2];
    unsigned vc[2][2], vn[2][2];
#pragma unroll
    for (int h = 0; h < 2; ++h)
#pragma unroll
        for (int i = 0; i < 2; ++i) vc[h][i] = (unsigned)S.arow(cur, h * HALF + Rs[i]) * (unsigned)(K * 2) + (unsigned)Cs[i];
    const char* cA = (const char*)g.A;
    const char* cB = (const char*)g.Bt + (size_t)S.brow0(cur) * K * 2;
    PG8_STAGEB(PG8_SB(0, 0), cB); PG8_STAGEB(PG8_SB(0, 1), cB + hstep); PG8_STAGE(PG8_SA(0, 0), cA, vc[0][0], vc[0][1]); PG8_STAGE(PG8_SA(0, 1), cA, vc[1][0], vc[1][1]);
    if (wr == 1) PG8_BAR;
    PG8_WAIT_V(2); PG8_BAR;
    PG8_STAGEB(PG8_SB(1, 0), cB + kstep); PG8_STAGE(PG8_SA(1, 0), cA + kstep, vc[0][0], vc[0][1]); PG8_STAGEB(PG8_SB(1, 1), cB + hstep + kstep);
    PG8_WAIT_V(6); PG8_BAR;
    for (;;) {
        const bool has_next = S.next(ui + 1, nxt);
        const char* nB = cB;
        if (has_next) {
            nB = (const char*)g.Bt + (size_t)S.brow0(nxt) * K * 2;
#pragma unroll
            for (int h = 0; h < 2; ++h)
#pragma unroll
                for (int i = 0; i < 2; ++i) vn[h][i] = (unsigned)S.arow(nxt, h * HALF + Rs[i]) * (unsigned)(K * 2) + (unsigned)Cs[i];
        } else {
#pragma unroll
            for (int h = 0; h < 2; ++h)
#pragma unroll
                for (int i = 0; i < 2; ++i) vn[h][i] = vc[h][i];
        }
        for (int t = 0; t < nt; t += 2) {
            const bool last = (t == nt - 2);
            const char* a1 = cA + (size_t)(t + 1) * kstep;
            const char* a2 = last ? cA : cA + (size_t)(t + 2) * kstep; const char* b2 = last ? nB : cB + (size_t)(t + 2) * kstep;
            const char* a3 = a2 + kstep; const char* b3 = b2 + kstep;
            const unsigned w00 = last ? vn[0][0] : vc[0][0], w01 = last ? vn[0][1] : vc[0][1], w10 = last ? vn[1][0] : vc[1][0], w11 = last ? vn[1][1] : vc[1][1];
            PG8_LDB(B0, 0, 0); PG8_LDB(B1, 0, 1); PG8_SCHED; PG8_LDA(At, 0, 0); PG8_STAGE(PG8_SA(1, 1), a1, vc[1][0], vc[1][1]);
            PG8_WAIT_V(8); PG8_WAIT_L(0); PG8_BAR; PG8_MMA(0, 0, At, B0); PG8_MMA(0, 1, At, B1); PG8_BAR; PG8_SCHED;
            PG8_LDA(At, 0, 1); PG8_STAGEB(PG8_SB(0, 0), b2); PG8_STAGEB(PG8_SB(0, 1), b2 + hstep); PG8_STAGE(PG8_SA(0, 0), a2, w00, w01);
            PG8_WAIT_V(8); PG8_WAIT_L(0); PG8_BAR; PG8_MMA(1, 0, At, B0); PG8_MMA(1, 1, At, B1); PG8_BAR; PG8_SCHED;
            PG8_LDB(B0, 1, 0); PG8_LDB(B1, 1, 1); PG8_SCHED; PG8_LDA(At, 1, 0); PG8_STAGE(PG8_SA(0, 1), a2, w10, w11);
            PG8_WAIT_V(8); PG8_WAIT_L(0); PG8_BAR; PG8_MMA(0, 0, At, B0); PG8_MMA(0, 1, At, B1); PG8_BAR; PG8_SCHED;
            PG8_LDA(At, 1, 1); PG8_STAGEB(PG8_SB(1, 0), b3); PG8_STAGEB(PG8_SB(1, 1), b3 + hstep); PG8_STAGE(PG8_SA(1, 0), a3, w00, w01);
            PG8_WAIT_V(8); PG8_WAIT_L(0); PG8_BAR; PG8_MMA(1, 0, At, B0); PG8_MMA(1, 1, At, B1); PG8_BAR; PG8_SCHED;
        }
        if constexpr (ALIGN_EPI) { if (wr == 0) PG8_BAR; }
        E(acc, cur, wr, wc, fr, fq);
        if (!has_next) break;
#pragma unroll
        for (int a = 0; a < 2; ++a)
#pragma unroll
            for (int b = 0; b < 2; ++b)
#pragma unroll
                for (int m = 0; m < 4; ++m)
#pragma unroll
                    for (int n = 0; n < 2; ++n) acc[a][b][m][n] = (f32x4){0.f, 0.f, 0.f, 0.f};
        cur = nxt; cB = nB; ++ui;
#pragma unroll
        for (int h = 0; h < 2; ++h)
#pragma unroll
            for (int i = 0; i < 2; ++i) vc[h][i] = vn[h][i];
        if constexpr (ALIGN_EPI) { if (wr == 1) PG8_BAR; }
    }
    PG8_WAIT_V(0);
    if constexpr (!ALIGN_EPI) { if (wr == 0) PG8_BAR; }
    PG8_BAR;
#undef PG8_SA
#undef PG8_SB
#undef PG8_STAGE
#undef PG8_STAGEB
#undef PG8_LDA
#undef PG8_LDB
#undef PG8_MMA
#undef PG8_WAIT_V
#undef PG8_WAIT_L
#undef PG8_BAR
#undef PG8_SCHED
}

struct StaticOrder {
    int nM, nN, nwg, G, c;
    __device__ void init(int Mrows, int N, int G_, int c_) { nM = Mrows / BM; nN = N / BM; nwg = nM * nN; G = G_; c = c_; }
    __device__ bool next(int i, Unit& u) const {
        const long L = (long)i * G + c; if (L >= nwg) return false;
        int wgid = (int)L; { const int q = nwg / 8, r = nwg % 8, xcd = wgid % 8, off = wgid / 8; wgid = (xcd < r ? xcd * (q + 1) : r * (q + 1) + (xcd - r) * q) + off; }
        const int nig = 8 * nN, gid = wgid / nig, fm = gid * 8, gsz = (nM - fm) < 8 ? (nM - fm) : 8;
        u.pm = fm + ((wgid % nig) % gsz); u.pn = (wgid % nig) / gsz; return true;
    }
    __device__ __forceinline__ int arow(const Unit& u, int rt) const { return u.pm * BM + rt; }
    __device__ __forceinline__ int brow0(const Unit& u) const { return u.pn * BM; }
};
}

#include <cmath>
namespace attn_body {
using bf16=unsigned short;
using bf16x8=__attribute__((ext_vector_type(8)))short;
using s16x4=__attribute__((ext_vector_type(4)))short;
using f32x16=__attribute__((ext_vector_type(16)))float;
using u32x4=__attribute__((ext_vector_type(4)))unsigned;
using u32x2=__attribute__((ext_vector_type(2)))unsigned;
constexpr int BATCH=4,NHEAD=8,SEQ=8192,D=64,DM=NHEAD*D,OPITCH=1024,MPITCH=1024;
constexpr int NW=8,QBLK=32,QB=QBLK*NW,KVBLK=64,NQB=SEQ/QB;
constexpr int ATTN_PITCH=DM, ATTN_UNIT_ROWS=QB;
__device__ __forceinline__ int crow(int r,int hi){return (r&3)+8*(r>>2)+4*hi;}
#define SBAR() __builtin_amdgcn_sched_barrier(0)
constexpr int NSLOT=3, SLOTB=8192;
constexpr int LDS_K=0, LDS_V=NSLOT*SLOTB, LDS_WS=2*NSLOT*SLOTB, LDS_OST=LDS_WS+NW*64*4, LDS_MK=LDS_OST+NW*4096, LDS_BYTES=LDS_MK+NW*1024;
__device__ __forceinline__ void glds16(const void*gsrc,unsigned lds_dst){unsigned keep;
  asm volatile("s_mov_b32 %0, m0\n\ts_mov_b32 m0, %2\n\ts_nop 0\n\tglobal_load_lds_dwordx4 %1, off\n\ts_mov_b32 m0, %0":"=&s"(keep):"v"(gsrc),"s"(lds_dst):"memory");}
__device__ __forceinline__ void glds4(const void*gsrc,unsigned lds_dst){unsigned keep;
  asm volatile("s_mov_b32 %0, m0\n\ts_mov_b32 m0, %2\n\ts_nop 0\n\tglobal_load_lds_dword %1, off\n\ts_mov_b32 m0, %0":"=&s"(keep):"v"(gsrc),"s"(lds_dst):"memory");}
__device__ __forceinline__ float mskf(float x,unsigned w,int pos){ unsigned m; asm("v_bfe_i32 %0, %1, %2, 1":"=v"(m):"v"(w),"n"(pos)); return __uint_as_float(__float_as_uint(x) & m); }
__device__ __forceinline__ float max3f(float a,float b,float c){float r;asm("v_max3_f32 %0, %1, %2, %3":"=v"(r):"v"(a),"v"(b),"v"(c));return r;}
__device__ __forceinline__ float max2f(float a,float b){float r;asm("v_max_f32_e32 %0, %1, %2":"=v"(r):"v"(a),"v"(b));return r;}
__device__ __forceinline__ float fadd_s(float a,float b){float r;asm("v_add_f32_e32 %0, %1, %2":"=v"(r):"v"(a),"v"(b));return r;}
__device__ __forceinline__ float fsub_s(float a,float b){float r;asm("v_sub_f32_e32 %0, %1, %2":"=v"(r):"v"(a),"v"(b));return r;}
typedef float f32x2_t __attribute__((ext_vector_type(2))); typedef __bf16 bf16x2_t __attribute__((ext_vector_type(2)));
__device__ __forceinline__ unsigned cvtpk_s(float lo,float hi){f32x2_t v={lo,hi};bf16x2_t b=__builtin_convertvector(v,bf16x2_t);return __builtin_bit_cast(unsigned,b);}
#define WAIT_BAR(N) asm volatile("s_waitcnt vmcnt(" #N ") lgkmcnt(0)\n\ts_barrier":::"memory")

__device__ __forceinline__ void qkt(f32x16&p0,f32x16&p1,const char*Kslot,const bf16x8*qr,const f32x16&negm,int r32,int hi){
  const char*kb=Kslot+hi*1024+r32*16;
  #pragma unroll
  for(int d0=0;d0<4;++d0){
    const bf16x8 b0=*reinterpret_cast<const bf16x8*>(kb+d0*2048);
    const bf16x8 b1=*reinterpret_cast<const bf16x8*>(kb+d0*2048+512);
    if(d0==0){p0=__builtin_amdgcn_mfma_f32_32x32x16_bf16(b0,qr[0],negm,0,0,0);p1=__builtin_amdgcn_mfma_f32_32x32x16_bf16(b1,qr[0],negm,0,0,0);}
    else{p0=__builtin_amdgcn_mfma_f32_32x32x16_bf16(b0,qr[d0],p0,0,0,0);p1=__builtin_amdgcn_mfma_f32_32x32x16_bf16(b1,qr[d0],p1,0,0,0);}}
}
typedef __attribute__((address_space(3))) const char* lds_cptr;
typedef short v4i16_t __attribute__((ext_vector_type(4)));
__device__ __forceinline__ void kload8(bf16x8*kf,lds_cptr kp){
  kf[0]=*(const __attribute__((address_space(3))) bf16x8*)(kp);      kf[1]=*(const __attribute__((address_space(3))) bf16x8*)(kp+512);
  kf[2]=*(const __attribute__((address_space(3))) bf16x8*)(kp+2048); kf[3]=*(const __attribute__((address_space(3))) bf16x8*)(kp+2560);
  kf[4]=*(const __attribute__((address_space(3))) bf16x8*)(kp+4096); kf[5]=*(const __attribute__((address_space(3))) bf16x8*)(kp+4608);
  kf[6]=*(const __attribute__((address_space(3))) bf16x8*)(kp+6144); kf[7]=*(const __attribute__((address_space(3))) bf16x8*)(kp+6656);
}
__device__ __forceinline__ void kload2(bf16x8*kf,lds_cptr kp,int j){ kf[2*j]=*(const __attribute__((address_space(3))) bf16x8*)(kp+j*2048); kf[2*j+1]=*(const __attribute__((address_space(3))) bf16x8*)(kp+j*2048+512); }
__device__ __forceinline__ s16x4 vtr(lds_cptr p){ return __builtin_bit_cast(s16x4,__builtin_amdgcn_ds_read_tr16_b64_v4i16((__attribute__((address_space(3))) v4i16_t*)p)); }
__device__ __forceinline__ float rowmax(const f32x16&p0,const f32x16&p1){
  float a=max3f(p0[0],p0[1],p1[0]),b=max3f(p0[2],p0[3],p1[1]);a=max3f(a,p1[2],p1[3]);
  #pragma unroll
  for(int r=4;r<16;r+=4){a=max3f(a,p0[r],p0[r+1]);b=max3f(b,p0[r+2],p0[r+3]);a=max3f(a,p1[r],p1[r+1]);b=max3f(b,p1[r+2],p1[r+3]);}
  const float m=max2f(a,b);
  auto rr=__builtin_amdgcn_permlane32_swap(__float_as_uint(m),__float_as_uint(m),false,false);
  return max2f(__uint_as_float(rr[0]),__uint_as_float(rr[1]));
}
__device__ __forceinline__ void pv(f32x16*o,int vb,bf16x8 pa0,bf16x8 pa1,bf16x8 pa2,bf16x8 pa3){
  #pragma unroll
  for(int d0=0;d0<2;++d0){s16x4 lo[4],hi[4];
    #pragma unroll
    for(int ks=0;ks<4;++ks){
      asm volatile("ds_read_b64_tr_b16 %0,%1 offset:%c2":"=&v"(lo[ks]):"v"(vb),"i"(d0*4096+ks*1024):"memory");
      asm volatile("ds_read_b64_tr_b16 %0,%1 offset:%c2":"=&v"(hi[ks]):"v"(vb),"i"(d0*4096+ks*1024+512):"memory");}
    asm volatile("s_waitcnt lgkmcnt(0)":::"memory");SBAR();
    #define PK(k) (bf16x8){lo[k][0],lo[k][1],lo[k][2],lo[k][3],hi[k][0],hi[k][1],hi[k][2],hi[k][3]}
    o[d0]=__builtin_amdgcn_mfma_f32_32x32x16_bf16(pa0,PK(0),o[d0],0,0,0);
    o[d0]=__builtin_amdgcn_mfma_f32_32x32x16_bf16(pa1,PK(1),o[d0],0,0,0);
    o[d0]=__builtin_amdgcn_mfma_f32_32x32x16_bf16(pa2,PK(2),o[d0],0,0,0);
    o[d0]=__builtin_amdgcn_mfma_f32_32x32x16_bf16(pa3,PK(3),o[d0],0,0,0);
    #undef PK
  }
}

#ifndef ATTN_STORE16
#define ATTN_STORE16(p,v) (*(u32x4*)(p)=(v))
#endif
template<int THRL> __device__ __forceinline__ void attn_unit(int b,int h,int qb,const bf16*Q,const bf16*__restrict__ K,const bf16*__restrict__ V,bf16*O,const unsigned char*__restrict__ MK,char*shm){
  const int tid=threadIdx.x,lane=tid&63,r32=lane&31,hi=lane>>5; const int wid=__builtin_amdgcn_readfirstlane(tid>>6);
  const long rowbase=(long)b*SEQ; const int q0=qb*QB;
  const bf16*Qw=Q+(rowbase+q0+wid*QBLK)*DM+h*D;
  const bf16*Kh=K+rowbase*DM+h*D,*Vh=V+rowbase*DM+h*D;
  const unsigned lds0=(unsigned)(uintptr_t)shm;
  float*wsf=(float*)(shm+LDS_WS)+wid*64;
  const bf16*ksrc=Kh+(long)lane*DM+wid*8;
  const bf16*vsrc=Vh+(long)(16*(wid&3)+(lane>>2))*DM+(wid>>2)*32+(lane&3)*8;
  const unsigned kdst=lds0+LDS_K+wid*1024, vdst=lds0+LDS_V+wid*1024;
  #define DMA_K(t,slot) glds16(ksrc+(long)(t)*KVBLK*DM,(unsigned)__builtin_amdgcn_readfirstlane(kdst+(slot)))
  #define DMA_V(t,slot) glds16(vsrc+(long)(t)*KVBLK*DM,(unsigned)__builtin_amdgcn_readfirstlane(vdst+(slot)))
  const unsigned char*msrc=MK+(rowbase+q0+wid*QBLK+(lane>>1))*(long)MPITCH+4*(lane&1);
  const unsigned mdst=lds0+LDS_MK+wid*1024;
  #define DMA_M(t) glds4(msrc+8*(long)(t),(unsigned)__builtin_amdgcn_readfirstlane(mdst+(((t)&3)<<8)))
  const lds_cptr mp0=(lds_cptr)shm+LDS_MK+wid*1024+r32*8;
  #define MLOAD(t) do{ const u32x2 mw_=*(const __attribute__((address_space(3))) u32x2*)(mp0+(((t)&3)<<8)); ml=mw_[0]>>(4*hi); mh=mw_[1]>>(4*hi); }while(0)
  const int vb0=(int)(lds0+LDS_V)+((lane>>4)&1)*32+(lane&3)*8+(4*hi+((lane&15)>>2))*64;
  const char*Kbase=shm+LDS_K; bf16x8 kf[8];
  const lds_cptr shm3=(lds_cptr)shm; const lds_cptr kp0=shm3+LDS_K+hi*1024+r32*16; const lds_cptr vp0=shm3+LDS_V+((lane>>4)&1)*32+(lane&3)*8+(4*hi+((lane&15)>>2))*64;
  const int NT=(q0+QB)/KVBLK;
  DMA_K(0,0);DMA_M(0);DMA_V(0,0);DMA_K(1,SLOTB);
  bf16x8 qr[4];
  #pragma unroll
  for(int d0=0;d0<4;++d0)qr[d0]=*reinterpret_cast<const bf16x8*>(&Qw[(long)r32*DM+d0*16+hi*8]);
  float mhat=0.f,l_reg=0.f;f32x16 o[2];o[0]=f32x16{};o[1]=f32x16{};f32x16 negm=f32x16{};asm volatile("":"+v"(negm));
  const int qrel=wid*QBLK+r32;
  #define CMASK(P0,P1,t) do{}while(0)
  unsigned ml=0u,mh=0u;
  bool resc=false;
  #define START(P0,P1) do{ const float rm=rowmax(P0,P1); resc=false; \
    { const float dl=rm; mhat=fadd_s(mhat,dl); \
      _Pragma("unroll") for(int r=0;r<16;++r){P0[r]=fsub_s(P0[r],dl);P1[r]=fsub_s(P1[r],dl);} \
      _Pragma("unroll") for(int r=0;r<16;++r)negm[r]=-mhat; asm volatile("":"+v"(negm)); } \
    _Pragma("unroll") for(int r=0;r<16;++r)P0[r]=__builtin_amdgcn_exp2f(P0[r]); }while(0)
  #define RESC() do{ if(resc){ asm volatile("s_waitcnt lgkmcnt(0)":::"memory"); \
      _Pragma("unroll") for(int d_=0;d_<2;++d_) _Pragma("unroll") for(int r=0;r<16;++r)o[d_][r]*=wsf[crow(r,hi)]; } }while(0)
  f32x16 pA0,pA1,pB0,pB1;
  int sl_prev=0,sl_cur=0,sl_next=SLOTB;
  #define ROT() do{sl_prev=sl_cur;sl_cur=sl_next;sl_next=(sl_next==(NSLOT-1)*SLOTB)?0:sl_next+SLOTB;}while(0)
  DMA_K(2,2*SLOTB);DMA_M(1);
  WAIT_BAR(4);
  qkt(pA0,pA1,Kbase,qr,negm,r32,hi);asm volatile("s_nop 15\n\ts_nop 7":"+v"(pA0),"+v"(pA1));CMASK(pA0,pA1,0);
  START(pA0,pA1);
  _Pragma("unroll") for(int r=0;r<16;++r)pA1[r]=__builtin_amdgcn_exp2f(pA1[r]);
  MLOAD(0);
  _Pragma("unroll") for(int r=0;r<16;++r){pA0[r]=mskf(pA0[r],ml,(r&3)+8*(r>>2));pA1[r]=mskf(pA1[r],mh,(r&3)+8*(r>>2));}
  WAIT_BAR(0);
  DMA_K(3,0);DMA_V(1,SLOTB);DMA_M(2);
  ROT();
  kload8(kf,kp0+sl_cur);
  WAIT_BAR(3);
  s16x4 vlo[8],vhi[8]; u32x4 pw0,pw1,pw2,pw3;
  #define PKW(P,B) cvtpk_s(P[B],P[B+1])
  #define PAF(k) __builtin_bit_cast(bf16x8,pw##k)
  #define VFR(i) (bf16x8){vlo[i][0],vlo[i][1],vlo[i][2],vlo[i][3],vhi[i][0],vhi[i][1],vhi[i][2],vhi[i][3]}
  #define PIN(x) asm volatile("":"+v"(x))
  #define MX3(a,b,c) __builtin_fmaxf(__builtin_fmaxf((a),(b)),(c))
  #define GAPA(MF,A0,A1,A2,A3,W0,W1,PW) do{ MF; sacc+=A0; sacc+=A1; sacc+=A2; sacc+=A3; PIN(sacc); W0; W1; PIN(PW); SBAR(); }while(0)
  #define EX(v) __builtin_amdgcn_exp2f(v)
  #define GAPB(MF,X,B,W) do{ MF; X[B]=mskf(EX(X[B]),W,2*(B)); X[B+1]=mskf(EX(X[B+1]),W,2*(B)+1); X[B+2]=mskf(EX(X[B+2]),W,2*(B)+2); X[B+3]=mskf(EX(X[B+3]),W,2*(B)+3); PIN(X); SBAR(); }while(0)
  #define VRD(i) do{ vlo[i]=vtr(vp_+(((i)>>2)*4096+((i)&3)*1024)); vhi[i]=vtr(vp_+(((i)>>2)*4096+((i)&3)*1024+512)); }while(0)
  #define KRD(G,j) do{ if(G){ kload2(kf,kp0+sl_next,j); SBAR(); } }while(0)
  #define STEP(C0,C1,P0,P1,t,GK,GV,GL,GM) do{ SBAR(); \
    const lds_cptr vp_=vp0+sl_prev; \
    VRD(0); SBAR(); float sacc=(P0[0]+P0[1]); \
    GAPA(C0=__builtin_amdgcn_mfma_f32_32x32x16_bf16(kf[0],qr[0],negm,0,0,0), P0[2],P0[3],P0[4],P0[5],     pw0[0]=PKW(P0,0), pw0[1]=PKW(P0,2), pw0); \
    VRD(4); SBAR(); GAPA(C1=__builtin_amdgcn_mfma_f32_32x32x16_bf16(kf[1],qr[0],negm,0,0,0), P0[6],P0[7],P0[8],P0[9],     pw0[2]=PKW(P0,4), pw0[3]=PKW(P0,6), pw0); \
    VRD(1); SBAR(); GAPA(C0=__builtin_amdgcn_mfma_f32_32x32x16_bf16(kf[2],qr[1],C0,0,0,0),   P0[10],P0[11],P0[12],P0[13], pw1[0]=PKW(P0,8), pw1[1]=PKW(P0,10), pw1); \
    VRD(5); SBAR(); GAPA(C1=__builtin_amdgcn_mfma_f32_32x32x16_bf16(kf[3],qr[1],C1,0,0,0),   P0[14],P0[15],P1[0],P1[1],   pw1[2]=PKW(P0,12),pw1[3]=PKW(P0,14), pw1); \
    VRD(2); SBAR(); GAPA(C0=__builtin_amdgcn_mfma_f32_32x32x16_bf16(kf[4],qr[2],C0,0,0,0),   P1[2],P1[3],P1[4],P1[5],     pw2[0]=PKW(P1,0), pw2[1]=PKW(P1,2), pw2); \
    VRD(6); SBAR(); GAPA(C1=__builtin_amdgcn_mfma_f32_32x32x16_bf16(kf[5],qr[2],C1,0,0,0),   P1[6],P1[7],P1[8],P1[9],     pw2[2]=PKW(P1,4), pw2[3]=PKW(P1,6), pw2); \
    VRD(3); SBAR(); GAPA(C0=__builtin_amdgcn_mfma_f32_32x32x16_bf16(kf[6],qr[3],C0,0,0,0),   P1[10],P1[11],P1[12],P1[13], pw3[0]=PKW(P1,8), pw3[1]=PKW(P1,10), pw3); \
    VRD(7); SBAR(); GAPA(C1=__builtin_amdgcn_mfma_f32_32x32x16_bf16(kf[7],qr[3],C1,0,0,0),   P1[14],P1[15],0.f,0.f,       pw3[2]=PKW(P1,12),pw3[3]=PKW(P1,14), pw3); \
    l_reg+=sacc; \
    if(GK){DMA_K((t)+3,sl_cur);} if(GV){DMA_V((t)+1,sl_next);} if(GM){DMA_M((t)+2);} \
    CMASK(C0,C1,t); \
    { float a=MX3(C0[0],C0[1],C1[0]),b=MX3(C0[2],C0[3],C1[1]); a=MX3(a,C1[2],C1[3]); \
      _Pragma("unroll") for(int r=4;r<16;r+=4){a=MX3(a,C0[r],C0[r+1]);b=MX3(b,C0[r+2],C0[r+3]);a=MX3(a,C1[r],C1[r+1]);b=MX3(b,C1[r+2],C1[r+3]);} \
      float rm=__builtin_fmaxf(a,b); { auto rr=__builtin_amdgcn_permlane32_swap(__float_as_uint(rm),__float_as_uint(rm),false,false); rm=__builtin_fmaxf(__uint_as_float(rr[0]),__uint_as_float(rr[1])); } \
      resc=false; \
      if(__builtin_expect(__any(rm>(float)THRL),0)){ const float dl=__builtin_fmaxf(rm,0.f); mhat+=dl; \
        _Pragma("unroll") for(int r=0;r<16;++r){C0[r]-=dl;C1[r]-=dl;} \
        _Pragma("unroll") for(int r=0;r<16;++r)negm[r]=-mhat; asm volatile("":"+v"(negm)); \
        const float f=__builtin_amdgcn_exp2f(-dl); l_reg*=f; if(hi==0)wsf[r32]=f; resc=true; } } \
    MLOAD(t); SBAR(); \
    GAPB(o[0]=__builtin_amdgcn_mfma_f32_32x32x16_bf16(PAF(0),VFR(0),o[0],0,0,0), C0,0,ml); \
    GAPB(o[1]=__builtin_amdgcn_mfma_f32_32x32x16_bf16(PAF(0),VFR(4),o[1],0,0,0), C0,4,ml); \
    KRD(GL,0); GAPB(o[0]=__builtin_amdgcn_mfma_f32_32x32x16_bf16(PAF(1),VFR(1),o[0],0,0,0), C0,8,ml); \
    KRD(GL,1); GAPB(o[1]=__builtin_amdgcn_mfma_f32_32x32x16_bf16(PAF(1),VFR(5),o[1],0,0,0), C0,12,ml); \
    KRD(GL,2); GAPB(o[0]=__builtin_amdgcn_mfma_f32_32x32x16_bf16(PAF(2),VFR(2),o[0],0,0,0), C1,0,mh); \
    KRD(GL,3); GAPB(o[1]=__builtin_amdgcn_mfma_f32_32x32x16_bf16(PAF(2),VFR(6),o[1],0,0,0), C1,4,mh); \
    GAPB(o[0]=__builtin_amdgcn_mfma_f32_32x32x16_bf16(PAF(3),VFR(3),o[0],0,0,0), C1,8,mh); \
    GAPB(o[1]=__builtin_amdgcn_mfma_f32_32x32x16_bf16(PAF(3),VFR(7),o[1],0,0,0), C1,12,mh); \
    }while(0)
  int t=1;
  #undef CMASK
  #define CMASK(P0,P1,t) do{}while(0)
  for(;t+5<NT;t+=2){
    STEP(pB0,pB1,pA0,pA1,t,true,true,true,true);     WAIT_BAR(3); RESC(); ROT();
    STEP(pA0,pA1,pB0,pB1,t+1,true,true,true,true);   WAIT_BAR(3); RESC(); ROT();
  }
  #undef CMASK
  #define CMASK(P0,P1,t) do{}while(0)
  #define ENDW(tt) do{ if((tt)+3<NT){WAIT_BAR(3);} else if((tt)+2<NT){WAIT_BAR(2);} else {WAIT_BAR(0);} }while(0)
  for(;t+1<NT;t+=2){
    STEP(pB0,pB1,pA0,pA1,t,(t+3<NT),(t+1<NT),(t+1<NT),(t+2<NT));       ENDW(t);   RESC(); ROT();
    STEP(pA0,pA1,pB0,pB1,t+1,(t+4<NT),(t+2<NT),(t+2<NT),(t+3<NT));     ENDW(t+1); RESC(); ROT();
  }
  STEP(pB0,pB1,pA0,pA1,NT-1,false,false,false,false); RESC();
  { float sacc=pB0[0]+pB0[1]; _Pragma("unroll") for(int r=2;r<16;++r)sacc+=pB0[r]; _Pragma("unroll") for(int r=0;r<16;++r)sacc+=pB1[r]; l_reg+=sacc;
    pw0=(u32x4){PKW(pB0,0),PKW(pB0,2),PKW(pB0,4),PKW(pB0,6)};pw1=(u32x4){PKW(pB0,8),PKW(pB0,10),PKW(pB0,12),PKW(pB0,14)};pw2=(u32x4){PKW(pB1,0),PKW(pB1,2),PKW(pB1,4),PKW(pB1,6)};pw3=(u32x4){PKW(pB1,8),PKW(pB1,10),PKW(pB1,12),PKW(pB1,14)};
    SBAR(); pv(o,vb0+sl_cur,PAF(0),PAF(1),PAF(2),PAF(3)); }
  #undef PKW
  #undef PAF
  #undef VFR
  #undef PIN
  #undef MX3
  #undef GAPA
  #undef GAPB
  #undef EX
  #undef VRD
  #undef KRD
  #undef STEP
  #undef ENDW
  {auto rr=__builtin_amdgcn_permlane32_swap(__float_as_uint(l_reg),__float_as_uint(l_reg),false,false);l_reg=__uint_as_float(rr[0])+__uint_as_float(rr[1]);}
  if(hi==0)wsf[32+r32]=l_reg;asm volatile("s_waitcnt lgkmcnt(0)":::"memory");
  float rli[16];
  #pragma unroll
  for(int r=0;r<16;++r)rli[r]=__builtin_amdgcn_rcpf(wsf[32+crow(r,hi)]);
  bf16*Ow=O+(rowbase+q0+wid*QBLK)*OPITCH+h*D;
  { bf16*stg=(bf16*)(shm+LDS_OST)+wid*2048;
    #pragma unroll
    for(int r=0;r<16;++r){const int orow=crow(r,hi);
      #pragma unroll
      for(int d0=0;d0<2;++d0)stg[orow*64+d0*32+r32]=(bf16)f2bf(o[d0][r]*rli[r]);}
    asm volatile("s_waitcnt lgkmcnt(0)":::"memory");
    #pragma unroll
    for(int i=0;i<4;++i){const int row=i*8+(lane>>3),ch=lane&7; const u32x4 v=*(const u32x4*)(stg+row*64+ch*8); ATTN_STORE16(Ow+(long)row*OPITCH+ch*8,v);} }
  asm volatile("s_waitcnt lgkmcnt(0)\n\ts_barrier":::"memory");
  #undef DMA_K
  #undef DMA_V
  #undef DMA_M
  #undef MLOAD
  #undef CMASK
  #undef START
  #undef RESC
  #undef ROT
}
constexpr int ATTN_LDS_BYTES=LDS_BYTES;
struct AttnTensors { const bf16* Q; const bf16* K; const bf16* V; bf16* O; const unsigned char* MK; };
struct AttnUnit { int bh; int qb; };
struct StaticOrder {
  int vcu;
  __device__ __forceinline__ explicit StaticOrder(int grid,int block):vcu((block%8)*(grid/8)+block/8){}
  __device__ __forceinline__ bool next(int i,AttnUnit&u)const{ if(i>=4)return false; const int s=vcu&7; u.bh=vcu>>3; u.qb=(i==0)?s:(i==1)?15-s:(i==2)?16+s:31-s; return true; }
  __device__ __forceinline__ void a_ready(const AttnUnit&)const{}
  __device__ __forceinline__ void done(const AttnUnit&)const{}
};
template<class Sched,int THRL=8> __device__ __forceinline__ void attn_phase(char*lds,const AttnTensors&T,const Sched&S){
  AttnUnit u;
  for(int i=0;S.next(i,u);++i){ S.a_ready(u); attn_unit<THRL>(u.bh/NHEAD,u.bh%NHEAD,u.qb,T.Q,T.K,T.V,T.O,T.MK,lds); S.done(u); }
}
#undef SBAR
#undef WAIT_BAR
}

struct Args { const void* in[15]; float* out; unsigned char* ws; int ph_lo, ph_hi; };
#define CAS __attribute__((address_space(4)))
struct Frame {
    LAS unsigned char* lds;
    gu32* ctl;
    unsigned char* ws;
    int tid, lane, wave;
    int vcu, G;
    const CAS Args* ka;
    __device__ __forceinline__ const float* inp(int k) const { return (const float*)ka->in[k]; }
#define FDEF(name, k) __device__ __forceinline__ const float* name() const { return inp(k); }
    FDEF(x, 0) FDEF(c, 1) FDEF(w_ada, 3) FDEF(b_ada, 4) FDEF(g_mix, 5) FDEF(w_in, 6) FDEF(w_o, 7) FDEF(g_ffn, 8) FDEF(w_rg, 9) FDEF(w_re, 10) FDEF(w_up, 11) FDEF(w_gate, 12) FDEF(w_down, 13) FDEF(g_fin, 14)
#undef FDEF
    __device__ __forceinline__ const int* pos() const { return (const int*)ka->in[2]; }
    __device__ __forceinline__ float* out() const { return ka->out; }
};

__device__ __forceinline__ void tr_put(LAS unsigned* T, int nb, int ns, int p, const f32x4 a, const f32x4 b) {
    T[(nb) * 33 + p] = pg8::cvt_pk_bf16(a.x, b.x); T[(nb + ns) * 33 + p] = pg8::cvt_pk_bf16(a.y, b.y);
    T[(nb + 2 * ns) * 33 + p] = pg8::cvt_pk_bf16(a.z, b.z); T[(nb + 3 * ns) * 33 + p] = pg8::cvt_pk_bf16(a.w, b.w);
}
__device__ __forceinline__ void tr_store(LAS unsigned* T, bf16* WT, int K, int n0, int k0, int lane) {
    LDS_WAIT(); asm volatile("" ::: "memory");
#pragma unroll
    for (int i = 0; i < 8; ++i) { const int n = (lane >> 3) + 8 * i, kc = lane & 7; const LAS unsigned* t = T + n * 33 + 4 * kc;
        v4u o; o.x = t[0]; o.y = t[1]; o.z = t[2]; o.w = t[3];
        *(GAS v4u*)(WT + (size_t)(n0 + n) * K + k0 + 8 * kc) = o; }
    LDS_WAIT(); asm volatile("" ::: "memory");
}
__device__ __forceinline__ void tr_tile_gu(const float* gate, const float* up, bf16* WT, int n0, int k0, LAS unsigned* T, int lane) {
    const int pq = lane >> 3, cq = lane & 7, c0 = n0 >> 1;
    f32x4 g0[4], g1[4], u0[4], u1[4];
#pragma unroll
    for (int i = 0; i < 4; ++i) { const int p = pq + 8 * i; const size_t o = (size_t)(k0 + 2 * p) * DEXP + c0 + 4 * cq;
        g0[i] = *(const GAS f32x4*)(gate + o); g1[i] = *(const GAS f32x4*)(gate + o + DEXP); u0[i] = *(const GAS f32x4*)(up + o); u1[i] = *(const GAS f32x4*)(up + o + DEXP); }
#pragma unroll
    for (int i = 0; i < 4; ++i) { const int p = pq + 8 * i; tr_put(T, 8 * cq, 2, p, g0[i], g1[i]); tr_put(T, 8 * cq + 1, 2, p, u0[i], u1[i]); }
    tr_store(T, WT, 1024, n0, k0, lane);
}
__device__ __forceinline__ void tr_tile_d(const float* wd, bf16* WT, int n0, int k0, LAS unsigned* T, int lane) {
    const int pq = lane >> 4, cq = lane & 15;
    f32x4 a[8], b[8];
#pragma unroll
    for (int i = 0; i < 8; ++i) { const int p = pq + 4 * i; const size_t o = (size_t)(k0 + 2 * p) * D + n0 + 4 * cq; a[i] = *(const GAS f32x4*)(wd + o); b[i] = *(const GAS f32x4*)(wd + o + D); }
#pragma unroll
    for (int i = 0; i < 8; ++i) { const int p = pq + 4 * i; tr_put(T, 4 * cq, 1, p, a[i], b[i]); }
    tr_store(T, WT, 512, n0, k0, lane);
}

template <class SrcFn>
__device__ __forceinline__ void tr_tile_gen(const SrcFn& src, int ldw, bf16* WT, int K, int n0, int k0, LAS unsigned* T, int lane) {
    const int pq = lane >> 4, cq = lane & 15; const float* sp = src(n0 + 4 * cq);
    f32x4 a[8], b[8];
#pragma unroll
    for (int i = 0; i < 8; ++i) { const int p = pq + 4 * i;
        if (sp) { a[i] = *(const GAS f32x4*)(sp + (size_t)(k0 + 2 * p) * ldw); b[i] = *(const GAS f32x4*)(sp + (size_t)(k0 + 2 * p + 1) * ldw); }
        else { a[i] = (f32x4){0.f, 0.f, 0.f, 0.f}; b[i] = a[i]; } }
#pragma unroll
    for (int i = 0; i < 8; ++i) { const int p = pq + 4 * i; tr_put(T, 4 * cq, 1, p, a[i], b[i]); }
    tr_store(T, WT, K, n0, k0, lane);
}

__device__ __forceinline__ int prope_dim(int p) { return p < 16 ? 8 * ((p >> 2) & 1) + 4 * (p >> 3) + (p & 3) : p; }
__device__ __forceinline__ int rrope_dim(int p) { return 32 * ((p >> 2) & 1) + 4 * (p >> 3) + (p & 3); }
__device__ __forceinline__ int win_src_col(int n) {
    if (n < 1024) return (n & ~63) + prope_dim(n & 63);
    if (n < 1536) return n;
    if (n < 2560) return (n & ~63) + prope_dim(n & 63);
    if (n < 3584) { const int q = n - 2560, sec = q >> 9, hd = (q >> 6) & 7; return (sec ? 3152 : 2640) + hd * 64 + rrope_dim(q & 63); }
    if (n < 4096) return 3664 + (n - 3584);
    if (n < 4608) return 4176 + (n - 4096);
    if (n < 4672) return 2560 + prope_dim(n - 4608);
    if (n < 4688) return 2624 + (n - 4672);
    return -1;
}

__device__ __forceinline__ void p0_prologue(Frame& F) {
    const int gw = F.vcu * NWAVES + F.wave, NGW = F.G * NWAVES;
    float* modp = (float*)(F.ws + WS_MODP);
    for (int rp2 = 0; rp2 < SUBREPS(20); ++rp2)
    for (int task = gw; task < 24 * 16; task += NGW) {
        const int cg = task % 24, ks = task / 24, j0 = cg * 256 + F.lane * 4;
        f32x4 a0 = {0, 0, 0, 0}, a1 = a0, a2 = a0, a3 = a0;
#pragma unroll 8
        for (int kk = 0; kk < 64; ++kk) { const int k = ks * 64 + kk; const f32x4 w = *(const GAS f32x4*)(F.w_ada() + (size_t)k * 6144 + j0);
            a0 += w * F.c()[0 * D + k]; a1 += w * F.c()[1 * D + k]; a2 += w * F.c()[2 * D + k]; a3 += w * F.c()[3 * D + k]; }
        *(GAS f32x4*)(modp + ((size_t)(ks * 4 + 0) * 6144 + j0)) = a0; *(GAS f32x4*)(modp + ((size_t)(ks * 4 + 1) * 6144 + j0)) = a1;
        *(GAS f32x4*)(modp + ((size_t)(ks * 4 + 2) * 6144 + j0)) = a2; *(GAS f32x4*)(modp + ((size_t)(ks * 4 + 3) * 6144 + j0)) = a3;
    }
    {
        float* c1 = (float*)(F.ws + WS_ROPE1); float* s1 = c1 + (size_t)M * 8;
        float* c2 = (float*)(F.ws + WS_ROPE2); float* s2 = c2 + (size_t)M * 32;
        const int gt = (F.vcu * NWAVES + F.wave) * 64 + F.lane, NGT = NGW * 64;
        for (int rp2 = 0; rp2 < SUBREPS(18); ++rp2)
        for (int i = gt; i < M * 40; i += NGT) {
            const int m = i / 40, j = i % 40; const float p = (float)F.pos()[m];
            if (j < 8) { const float inv = powf(500000.0f, -(float)j / 8.0f); float sn, cs; sincosf(p * inv, &sn, &cs); c1[m * 8 + j] = cs; s1[m * 8 + j] = sn; }
            else { const int jj = j - 8; const float inv = powf(10000.0f, -(float)jj / 32.0f); float sn, cs; sincosf(p * inv, &sn, &cs); c2[m * 32 + jj] = cs; s2[m * 32 + jj] = sn; }
        }
    }
    {
        constexpr int I_IN = (NPAD / 64) * (D / 64), I_O = (D / 64) * (D / 64);
        bf16* wint = (bf16*)(F.ws + WS_WIN); bf16* wot = (bf16*)(F.ws + WS_WO);
        const float* w_in = F.w_in(); const float* w_o = F.w_o();
        LAS unsigned* T = (LAS unsigned*)(F.lds + F.wave * 16384);
        for (int rp2 = 0; rp2 < SUBREPS(19); ++rp2)
        for (int it = gw; it < I_IN + I_O; it += NGW) {
            if (it < I_IN) { const int nb = it / 16, kb = it % 16;
                tr_tile_gen([&](int n) -> const float* { const int sc = win_src_col(n); return sc < 0 ? nullptr : w_in + sc; }, DIN, wint, D, nb * 64, kb * 64, T, F.lane); }
            else { const int r = it - I_IN, nb = r / 16, kb = r % 16;
                tr_tile_gen([&](int n) -> const float* { return w_o + n; }, D, wot, D, nb * 64, kb * 64, T, F.lane); }
        }
    }
}

__device__ __forceinline__ float mod_value(const float* modp, const float* b_ada, int b, int j) {
    float s = 0.f;
#pragma unroll
    for (int ks = 0; ks < 16; ++ks) s += modp[(size_t)(ks * 4 + b) * 6144 + j];
    return s + b_ada[j];
}
__device__ __forceinline__ void p1_norm(Frame& F) {
    const float* modp = (const float*)(F.ws + WS_MODP);
    LAS float* G1 = (LAS float*)F.lds;
    LAS float* S1 = G1 + 4 * D;
    for (int i = F.tid; i < 4 * D; i += NWAVES * 64) { const int b = i >> 10, col = i & 1023;
        const float sh = mod_value(modp, F.b_ada(), b, col), sc = mod_value(modp, F.b_ada(), b, 1024 + col);
        G1[i] = F.g_mix()[col] * (1.f + sc); S1[i] = sh; }
    if (blockIdx.x < 4) { float* mod = (float*)(F.ws + WS_MOD); const int b = blockIdx.x;
        for (int j = F.tid; j < 6144; j += NWAVES * 64) mod[b * 6144 + j] = mod_value(modp, F.b_ada(), b, j); }
    __syncthreads();
    const int gw = F.vcu * NWAVES + F.wave, NGW = F.G * NWAVES;
    bf16* H = (bf16*)(F.ws + WS_H);
    f32x4 nv[4];
    if (gw < M) { const GAS f32x4* xr = (const GAS f32x4*)(F.x() + (size_t)gw * D) + F.lane;
#pragma unroll
        for (int j = 0; j < 4; ++j) nv[j] = xr[64 * j]; }
    for (int m = gw; m < M; m += NGW) {
        const int b = m >> 13;
        f32x4 v[4]; float s = 0.f;
#pragma unroll
        for (int j = 0; j < 4; ++j) v[j] = nv[j];
        if (m + NGW < M) { const GAS f32x4* xr = (const GAS f32x4*)(F.x() + (size_t)(m + NGW) * D) + F.lane;
#pragma unroll
            for (int j = 0; j < 4; ++j) nv[j] = xr[64 * j]; }
#pragma unroll
        for (int j = 0; j < 4; ++j) s += (v[j].x * v[j].x + v[j].y * v[j].y) + (v[j].z * v[j].z + v[j].w * v[j].w);
        const float r = 1.f / sqrtf(wave_sum(s) * (1.f / D) + EPS);
        GAS unsigned long long* o8 = (GAS unsigned long long*)(H + (size_t)m * D) + F.lane;
#pragma unroll
        for (int j = 0; j < 4; ++j) { const int col = 4 * F.lane + 256 * j; const f32x4 g = *(const LAS f32x4*)(G1 + b * D + col), sh = *(const LAS f32x4*)(S1 + b * D + col);
            const f32x4 h = v[j] * r * g + sh;
            o8[64 * j] = (unsigned long long)pk2(h.x, h.y) | ((unsigned long long)pk2(h.z, h.w) << 32); }
    }
    __syncthreads();
}

struct EpiInProj {
    static constexpr bool PERM = true;
    unsigned char* ws;
    __device__ __forceinline__ void operator()(f32x4 (&acc)[2][2][4][2], const pg8::Unit& u, int wr, int wc, int fr, int fq) const {
        const int pn = u.pn; const int row0 = u.pm * 256 + wr * 64 + fr;
        const bool prope = (pn < 4) || (pn >= 6 && pn < 10) || (pn == 18);
        const bool rrope = (pn >= 10 && pn < 14);
        const bool roped = rrope || (prope && (wc & 1) == 0 && !(pn == 18 && wc != 0));
        const int g = 4 * (wc & 1) + fq;
        const bool act = rrope || (fq < 2);
        const int tl = rrope ? 32 : 8;
        const float* ct = (const float*)(ws + (rrope ? WS_ROPE2 : WS_ROPE1)) + 4 * (act ? g : 0); const float* stb = ct + (size_t)M * tl;
        bf16* base; int ld, colt; float sc = 1.f;
        if (pn < 2) { base = (bf16*)(ws + WS_QA); ld = 512; colt = pn * 256; sc = C2; }
        else if (pn < 4) { base = (bf16*)(ws + WS_KA); ld = 512; colt = (pn - 2) * 256; }
        else if (pn < 6) { base = (bf16*)(ws + WS_VA); ld = 512; colt = (pn - 4) * 256; }
        else if (pn < 10) { base = (bf16*)(ws + WS_QI); ld = 1024; colt = (pn - 6) * 256; }
        else if (pn < 12) { base = (bf16*)(ws + WS_QB); ld = 512; colt = (pn - 10) * 256; }
        else if (pn < 14) { base = (bf16*)(ws + WS_KB); ld = 512; colt = (pn - 12) * 256; sc = 0.125f; }
        else if (pn < 16) { base = (bf16*)(ws + WS_VB); ld = 512; colt = (pn - 14) * 256; }
        else if (pn < 18) { base = (bf16*)(ws + WS_GB); ld = 512; colt = (pn - 16) * 256; }
        else { base = (bf16*)(ws + WS_KI); ld = 64; colt = 0; }
        int colA[2], colB[2];
#pragma unroll
        for (int bj = 0; bj < 2; ++bj) { const int col = bj * 128 + wc * 32 + 8 * fq, hb = col & ~63;
            if (rrope) { colA[bj] = hb + 4 * g; colB[bj] = hb + 32 + 4 * g; }
            else if (prope && (wc & 1) == 0 && fq < 2 && !(pn == 18 && wc != 0)) { colA[bj] = hb + 4 * g; colB[bj] = hb + 8 + 4 * g; }
            else { colA[bj] = col; colB[bj] = col + 4; } }
        float* wi = (float*)(ws + WS_WI);
        f32x4 cnx = {0.f, 0.f, 0.f, 0.f}, snx = cnx;
        if (roped) { cnx = *(const GAS f32x4*)(ct + (size_t)row0 * tl); snx = *(const GAS f32x4*)(stb + (size_t)row0 * tl); }
#pragma unroll
        for (int ai = 0; ai < 2; ++ai)
#pragma unroll
            for (int m = 0; m < 4; ++m) { const int row = row0 + ai * 128 + m * 16;
                if (roped) {
                    const f32x4 cs = cnx, sn = snx;
                    if (!(ai == 1 && m == 3)) { const int rn = row0 + ((m == 3) ? 128 : ai * 128 + (m + 1) * 16);
                        cnx = *(const GAS f32x4*)(ct + (size_t)rn * tl); snx = *(const GAS f32x4*)(stb + (size_t)rn * tl); }
#pragma unroll
                    for (int bj = 0; bj < 2; ++bj) { const f32x4 x1 = acc[ai][bj][m][0], x2 = acc[ai][bj][m][1];
                        if (act) { acc[ai][bj][m][0] = x1 * cs - x2 * sn; acc[ai][bj][m][1] = x2 * cs + x1 * sn; } }
                }
                if (pn < 18) {
#pragma unroll
                    for (int bj = 0; bj < 2; ++bj) {
                        const f32x4 v0 = acc[ai][bj][m][0] * sc, v1 = acc[ai][bj][m][1] * sc; v2u wa, wb;
                        wa.x = pg8::cvt_pk_bf16(v0[0], v0[1]); wa.y = pg8::cvt_pk_bf16(v0[2], v0[3]); wb.x = pg8::cvt_pk_bf16(v1[0], v1[1]); wb.y = pg8::cvt_pk_bf16(v1[2], v1[3]);
                        bf16* rp = base + (size_t)row * ld + colt;
                        *(GAS v2u*)(rp + colA[bj]) = wa; *(GAS v2u*)(rp + colB[bj]) = wb; }
                } else {
                    const int col = wc * 32 + 8 * fq;
                    const f32x4 v0 = acc[ai][0][m][0], v1 = acc[ai][0][m][1];
                    if (col < 64) { v2u wa, wb; wa.x = pg8::cvt_pk_bf16(v0[0], v0[1]); wa.y = pg8::cvt_pk_bf16(v0[2], v0[3]); wb.x = pg8::cvt_pk_bf16(v1[0], v1[1]); wb.y = pg8::cvt_pk_bf16(v1[2], v1[3]);
                        *(GAS v2u*)(base + (size_t)row * 64 + colA[0]) = wa; *(GAS v2u*)(base + (size_t)row * 64 + colB[0]) = wb; }
                    else if (col < 80) { *(GAS f32x4*)(wi + (size_t)row * 16 + (col - 64)) = v0 * 0.25f; *(GAS f32x4*)(wi + (size_t)row * 16 + (col - 64) + 4) = v1 * 0.25f; }
                }
                asm volatile("" ::: "memory");
            }
    }
};

struct EpiOutProj {
    static constexpr bool PERM = true;
    bf16* mix; const float* mod;
    __device__ __forceinline__ void operator()(f32x4 (&acc)[2][2][4][2], const pg8::Unit& u, int wr, int wc, int fr, int fq) const {
        const int row0 = u.pm * 256 + wr * 64 + fr; const int b = (u.pm * 256) >> 13;
#pragma unroll
        for (int bj = 0; bj < 2; ++bj) { const int col = u.pn * 256 + bj * 128 + wc * 32 + 8 * fq;
            const f32x4 g0 = *(const GAS f32x4*)(mod + b * 6144 + 2048 + col), g1 = *(const GAS f32x4*)(mod + b * 6144 + 2048 + col + 4);
#pragma unroll
            for (int ai = 0; ai < 2; ++ai)
#pragma unroll
                for (int m = 0; m < 4; ++m) { const f32x4 v0 = acc[ai][bj][m][0] * g0, v1 = acc[ai][bj][m][1] * g1; v4u w;
                    w.x = pg8::cvt_pk_bf16(v0[0], v0[1]); w.y = pg8::cvt_pk_bf16(v0[2], v0[3]); w.z = pg8::cvt_pk_bf16(v1[0], v1[1]); w.w = pg8::cvt_pk_bf16(v1[2], v1[3]);
                    *(GAS v4u*)(mix + (size_t)(row0 + ai * 128 + m * 16) * D + col) = w; } }
    }
};

__device__ __forceinline__ float ret_log_gamma(int h) { return log1pf(-exp2f(-5.0f - (float)h)); }
__device__ __forceinline__ int crow(int r, int hi) { return (r & 3) + 8 * (r >> 2) + 4 * hi; }

typedef short v4i16_t __attribute__((ext_vector_type(4)));
constexpr size_t WS_TOT = WS_MASK;
constexpr size_t WS_CARRY = WS_MASK + 8 * MiB;
__device__ __forceinline__ void ra_states(Frame& F) {
    const bf16* KB = (const bf16*)(F.ws + WS_KB); const bf16* VB = (const bf16*)(F.ws + WS_VB);
    float* ST = (float*)(F.ws + WS_ST); float* TOT = (float*)(F.ws + WS_TOT);
    const int lane = F.lane, r32 = lane & 31, hi = lane >> 5, gi = lane & 15, gg = lane >> 4, wave = F.wave;
    const int half = wave >> 2, et = (wave >> 1) & 1, dt = wave & 1, ht = F.tid & 255;
    for (int unit = F.vcu; unit < 256; unit += F.G) {
        const int bh = unit >> 3, h = bh & 7, b = bh >> 3, c0 = (unit & 7) * 16 + half * 8;
        const float lg = ret_log_gamma(h), g = __expf(64.f * lg);
        f32x16 acc = f32x16{};
        const int offA = (((gi >> 2) + 8 * hi) * 64 + 32 * et + 16 * (gg & 1) + 4 * (gi & 3)) * 2;
        const int offB = (((gi >> 2) + 8 * hi) * 64 + 32 * dt + 16 * (gg & 1) + 4 * (gi & 3)) * 2;
        v4u nk[2], nvv[2];
#define RA_LOAD(cc) do { const size_t t0_ = (size_t)b * SEQ + (size_t)(cc) * 64; _Pragma("unroll") for (int p = 0; p < 2; ++p) { const int idx = ht + 256 * p, row = idx >> 3, q = idx & 7; \
            nk[p] = *(const GAS v4u*)(KB + (t0_ + row) * 512 + h * 64 + q * 8); nvv[p] = *(const GAS v4u*)(VB + (t0_ + row) * 512 + h * 64 + q * 8); } } while (0)
        RA_LOAD(c0);
#pragma unroll 1
        for (int i = 0; i < 8; ++i) {
            const int c = c0 + i;
            LAS unsigned short* Ks = (LAS unsigned short*)(F.lds + (half * 2 + (i & 1)) * 16384);
            LAS unsigned short* Vs = Ks + 4096;
#pragma unroll
            for (int p = 0; p < 2; ++p) { const int idx = ht + 256 * p, row = idx >> 3, q = idx & 7;
                v4u kk = nk[p]; const float z = __expf((63.f - (float)row) * lg); unsigned* kw = (unsigned*)&kk;
#pragma unroll
                for (int e = 0; e < 4; ++e) kw[e] = pg8::cvt_pk_bf16(bf2f((unsigned short)(kw[e] & 0xffff)) * z, bf2f((unsigned short)(kw[e] >> 16)) * z);
                *(LAS v4u*)(Ks + row * 64 + q * 8) = kk; *(LAS v4u*)(Vs + row * 64 + q * 8) = nvv[p]; }
            if (i < 7) RA_LOAD(c + 1);
            { float* st = ST + ((size_t)bh * 128 + c) * 4096;
#pragma unroll
                for (int r = 0; r < 16; ++r) st[(32 * et + crow(r, hi)) * 64 + 32 * dt + r32] = acc[r]; }
#pragma unroll
            for (int r = 0; r < 16; ++r) acc[r] *= g;
            __syncthreads();
#pragma unroll
            for (int ks = 0; ks < 4; ++ks) {
                const LAS unsigned char* va = (const LAS unsigned char*)Vs + offA + ks * 16 * 64 * 2; const LAS unsigned char* kb = (const LAS unsigned char*)Ks + offB + ks * 16 * 64 * 2;
                const v4i16_t a0 = __builtin_amdgcn_ds_read_tr16_b64_v4i16((LAS v4i16_t*)va), a1 = __builtin_amdgcn_ds_read_tr16_b64_v4i16((LAS v4i16_t*)(va + 4 * 64 * 2));
                const v4i16_t b0 = __builtin_amdgcn_ds_read_tr16_b64_v4i16((LAS v4i16_t*)kb), b1 = __builtin_amdgcn_ds_read_tr16_b64_v4i16((LAS v4i16_t*)(kb + 4 * 64 * 2));
                acc = __builtin_amdgcn_mfma_f32_32x32x16_bf16((bf16x8){a0[0], a0[1], a0[2], a0[3], a1[0], a1[1], a1[2], a1[3]}, (bf16x8){b0[0], b0[1], b0[2], b0[3], b1[0], b1[1], b1[2], b1[3]}, acc, 0, 0, 0); }
        }
#undef RA_LOAD
        { float* tt = TOT + ((size_t)bh * 16 + (unit & 7) * 2 + half) * 4096;
#pragma unroll
            for (int r = 0; r < 16; ++r) tt[(32 * et + crow(r, hi)) * 64 + 32 * dt + r32] = acc[r]; }
        __syncthreads();
    }
}
__device__ __forceinline__ void rb_carry(Frame& F) {
    const float* TOT = (const float*)(F.ws + WS_TOT); float* CAR = (float*)(F.ws + WS_CARRY);
    const int gt = (F.vcu * NWAVES + F.wave) * 64 + F.lane, NGT = F.G * NWAVES * 64;
    for (int i = gt; i < 32 * 4096; i += NGT) {
        const int bh = i >> 12, el = i & 4095, h = bh & 7;
        const float g8 = __expf(512.f * ret_log_gamma(h));
        const float* p = TOT + (size_t)bh * 16 * 4096 + el; float* q = CAR + (size_t)bh * 16 * 4096 + el; float run = 0.f;
#pragma unroll
        for (int gI = 0; gI < 16; ++gI) { const float t = p[(size_t)gI * 4096]; q[(size_t)gI * 4096] = run; run = run * g8 + t; }
    }
}
__device__ __forceinline__ void r3_out(Frame& F) {
    const int gw = F.vcu * NWAVES + F.wave, NGW = F.G * NWAVES;
    LAS unsigned short* Vs = (LAS unsigned short*)(F.lds + F.wave * 16384);
    const bf16* QB = (const bf16*)(F.ws + WS_QB); const bf16* KB = (const bf16*)(F.ws + WS_KB); const bf16* VB = (const bf16*)(F.ws + WS_VB); const bf16* GB = (const bf16*)(F.ws + WS_GB);
    const float* ST = (const float*)(F.ws + WS_ST); const float* CAR = (const float*)(F.ws + WS_CARRY); bf16* Y = (bf16*)(F.ws + WS_Y);
    const int lane = F.lane, r32 = lane & 31, hi = lane >> 5, gi = lane & 15, gg = lane >> 4;
    const int vtr_off = (((gi >> 2) + 4 * hi) * 64 + 16 * (gg & 1) + 4 * (gi & 3)) * 2;
    for (int u = gw; u < NB * 8 * 128; u += NGW) {
        const int c = u & 127, h = (u >> 7) & 7, b = u >> 10;
        const float lg = ret_log_gamma(h), gpc = __expf(64.f * (float)(c & 7) * lg);
        const size_t tok0 = (size_t)b * SEQ + (size_t)c * 64;
        { const GAS v4u* vp = (const GAS v4u*)(VB + (tok0 + lane) * 512 + h * 64);
#pragma unroll
            for (int q = 0; q < 8; ++q) *(LAS v4u*)(Vs + lane * 64 + q * 8) = vp[q]; }
        bf16x8 qf[2][4], pf[2][4];
#pragma unroll
        for (int t = 0; t < 2; ++t)
#pragma unroll
            for (int ks = 0; ks < 4; ++ks) {
                qf[t][ks] = *(const GAS bf16x8*)(QB + (tok0 + 32 * t + r32) * 512 + h * 64 + 16 * ks + 8 * hi);
                const float* sp = ST + (size_t)u * 4096 + (32 * t + r32) * 64 + 16 * ks + 8 * hi;
                const float* cp = CAR + ((size_t)(u >> 7) * 16 + (c >> 3)) * 4096 + (32 * t + r32) * 64 + 16 * ks + 8 * hi;
                const f32x4 s0 = *(const GAS f32x4*)sp + *(const GAS f32x4*)cp * gpc, s1 = *(const GAS f32x4*)(sp + 4) + *(const GAS f32x4*)(cp + 4) * gpc;
                v4u w; w.x = pg8::cvt_pk_bf16(s0.x, s0.y); w.y = pg8::cvt_pk_bf16(s0.z, s0.w); w.z = pg8::cvt_pk_bf16(s1.x, s1.y); w.w = pg8::cvt_pk_bf16(s1.z, s1.w);
                pf[t][ks] = __builtin_bit_cast(bf16x8, w); }
        float emr[16];
#pragma unroll
        for (int r = 0; r < 16; ++r) emr[r] = __expf(-(float)crow(r, hi) * lg);
        const float em32 = __expf(-32.f * lg);
        LDS_WAIT(); asm volatile("" ::: "memory");
#pragma unroll
        for (int nt = 0; nt < 2; ++nt) {
            const int n = 32 * nt + r32;
            const float en = __expf((float)n * lg), xi = __expf((float)(n + 1) * lg);
            f32x16 y[2]; y[0] = f32x16{}; y[1] = f32x16{};
#pragma unroll
            for (int et = 0; et < 2; ++et)
#pragma unroll
                for (int ks = 0; ks < 4; ++ks) y[et] = __builtin_amdgcn_mfma_f32_32x32x16_bf16(pf[et][ks], qf[nt][ks], y[et], 0, 0, 0);
#pragma unroll
            for (int r = 0; r < 16; ++r) { y[0][r] *= xi; y[1][r] *= xi; }
#pragma unroll
            for (int mt = 0; mt <= nt; ++mt) {
                f32x16 st = f32x16{};
#pragma unroll
                for (int ks = 0; ks < 4; ++ks) { const bf16x8 kf = *(const GAS bf16x8*)(KB + (tok0 + 32 * mt + r32) * 512 + h * 64 + 16 * ks + 8 * hi);
                    st = __builtin_amdgcn_mfma_f32_32x32x16_bf16(kf, qf[nt][ks], st, 0, 0, 0); }
                const float enm = mt ? en * em32 : en;
#pragma unroll
                for (int r = 0; r < 16; ++r) { const int m = 32 * mt + crow(r, hi); st[r] = (n >= m) ? st[r] * (enm * emr[r]) : 0.f; }
#pragma unroll
                for (int s2 = 0; s2 < 2; ++s2) {
                    v4u pw; pw.x = pg8::cvt_pk_bf16(st[8 * s2 + 0], st[8 * s2 + 1]); pw.y = pg8::cvt_pk_bf16(st[8 * s2 + 2], st[8 * s2 + 3]); pw.z = pg8::cvt_pk_bf16(st[8 * s2 + 4], st[8 * s2 + 5]); pw.w = pg8::cvt_pk_bf16(st[8 * s2 + 6], st[8 * s2 + 7]);
                    const bf16x8 pb = __builtin_bit_cast(bf16x8, pw);
#pragma unroll
                    for (int et = 0; et < 2; ++et) {
                        const LAS unsigned char* vb = (const LAS unsigned char*)Vs + vtr_off + ((32 * mt + 16 * s2) * 64 + 32 * et) * 2;
                        const v4i16_t lo = __builtin_amdgcn_ds_read_tr16_b64_v4i16((LAS v4i16_t*)vb), hh = __builtin_amdgcn_ds_read_tr16_b64_v4i16((LAS v4i16_t*)(vb + 8 * 64 * 2));
                        const bf16x8 va = (bf16x8){lo[0], lo[1], lo[2], lo[3], hh[0], hh[1], hh[2], hh[3]};
                        y[et] = __builtin_amdgcn_mfma_f32_32x32x16_bf16(va, pb, y[et], 0, 0, 0); }
                }
            }
            float sm = 0.f;
#pragma unroll
            for (int r = 0; r < 16; ++r) sm += y[0][r] + y[1][r];
            sm += __shfl_xor(sm, 32);
            const float mu = sm * (1.f / 64.f); float q = 0.f;
#pragma unroll
            for (int r = 0; r < 16; ++r) { y[0][r] -= mu; y[1][r] -= mu; q += y[0][r] * y[0][r] + y[1][r] * y[1][r]; }
            q += __shfl_xor(q, 32);
            const float rs = __builtin_amdgcn_rsqf(q * (1.f / 64.f) + EPS);
            const size_t tok = tok0 + n;
#pragma unroll
            for (int et = 0; et < 2; ++et)
#pragma unroll
                for (int g4 = 0; g4 < 4; ++g4) { const int e0 = 32 * et + 8 * g4 + 4 * hi;
                    const v2u gv = *(const GAS v2u*)(GB + tok * 512 + h * 64 + e0);
                    float o4[4];
#pragma unroll
                    for (int i = 0; i < 4; ++i) { const float g = bf2f((unsigned short)((i & 1) ? ((i & 2) ? gv.y : gv.x) >> 16 : ((i & 2) ? gv.y : gv.x) & 0xffff));
                        const float sg = g * __builtin_amdgcn_rcpf(1.f + __expf(-g)); o4[i] = sg * y[et][4 * g4 + i] * rs; }
                    v2u ov; ov.x = pg8::cvt_pk_bf16(o4[0], o4[1]); ov.y = pg8::cvt_pk_bf16(o4[2], o4[3]);
                    *(GAS v2u*)(Y + tok * D + 512 + h * 64 + e0) = ov; }
        }
        LDS_WAIT(); asm volatile("" ::: "memory");
    }
}

__device__ __forceinline__ void p_norm2_route(Frame& F) {
    const float* mod = (const float*)(F.ws + WS_MOD);
    LAS f32x4* RG = (LAS f32x4*)F.lds;
    LAS f32x4* RE = (LAS f32x4*)(F.lds + 16384);
    { const float* wrg = F.w_rg(); const float* wre = F.w_re();
        for (int i = F.tid; i < 1024; i += NWAVES * 64) { const int ln = (i & 255) >> 2, j = i >> 8, t = i & 3; RG[(j * 4 + t) * 64 + ln] = *(const GAS f32x4*)(wrg + (size_t)i * 4); }
        for (int i = F.tid; i < 4 * 1024 * 2; i += NWAVES * 64) { const int g = i >> 11, row = (i >> 1) & 1023, hf = i & 1, ln = (row & 255) >> 2, j = row >> 8, t = row & 3;
            RE[g * 2048 + ((j * 4 + t) * 2 + hf) * 64 + ln] = *(const GAS f32x4*)(wre + ((size_t)g * 1024 + row) * 8 + hf * 4); } }
    constexpr int RT_CAP = 300;
    LAS unsigned* RC = (LAS unsigned*)(F.lds + 147456);
    LAS unsigned* REC = RC + 65;
    static_assert(147456 + (65 + 3 * RT_CAP) * 4 <= RING_BYTES + AUX_BYTES, "router LDS map");
    for (int i = F.tid; i < 65; i += NWAVES * 64) RC[i] = 0u;
    __syncthreads();
    const int gw = F.vcu * NWAVES + F.wave, NGW = F.G * NWAVES;
    const float* X = F.x(); const bf16* MIX = (const bf16*)(F.ws + WS_MIX); bf16* H2 = (bf16*)(F.ws + WS_H2);
    unsigned* ltok = (unsigned*)(F.ws + WS_ROUTE); float* lw = (float*)(F.ws + WS_ROUTE + 4 * MiB);
    f32x4 nv[4]; v2u nm[4];
#define N2_LOAD(mm) do { const GAS f32x4* xr = (const GAS f32x4*)(X + (size_t)(mm) * D) + F.lane; \
        _Pragma("unroll") for (int j = 0; j < 4; ++j) { nv[j] = xr[64 * j]; nm[j] = *(const GAS v2u*)(MIX + (size_t)(mm) * D + 4 * F.lane + 256 * j); } } while (0)
    if (gw < M) N2_LOAD(gw);
    for (int m = gw; m < M; m += NGW) {
        const int b = m >> 13;
        f32x4 v[4]; float s = 0.f;
#pragma unroll
        for (int j = 0; j < 4; ++j) { v[j] = nv[j]; v[j].x += bf2f((unsigned short)(nm[j].x & 0xffff)); v[j].y += bf2f((unsigned short)(nm[j].x >> 16)); v[j].z += bf2f((unsigned short)(nm[j].y & 0xffff)); v[j].w += bf2f((unsigned short)(nm[j].y >> 16)); }
        if (m + NGW < M) N2_LOAD(m + NGW);
#pragma unroll
        for (int j = 0; j < 4; ++j) s += (v[j].x * v[j].x + v[j].y * v[j].y) + (v[j].z * v[j].z + v[j].w * v[j].w);
        const float r = 1.f / sqrtf(wave_sum(s) * (1.f / D) + EPS);
        GAS unsigned long long* o8 = (GAS unsigned long long*)(H2 + (size_t)m * D) + F.lane;
        f32x4 lg = {0.f, 0.f, 0.f, 0.f};
#pragma unroll
        for (int j = 0; j < 4; ++j) { const int col = 4 * F.lane + 256 * j;
            const f32x4 g = *(const GAS f32x4*)(F.g_ffn() + col) * (*(const GAS f32x4*)(mod + b * 6144 + 4096 + col) + 1.f), sh = *(const GAS f32x4*)(mod + b * 6144 + 3072 + col);
            v[j] = v[j] * r * g + sh;
            o8[64 * j] = (unsigned long long)pk2(v[j].x, v[j].y) | ((unsigned long long)pk2(v[j].z, v[j].w) << 32);
            const LAS f32x4* wg = RG + (j * 4) * 64 + F.lane;
            lg += wg[0] * v[j].x; lg += wg[64] * v[j].y; lg += wg[128] * v[j].z; lg += wg[192] * v[j].w; }
        lg.x = wave_sum(lg.x); lg.y = wave_sum(lg.y); lg.z = wave_sum(lg.z); lg.w = wave_sum(lg.w);
        int grp = 0; float mx = lg.x;
        if (lg.y > mx) { mx = lg.y; grp = 1; } if (lg.z > mx) { mx = lg.z; grp = 2; } if (lg.w > mx) { mx = lg.w; grp = 3; }
        const float pgrp = 1.f / (expf(lg.x - mx) + expf(lg.y - mx) + expf(lg.z - mx) + expf(lg.w - mx));
        f32x4 f0 = {0.f, 0.f, 0.f, 0.f}, f1 = f0;
        const LAS f32x4* reg = RE + grp * 2048 + F.lane;
#pragma unroll
        for (int j = 0; j < 4; ++j) { const LAS f32x4* we = reg + (j * 8) * 64;
            f0 += we[0] * v[j].x; f1 += we[64] * v[j].x; f0 += we[128] * v[j].y; f1 += we[192] * v[j].y; f0 += we[256] * v[j].z; f1 += we[320] * v[j].z; f0 += we[384] * v[j].w; f1 += we[448] * v[j].w; }
        float fe[8];
        fe[0] = wave_sum(f0.x); fe[1] = wave_sum(f0.y); fe[2] = wave_sum(f0.z); fe[3] = wave_sum(f0.w); fe[4] = wave_sum(f1.x); fe[5] = wave_sum(f1.y); fe[6] = wave_sum(f1.z); fe[7] = wave_sum(f1.w);
        int i1 = 0; float m1 = fe[0];
#pragma unroll
        for (int e = 1; e < 8; ++e) if (fe[e] > m1) { m1 = fe[e]; i1 = e; }
        int i2 = -1; float m2 = -INFINITY;
#pragma unroll
        for (int e = 0; e < 8; ++e) if (e != i1 && fe[e] > m2) { m2 = fe[e]; i2 = e; }
        const float e2 = expf(m2 - m1); const float w1 = pgrp / (1.f + e2), w2 = pgrp * e2 / (1.f + e2);
        if (F.lane < 2) { const int e = grp * 8 + (F.lane ? i2 : i1); const float w = F.lane ? w2 : w1;
            const unsigned slot = __hip_atomic_fetch_add(RC + 64, 1u, __ATOMIC_RELAXED, __HIP_MEMORY_SCOPE_WORKGROUP);
            if (slot < (unsigned)RT_CAP) { const unsigned lp = __hip_atomic_fetch_add(RC + e, 1u, __ATOMIC_RELAXED, __HIP_MEMORY_SCOPE_WORKGROUP);
                REC[slot] = ((unsigned)e << 16) | lp; REC[RT_CAP + slot] = (unsigned)m | ((unsigned)F.lane << 31); REC[2 * RT_CAP + slot] = __float_as_uint(w); }
            else { const unsigned p = __hip_atomic_fetch_add((unsigned*)(F.ctl + CW_ECNT + 64 * e), 1u, RLX_AGENT);
                ltok[(size_t)e * M + p] = (unsigned)m | ((unsigned)F.lane << 31); lw[(size_t)e * M + p] = w; } }
    }
    __syncthreads();
    if (F.tid < NEXP) { const unsigned c = RC[F.tid]; RC[32 + F.tid] = c ? __hip_atomic_fetch_add((unsigned*)(F.ctl + CW_ECNT + 64 * F.tid), c, RLX_AGENT) : 0u; }
    __syncthreads();
    { const unsigned nrec = RC[64] < (unsigned)RT_CAP ? RC[64] : (unsigned)RT_CAP;
        for (unsigned r = F.tid; r < nrec; r += NWAVES * 64) { const unsigned ep = REC[r], e = ep >> 16, p = RC[32 + e] + (ep & 0xffffu);
            ltok[(size_t)e * M + p] = REC[RT_CAP + r]; lw[(size_t)e * M + p] = __uint_as_float(REC[2 * RT_CAP + r]); } }
    __syncthreads();
}
__device__ __forceinline__ void p_expert_convert(Frame& F, int part, int nparts) {
    const int gw = F.vcu * NWAVES + F.wave, NGW = F.G * NWAVES;
    int ln = F.lane; asm volatile("" : "+v"(ln));
    LAS unsigned* T = (LAS unsigned*)(F.lds + F.wave * 16384);
    bf16* wgu = (bf16*)(F.ws + WS_WGU); bf16* wd = (bf16*)(F.ws + WS_WD);
    constexpr int I_GU = NEXP * 16 * 16, I_D = NEXP * 16 * 8;
    int k = 0;
    for (int it = gw; it < I_GU + I_D; it += NGW, ++k) {
        if (k % nparts != part) continue;
        if (it < I_GU) { const int e = it >> 8, r = it & 255, nt = r >> 4, kt = r & 15;
            tr_tile_gu(F.w_gate() + (size_t)e * D * DEXP, F.w_up() + (size_t)e * D * DEXP, wgu + (size_t)e * 1024 * 1024, nt * 64, kt * 64, T, ln); }
        else { const int q = it - I_GU, e = q >> 7, r = q & 127, nt = r >> 3, kt = r & 7;
            tr_tile_d(F.w_down() + (size_t)e * DEXP * D, wd + (size_t)e * 1024 * 512, nt * 64, kt * 64, T, ln); }
    }
}

constexpr int MOE_MAXU = 5;
struct MoeSched {
    int G, c, nunits; LAS int* blkstart; LAS unsigned* tok; bool gather;
    __device__ __forceinline__ bool next(int i, pg8::Unit& u) const {
        const int L = i * G + c; if (L >= nunits || i >= MOE_MAXU) return false;
        const int blk = L >> 2, pnl = L & 3; int e = 0;
#pragma unroll 1
        for (int k = 1; k < NEXP; ++k) if (blkstart[k] <= blk) e = k;
        u.pm = i | (blk << 8); u.pn = e * 4 + pnl; return true;
    }
    __device__ __forceinline__ int arow(const pg8::Unit& u, int rt) const {
        if (gather) { const unsigned t = tok[(u.pm & 255) * 256 + rt]; return (int)(t == 0xffffffffu ? 0u : (t & 0x7fffffffu)); }
        return (u.pm >> 8) * 256 + rt;
    }
    __device__ __forceinline__ int brow0(const pg8::Unit& u) const { return u.pn * 256; }
};
__device__ __forceinline__ int moe_tables(Frame& F, LAS int* blkstart, LAS unsigned* tok, LAS float* wts) {
    if (F.tid == 0) { int acc = 0; for (int e = 0; e < NEXP; ++e) { blkstart[e] = acc; const unsigned cnt = __hip_atomic_load((unsigned*)(F.ctl + CW_ECNT + 64 * e), RLX_AGENT); acc += (int)((cnt + 255u) >> 8); } blkstart[NEXP] = acc; }
    __syncthreads();
    const int nunits = blkstart[NEXP] * 4;
    const unsigned* ltok = (const unsigned*)(F.ws + WS_ROUTE); const float* lw = (const float*)(F.ws + WS_ROUTE + 4 * MiB);
    for (int i = 0; i < MOE_MAXU; ++i) { const int L = i * F.G + F.vcu; if (L >= nunits) break;
        const int blk = L >> 2; int e = 0;
        for (int k = 1; k < NEXP; ++k) if (blkstart[k] <= blk) e = k;
        const unsigned cnt = __hip_atomic_load((unsigned*)(F.ctl + CW_ECNT + 64 * e), RLX_AGENT);
        for (int r = F.tid; r < 256; r += NWAVES * 64) { const unsigned p = (unsigned)(blk - blkstart[e]) * 256u + (unsigned)r;
            tok[i * 256 + r] = p < cnt ? ltok[(size_t)e * M + p] : 0xffffffffu; wts[i * 256 + r] = p < cnt ? lw[(size_t)e * M + p] : 0.f; } }
    __syncthreads();
    return nunits;
}
struct EpiMoe1 {
    static constexpr bool PERM = true;
    bf16* act;
    __device__ __forceinline__ void operator()(f32x4 (&acc)[2][2][4][2], const pg8::Unit& u, int wr, int wc, int fr, int fq) const {
        const int blk = u.pm >> 8, pnl = u.pn & 3; const int row0 = blk * 256 + wr * 64 + fr;
#pragma unroll
        for (int bj = 0; bj < 2; ++bj) { const int ac = pnl * 128 + (bj * 128 + wc * 32 + 8 * fq) / 2;
#pragma unroll
            for (int ai = 0; ai < 2; ++ai)
#pragma unroll
                for (int m = 0; m < 4; ++m) { const f32x4 v0 = acc[ai][bj][m][0], v1 = acc[ai][bj][m][1];
                    const float a0 = v0[0] / (1.f + __expf(-v0[0])) * v0[1], a1 = v0[2] / (1.f + __expf(-v0[2])) * v0[3];
                    const float a2 = v1[0] / (1.f + __expf(-v1[0])) * v1[1], a3 = v1[2] / (1.f + __expf(-v1[2])) * v1[3];
                    v2u w; w.x = pg8::cvt_pk_bf16(a0, a1); w.y = pg8::cvt_pk_bf16(a2, a3);
                    *(GAS v2u*)(act + (size_t)(row0 + ai * 128 + m * 16) * DEXP + ac) = w; } }
    }
};
struct EpiMoe2 {
    static constexpr bool PERM = true;
    bf16* c0; bf16* c1; LAS unsigned* tok; LAS float* wts;
    __device__ __forceinline__ void operator()(f32x4 (&acc)[2][2][4][2], const pg8::Unit& u, int wr, int wc, int fr, int fq) const {
        const int li = u.pm & 255, pnl = u.pn & 3;
#pragma unroll
        for (int ai = 0; ai < 2; ++ai)
#pragma unroll
            for (int m = 0; m < 4; ++m) { const int rt = ai * 128 + wr * 64 + m * 16 + fr; const unsigned en = tok[li * 256 + rt]; const float w = wts[li * 256 + rt];
                if (en != 0xffffffffu) { bf16* dst = ((en >> 31) ? c1 : c0) + (size_t)(en & 0x7fffffffu) * D + pnl * 256 + wc * 32 + 8 * fq;
#pragma unroll
                    for (int bj = 0; bj < 2; ++bj) { const f32x4 v0 = acc[ai][bj][m][0] * w, v1 = acc[ai][bj][m][1] * w; v4u o;
                        o.x = pg8::cvt_pk_bf16(v0[0], v0[1]); o.y = pg8::cvt_pk_bf16(v0[2], v0[3]); o.z = pg8::cvt_pk_bf16(v1[0], v1[1]); o.w = pg8::cvt_pk_bf16(v1[2], v1[3]);
                        *(GAS v4u*)(dst + bj * 128) = o; } } }
    }
};

typedef _Float16 h16x2 __attribute__((ext_vector_type(2)));
__device__ __forceinline__ unsigned pk_f16_rtz(float a, float b) { return __builtin_bit_cast(unsigned, __builtin_amdgcn_cvt_pkrtz(a, b)); }
__device__ __forceinline__ unsigned sortable16x2(unsigned x) { const unsigned m = ((x >> 15) & 0x00010001u) * 0xFFFFu; return x ^ (m | 0x80008000u); }
constexpr int IDX_HS = 257;
constexpr int IDX_WT_OFF = 68 * 1024, IDX_RH_OFF = 72 * 1024, IDX_P2_OFF = IDX_RH_OFF + 32 * IDX_HS * 4, IDX_P2_BYTES = 4480;
static_assert(IDX_P2_OFF + 8 * IDX_P2_BYTES <= RING_BYTES + AUX_BYTES, "indexer LDS map");
template <int NC>
__device__ __forceinline__ void hist_find(LAS unsigned* H, int lane, unsigned K, unsigned& bsel, unsigned& above, unsigned& atb) {
    unsigned t[4];
#pragma unroll
    for (int q = 0; q < 4; ++q) { unsigned a = 0;
#pragma unroll
        for (int c = 0; c < NC; ++c) a += H[c * IDX_HS + 4 * lane + q];
        t[q] = a; }
    const unsigned ls = (t[0] + t[1]) + (t[2] + t[3]);
    unsigned suf = ls;
#pragma unroll
    for (int o = 1; o < 64; o <<= 1) { const unsigned v = __shfl_down(suf, o); if (lane + o < 64) suf += v; }
    unsigned ab = suf - ls; bool found = false; unsigned fb = 0, fa = 0, ft = 0;
#pragma unroll
    for (int q = 3; q >= 0; --q) { if (!found && ab < K && ab + t[q] >= K) { found = true; fb = 4 * lane + q; fa = ab; ft = t[q]; } ab += t[q]; }
    const unsigned long long bal = __ballot(found);
    const int src = bal ? (int)__builtin_ctzll(bal) : 0;
    bsel = __shfl(fb, src); above = __shfl(fa, src); atb = __shfl(ft, src);
}
__device__ __forceinline__ void sel_load(v4u (&ch)[16], const unsigned short* srow, int n, int lane) {
    const int nchunks = n >> 3;
#pragma unroll
    for (int j = 0; j < 16; ++j) { const int c = lane + 64 * j;
        unsigned off = (unsigned)c * 16u; asm volatile("" : "+v"(off));
        if (c < nchunks) ch[j] = *(const GAS v4u*)((const char*)srow + off); else ch[j] = (v4u){0u, 0u, 0u, 0u}; }
}
__device__ __forceinline__ unsigned pk_max_u16(unsigned a, unsigned b) { unsigned r; asm("v_pk_max_u16 %0, %1, %2" : "=v"(r) : "v"(a), "v"(b)); return r; }
__device__ __forceinline__ unsigned pk_min_u16(unsigned a, unsigned b) { unsigned r; asm("v_pk_min_u16 %0, %1, %2" : "=v"(r) : "v"(a), "v"(b)); return r; }
__device__ __forceinline__ void sel_compute(const v4u (&ch)[16], const unsigned short* srow, int n, unsigned char* mrow, LAS unsigned* RH, LAS unsigned* P2, int lane) {
    const int nchunks = n >> 3;
    if (n <= 256) {
#pragma unroll 1
        for (int j = 0; j < 16; ++j) { const int c = lane + 64 * j; mrow[c] = (c < nchunks) ? (unsigned char)0xFF : (unsigned char)0; }
        return;
    }
    unsigned b1, above1, at1; hist_find<1>(RH, lane, 256u, b1, above1, at1);
    for (int i = lane; i < 4 * IDX_HS; i += 64) P2[i] = 0u;
    LAS unsigned* hb = P2 + (lane & 3) * IDX_HS;
    unsigned pat = (b1 << 8) | (b1 << 24), c256 = 0x01000100u, c1 = 0x00010001u;
    asm volatile("" : "+v"(pat), "+v"(c256), "+v"(c1));
#pragma unroll
    for (int j = 0; j < 16; ++j) { if (64 * j < nchunks) {
#pragma unroll
        for (int i = 0; i < 4; ++i) { const unsigned w = ch[j][i]; const unsigned m = pk_min_u16(w ^ pat, c256);
            __hip_atomic_fetch_add(hb + (w & 0xffu), ((m >> 8) & 1u) ^ 1u, __ATOMIC_RELAXED, __HIP_MEMORY_SCOPE_WORKGROUP);
            __hip_atomic_fetch_add(hb + ((w >> 16) & 0xffu), (m >> 24) ^ 1u, __ATOMIC_RELAXED, __HIP_MEMORY_SCOPE_WORKGROUP); } } __builtin_amdgcn_sched_barrier(0); }
    unsigned b2, above2, teq; hist_find<4>(P2, lane, 256u - above1, b2, above2, teq);
    const unsigned tau = (b1 << 8) | b2; const unsigned r = 256u - above1 - above2;
    if (r >= teq) {
        unsigned tt = tau | (tau << 16); asm volatile("" : "+v"(tt));
#pragma unroll
        for (int j = 0; j < 16; ++j) { const int c = lane + 64 * j; unsigned acc = 0u;
#pragma unroll
            for (int i = 0; i < 4; ++i) { const unsigned w = ch[j][i]; const unsigned ns = pk_min_u16(pk_max_u16(w, tt) ^ w, c1);
                acc |= ns << (2 * i); }
            const unsigned bits = ~(acc | (acc >> 15)) & 0xffu;
            { unsigned off = (unsigned)c; asm volatile("" : "+v"(off)); mrow[off] = (unsigned char)bits; } __builtin_amdgcn_sched_barrier(0); }
    } else {
        unsigned running = 0u;
#pragma unroll 1
        for (int j = 0; j < 16; ++j) { const int c = lane + 64 * j;
            v4u x = {0u, 0u, 0u, 0u};
            if (c < nchunks) x = *(const GAS v4u*)(srow + (size_t)c * 8);
            unsigned gt = 0u, eq = 0u;
#pragma unroll
            for (int i = 0; i < 4; ++i) { const unsigned w = x[i], k0 = w & 0xffffu, k1 = w >> 16;
                gt |= (k0 > tau ? 1u : 0u) << (2 * i); gt |= (k1 > tau ? 1u : 0u) << (2 * i + 1); eq |= (k0 == tau ? 1u : 0u) << (2 * i); eq |= (k1 == tau ? 1u : 0u) << (2 * i + 1); }
            const unsigned tc = (unsigned)__builtin_popcount(eq); unsigned inc = tc;
#pragma unroll
            for (int o = 1; o < 64; o <<= 1) { const unsigned v = __shfl_up(inc, o); if (lane >= o) inc += v; }
            const unsigned base = running + inc - tc;
            int take = (int)r - (int)base; take = take < 0 ? 0 : (take > 8 ? 8 : take);
            unsigned e2 = eq, kept = 0u;
#pragma unroll
            for (int t = 0; t < 8; ++t) { const unsigned low = e2 & (0u - e2); if (t < take) kept |= low; e2 &= e2 - 1u; }
            running += __shfl(inc, 63);
            mrow[c] = (unsigned char)(gt | kept); }
    }
}
__device__ __forceinline__ void p_indexer(Frame& F) {
    const bf16* QI = (const bf16*)(F.ws + WS_QI); const bf16* KI = (const bf16*)(F.ws + WS_KI); const float* WI = (const float*)(F.ws + WS_WI);
    unsigned short* scr = (unsigned short*)(F.ws + WS_SCR) + (size_t)blockIdx.x * 32 * 8192;
    unsigned char* MASK = (unsigned char*)(F.ws + WS_MASK);
    const int tid = F.tid, lane = F.lane, wave = F.wave, r32 = lane & 31, hi = lane >> 5;
    LAS unsigned char* lds = F.lds;
    const int b = F.vcu >> 6, wq = F.vcu & 63;
#pragma unroll 1
    for (int ui = 0; ui < 4; ++ui) {
        const int qb32 = (ui == 0) ? wq : (ui == 1) ? 127 - wq : (ui == 2) ? 128 + wq : 255 - wq;
        const int n = 64 * ((qb32 >> 1) + 1), ntiles = n >> 5;
        const size_t tokb = (size_t)b * SEQ, tok0 = tokb + (size_t)qb32 * 32;
#pragma unroll
        for (int i = 0; i < 8; ++i) { const int f = wave + 8 * i, hh = f >> 2, ks = f & 3;
            const v4u v = *(const GAS v4u*)(QI + (tok0 + r32) * 1024 + hh * 64 + 16 * ks + 8 * hi); *(LAS v4u*)(lds + f * 1024 + lane * 16) = v; }
        { LAS float* wt = (LAS float*)(lds + IDX_WT_OFF);
            const int q = tid & 31, hh = tid >> 5; wt[hh * 32 + q] = WI[(tok0 + q) * 16 + hh] * 0.125f;
            LAS unsigned* rh = (LAS unsigned*)(lds + IDX_RH_OFF); for (int i = tid; i < 32 * IDX_HS; i += NWAVES * 64) rh[i] = 0u; }
        { const int q = tid & 31, dg = tid >> 5; f32x4 a = {0.f, 0.f, 0.f, 0.f};
#pragma unroll
            for (int hh = 0; hh < 16; ++hh) { const float wv = WI[(tok0 + q) * 16 + hh] * 0.125f; const v2u qv = *(const GAS v2u*)(QI + (tok0 + q) * 1024 + hh * 64 + 4 * dg);
                a.x += wv * bf2f((unsigned short)(qv.x & 0xffff)); a.y += wv * bf2f((unsigned short)(qv.x >> 16)); a.z += wv * bf2f((unsigned short)(qv.y & 0xffff)); a.w += wv * bf2f((unsigned short)(qv.y >> 16)); }
            v2u o; o.x = pk2(a.x, a.y); o.y = pk2(a.z, a.w);
            *(LAS v2u*)(lds + (64 + (dg >> 2)) * 1024 + (q + 32 * ((dg >> 1) & 1)) * 16 + (dg & 1) * 8) = o; }
        __syncthreads();
        LAS unsigned* hrow = (LAS unsigned*)(lds + IDX_RH_OFF) + r32 * IDX_HS;
        bf16x8 kf[2][4];
#define IDX_KLOAD(TT) do { _Pragma("unroll") for (int j = 0; j < 2; ++j) { const int T = ((TT) + j < ntiles) ? (TT) + j : ntiles - 1; \
            _Pragma("unroll") for (int ks = 0; ks < 4; ++ks) kf[j][ks] = *(const GAS bf16x8*)(KI + (tokb + (size_t)T * 32 + r32) * 64 + 16 * ks + 8 * hi); } } while (0)
#define IDX_FMA4(S, P, B, W) do { asm volatile("v_fma_f32 %0, |%4|, %8, %0\n\tv_fma_f32 %1, |%5|, %8, %1\n\tv_fma_f32 %2, |%6|, %8, %2\n\tv_fma_f32 %3, |%7|, %8, %3" \
                : "+v"(S[B]), "+v"(S[B + 1]), "+v"(S[B + 2]), "+v"(S[B + 3]) : "v"(P[B]), "v"(P[B + 1]), "v"(P[B + 2]), "v"(P[B + 3]), "v"(W)); __builtin_amdgcn_sched_barrier(0); } while (0)
#define IDX_QF(base, ks) (*(const LAS bf16x8*)((base) + (ks) * 1024))
#define IDX_MF(N, K, Q, C) N = __builtin_amdgcn_mfma_f32_32x32x16_bf16(K, Q, C, 0, 0, 0); __builtin_amdgcn_sched_barrier(0)
#define IDX_PSTEP(N0, N1, P0, P1, W, CUR, NXT) do { \
                IDX_MF(N0, kf[0][0], qa, f32x16{}); IDX_FMA4(sc[0], P0, 0, W); \
                IDX_MF(N1, kf[1][0], qa, f32x16{}); IDX_FMA4(sc[0], P0, 4, W); qa = IDX_QF(CUR, 2); \
                IDX_MF(N0, kf[0][1], qb, N0); IDX_FMA4(sc[0], P0, 8, W); \
                IDX_MF(N1, kf[1][1], qb, N1); IDX_FMA4(sc[0], P0, 12, W); qb = IDX_QF(CUR, 3); \
                IDX_MF(N0, kf[0][2], qa, N0); IDX_FMA4(sc[1], P1, 0, W); \
                IDX_MF(N1, kf[1][2], qa, N1); IDX_FMA4(sc[1], P1, 4, W); qa = IDX_QF(NXT, 0); \
                IDX_MF(N0, kf[0][3], qb, N0); IDX_FMA4(sc[1], P1, 8, W); \
                IDX_MF(N1, kf[1][3], qb, N1); IDX_FMA4(sc[1], P1, 12, W); qb = IDX_QF(NXT, 1); } while (0)
        if (wave * 2 < ntiles) IDX_KLOAD(wave * 2);
#pragma unroll 1
        for (int T0 = wave * 2; T0 < ntiles; T0 += 16) {
            f32x16 sc[2];
            sc[0] = f32x16{}; sc[1] = f32x16{};
#pragma unroll
            for (int ks = 0; ks < 4; ++ks) { const bf16x8 qf = *(const LAS bf16x8*)(lds + (64 + ks) * 1024 + lane * 16);
                sc[0] = __builtin_amdgcn_mfma_f32_32x32x16_bf16(kf[0][ks], qf, sc[0], 0, 0, 0); sc[1] = __builtin_amdgcn_mfma_f32_32x32x16_bf16(kf[1][ks], qf, sc[1], 0, 0, 0); }
            {
                f32x16 dA0 = f32x16{}, dA1 = f32x16{}, dB0 = f32x16{}, dB1 = f32x16{};
                float wprev = 0.f;
                const LAS unsigned char* qbase = lds + lane * 16;
                const LAS unsigned char* wbase = lds + IDX_WT_OFF + r32 * 4;
                bf16x8 qa = IDX_QF(qbase, 0), qb = IDX_QF(qbase, 1);
#pragma unroll 1
                for (int hh = 0; hh < 16; hh += 2) {
                    const float wh0 = *(const LAS float*)(wbase + hh * 128), wh1 = *(const LAS float*)(wbase + hh * 128 + 128);
                    IDX_PSTEP(dA0, dA1, dB0, dB1, wprev, qbase, qbase + 4096);
                    IDX_PSTEP(dB0, dB1, dA0, dA1, wh0, qbase + 4096, qbase + 8192);
                    wprev = wh1; qbase += 8192;
                }
                asm volatile("s_nop 15\n\ts_nop 7" ::: "memory");
#pragma unroll
                for (int r = 0; r < 16; r += 4) { IDX_FMA4(sc[0], dB0, r, wprev); }
#pragma unroll
                for (int r = 0; r < 16; r += 4) { IDX_FMA4(sc[1], dB1, r, wprev); }
            }
            if (T0 + 16 < ntiles) IDX_KLOAD(T0 + 16);
#pragma unroll
            for (int j = 0; j < 2; ++j) { if (T0 + j < ntiles) { unsigned short* dst = scr + (size_t)r32 * 8192 + (size_t)(T0 + j) * 32 + 4 * hi;
#pragma unroll
                for (int g = 0; g < 4; ++g) { v2u o; o.x = sortable16x2(pk_f16_rtz(sc[j][4 * g], sc[j][4 * g + 1])); o.y = sortable16x2(pk_f16_rtz(sc[j][4 * g + 2], sc[j][4 * g + 3])); *(GAS v2u*)(dst + 8 * g) = o;
                    __hip_atomic_fetch_add(hrow + ((o.x >> 8) & 255u), 1u, __ATOMIC_RELAXED, __HIP_MEMORY_SCOPE_WORKGROUP); __hip_atomic_fetch_add(hrow + (o.x >> 24), 1u, __ATOMIC_RELAXED, __HIP_MEMORY_SCOPE_WORKGROUP);
                    __hip_atomic_fetch_add(hrow + ((o.y >> 8) & 255u), 1u, __ATOMIC_RELAXED, __HIP_MEMORY_SCOPE_WORKGROUP); __hip_atomic_fetch_add(hrow + (o.y >> 24), 1u, __ATOMIC_RELAXED, __HIP_MEMORY_SCOPE_WORKGROUP); } } }
        }
#undef IDX_QF
#undef IDX_MF
#undef IDX_PSTEP
#undef IDX_FMA4
        VM_WAIT(); __syncthreads();
        __builtin_amdgcn_fence(__ATOMIC_ACQUIRE, "agent");
        { LAS unsigned* P2 = (LAS unsigned*)(lds + IDX_P2_OFF + wave * IDX_P2_BYTES); LAS unsigned* RH = (LAS unsigned*)(lds + IDX_RH_OFF) + wave * 4 * IDX_HS;
            const unsigned short* sr = scr + (size_t)wave * 4 * 8192; unsigned char* mr = MASK + (tok0 + wave * 4) * 1024;
#pragma unroll 1
            for (int rp3 = 0; rp3 < SUBREPS(16); ++rp3) {
            { int ls = lane; asm volatile("" : "+v"(ls));
                v4u chA[16], chB[16];
                sel_load(chA, sr, n, ls); sel_load(chB, sr + 8192, n, ls);
                sel_compute(chA, sr, n, mr, RH, P2, ls);
                sel_load(chA, sr + 2 * 8192, n, ls);
                sel_compute(chB, sr + 8192, n, mr + 1024, RH + IDX_HS, P2, ls);
                sel_load(chB, sr + 3 * 8192, n, ls);
                sel_compute(chA, sr + 2 * 8192, n, mr + 2 * 1024, RH + 2 * IDX_HS, P2, ls);
                sel_compute(chB, sr + 3 * 8192, n, mr + 3 * 1024, RH + 3 * IDX_HS, P2, ls); } } }
        __syncthreads();
    }
}

template <bool WITH_MOE>
__device__ __forceinline__ void p_final(Frame& F) {
    const int gw = F.vcu * NWAVES + F.wave, NGW = F.G * NWAVES;
    const float* X = F.x(); const bf16* MIX = (const bf16*)(F.ws + WS_MIX); const float* mod = (const float*)(F.ws + WS_MOD);
    const bf16* C0 = (const bf16*)(F.ws + WS_C0); const bf16* C1 = (const bf16*)(F.ws + WS_C1);
    f32x4 nv[4]; v2u nm[4], na[4], nc[4];
#define FIN_LOAD(mm) do { const GAS f32x4* xr = (const GAS f32x4*)(X + (size_t)(mm) * D) + F.lane; \
        _Pragma("unroll") for (int j = 0; j < 4; ++j) { nv[j] = xr[64 * j]; nm[j] = *(const GAS v2u*)(MIX + (size_t)(mm) * D + 4 * F.lane + 256 * j); if (WITH_MOE) { const int col = 4 * F.lane + 256 * j; na[j] = *(const GAS v2u*)(C0 + (size_t)(mm) * D + col); nc[j] = *(const GAS v2u*)(C1 + (size_t)(mm) * D + col); } } } while (0)
    if (gw < M) FIN_LOAD(gw);
    for (int m = gw; m < M; m += NGW) {
        const int b = m >> 13;
        f32x4 v[4]; v2u ca[4], cc[4]; float s = 0.f;
#pragma unroll
        for (int j = 0; j < 4; ++j) { v[j] = nv[j]; ca[j] = na[j]; cc[j] = nc[j];
            v[j].x += bf2f((unsigned short)(nm[j].x & 0xffff)); v[j].y += bf2f((unsigned short)(nm[j].x >> 16)); v[j].z += bf2f((unsigned short)(nm[j].y & 0xffff)); v[j].w += bf2f((unsigned short)(nm[j].y >> 16)); }
        if (m + NGW < M) FIN_LOAD(m + NGW);
#pragma unroll
        for (int j = 0; j < 4; ++j) {
            if (WITH_MOE) { const int col = 4 * F.lane + 256 * j; const f32x4 gt = *(const GAS f32x4*)(mod + b * 6144 + 5120 + col);
                const v2u a = ca[j], c = cc[j];
                f32x4 mo; mo.x = bf2f((unsigned short)(a.x & 0xffff)) + bf2f((unsigned short)(c.x & 0xffff)); mo.y = bf2f((unsigned short)(a.x >> 16)) + bf2f((unsigned short)(c.x >> 16));
                mo.z = bf2f((unsigned short)(a.y & 0xffff)) + bf2f((unsigned short)(c.y & 0xffff)); mo.w = bf2f((unsigned short)(a.y >> 16)) + bf2f((unsigned short)(c.y >> 16));
                v[j] = v[j] + gt * mo; }
            s += (v[j].x * v[j].x + v[j].y * v[j].y) + (v[j].z * v[j].z + v[j].w * v[j].w); }
        const float r = 1.f / sqrtf(wave_sum(s) * (1.f / D) + EPS);
        GAS f32x4* o = (GAS f32x4*)(F.out() + (size_t)m * D) + F.lane;
#pragma unroll
        for (int j = 0; j < 4; ++j) { const f32x4 g = *(const GAS f32x4*)(F.g_fin() + 4 * F.lane + 256 * j); o[64 * j] = v[j] * r * g; }
    }
}

constexpr int N_PHASES = 16;
__global__ void __launch_bounds__(NWAVES * 64, 2) mk_fwd(Args args) {
    extern __shared__ __attribute__((aligned(16))) unsigned char lds[];
    Frame F;
    F.lds = (LAS unsigned char*)lds;
    F.tid = threadIdx.x; F.lane = F.tid & 63; F.wave = __builtin_amdgcn_readfirstlane(F.tid >> 6);
    F.G = gridDim.x; { const int bx = blockIdx.x; F.vcu = (F.G % 8 == 0) ? (bx % 8) * (F.G / 8) + bx / 8 : bx; }
    F.ws = args.ws; F.ctl = (gu32*)(args.ws + WS_CTL);
    F.ka = (const CAS Args*)__builtin_amdgcn_kernarg_segment_ptr();
    volatile LAS unsigned* LCTL = (volatile LAS unsigned*)(F.lds + LDSCTL_OFF);
    for (int u = F.tid; u < 64; u += NWAVES * 64) LCTL[u] = 0u;
    __syncthreads();
    const bool multi = (args.ph_hi - args.ph_lo) > 1;
    XcdBarrier bar; bar.bar = (unsigned*)(F.ctl + CW_BAR); bar.x = 0; bar.st = nullptr;
    if (multi) bar = xcd_barrier_post((unsigned*)(F.ctl + CW_BAR), LCTL + 8);
    const int lo = args.ph_lo, hi = args.ph_hi;
#ifndef PH_MASK
#define PH_MASK 0xffffffffu
#endif
#define IN(k) (((PH_MASK >> (k)) & 1u) && lo <= (k) && (k) < hi)
#define REPS(k) (1 + (int)((REP_MASK >> (k)) & 1u))
#define SEAM(k) do { if (IN(k) && IN((k) + 1)) xcd_barrier(bar); } while (0)

    if (IN(0)) _Pragma("unroll") for (int rp_ = 0; rp_ < REPS(0); ++rp_) { p0_prologue(F); } SEAM(0);
    if (multi && ((REP_MASK >> 21) & 1u)) { for (int q = 0; q < 8; ++q) xcd_barrier(bar); }
    if (IN(1)) _Pragma("unroll") for (int rp_ = 0; rp_ < REPS(1); ++rp_) { p1_norm(F); } SEAM(1);
    if (IN(2)) _Pragma("unroll") for (int rp_ = 0; rp_ < REPS(2); ++rp_) {
        pg8::Gemm g{(const bf16*)(F.ws + WS_H), (const bf16*)(F.ws + WS_WIN), D}; pg8::StaticOrder S; S.init(M, NPAD, F.G, (int)blockIdx.x);
        EpiInProj E{F.ws};
        pg8::gemm_phase<EpiInProj, pg8::StaticOrder, true>(F.lds, g, S, E);
    } SEAM(2);
    if (IN(3)) _Pragma("unroll") for (int rp_ = 0; rp_ < REPS(3); ++rp_) { ra_states(F); } SEAM(3);
    if (IN(4)) _Pragma("unroll") for (int rp_ = 0; rp_ < REPS(4); ++rp_) { rb_carry(F); } SEAM(4);
    if (IN(5)) _Pragma("unroll") for (int rp_ = 0; rp_ < REPS(5); ++rp_) { r3_out(F);
    } SEAM(5);
    if (IN(6)) _Pragma("unroll") for (int rp_ = 0; rp_ < REPS(6); ++rp_) { p_indexer(F); } SEAM(6);
    if (IN(7)) _Pragma("unroll") for (int rp_ = 0; rp_ < REPS(7); ++rp_) {
        const attn_body::AttnTensors AT{(const bf16*)(F.ws + WS_QA), (const bf16*)(F.ws + WS_KA), (const bf16*)(F.ws + WS_VA), (bf16*)(F.ws + WS_Y), (const unsigned char*)(F.ws + WS_MASK)};
        const attn_body::StaticOrder S((int)F.G, (int)blockIdx.x);
        { attn_body::AttnUnit u;
            for (int i = 0; S.next(i, u); ++i) { attn_body::attn_unit<8>(u.bh / attn_body::NHEAD, u.bh % attn_body::NHEAD, u.qb, AT.Q, AT.K, AT.V, AT.O, AT.MK, (char*)lds);
                p_expert_convert(F, i, 4); __syncthreads(); } }
    } SEAM(7);
    if (IN(8)) _Pragma("unroll") for (int rp_ = 0; rp_ < REPS(8); ++rp_) {
        pg8::Gemm g{(const bf16*)(F.ws + WS_Y), (const bf16*)(F.ws + WS_WO), D}; pg8::StaticOrder S; S.init(M, D, F.G, (int)blockIdx.x);
        EpiOutProj E{(bf16*)(F.ws + WS_MIX), (const float*)(F.ws + WS_MOD)};
        pg8::gemm_phase<EpiOutProj, pg8::StaticOrder, true>(F.lds, g, S, E);
    } SEAM(8);
    if (IN(9)) _Pragma("unroll") for (int rp_ = 0; rp_ < REPS(9); ++rp_) { p_norm2_route(F); } SEAM(9);
    if (IN(10)) _Pragma("unroll") for (int rp_ = 0; rp_ < REPS(10); ++rp_) {
        LAS int* blkstart = (LAS int*)(F.lds + AUX_OFF); LAS unsigned* tok = (LAS unsigned*)(F.lds + AUX_OFF + 256); LAS float* wts = (LAS float*)(F.lds + AUX_OFF + 256 + MOE_MAXU * 1024);
        const int nunits = moe_tables(F, blkstart, tok, wts);
        pg8::Gemm g{(const bf16*)(F.ws + WS_H2), (const bf16*)(F.ws + WS_WGU), D}; MoeSched S{F.G, F.vcu, nunits, blkstart, tok, true};
        EpiMoe1 E{(bf16*)(F.ws + WS_ACT)};
        pg8::gemm_phase<EpiMoe1, MoeSched, true>(F.lds, g, S, E);
    } SEAM(10);
    if (IN(11)) _Pragma("unroll") for (int rp_ = 0; rp_ < REPS(11); ++rp_) {
        LAS int* blkstart = (LAS int*)(F.lds + AUX_OFF); LAS unsigned* tok = (LAS unsigned*)(F.lds + AUX_OFF + 256); LAS float* wts = (LAS float*)(F.lds + AUX_OFF + 256 + MOE_MAXU * 1024);
        const int nunits = moe_tables(F, blkstart, tok, wts);
        pg8::Gemm g{(const bf16*)(F.ws + WS_ACT), (const bf16*)(F.ws + WS_WD), DEXP}; MoeSched S{F.G, F.vcu, nunits, blkstart, tok, false};
        EpiMoe2 E{(bf16*)(F.ws + WS_C0), (bf16*)(F.ws + WS_C1), tok, wts};
        pg8::gemm_phase<EpiMoe2, MoeSched, true>(F.lds, g, S, E);
    } SEAM(11);
    if (IN(12)) _Pragma("unroll") for (int rp_ = 0; rp_ < REPS(12); ++rp_) { p_final<true>(F); }
#undef IN
#undef SEAM
}

extern "C" void kernel_launch(void* const* d_in, const int* in_sizes, int n_in, void* d_out, int out_size, void* d_ws, size_t ws_size, hipStream_t stream) {
    static int grid = 0;
    if (grid == 0) {
        if (n_in != 15 || out_size != M * D || ws_size < WS_END) { fprintf(stderr, "kernel_launch: unexpected shapes (n_in %d out %d ws %zu)\n", n_in, out_size, ws_size); grid = -1; return; }
        int dev = 0, cus = 0, per_cu = 0;
        if (hipGetDevice(&dev) != hipSuccess || hipDeviceGetAttribute(&cus, hipDeviceAttributeMultiprocessorCount, dev) != hipSuccess) { grid = -1; return; }
        if (hipFuncSetAttribute((const void*)mk_fwd, hipFuncAttributeMaxDynamicSharedMemorySize, LDS_BYTES) != hipSuccess) { fprintf(stderr, "kernel_launch: hipFuncSetAttribute failed\n"); grid = -1; return; }
        if (hipOccupancyMaxActiveBlocksPerMultiprocessor(&per_cu, (const void*)mk_fwd, NWAVES * 64, LDS_BYTES) != hipSuccess || per_cu < 1) { fprintf(stderr, "kernel_launch: occupancy query says %d\n", per_cu); }
        (void)hipGetLastError();
        grid = cus;
    }
    if (grid < 0) return;
    (void)hipMemsetAsync((char*)d_ws + WS_CTL, 0, CTL_ZERO_BYTES, stream);
    Args a{};
    for (int i = 0; i < 15; ++i) a.in[i] = d_in[i];
    a.out = (float*)d_out; a.ws = (unsigned char*)d_ws;
#if MK_N_LAUNCHES == 1
    a.ph_lo = 0; a.ph_hi = N_PHASES;
    hipLaunchKernelGGL(mk_fwd, dim3(grid), dim3(NWAVES * 64), LDS_BYTES, stream, a);
#else
    for (int p = 0; p < N_PHASES; ++p) { a.ph_lo = p; a.ph_hi = p + 1; hipLaunchKernelGGL(mk_fwd, dim3(grid), dim3(NWAVES * 64), LDS_BYTES, stream, a); }
#endif
}
```

```cpp
#include <hip/hip_runtime.h>
#include <cstdio>
#include <cstdint>

#ifndef REP_MASK
#define REP_MASK 0u
#endif
#define SUBREPS(k) (1 + (int)((REP_MASK >> (k)) & 1u))
#ifndef MK_N_LAUNCHES
#define MK_N_LAUNCHES 1
#endif

#define GAS __attribute__((address_space(1)))
#define LAS __attribute__((address_space(3)))
typedef unsigned short bf16;
typedef unsigned v4u __attribute__((ext_vector_type(4)));
typedef unsigned v2u __attribute__((ext_vector_type(2)));
typedef float f32x4 __attribute__((ext_vector_type(4)));
typedef float f32x16 __attribute__((ext_vector_type(16)));
typedef short bf16x8 __attribute__((ext_vector_type(8)));
typedef GAS unsigned gu32;
#define RLX_AGENT __ATOMIC_RELAXED, __HIP_MEMORY_SCOPE_AGENT
#define LDS_WAIT() asm volatile("s_waitcnt lgkmcnt(0)" ::: "memory")
#define VM_WAIT() asm volatile("s_waitcnt vmcnt(0)" ::: "memory")

constexpr int NB = 4, SEQ = 8192, M = NB * SEQ, D = 1024;
constexpr int DIN = 4688, NPAD = 4864;
constexpr int NEXP = 32, DEXP = 512;
constexpr float EPS = 1e-6f;
constexpr float C2 = 0.125f * 1.4426950408889634f;

constexpr size_t MiB = 1u << 20;
constexpr size_t WS_CTL = 0, CTL_ZERO_BYTES = 1 * MiB;
constexpr size_t WS_MODP = 1 * MiB;
constexpr size_t WS_MOD = 3 * MiB;
constexpr size_t WS_WIN = 4 * MiB;
constexpr size_t WS_WO = 14 * MiB;
constexpr size_t WS_H = 16 * MiB;
constexpr size_t WS_ST = 16 * MiB;
constexpr size_t WS_MIX = 16 * MiB;
constexpr size_t WS_QA = 80 * MiB, WS_KA = 112 * MiB, WS_VA = 144 * MiB;
constexpr size_t WS_ROUTE = 144 * MiB;
constexpr size_t WS_QI = 176 * MiB;
constexpr size_t WS_H2 = 176 * MiB;
constexpr size_t WS_C0 = 176 * MiB;
constexpr size_t WS_KI = 240 * MiB;
constexpr size_t WS_WI = 244 * MiB;
constexpr size_t WS_QB = 248 * MiB, WS_KB = 280 * MiB, WS_VB = 312 * MiB, WS_GB = 344 * MiB;
constexpr size_t WS_SCR = 248 * MiB;
constexpr size_t WS_WGU = 248 * MiB;
constexpr size_t WS_C1 = 248 * MiB;
constexpr size_t WS_WD = 312 * MiB;
constexpr size_t WS_Y = 376 * MiB;
constexpr size_t WS_ACT = 376 * MiB;
constexpr size_t WS_MASK = 440 * MiB;
constexpr size_t WS_ROPE1 = 474 * MiB;
constexpr size_t WS_ROPE2 = 476 * MiB;
constexpr size_t WS_END = 512 * MiB;

constexpr int CW_BAR = 4096;
constexpr int CW_ECNT = 16384;

constexpr int NWAVES = 8;
constexpr int RING_BYTES = 131072;
constexpr int AUX_OFF = RING_BYTES, AUX_BYTES = 20480;
constexpr int LDSCTL_OFF = AUX_OFF + AUX_BYTES;
constexpr int LDS_BYTES = LDSCTL_OFF + 256;

__device__ __forceinline__ unsigned f2bf(float f) { unsigned u = __builtin_bit_cast(unsigned, f); return (u + 0x7fffu + ((u >> 16) & 1u)) >> 16; }
__device__ __forceinline__ unsigned pk2(float lo, float hi) { return f2bf(lo) | (f2bf(hi) << 16); }
__device__ __forceinline__ float bf2f(unsigned short b) { return __builtin_bit_cast(float, (unsigned)b << 16); }
__device__ __forceinline__ float wave_sum(float v) {
#pragma unroll
    for (int o = 1; o < 64; o <<= 1) v += __shfl_xor(v, o);
    return v;
}

#define XB_TMO      128
#define XB_XCNT(j)  (256  + 64 * (j))
#define XB_XSUB(j)  (1280 + 64 * (j))
#define XB_XGEN(j)  (2304 + 64 * (j))
#define XB_TOP      3328
#define XB_TOPGEN   3392
#define XCD_BAR_WORDS 3456
#define XB_SPIN_CAP (1u << 18)
__device__ __forceinline__ unsigned xb_ld(unsigned* p)              { return __hip_atomic_load(p, __ATOMIC_RELAXED, __HIP_MEMORY_SCOPE_AGENT); }
__device__ __forceinline__ unsigned xb_add(unsigned* p, unsigned v) { return __hip_atomic_fetch_add(p, v, __ATOMIC_RELAXED, __HIP_MEMORY_SCOPE_AGENT); }
__device__ __forceinline__ unsigned xb_xcc_id() { return (unsigned)__builtin_amdgcn_s_getreg((3 << 11) | 20) & 0xFu; }
#define XB_SPIN(cond, bar) do { unsigned _sp = 0; while (cond) { __builtin_amdgcn_s_sleep(1); \
    if ((++_sp & 255u) == 0u) { if (xb_ld(&(bar)[XB_TMO])) break; if (_sp > XB_SPIN_CAP) { atomicAdd(&(bar)[XB_TMO], 1u); break; } } } } while (0)
struct XcdBarrier { unsigned* bar; unsigned x; volatile LAS unsigned* st; };
__device__ __forceinline__ XcdBarrier xcd_barrier_post(unsigned* bar, volatile LAS unsigned* st) {
    XcdBarrier b; b.bar = bar; b.x = xb_xcc_id(); b.st = st;
    if (threadIdx.x == 0) (void)xb_add(&bar[XB_XCNT(b.x)], 1u);
    return b;
}
__device__ __forceinline__ void xcd_barrier_complete(unsigned* bar, unsigned x, unsigned& nloc, unsigned& nx) {
    const unsigned G = gridDim.x * gridDim.y * gridDim.z;
    unsigned sum, cnt, mine, sp = 0u;
    for (;;) {
        sum = 0u; cnt = 0u; mine = 0u;
#pragma unroll
        for (unsigned j = 0; j < 16; ++j) { const unsigned c = xb_ld(&bar[XB_XCNT(j)]); sum += c; cnt += (c > 0u) ? 1u : 0u; mine = (j == x) ? c : mine; }
        if (sum == G) break;
        __builtin_amdgcn_s_sleep(1);
        if ((++sp & 255u) == 0u) { if (xb_ld(&bar[XB_TMO])) break; if (sp > XB_SPIN_CAP) { atomicAdd(&bar[XB_TMO], 1u); break; } }
    }
    nloc = mine > 0u ? mine : 1u; nx = cnt > 0u ? cnt : 1u;
}
__device__ __forceinline__ void xcd_barrier(const XcdBarrier& b) {
    asm volatile("s_waitcnt vmcnt(0)" ::: "memory");
    __syncthreads();
    if (threadIdx.x == 0) {
        unsigned* bar = b.bar;
        __builtin_amdgcn_s_waitcnt(0);
        unsigned nloc = b.st[0], nx = b.st[1];
        if (nloc == 0u) { xcd_barrier_complete(bar, b.x, nloc, nx); b.st[0] = nloc; b.st[1] = nx; }
        const unsigned old = xb_add(&bar[XB_XSUB(b.x)], 1u);
        const unsigned gen = old / nloc;
        if (old + 1u == (gen + 1u) * nloc) {
            __builtin_amdgcn_fence(__ATOMIC_RELEASE, "agent");
            asm volatile("s_waitcnt vmcnt(0)" ::: "memory");
            const unsigned og = xb_add(&bar[XB_TOP], 1u);
            const unsigned tg = og / nx;
            if (og + 1u == (tg + 1u) * nx) xb_add(&bar[XB_TOPGEN], 1u);
            else XB_SPIN(xb_ld(&bar[XB_TOPGEN]) == tg, bar);
            __builtin_amdgcn_fence(__ATOMIC_ACQUIRE, "agent");
            xb_add(&bar[XB_XGEN(b.x)], 1u);
            asm volatile("s_waitcnt vmcnt(0)" ::: "memory");
        } else {
            XB_SPIN(xb_ld(&bar[XB_XGEN(b.x)]) == gen, bar);
            __builtin_amdgcn_fence(__ATOMIC_ACQUIRE, "agent");
            asm volatile("s_waitcnt vmcnt(0)" ::: "memory");
        }
    }
    __syncthreads();
}

namespace pg8 {
typedef unsigned short bf16_t;
constexpr int BM = 256, BK = 64, HALF = 128, HTB = HALF * BK * 2, STAGE_BYTES = 8 * HTB;
__host__ __device__ __forceinline__ int lds_byte(int r, int c) { const int st = (r >> 4) * 2 + (c >> 5), rr = r & 15, cc = c & 31, ob = rr * 64 + cc * 2; return st * 1024 + (ob ^ (((ob >> 9) & 1) << 5)); }
__host__ __device__ __forceinline__ void stage_rc(int b, int& R, int& C) { const int st = b / 1024, sb = b % 1024, swz = sb ^ (((sb >> 9) & 1) << 5); R = (st >> 1) * 16 + swz / 64; C = (st & 1) * 32 + (swz % 64) / 2; }
__host__ __device__ __forceinline__ int perm32(int rho) { const int n = rho >> 4, i = rho & 15; return 8 * (i >> 2) + 4 * n + (i & 3); }
struct Unit { int pm, pn; };
struct Gemm { const bf16_t* A; const bf16_t* Bt; int K; };
__device__ __forceinline__ unsigned cvt_pk_bf16(float lo, float hi) { unsigned r; asm volatile("v_cvt_pk_bf16_f32 %0, %1, %2" : "=v"(r) : "v"(lo), "v"(hi)); return r; }

template <class Epi, class Sched, bool ALIGN_EPI>
__device__ __forceinline__ void gemm_phase(LAS unsigned char* lds, const Gemm g, const Sched& S, const Epi& E) {
    const int tid = threadIdx.x, wid = __builtin_amdgcn_readfirstlane(tid >> 6), lane = tid & 63, wr = wid >> 2, wc = wid & 3, fr = lane & 15, fq = lane >> 4;
    const int K = g.K, nt = K / BK;
    int Rs[2], Cs[2]; unsigned voffB[2];
#pragma unroll
    for (int i = 0; i < 2; ++i) { int R, C; stage_rc(tid * 16 + i * 8192, R, C); const int Rb = Epi::PERM ? ((R & ~31) + perm32(R & 31)) : R;
        Rs[i] = R; Cs[i] = C * 2; voffB[i] = (unsigned)(Rb * K + C) * 2u; }
    const size_t kstep = (size_t)(BK * 2);
    const size_t hstep = (size_t)HALF * K * 2;
    const unsigned ldsw = (unsigned)wid * 1024u;
    const int aoff = lds_byte(wr * 64 + fr, fq * 8), boff = lds_byte(wc * 32 + fr, fq * 8);
#define PG8_SA(b, h) (((b) * 2 + (h)) * HTB)
#define PG8_SB(b, h) ((4 + (b) * 2 + (h)) * HTB)
#define PG8_STAGE(bufoff, gbase, v0, v1) do { \
        __builtin_amdgcn_global_load_lds((const unsigned*)((const char*)(gbase) + (v0)), (LAS unsigned*)(lds + (bufoff) + ldsw), 16, 0, 0); \
        __builtin_amdgcn_global_load_lds((const unsigned*)((const char*)(gbase) + (v1)), (LAS unsigned*)(lds + (bufoff) + ldsw + 8192), 16, 0, 0); } while (0)
#define PG8_STAGEB(bufoff, gbase) PG8_STAGE(bufoff, gbase, voffB[0], voffB[1])
#define PG8_LDA(dst, b, h) do { _Pragma("unroll") for (int m = 0; m < 4; ++m) _Pragma("unroll") for (int k = 0; k < 2; ++k) dst[m][k] = *(const LAS bf16x8*)(lds + PG8_SA(b, h) + aoff + m * 2048 + k * 1024); } while (0)
#define PG8_LDB(dst, b, h) do { _Pragma("unroll") for (int n = 0; n < 2; ++n) _Pragma("unroll") for (int k = 0; k < 2; ++k) dst[n][k] = *(const LAS bf16x8*)(lds + PG8_SB(b, h) + boff + n * 2048 + k * 1024); } while (0)
#define PG8_MMA(ai, bj, At, Bt) do { __builtin_amdgcn_s_setprio(1); _Pragma("unroll") for (int m = 0; m < 4; ++m) _Pragma("unroll") for (int n = 0; n < 2; ++n) _Pragma("unroll") for (int k = 0; k < 2; ++k) \
        acc[ai][bj][m][n] = __builtin_amdgcn_mfma_f32_16x16x32_bf16(Bt[n][k], At[m][k], acc[ai][bj][m][n], 0, 0, 0); __builtin_amdgcn_s_setprio(0); } while (0)
#define PG8_WAIT_V(n) asm volatile("s_waitcnt vmcnt(" #n ")" ::: "memory")
#define PG8_WAIT_L(n) asm volatile("s_waitcnt lgkmcnt(" #n ")" ::: "memory")
#define PG8_BAR __builtin_amdgcn_s_barrier()
#define PG8_SCHED __builtin_amdgcn_sched_barrier(0)
    Unit cur, nxt; int ui = 0;
    if (!S.next(0, cur)) return;
    f32x4 acc[2][2][4][2];
#pragma unroll
    for (int a = 0; a < 2; ++a)
#pragma unroll
        for (int b = 0; b < 2; ++b)
#pragma unroll
            for (int m = 0; m < 4; ++m)
#pragma unroll
                for (int n = 0; n < 2; ++n) acc[a][b][m][n] = (f32x4){0.f, 0.f, 0.f, 0.f};
    bf16x8 At[4][2], B0[2][2], B1[2][2];
    unsigned vc[2][2], vn[2][2];
#pragma unroll
    for (int h = 0; h < 2; ++h)
#pragma unroll
        for (int i = 0; i < 2; ++i) vc[h][i] = (unsigned)S.arow(cur, h * HALF + Rs[i]) * (unsigned)(K * 2) + (unsigned)Cs[i];
    const char* cA = (const char*)g.A;
    const char* cB = (const char*)g.Bt + (size_t)S.brow0(cur) * K * 2;
    PG8_STAGEB(PG8_SB(0, 0), cB); PG8_STAGEB(PG8_SB(0, 1), cB + hstep); PG8_STAGE(PG8_SA(0, 0), cA, vc[0][0], vc[0][1]); PG8_STAGE(PG8_SA(0, 1), cA, vc[1][0], vc[1][1]);
    if (wr == 1) PG8_BAR;
    PG8_WAIT_V(2); PG8_BAR;
    PG8_STAGEB(PG8_SB(1, 0), cB + kstep); PG8_STAGE(PG8_SA(1, 0), cA + kstep, vc[0][0], vc[0][1]); PG8_STAGEB(PG8_SB(1, 1), cB + hstep + kstep);
    PG8_WAIT_V(6); PG8_BAR;
    for (;;) {
        const bool has_next = S.next(ui + 1, nxt);
        const char* nB = cB;
        if (has_next) {
            nB = (const char*)g.Bt + (size_t)S.brow0(nxt) * K * 2;
#pragma unroll
            for (int h = 0; h < 2; ++h)
#pragma unroll
                for (int i = 0; i < 2; ++i) vn[h][i] = (unsigned)S.arow(nxt, h * HALF + Rs[i]) * (unsigned)(K * 2) + (unsigned)Cs[i];
        } else {
#pragma unroll
            for (int h = 0; h < 2; ++h)
#pragma unroll
                for (int i = 0; i < 2; ++i) vn[h][i] = vc[h][i];
        }
        for (int t = 0; t < nt; t += 2) {
            const bool last = (t == nt - 2);
            const char* a1 = cA + (size_t)(t + 1) * kstep;
            const char* a2 = last ? cA : cA + (size_t)(t + 2) * kstep; const char* b2 = last ? nB : cB + (size_t)(t + 2) * kstep;
            const char* a3 = a2 + kstep; const char* b3 = b2 + kstep;
            const unsigned w00 = last ? vn[0][0] : vc[0][0], w01 = last ? vn[0][1] : vc[0][1], w10 = last ? vn[1][0] : vc[1][0], w11 = last ? vn[1][1] : vc[1][1];
            PG8_LDB(B0, 0, 0); PG8_LDB(B1, 0, 1); PG8_SCHED; PG8_LDA(At, 0, 0); PG8_STAGE(PG8_SA(1, 1), a1, vc[1][0], vc[1][1]);
            PG8_WAIT_V(8); PG8_WAIT_L(0); PG8_BAR; PG8_MMA(0, 0, At, B0); PG8_MMA(0, 1, At, B1); PG8_BAR; PG8_SCHED;
            PG8_LDA(At, 0, 1); PG8_STAGEB(PG8_SB(0, 0), b2); PG8_STAGEB(PG8_SB(0, 1), b2 + hstep); PG8_STAGE(PG8_SA(0, 0), a2, w00, w01);
            PG8_WAIT_V(8); PG8_WAIT_L(0); PG8_BAR; PG8_MMA(1, 0, At, B0); PG8_MMA(1, 1, At, B1); PG8_BAR; PG8_SCHED;
            PG8_LDB(B0, 1, 0); PG8_LDB(B1, 1, 1); PG8_SCHED; PG8_LDA(At, 1, 0); PG8_STAGE(PG8_SA(0, 1), a2, w10, w11);
            PG8_WAIT_V(8); PG8_WAIT_L(0); PG8_BAR; PG8_MMA(0, 0, At, B0); PG8_MMA(0, 1, At, B1); PG8_BAR; PG8_SCHED;
            PG8_LDA(At, 1, 1); PG8_STAGEB(PG8_SB(1, 0), b3); PG8_STAGEB(PG8_SB(1, 1), b3 + hstep); PG8_STAGE(PG8_SA(1, 0), a3, w00, w01);
            PG8_WAIT_V(8); PG8_WAIT_L(0); PG8_BAR; PG8_MMA(1, 0, At, B0); PG8_MMA(1, 1, At, B1); PG8_BAR; PG8_SCHED;
        }
        if constexpr (ALIGN_EPI) { if (wr == 0) PG8_BAR; }
        E(acc, cur, wr, wc, fr, fq);
        if (!has_next) break;
#pragma unroll
        for (int a = 0; a < 2; ++a)
#pragma unroll
            for (int b = 0; b < 2; ++b)
#pragma unroll
                for (int m = 0; m < 4; ++m)
#pragma unroll
                    for (int n = 0; n < 2; ++n) acc[a][b][m][n] = (f32x4){0.f, 0.f, 0.f, 0.f};
        cur = nxt; cB = nB; ++ui;
#pragma unroll
        for (int h = 0; h < 2; ++h)
#pragma unroll
            for (int i = 0; i < 2; ++i) vc[h][i] = vn[h][i];
        if constexpr (ALIGN_EPI) { if (wr == 1) PG8_BAR; }
    }
    PG8_WAIT_V(0);
    if constexpr (!ALIGN_EPI) { if (wr == 0) PG8_BAR; }
    PG8_BAR;
#undef PG8_SA
#undef PG8_SB
#undef PG8_STAGE
#undef PG8_STAGEB
#undef PG8_LDA
#undef PG8_LDB
#undef PG8_MMA
#undef PG8_WAIT_V
#undef PG8_WAIT_L
#undef PG8_BAR
#undef PG8_SCHED
}

struct StaticOrder {
    int nM, nN, nwg, G, c;
    __device__ void init(int Mrows, int N, int G_, int c_) { nM = Mrows / BM; nN = N / BM; nwg = nM * nN; G = G_; c = c_; }
    __device__ bool next(int i, Unit& u) const {
        const long L = (long)i * G + c; if (L >= nwg) return false;
        int wgid = (int)L; { const int q = nwg / 8, r = nwg % 8, xcd = wgid % 8, off = wgid / 8; wgid = (xcd < r ? xcd * (q + 1) : r * (q + 1) + (xcd - r) * q) + off; }
        const int nig = 8 * nN, gid = wgid / nig, fm = gid * 8, gsz = (nM - fm) < 8 ? (nM - fm) : 8;
        u.pm = fm + ((wgid % nig) % gsz); u.pn = (wgid % nig) / gsz; return true;
    }
    __device__ __forceinline__ int arow(const Unit& u, int rt) const { return u.pm * BM + rt; }
    __device__ __forceinline__ int brow0(const Unit& u) const { return u.pn * BM; }
};
}

#include <cmath>
namespace attn_body {
using bf16=unsigned short;
using bf16x8=__attribute__((ext_vector_type(8)))short;
using s16x4=__attribute__((ext_vector_type(4)))short;
using f32x16=__attribute__((ext_vector_type(16)))float;
using u32x4=__attribute__((ext_vector_type(4)))unsigned;
using u32x2=__attribute__((ext_vector_type(2)))unsigned;
constexpr int BATCH=4,NHEAD=8,SEQ=8192,D=64,DM=NHEAD*D,OPITCH=1024,MPITCH=1024;
constexpr int NW=8,QBLK=32,QB=QBLK*NW,KVBLK=64,NQB=SEQ/QB;
constexpr int ATTN_PITCH=DM, ATTN_UNIT_ROWS=QB;
__device__ __forceinline__ int crow(int r,int hi){return (r&3)+8*(r>>2)+4*hi;}
#define SBAR() __builtin_amdgcn_sched_barrier(0)
constexpr int NSLOT=3, SLOTB=8192;
constexpr int LDS_K=0, LDS_V=NSLOT*SLOTB, LDS_WS=2*NSLOT*SLOTB, LDS_OST=LDS_WS+NW*64*4, LDS_MK=LDS_OST+NW*4096, LDS_BYTES=LDS_MK+NW*1024;
__device__ __forceinline__ void glds16(const void*gsrc,unsigned lds_dst){unsigned keep;
  asm volatile("s_mov_b32 %0, m0\n\ts_mov_b32 m0, %2\n\ts_nop 0\n\tglobal_load_lds_dwordx4 %1, off\n\ts_mov_b32 m0, %0":"=&s"(keep):"v"(gsrc),"s"(lds_dst):"memory");}
__device__ __forceinline__ void glds4(const void*gsrc,unsigned lds_dst){unsigned keep;
  asm volatile("s_mov_b32 %0, m0\n\ts_mov_b32 m0, %2\n\ts_nop 0\n\tglobal_load_lds_dword %1, off\n\ts_mov_b32 m0, %0":"=&s"(keep):"v"(gsrc),"s"(lds_dst):"memory");}
__device__ __forceinline__ float mskf(float x,unsigned w,int pos){ unsigned m; asm("v_bfe_i32 %0, %1, %2, 1":"=v"(m):"v"(w),"n"(pos)); return __uint_as_float(__float_as_uint(x) & m); }
__device__ __forceinline__ float max3f(float a,float b,float c){float r;asm("v_max3_f32 %0, %1, %2, %3":"=v"(r):"v"(a),"v"(b),"v"(c));return r;}
__device__ __forceinline__ float max2f(float a,float b){float r;asm("v_max_f32_e32 %0, %1, %2":"=v"(r):"v"(a),"v"(b));return r;}
__device__ __forceinline__ float fadd_s(float a,float b){float r;asm("v_add_f32_e32 %0, %1, %2":"=v"(r):"v"(a),"v"(b));return r;}
__device__ __forceinline__ float fsub_s(float a,float b){float r;asm("v_sub_f32_e32 %0, %1, %2":"=v"(r):"v"(a),"v"(b));return r;}
typedef float f32x2_t __attribute__((ext_vector_type(2))); typedef __bf16 bf16x2_t __attribute__((ext_vector_type(2)));
__device__ __forceinline__ unsigned cvtpk_s(float lo,float hi){f32x2_t v={lo,hi};bf16x2_t b=__builtin_convertvector(v,bf16x2_t);return __builtin_bit_cast(unsigned,b);}
#define WAIT_BAR(N) asm volatile("s_waitcnt vmcnt(" #N ") lgkmcnt(0)\n\ts_barrier":::"memory")

__device__ __forceinline__ void qkt(f32x16&p0,f32x16&p1,const char*Kslot,const bf16x8*qr,const f32x16&negm,int r32,int hi){
  const char*kb=Kslot+hi*1024+r32*16;
  #pragma unroll
  for(int d0=0;d0<4;++d0){
    const bf16x8 b0=*reinterpret_cast<const bf16x8*>(kb+d0*2048);
    const bf16x8 b1=*reinterpret_cast<const bf16x8*>(kb+d0*2048+512);
    if(d0==0){p0=__builtin_amdgcn_mfma_f32_32x32x16_bf16(b0,qr[0],negm,0,0,0);p1=__builtin_amdgcn_mfma_f32_32x32x16_bf16(b1,qr[0],negm,0,0,0);}
    else{p0=__builtin_amdgcn_mfma_f32_32x32x16_bf16(b0,qr[d0],p0,0,0,0);p1=__builtin_amdgcn_mfma_f32_32x32x16_bf16(b1,qr[d0],p1,0,0,0);}}
}
typedef __attribute__((address_space(3))) const char* lds_cptr;
typedef short v4i16_t __attribute__((ext_vector_type(4)));
__device__ __forceinline__ void kload8(bf16x8*kf,lds_cptr kp){
  kf[0]=*(const __attribute__((address_space(3))) bf16x8*)(kp);      kf[1]=*(const __attribute__((address_space(3))) bf16x8*)(kp+512);
  kf[2]=*(const __attribute__((address_space(3))) bf16x8*)(kp+2048); kf[3]=*(const __attribute__((address_space(3))) bf16x8*)(kp+2560);
  kf[4]=*(const __attribute__((address_space(3))) bf16x8*)(kp+4096); kf[5]=*(const __attribute__((address_space(3))) bf16x8*)(kp+4608);
  kf[6]=*(const __attribute__((address_space(3))) bf16x8*)(kp+6144); kf[7]=*(const __attribute__((address_space(3))) bf16x8*)(kp+6656);
}
__device__ __forceinline__ void kload2(bf16x8*kf,lds_cptr kp,int j){ kf[2*j]=*(const __attribute__((address_space(3))) bf16x8*)(kp+j*2048); kf[2*j+1]=*(const __attribute__((address_space(3))) bf16x8*)(kp+j*2048+512); }
__device__ __forceinline__ s16x4 vtr(lds_cptr p){ return __builtin_bit_cast(s16x4,__builtin_amdgcn_ds_read_tr16_b64_v4i16((__attribute__((address_space(3))) v4i16_t*)p)); }
__device__ __forceinline__ float rowmax(const f32x16&p0,const f32x16&p1){
  float a=max3f(p0[0],p0[1],p1[0]),b=max3f(p0[2],p0[3],p1[1]);a=max3f(a,p1[2],p1[3]);
  #pragma unroll
  for(int r=4;r<16;r+=4){a=max3f(a,p0[r],p0[r+1]);b=max3f(b,p0[r+2],p0[r+3]);a=max3f(a,p1[r],p1[r+1]);b=max3f(b,p1[r+2],p1[r+3]);}
  const float m=max2f(a,b);
  auto rr=__builtin_amdgcn_permlane32_swap(__float_as_uint(m),__float_as_uint(m),false,false);
  return max2f(__uint_as_float(rr[0]),__uint_as_float(rr[1]));
}
__device__ __forceinline__ void pv(f32x16*o,int vb,bf16x8 pa0,bf16x8 pa1,bf16x8 pa2,bf16x8 pa3){
  #pragma unroll
  for(int d0=0;d0<2;++d0){s16x4 lo[4],hi[4];
    #pragma unroll
    for(int ks=0;ks<4;++ks){
      asm volatile("ds_read_b64_tr_b16 %0,%1 offset:%c2":"=&v"(lo[ks]):"v"(vb),"i"(d0*4096+ks*1024):"memory");
      asm volatile("ds_read_b64_tr_b16 %0,%1 offset:%c2":"=&v"(hi[ks]):"v"(vb),"i"(d0*4096+ks*1024+512):"memory");}
    asm volatile("s_waitcnt lgkmcnt(0)":::"memory");SBAR();
    #define PK(k) (bf16x8){lo[k][0],lo[k][1],lo[k][2],lo[k][3],hi[k][0],hi[k][1],hi[k][2],hi[k][3]}
    o[d0]=__builtin_amdgcn_mfma_f32_32x32x16_bf16(pa0,PK(0),o[d0],0,0,0);
    o[d0]=__builtin_amdgcn_mfma_f32_32x32x16_bf16(pa1,PK(1),o[d0],0,0,0);
    o[d0]=__builtin_amdgcn_mfma_f32_32x32x16_bf16(pa2,PK(2),o[d0],0,0,0);
    o[d0]=__builtin_amdgcn_mfma_f32_32x32x16_bf16(pa3,PK(3),o[d0],0,0,0);
    #undef PK
  }
}

#ifndef ATTN_STORE16
#define ATTN_STORE16(p,v) (*(u32x4*)(p)=(v))
#endif
template<int THRL> __device__ __forceinline__ void attn_unit(int b,int h,int qb,const bf16*Q,const bf16*__restrict__ K,const bf16*__restrict__ V,bf16*O,const unsigned char*__restrict__ MK,char*shm){
  const int tid=threadIdx.x,lane=tid&63,r32=lane&31,hi=lane>>5; const int wid=__builtin_amdgcn_readfirstlane(tid>>6);
  const long rowbase=(long)b*SEQ; const int q0=qb*QB;
  const bf16*Qw=Q+(rowbase+q0+wid*QBLK)*DM+h*D;
  const bf16*Kh=K+rowbase*DM+h*D,*Vh=V+rowbase*DM+h*D;
  const unsigned lds0=(unsigned)(uintptr_t)shm;
  float*wsf=(float*)(shm+LDS_WS)+wid*64;
  const bf16*ksrc=Kh+(long)lane*DM+wid*8;
  const bf16*vsrc=Vh+(long)(16*(wid&3)+(lane>>2))*DM+(wid>>2)*32+(lane&3)*8;
  const unsigned kdst=lds0+LDS_K+wid*1024, vdst=lds0+LDS_V+wid*1024;
  #define DMA_K(t,slot) glds16(ksrc+(long)(t)*KVBLK*DM,(unsigned)__builtin_amdgcn_readfirstlane(kdst+(slot)))
  #define DMA_V(t,slot) glds16(vsrc+(long)(t)*KVBLK*DM,(unsigned)__builtin_amdgcn_readfirstlane(vdst+(slot)))
  const unsigned char*msrc=MK+(rowbase+q0+wid*QBLK+(lane>>1))*(long)MPITCH+4*(lane&1);
  const unsigned mdst=lds0+LDS_MK+wid*1024;
  #define DMA_M(t) glds4(msrc+8*(long)(t),(unsigned)__builtin_amdgcn_readfirstlane(mdst+(((t)&3)<<8)))
  const lds_cptr mp0=(lds_cptr)shm+LDS_MK+wid*1024+r32*8;
  #define MLOAD(t) do{ const u32x2 mw_=*(const __attribute__((address_space(3))) u32x2*)(mp0+(((t)&3)<<8)); ml=mw_[0]>>(4*hi); mh=mw_[1]>>(4*hi); }while(0)
  const int vb0=(int)(lds0+LDS_V)+((lane>>4)&1)*32+(lane&3)*8+(4*hi+((lane&15)>>2))*64;
  const char*Kbase=shm+LDS_K; bf16x8 kf[8];
  const lds_cptr shm3=(lds_cptr)shm; const lds_cptr kp0=shm3+LDS_K+hi*1024+r32*16; const lds_cptr vp0=shm3+LDS_V+((lane>>4)&1)*32+(lane&3)*8+(4*hi+((lane&15)>>2))*64;
  const int NT=(q0+QB)/KVBLK;
  DMA_K(0,0);DMA_M(0);DMA_V(0,0);DMA_K(1,SLOTB);
  bf16x8 qr[4];
  #pragma unroll
  for(int d0=0;d0<4;++d0)qr[d0]=*reinterpret_cast<const bf16x8*>(&Qw[(long)r32*DM+d0*16+hi*8]);
  float mhat=0.f,l_reg=0.f;f32x16 o[2];o[0]=f32x16{};o[1]=f32x16{};f32x16 negm=f32x16{};asm volatile("":"+v"(negm));
  const int qrel=wid*QBLK+r32;
  #define CMASK(P0,P1,t) do{}while(0)
  unsigned ml=0u,mh=0u;
  bool resc=false;
  #define START(P0,P1) do{ const float rm=rowmax(P0,P1); resc=false; \
    { const float dl=rm; mhat=fadd_s(mhat,dl); \
      _Pragma("unroll") for(int r=0;r<16;++r){P0[r]=fsub_s(P0[r],dl);P1[r]=fsub_s(P1[r],dl);} \
      _Pragma("unroll") for(int r=0;r<16;++r)negm[r]=-mhat; asm volatile("":"+v"(negm)); } \
    _Pragma("unroll") for(int r=0;r<16;++r)P0[r]=__builtin_amdgcn_exp2f(P0[r]); }while(0)
  #define RESC() do{ if(resc){ asm volatile("s_waitcnt lgkmcnt(0)":::"memory"); \
      _Pragma("unroll") for(int d_=0;d_<2;++d_) _Pragma("unroll") for(int r=0;r<16;++r)o[d_][r]*=wsf[crow(r,hi)]; } }while(0)
  f32x16 pA0,pA1,pB0,pB1;
  int sl_prev=0,sl_cur=0,sl_next=SLOTB;
  #define ROT() do{sl_prev=sl_cur;sl_cur=sl_next;sl_next=(sl_next==(NSLOT-1)*SLOTB)?0:sl_next+SLOTB;}while(0)
  DMA_K(2,2*SLOTB);DMA_M(1);
  WAIT_BAR(4);
  qkt(pA0,pA1,Kbase,qr,negm,r32,hi);asm volatile("s_nop 15\n\ts_nop 7":"+v"(pA0),"+v"(pA1));CMASK(pA0,pA1,0);
  START(pA0,pA1);
  _Pragma("unroll") for(int r=0;r<16;++r)pA1[r]=__builtin_amdgcn_exp2f(pA1[r]);
  MLOAD(0);
  _Pragma("unroll") for(int r=0;r<16;++r){pA0[r]=mskf(pA0[r],ml,(r&3)+8*(r>>2));pA1[r]=mskf(pA1[r],mh,(r&3)+8*(r>>2));}
  WAIT_BAR(0);
  DMA_K(3,0);DMA_V(1,SLOTB);DMA_M(2);
  ROT();
  kload8(kf,kp0+sl_cur);
  WAIT_BAR(3);
  s16x4 vlo[8],vhi[8]; u32x4 pw0,pw1,pw2,pw3;
  #define PKW(P,B) cvtpk_s(P[B],P[B+1])
  #define PAF(k) __builtin_bit_cast(bf16x8,pw##k)
  #define VFR(i) (bf16x8){vlo[i][0],vlo[i][1],vlo[i][2],vlo[i][3],vhi[i][0],vhi[i][1],vhi[i][2],vhi[i][3]}
  #define PIN(x) asm volatile("":"+v"(x))
  #define MX3(a,b,c) __builtin_fmaxf(__builtin_fmaxf((a),(b)),(c))
  #define GAPA(MF,A0,A1,A2,A3,W0,W1,PW) do{ MF; sacc+=A0; sacc+=A1; sacc+=A2; sacc+=A3; PIN(sacc); W0; W1; PIN(PW); SBAR(); }while(0)
  #define EX(v) __builtin_amdgcn_exp2f(v)
  #define GAPB(MF,X,B,W) do{ MF; X[B]=mskf(EX(X[B]),W,2*(B)); X[B+1]=mskf(EX(X[B+1]),W,2*(B)+1); X[B+2]=mskf(EX(X[B+2]),W,2*(B)+2); X[B+3]=mskf(EX(X[B+3]),W,2*(B)+3); PIN(X); SBAR(); }while(0)
  #define VRD(i) do{ vlo[i]=vtr(vp_+(((i)>>2)*4096+((i)&3)*1024)); vhi[i]=vtr(vp_+(((i)>>2)*4096+((i)&3)*1024+512)); }while(0)
  #define KRD(G,j) do{ if(G){ kload2(kf,kp0+sl_next,j); SBAR(); } }while(0)
  #define STEP(C0,C1,P0,P1,t,GK,GV,GL,GM) do{ SBAR(); \
    const lds_cptr vp_=vp0+sl_prev; \
    VRD(0); SBAR(); float sacc=(P0[0]+P0[1]); \
    GAPA(C0=__builtin_amdgcn_mfma_f32_32x32x16_bf16(kf[0],qr[0],negm,0,0,0), P0[2],P0[3],P0[4],P0[5],     pw0[0]=PKW(P0,0), pw0[1]=PKW(P0,2), pw0); \
    VRD(4); SBAR(); GAPA(C1=__builtin_amdgcn_mfma_f32_32x32x16_bf16(kf[1],qr[0],negm,0,0,0), P0[6],P0[7],P0[8],P0[9],     pw0[2]=PKW(P0,4), pw0[3]=PKW(P0,6), pw0); \
    VRD(1); SBAR(); GAPA(C0=__builtin_amdgcn_mfma_f32_32x32x16_bf16(kf[2],qr[1],C0,0,0,0),   P0[10],P0[11],P0[12],P0[13], pw1[0]=PKW(P0,8), pw1[1]=PKW(P0,10), pw1); \
    VRD(5); SBAR(); GAPA(C1=__builtin_amdgcn_mfma_f32_32x32x16_bf16(kf[3],qr[1],C1,0,0,0),   P0[14],P0[15],P1[0],P1[1],   pw1[2]=PKW(P0,12),pw1[3]=PKW(P0,14), pw1); \
    VRD(2); SBAR(); GAPA(C0=__builtin_amdgcn_mfma_f32_32x32x16_bf16(kf[4],qr[2],C0,0,0,0),   P1[2],P1[3],P1[4],P1[5],     pw2[0]=PKW(P1,0), pw2[1]=PKW(P1,2), pw2); \
    VRD(6); SBAR(); GAPA(C1=__builtin_amdgcn_mfma_f32_32x32x16_bf16(kf[5],qr[2],C1,0,0,0),   P1[6],P1[7],P1[8],P1[9],     pw2[2]=PKW(P1,4), pw2[3]=PKW(P1,6), pw2); \
    VRD(3); SBAR(); GAPA(C0=__builtin_amdgcn_mfma_f32_32x32x16_bf16(kf[6],qr[3],C0,0,0,0),   P1[10],P1[11],P1[12],P1[13], pw3[0]=PKW(P1,8), pw3[1]=PKW(P1,10), pw3); \
    VRD(7); SBAR(); GAPA(C1=__builtin_amdgcn_mfma_f32_32x32x16_bf16(kf[7],qr[3],C1,0,0,0),   P1[14],P1[15],0.f,0.f,       pw3[2]=PKW(P1,12),pw3[3]=PKW(P1,14), pw3); \
    l_reg+=sacc; \
    if(GK){DMA_K((t)+3,sl_cur);} if(GV){DMA_V((t)+1,sl_next);} if(GM){DMA_M((t)+2);} \
    CMASK(C0,C1,t); \
    { float a=MX3(C0[0],C0[1],C1[0]),b=MX3(C0[2],C0[3],C1[1]); a=MX3(a,C1[2],C1[3]); \
      _Pragma("unroll") for(int r=4;r<16;r+=4){a=MX3(a,C0[r],C0[r+1]);b=MX3(b,C0[r+2],C0[r+3]);a=MX3(a,C1[r],C1[r+1]);b=MX3(b,C1[r+2],C1[r+3]);} \
      float rm=__builtin_fmaxf(a,b); { auto rr=__builtin_amdgcn_permlane32_swap(__float_as_uint(rm),__float_as_uint(rm),false,false); rm=__builtin_fmaxf(__uint_as_float(rr[0]),__uint_as_float(rr[1])); } \
      resc=false; \
      if(__builtin_expect(__any(rm>(float)THRL),0)){ const float dl=__builtin_fmaxf(rm,0.f); mhat+=dl; \
        _Pragma("unroll") for(int r=0;r<16;++r){C0[r]-=dl;C1[r]-=dl;} \
        _Pragma("unroll") for(int r=0;r<16;++r)negm[r]=-mhat; asm volatile("":"+v"(negm)); \
        const float f=__builtin_amdgcn_exp2f(-dl); l_reg*=f; if(hi==0)wsf[r32]=f; resc=true; } } \
    MLOAD(t); SBAR(); \
    GAPB(o[0]=__builtin_amdgcn_mfma_f32_32x32x16_bf16(PAF(0),VFR(0),o[0],0,0,0), C0,0,ml); \
    GAPB(o[1]=__builtin_amdgcn_mfma_f32_32x32x16_bf16(PAF(0),VFR(4),o[1],0,0,0), C0,4,ml); \
    KRD(GL,0); GAPB(o[0]=__builtin_amdgcn_mfma_f32_32x32x16_bf16(PAF(1),VFR(1),o[0],0,0,0), C0,8,ml); \
    KRD(GL,1); GAPB(o[1]=__builtin_amdgcn_mfma_f32_32x32x16_bf16(PAF(1),VFR(5),o[1],0,0,0), C0,12,ml); \
    KRD(GL,2); GAPB(o[0]=__builtin_amdgcn_mfma_f32_32x32x16_bf16(PAF(2),VFR(2),o[0],0,0,0), C1,0,mh); \
    KRD(GL,3); GAPB(o[1]=__builtin_amdgcn_mfma_f32_32x32x16_bf16(PAF(2),VFR(6),o[1],0,0,0), C1,4,mh); \
    GAPB(o[0]=__builtin_amdgcn_mfma_f32_32x32x16_bf16(PAF(3),VFR(3),o[0],0,0,0), C1,8,mh); \
    GAPB(o[1]=__builtin_amdgcn_mfma_f32_32x32x16_bf16(PAF(3),VFR(7),o[1],0,0,0), C1,12,mh); \
    }while(0)
  int t=1;
  #undef CMASK
  #define CMASK(P0,P1,t) do{}while(0)
  for(;t+5<NT;t+=2){
    STEP(pB0,pB1,pA0,pA1,t,true,true,true,true);     WAIT_BAR(3); RESC(); ROT();
    STEP(pA0,pA1,pB0,pB1,t+1,true,true,true,true);   WAIT_BAR(3); RESC(); ROT();
  }
  #undef CMASK
  #define CMASK(P0,P1,t) do{}while(0)
  #define ENDW(tt) do{ if((tt)+3<NT){WAIT_BAR(3);} else if((tt)+2<NT){WAIT_BAR(2);} else {WAIT_BAR(0);} }while(0)
  for(;t+1<NT;t+=2){
    STEP(pB0,pB1,pA0,pA1,t,(t+3<NT),(t+1<NT),(t+1<NT),(t+2<NT));       ENDW(t);   RESC(); ROT();
    STEP(pA0,pA1,pB0,pB1,t+1,(t+4<NT),(t+2<NT),(t+2<NT),(t+3<NT));     ENDW(t+1); RESC(); ROT();
  }
  STEP(pB0,pB1,pA0,pA1,NT-1,false,false,false,false); RESC();
  { float sacc=pB0[0]+pB0[1]; _Pragma("unroll") for(int r=2;r<16;++r)sacc+=pB0[r]; _Pragma("unroll") for(int r=0;r<16;++r)sacc+=pB1[r]; l_reg+=sacc;
    pw0=(u32x4){PKW(pB0,0),PKW(pB0,2),PKW(pB0,4),PKW(pB0,6)};pw1=(u32x4){PKW(pB0,8),PKW(pB0,10),PKW(pB0,12),PKW(pB0,14)};pw2=(u32x4){PKW(pB1,0),PKW(pB1,2),PKW(pB1,4),PKW(pB1,6)};pw3=(u32x4){PKW(pB1,8),PKW(pB1,10),PKW(pB1,12),PKW(pB1,14)};
    SBAR(); pv(o,vb0+sl_cur,PAF(0),PAF(1),PAF(2),PAF(3)); }
  #undef PKW
  #undef PAF
  #undef VFR
  #undef PIN
  #undef MX3
  #undef GAPA
  #undef GAPB
  #undef EX
  #undef VRD
  #undef KRD
  #undef STEP
  #undef ENDW
  {auto rr=__builtin_amdgcn_permlane32_swap(__float_as_uint(l_reg),__float_as_uint(l_reg),false,false);l_reg=__uint_as_float(rr[0])+__uint_as_float(rr[1]);}
  if(hi==0)wsf[32+r32]=l_reg;asm volatile("s_waitcnt lgkmcnt(0)":::"memory");
  float rli[16];
  #pragma unroll
  for(int r=0;r<16;++r)rli[r]=__builtin_amdgcn_rcpf(wsf[32+crow(r,hi)]);
  bf16*Ow=O+(rowbase+q0+wid*QBLK)*OPITCH+h*D;
  { bf16*stg=(bf16*)(shm+LDS_OST)+wid*2048;
    #pragma unroll
    for(int r=0;r<16;++r){const int orow=crow(r,hi);
      #pragma unroll
      for(int d0=0;d0<2;++d0)stg[orow*64+d0*32+r32]=(bf16)f2bf(o[d0][r]*rli[r]);}
    asm volatile("s_waitcnt lgkmcnt(0)":::"memory");
    #pragma unroll
    for(int i=0;i<4;++i){const int row=i*8+(lane>>3),ch=lane&7; const u32x4 v=*(const u32x4*)(stg+row*64+ch*8); ATTN_STORE16(Ow+(long)row*OPITCH+ch*8,v);} }
  asm volatile("s_waitcnt lgkmcnt(0)\n\ts_barrier":::"memory");
  #undef DMA_K
  #undef DMA_V
  #undef DMA_M
  #undef MLOAD
  #undef CMASK
  #undef START
  #undef RESC
  #undef ROT
}
constexpr int ATTN_LDS_BYTES=LDS_BYTES;
struct AttnTensors { const bf16* Q; const bf16* K; const bf16* V; bf16* O; const unsigned char* MK; };
struct AttnUnit { int bh; int qb; };
struct StaticOrder {
  int vcu;
  __device__ __forceinline__ explicit StaticOrder(int grid,int block):vcu((block%8)*(grid/8)+block/8){}
  __device__ __forceinline__ bool next(int i,AttnUnit&u)const{ if(i>=4)return false; const int s=vcu&7; u.bh=vcu>>3; u.qb=(i==0)?s:(i==1)?15-s:(i==2)?16+s:31-s; return true; }
  __device__ __forceinline__ void a_ready(const AttnUnit&)const{}
  __device__ __forceinline__ void done(const AttnUnit&)const{}
};
template<class Sched,int THRL=8> __device__ __forceinline__ void attn_phase(char*lds,const AttnTensors&T,const Sched&S){
  AttnUnit u;
  for(int i=0;S.next(i,u);++i){ S.a_ready(u); attn_unit<THRL>(u.bh/NHEAD,u.bh%NHEAD,u.qb,T.Q,T.K,T.V,T.O,T.MK,lds); S.done(u); }
}
#undef SBAR
#undef WAIT_BAR
}

struct Args { const void* in[15]; float* out; unsigned char* ws; int ph_lo, ph_hi; };
#define CAS __attribute__((address_space(4)))
struct Frame {
    LAS unsigned char* lds;
    gu32* ctl;
    unsigned char* ws;
    int tid, lane, wave;
    int vcu, G;
    const CAS Args* ka;
    __device__ __forceinline__ const float* inp(int k) const { return (const float*)ka->in[k]; }
#define FDEF(name, k) __device__ __forceinline__ const float* name() const { return inp(k); }
    FDEF(x, 0) FDEF(c, 1) FDEF(w_ada, 3) FDEF(b_ada, 4) FDEF(g_mix, 5) FDEF(w_in, 6) FDEF(w_o, 7) FDEF(g_ffn, 8) FDEF(w_rg, 9) FDEF(w_re, 10) FDEF(w_up, 11) FDEF(w_gate, 12) FDEF(w_down, 13) FDEF(g_fin, 14)
#undef FDEF
    __device__ __forceinline__ const int* pos() const { return (const int*)ka->in[2]; }
    __device__ __forceinline__ float* out() const { return ka->out; }
};

__device__ __forceinline__ void tr_put(LAS unsigned* T, int nb, int ns, int p, const f32x4 a, const f32x4 b) {
    T[(nb) * 33 + p] = pg8::cvt_pk_bf16(a.x, b.x); T[(nb + ns) * 33 + p] = pg8::cvt_pk_bf16(a.y, b.y);
    T[(nb + 2 * ns) * 33 + p] = pg8::cvt_pk_bf16(a.z, b.z); T[(nb + 3 * ns) * 33 + p] = pg8::cvt_pk_bf16(a.w, b.w);
}
__device__ __forceinline__ void tr_store(LAS unsigned* T, bf16* WT, int K, int n0, int k0, int lane) {
    LDS_WAIT(); asm volatile("" ::: "memory");
#pragma unroll
    for (int i = 0; i < 8; ++i) { const int n = (lane >> 3) + 8 * i, kc = lane & 7; const LAS unsigned* t = T + n * 33 + 4 * kc;
        v4u o; o.x = t[0]; o.y = t[1]; o.z = t[2]; o.w = t[3];
        *(GAS v4u*)(WT + (size_t)(n0 + n) * K + k0 + 8 * kc) = o; }
    LDS_WAIT(); asm volatile("" ::: "memory");
}
__device__ __forceinline__ void tr_tile_gu(const float* gate, const float* up, bf16* WT, int n0, int k0, LAS unsigned* T, int lane) {
    const int pq = lane >> 3, cq = lane & 7, c0 = n0 >> 1;
    f32x4 g0[4], g1[4], u0[4], u1[4];
#pragma unroll
    for (int i = 0; i < 4; ++i) { const int p = pq + 8 * i; const size_t o = (size_t)(k0 + 2 * p) * DEXP + c0 + 4 * cq;
        g0[i] = *(const GAS f32x4*)(gate + o); g1[i] = *(const GAS f32x4*)(gate + o + DEXP); u0[i] = *(const GAS f32x4*)(up + o); u1[i] = *(const GAS f32x4*)(up + o + DEXP); }
#pragma unroll
    for (int i = 0; i < 4; ++i) { const int p = pq + 8 * i; tr_put(T, 8 * cq, 2, p, g0[i], g1[i]); tr_put(T, 8 * cq + 1, 2, p, u0[i], u1[i]); }
    tr_store(T, WT, 1024, n0, k0, lane);
}
__device__ __forceinline__ void tr_tile_d(const float* wd, bf16* WT, int n0, int k0, LAS unsigned* T, int lane) {
    const int pq = lane >> 4, cq = lane & 15;
    f32x4 a[8], b[8];
#pragma unroll
    for (int i = 0; i < 8; ++i) { const int p = pq + 4 * i; const size_t o = (size_t)(k0 + 2 * p) * D + n0 + 4 * cq; a[i] = *(const GAS f32x4*)(wd + o); b[i] = *(const GAS f32x4*)(wd + o + D); }
#pragma unroll
    for (int i = 0; i < 8; ++i) { const int p = pq + 4 * i; tr_put(T, 4 * cq, 1, p, a[i], b[i]); }
    tr_store(T, WT, 512, n0, k0, lane);
}

template <class SrcFn>
__device__ __forceinline__ void tr_tile_gen(const SrcFn& src, int ldw, bf16* WT, int K, int n0, int k0, LAS unsigned* T, int lane) {
    const int pq = lane >> 4, cq = lane & 15; const float* sp = src(n0 + 4 * cq);
    f32x4 a[8], b[8];
#pragma unroll
    for (int i = 0; i < 8; ++i) { const int p = pq + 4 * i;
        if (sp) { a[i] = *(const GAS f32x4*)(sp + (size_t)(k0 + 2 * p) * ldw); b[i] = *(const GAS f32x4*)(sp + (size_t)(k0 + 2 * p + 1) * ldw); }
        else { a[i] = (f32x4){0.f, 0.f, 0.f, 0.f}; b[i] = a[i]; } }
#pragma unroll
    for (int i = 0; i < 8; ++i) { const int p = pq + 4 * i; tr_put(T, 4 * cq, 1, p, a[i], b[i]); }
    tr_store(T, WT, K, n0, k0, lane);
}

__device__ __forceinline__ int prope_dim(int p) { return p < 16 ? 8 * ((p >> 2) & 1) + 4 * (p >> 3) + (p & 3) : p; }
__device__ __forceinline__ int rrope_dim(int p) { return 32 * ((p >> 2) & 1) + 4 * (p >> 3) + (p & 3); }
__device__ __forceinline__ int win_src_col(int n) {
    if (n < 1024) return (n & ~63) + prope_dim(n & 63);
    if (n < 1536) return n;
    if (n < 2560) return (n & ~63) + prope_dim(n & 63);
    if (n < 3584) { const int q = n - 2560, sec = q >> 9, hd = (q >> 6) & 7; return (sec ? 3152 : 2640) + hd * 64 + rrope_dim(q & 63); }
    if (n < 4096) return 3664 + (n - 3584);
    if (n < 4608) return 4176 + (n - 4096);
    if (n < 4672) return 2560 + prope_dim(n - 4608);
    if (n < 4688) return 2624 + (n - 4672);
    return -1;
}

__device__ __forceinline__ void p0_prologue(Frame& F) {
    const int gw = F.vcu * NWAVES + F.wave, NGW = F.G * NWAVES;
    float* modp = (float*)(F.ws + WS_MODP);
    for (int rp2 = 0; rp2 < SUBREPS(20); ++rp2)
    for (int task = gw; task < 24 * 16; task += NGW) {
        const int cg = task % 24, ks = task / 24, j0 = cg * 256 + F.lane * 4;
        f32x4 a0 = {0, 0, 0, 0}, a1 = a0, a2 = a0, a3 = a0;
#pragma unroll 8
        for (int kk = 0; kk < 64; ++kk) { const int k = ks * 64 + kk; const f32x4 w = *(const GAS f32x4*)(F.w_ada() + (size_t)k * 6144 + j0);
            a0 += w * F.c()[0 * D + k]; a1 += w * F.c()[1 * D + k]; a2 += w * F.c()[2 * D + k]; a3 += w * F.c()[3 * D + k]; }
        *(GAS f32x4*)(modp + ((size_t)(ks * 4 + 0) * 6144 + j0)) = a0; *(GAS f32x4*)(modp + ((size_t)(ks * 4 + 1) * 6144 + j0)) = a1;
        *(GAS f32x4*)(modp + ((size_t)(ks * 4 + 2) * 6144 + j0)) = a2; *(GAS f32x4*)(modp + ((size_t)(ks * 4 + 3) * 6144 + j0)) = a3;
    }
    {
        float* c1 = (float*)(F.ws + WS_ROPE1); float* s1 = c1 + (size_t)M * 8;
        float* c2 = (float*)(F.ws + WS_ROPE2); float* s2 = c2 + (size_t)M * 32;
        const int gt = (F.vcu * NWAVES + F.wave) * 64 + F.lane, NGT = NGW * 64;
        for (int rp2 = 0; rp2 < SUBREPS(18); ++rp2)
        for (int i = gt; i < M * 40; i += NGT) {
            const int m = i / 40, j = i % 40; const float p = (float)F.pos()[m];
            if (j < 8) { const float inv = powf(500000.0f, -(float)j / 8.0f); float sn, cs; sincosf(p * inv, &sn, &cs); c1[m * 8 + j] = cs; s1[m * 8 + j] = sn; }
            else { const int jj = j - 8; const float inv = powf(10000.0f, -(float)jj / 32.0f); float sn, cs; sincosf(p * inv, &sn, &cs); c2[m * 32 + jj] = cs; s2[m * 32 + jj] = sn; }
        }
    }
    {
        constexpr int I_IN = (NPAD / 64) * (D / 64), I_O = (D / 64) * (D / 64);
        bf16* wint = (bf16*)(F.ws + WS_WIN); bf16* wot = (bf16*)(F.ws + WS_WO);
        const float* w_in = F.w_in(); const float* w_o = F.w_o();
        LAS unsigned* T = (LAS unsigned*)(F.lds + F.wave * 16384);
        for (int rp2 = 0; rp2 < SUBREPS(19); ++rp2)
        for (int it = gw; it < I_IN + I_O; it += NGW) {
            if (it < I_IN) { const int nb = it / 16, kb = it % 16;
                tr_tile_gen([&](int n) -> const float* { const int sc = win_src_col(n); return sc < 0 ? nullptr : w_in + sc; }, DIN, wint, D, nb * 64, kb * 64, T, F.lane); }
            else { const int r = it - I_IN, nb = r / 16, kb = r % 16;
                tr_tile_gen([&](int n) -> const float* { return w_o + n; }, D, wot, D, nb * 64, kb * 64, T, F.lane); }
        }
    }
}

__device__ __forceinline__ float mod_value(const float* modp, const float* b_ada, int b, int j) {
    float s = 0.f;
#pragma unroll
    for (int ks = 0; ks < 16; ++ks) s += modp[(size_t)(ks * 4 + b) * 6144 + j];
    return s + b_ada[j];
}
__device__ __forceinline__ void p1_norm(Frame& F) {
    const float* modp = (const float*)(F.ws + WS_MODP);
    LAS float* G1 = (LAS float*)F.lds;
    LAS float* S1 = G1 + 4 * D;
    for (int i = F.tid; i < 4 * D; i += NWAVES * 64) { const int b = i >> 10, col = i & 1023;
        const float sh = mod_value(modp, F.b_ada(), b, col), sc = mod_value(modp, F.b_ada(), b, 1024 + col);
        G1[i] = F.g_mix()[col] * (1.f + sc); S1[i] = sh; }
    if (blockIdx.x < 4) { float* mod = (float*)(F.ws + WS_MOD); const int b = blockIdx.x;
        for (int j = F.tid; j < 6144; j += NWAVES * 64) mod[b * 6144 + j] = mod_value(modp, F.b_ada(), b, j); }
    __syncthreads();
    const int gw = F.vcu * NWAVES + F.wave, NGW = F.G * NWAVES;
    bf16* H = (bf16*)(F.ws + WS_H);
    f32x4 nv[4];
    if (gw < M) { const GAS f32x4* xr = (const GAS f32x4*)(F.x() + (size_t)gw * D) + F.lane;
#pragma unroll
        for (int j = 0; j < 4; ++j) nv[j] = xr[64 * j]; }
    for (int m = gw; m < M; m += NGW) {
        const int b = m >> 13;
        f32x4 v[4]; float s = 0.f;
#pragma unroll
        for (int j = 0; j < 4; ++j) v[j] = nv[j];
        if (m + NGW < M) { const GAS f32x4* xr = (const GAS f32x4*)(F.x() + (size_t)(m + NGW) * D) + F.lane;
#pragma unroll
            for (int j = 0; j < 4; ++j) nv[j] = xr[64 * j]; }
#pragma unroll
        for (int j = 0; j < 4; ++j) s += (v[j].x * v[j].x + v[j].y * v[j].y) + (v[j].z * v[j].z + v[j].w * v[j].w);
        const float r = 1.f / sqrtf(wave_sum(s) * (1.f / D) + EPS);
        GAS unsigned long long* o8 = (GAS unsigned long long*)(H + (size_t)m * D) + F.lane;
#pragma unroll
        for (int j = 0; j < 4; ++j) { const int col = 4 * F.lane + 256 * j; const f32x4 g = *(const LAS f32x4*)(G1 + b * D + col), sh = *(const LAS f32x4*)(S1 + b * D + col);
            const f32x4 h = v[j] * r * g + sh;
            o8[64 * j] = (unsigned long long)pk2(h.x, h.y) | ((unsigned long long)pk2(h.z, h.w) << 32); }
    }
    __syncthreads();
}

struct EpiInProj {
    static constexpr bool PERM = true;
    unsigned char* ws;
    __device__ __forceinline__ void operator()(f32x4 (&acc)[2][2][4][2], const pg8::Unit& u, int wr, int wc, int fr, int fq) const {
        const int pn = u.pn; const int row0 = u.pm * 256 + wr * 64 + fr;
        const bool prope = (pn < 4) || (pn >= 6 && pn < 10) || (pn == 18);
        const bool rrope = (pn >= 10 && pn < 14);
        const bool roped = rrope || (prope && (wc & 1) == 0 && !(pn == 18 && wc != 0));
        const int g = 4 * (wc & 1) + fq;
        const bool act = rrope || (fq < 2);
        const int tl = rrope ? 32 : 8;
        const float* ct = (const float*)(ws + (rrope ? WS_ROPE2 : WS_ROPE1)) + 4 * (act ? g : 0); const float* stb = ct + (size_t)M * tl;
        bf16* base; int ld, colt; float sc = 1.f;
        if (pn < 2) { base = (bf16*)(ws + WS_QA); ld = 512; colt = pn * 256; sc = C2; }
        else if (pn < 4) { base = (bf16*)(ws + WS_KA); ld = 512; colt = (pn - 2) * 256; }
        else if (pn < 6) { base = (bf16*)(ws + WS_VA); ld = 512; colt = (pn - 4) * 256; }
        else if (pn < 10) { base = (bf16*)(ws + WS_QI); ld = 1024; colt = (pn - 6) * 256; }
        else if (pn < 12) { base = (bf16*)(ws + WS_QB); ld = 512; colt = (pn - 10) * 256; }
        else if (pn < 14) { base = (bf16*)(ws + WS_KB); ld = 512; colt = (pn - 12) * 256; sc = 0.125f; }
        else if (pn < 16) { base = (bf16*)(ws + WS_VB); ld = 512; colt = (pn - 14) * 256; }
        else if (pn < 18) { base = (bf16*)(ws + WS_GB); ld = 512; colt = (pn - 16) * 256; }
        else { base = (bf16*)(ws + WS_KI); ld = 64; colt = 0; }
        int colA[2], colB[2];
#pragma unroll
        for (int bj = 0; bj < 2; ++bj) { const int col = bj * 128 + wc * 32 + 8 * fq, hb = col & ~63;
            if (rrope) { colA[bj] = hb + 4 * g; colB[bj] = hb + 32 + 4 * g; }
            else if (prope && (wc & 1) == 0 && fq < 2 && !(pn == 18 && wc != 0)) { colA[bj] = hb + 4 * g; colB[bj] = hb + 8 + 4 * g; }
            else { colA[bj] = col; colB[bj] = col + 4; } }
        float* wi = (float*)(ws + WS_WI);
        f32x4 cnx = {0.f, 0.f, 0.f, 0.f}, snx = cnx;
        if (roped) { cnx = *(const GAS f32x4*)(ct + (size_t)row0 * tl); snx = *(const GAS f32x4*)(stb + (size_t)row0 * tl); }
#pragma unroll
        for (int ai = 0; ai < 2; ++ai)
#pragma unroll
            for (int m = 0; m < 4; ++m) { const int row = row0 + ai * 128 + m * 16;
                if (roped) {
                    const f32x4 cs = cnx, sn = snx;
                    if (!(ai == 1 && m == 3)) { const int rn = row0 + ((m == 3) ? 128 : ai * 128 + (m + 1) * 16);
                        cnx = *(const GAS f32x4*)(ct + (size_t)rn * tl); snx = *(const GAS f32x4*)(stb + (size_t)rn * tl); }
#pragma unroll
                    for (int bj = 0; bj < 2; ++bj) { const f32x4 x1 = acc[ai][bj][m][0], x2 = acc[ai][bj][m][1];
                        if (act) { acc[ai][bj][m][0] = x1 * cs - x2 * sn; acc[ai][bj][m][1] = x2 * cs + x1 * sn; } }
                }
                if (pn < 18) {
#pragma unroll
                    for (int bj = 0; bj < 2; ++bj) {
                        const f32x4 v0 = acc[ai][bj][m][0] * sc, v1 = acc[ai][bj][m][1] * sc; v2u wa, wb;
                        wa.x = pg8::cvt_pk_bf16(v0[0], v0[1]); wa.y = pg8::cvt_pk_bf16(v0[2], v0[3]); wb.x = pg8::cvt_pk_bf16(v1[0], v1[1]); wb.y = pg8::cvt_pk_bf16(v1[2], v1[3]);
                        bf16* rp = base + (size_t)row * ld + colt;
                        *(GAS v2u*)(rp + colA[bj]) = wa; *(GAS v2u*)(rp + colB[bj]) = wb; }
                } else {
                    const int col = wc * 32 + 8 * fq;
                    const f32x4 v0 = acc[ai][0][m][0], v1 = acc[ai][0][m][1];
                    if (col < 64) { v2u wa, wb; wa.x = pg8::cvt_pk_bf16(v0[0], v0[1]); wa.y = pg8::cvt_pk_bf16(v0[2], v0[3]); wb.x = pg8::cvt_pk_bf16(v1[0], v1[1]); wb.y = pg8::cvt_pk_bf16(v1[2], v1[3]);
                        *(GAS v2u*)(base + (size_t)row * 64 + colA[0]) = wa; *(GAS v2u*)(base + (size_t)row * 64 + colB[0]) = wb; }
                    else if (col < 80) { *(GAS f32x4*)(wi + (size_t)row * 16 + (col - 64)) = v0 * 0.25f; *(GAS f32x4*)(wi + (size_t)row * 16 + (col - 64) + 4) = v1 * 0.25f; }
                }
                asm volatile("" ::: "memory");
            }
    }
};

struct EpiOutProj {
    static constexpr bool PERM = true;
    bf16* mix; const float* mod;
    __device__ __forceinline__ void operator()(f32x4 (&acc)[2][2][4][2], const pg8::Unit& u, int wr, int wc, int fr, int fq) const {
        const int row0 = u.pm * 256 + wr * 64 + fr; const int b = (u.pm * 256) >> 13;
#pragma unroll
        for (int bj = 0; bj < 2; ++bj) { const int col = u.pn * 256 + bj * 128 + wc * 32 + 8 * fq;
            const f32x4 g0 = *(const GAS f32x4*)(mod + b * 6144 + 2048 + col), g1 = *(const GAS f32x4*)(mod + b * 6144 + 2048 + col + 4);
#pragma unroll
            for (int ai = 0; ai < 2; ++ai)
#pragma unroll
                for (int m = 0; m < 4; ++m) { const f32x4 v0 = acc[ai][bj][m][0] * g0, v1 = acc[ai][bj][m][1] * g1; v4u w;
                    w.x = pg8::cvt_pk_bf16(v0[0], v0[1]); w.y = pg8::cvt_pk_bf16(v0[2], v0[3]); w.z = pg8::cvt_pk_bf16(v1[0], v1[1]); w.w = pg8::cvt_pk_bf16(v1[2], v1[3]);
                    *(GAS v4u*)(mix + (size_t)(row0 + ai * 128 + m * 16) * D + col) = w; } }
    }
};

__device__ __forceinline__ float ret_log_gamma(int h) { return log1pf(-exp2f(-5.0f - (float)h)); }
__device__ __forceinline__ int crow(int r, int hi) { return (r & 3) + 8 * (r >> 2) + 4 * hi; }

typedef short v4i16_t __attribute__((ext_vector_type(4)));
constexpr size_t WS_TOT = WS_MASK;
constexpr size_t WS_CARRY = WS_MASK + 8 * MiB;
__device__ __forceinline__ void ra_states(Frame& F) {
    const bf16* KB = (const bf16*)(F.ws + WS_KB); const bf16* VB = (const bf16*)(F.ws + WS_VB);
    float* ST = (float*)(F.ws + WS_ST); float* TOT = (float*)(F.ws + WS_TOT);
    const int lane = F.lane, r32 = lane & 31, hi = lane >> 5, gi = lane & 15, gg = lane >> 4, wave = F.wave;
    const int half = wave >> 2, et = (wave >> 1) & 1, dt = wave & 1, ht = F.tid & 255;
    for (int unit = F.vcu; unit < 256; unit += F.G) {
        const int bh = unit >> 3, h = bh & 7, b = bh >> 3, c0 = (unit & 7) * 16 + half * 8;
        const float lg = ret_log_gamma(h), g = __expf(64.f * lg);
        f32x16 acc = f32x16{};
        const int offA = (((gi >> 2) + 8 * hi) * 64 + 32 * et + 16 * (gg & 1) + 4 * (gi & 3)) * 2;
        const int offB = (((gi >> 2) + 8 * hi) * 64 + 32 * dt + 16 * (gg & 1) + 4 * (gi & 3)) * 2;
        v4u nk[2], nvv[2];
#define RA_LOAD(cc) do { const size_t t0_ = (size_t)b * SEQ + (size_t)(cc) * 64; _Pragma("unroll") for (int p = 0; p < 2; ++p) { const int idx = ht + 256 * p, row = idx >> 3, q = idx & 7; \
            nk[p] = *(const GAS v4u*)(KB + (t0_ + row) * 512 + h * 64 + q * 8); nvv[p] = *(const GAS v4u*)(VB + (t0_ + row) * 512 + h * 64 + q * 8); } } while (0)
        RA_LOAD(c0);
#pragma unroll 1
        for (int i = 0; i < 8; ++i) {
            const int c = c0 + i;
            LAS unsigned short* Ks = (LAS unsigned short*)(F.lds + (half * 2 + (i & 1)) * 16384);
            LAS unsigned short* Vs = Ks + 4096;
#pragma unroll
            for (int p = 0; p < 2; ++p) { const int idx = ht + 256 * p, row = idx >> 3, q = idx & 7;
                v4u kk = nk[p]; const float z = __expf((63.f - (float)row) * lg); unsigned* kw = (unsigned*)&kk;
#pragma unroll
                for (int e = 0; e < 4; ++e) kw[e] = pg8::cvt_pk_bf16(bf2f((unsigned short)(kw[e] & 0xffff)) * z, bf2f((unsigned short)(kw[e] >> 16)) * z);
                *(LAS v4u*)(Ks + row * 64 + q * 8) = kk; *(LAS v4u*)(Vs + row * 64 + q * 8) = nvv[p]; }
            if (i < 7) RA_LOAD(c + 1);
            { float* st = ST + ((size_t)bh * 128 + c) * 4096;
#pragma unroll
                for (int r = 0; r < 16; ++r) st[(32 * et + crow(r, hi)) * 64 + 32 * dt + r32] = acc[r]; }
#pragma unroll
            for (int r = 0; r < 16; ++r) acc[r] *= g;
            __syncthreads();
#pragma unroll
            for (int ks = 0; ks < 4; ++ks) {
                const LAS unsigned char* va = (const LAS unsigned char*)Vs + offA + ks * 16 * 64 * 2; const LAS unsigned char* kb = (const LAS unsigned char*)Ks + offB + ks * 16 * 64 * 2;
                const v4i16_t a0 = __builtin_amdgcn_ds_read_tr16_b64_v4i16((LAS v4i16_t*)va), a1 = __builtin_amdgcn_ds_read_tr16_b64_v4i16((LAS v4i16_t*)(va + 4 * 64 * 2));
                const v4i16_t b0 = __builtin_amdgcn_ds_read_tr16_b64_v4i16((LAS v4i16_t*)kb), b1 = __builtin_amdgcn_ds_read_tr16_b64_v4i16((LAS v4i16_t*)(kb + 4 * 64 * 2));
                acc = __builtin_amdgcn_mfma_f32_32x32x16_bf16((bf16x8){a0[0], a0[1], a0[2], a0[3], a1[0], a1[1], a1[2], a1[3]}, (bf16x8){b0[0], b0[1], b0[2], b0[3], b1[0], b1[1], b1[2], b1[3]}, acc, 0, 0, 0); }
        }
#undef RA_LOAD
        { float* tt = TOT + ((size_t)bh * 16 + (unit & 7) * 2 + half) * 4096;
#pragma unroll
            for (int r = 0; r < 16; ++r) tt[(32 * et + crow(r, hi)) * 64 + 32 * dt + r32] = acc[r]; }
        __syncthreads();
    }
}
__device__ __forceinline__ void rb_carry(Frame& F) {
    const float* TOT = (const float*)(F.ws + WS_TOT); float* CAR = (float*)(F.ws + WS_CARRY);
    const int gt = (F.vcu * NWAVES + F.wave) * 64 + F.lane, NGT = F.G * NWAVES * 64;
    for (int i = gt; i < 32 * 4096; i += NGT) {
        const int bh = i >> 12, el = i & 4095, h = bh & 7;
        const float g8 = __expf(512.f * ret_log_gamma(h));
        const float* p = TOT + (size_t)bh * 16 * 4096 + el; float* q = CAR + (size_t)bh * 16 * 4096 + el; float run = 0.f;
#pragma unroll
        for (int gI = 0; gI < 16; ++gI) { const float t = p[(size_t)gI * 4096]; q[(size_t)gI * 4096] = run; run = run * g8 + t; }
    }
}
__device__ __forceinline__ void r3_out(Frame& F) {
    const int gw = F.vcu * NWAVES + F.wave, NGW = F.G * NWAVES;
    LAS unsigned short* Vs = (LAS unsigned short*)(F.lds + F.wave * 16384);
    const bf16* QB = (const bf16*)(F.ws + WS_QB); const bf16* KB = (const bf16*)(F.ws + WS_KB); const bf16* VB = (const bf16*)(F.ws + WS_VB); const bf16* GB = (const bf16*)(F.ws + WS_GB);
    const float* ST = (const float*)(F.ws + WS_ST); const float* CAR = (const float*)(F.ws + WS_CARRY); bf16* Y = (bf16*)(F.ws + WS_Y);
    const int lane = F.lane, r32 = lane & 31, hi = lane >> 5, gi = lane & 15, gg = lane >> 4;
    const int vtr_off = (((gi >> 2) + 4 * hi) * 64 + 16 * (gg & 1) + 4 * (gi & 3)) * 2;
    for (int u = gw; u < NB * 8 * 128; u += NGW) {
        const int c = u & 127, h = (u >> 7) & 7, b = u >> 10;
        const float lg = ret_log_gamma(h), gpc = __expf(64.f * (float)(c & 7) * lg);
        const size_t tok0 = (size_t)b * SEQ + (size_t)c * 64;
        { const GAS v4u* vp = (const GAS v4u*)(VB + (tok0 + lane) * 512 + h * 64);
#pragma unroll
            for (int q = 0; q < 8; ++q) *(LAS v4u*)(Vs + lane * 64 + q * 8) = vp[q]; }
        bf16x8 qf[2][4], pf[2][4];
#pragma unroll
        for (int t = 0; t < 2; ++t)
#pragma unroll
            for (int ks = 0; ks < 4; ++ks) {
                qf[t][ks] = *(const GAS bf16x8*)(QB + (tok0 + 32 * t + r32) * 512 + h * 64 + 16 * ks + 8 * hi);
                const float* sp = ST + (size_t)u * 4096 + (32 * t + r32) * 64 + 16 * ks + 8 * hi;
                const float* cp = CAR + ((size_t)(u >> 7) * 16 + (c >> 3)) * 4096 + (32 * t + r32) * 64 + 16 * ks + 8 * hi;
                const f32x4 s0 = *(const GAS f32x4*)sp + *(const GAS f32x4*)cp * gpc, s1 = *(const GAS f32x4*)(sp + 4) + *(const GAS f32x4*)(cp + 4) * gpc;
                v4u w; w.x = pg8::cvt_pk_bf16(s0.x, s0.y); w.y = pg8::cvt_pk_bf16(s0.z, s0.w); w.z = pg8::cvt_pk_bf16(s1.x, s1.y); w.w = pg8::cvt_pk_bf16(s1.z, s1.w);
                pf[t][ks] = __builtin_bit_cast(bf16x8, w); }
        float emr[16];
#pragma unroll
        for (int r = 0; r < 16; ++r) emr[r] = __expf(-(float)crow(r, hi) * lg);
        const float em32 = __expf(-32.f * lg);
        LDS_WAIT(); asm volatile("" ::: "memory");
#pragma unroll
        for (int nt = 0; nt < 2; ++nt) {
            const int n = 32 * nt + r32;
            const float en = __expf((float)n * lg), xi = __expf((float)(n + 1) * lg);
            f32x16 y[2]; y[0] = f32x16{}; y[1] = f32x16{};
#pragma unroll
            for (int et = 0; et < 2; ++et)
#pragma unroll
                for (int ks = 0; ks < 4; ++ks) y[et] = __builtin_amdgcn_mfma_f32_32x32x16_bf16(pf[et][ks], qf[nt][ks], y[et], 0, 0, 0);
#pragma unroll
            for (int r = 0; r < 16; ++r) { y[0][r] *= xi; y[1][r] *= xi; }
#pragma unroll
            for (int mt = 0; mt <= nt; ++mt) {
                f32x16 st = f32x16{};
#pragma unroll
                for (int ks = 0; ks < 4; ++ks) { const bf16x8 kf = *(const GAS bf16x8*)(KB + (tok0 + 32 * mt + r32) * 512 + h * 64 + 16 * ks + 8 * hi);
                    st = __builtin_amdgcn_mfma_f32_32x32x16_bf16(kf, qf[nt][ks], st, 0, 0, 0); }
                const float enm = mt ? en * em32 : en;
#pragma unroll
                for (int r = 0; r < 16; ++r) { const int m = 32 * mt + crow(r, hi); st[r] = (n >= m) ? st[r] * (enm * emr[r]) : 0.f; }
#pragma unroll
                for (int s2 = 0; s2 < 2; ++s2) {
                    v4u pw; pw.x = pg8::cvt_pk_bf16(st[8 * s2 + 0], st[8 * s2 + 1]); pw.y = pg8::cvt_pk_bf16(st[8 * s2 + 2], st[8 * s2 + 3]); pw.z = pg8::cvt_pk_bf16(st[8 * s2 + 4], st[8 * s2 + 5]); pw.w = pg8::cvt_pk_bf16(st[8 * s2 + 6], st[8 * s2 + 7]);
                    const bf16x8 pb = __builtin_bit_cast(bf16x8, pw);
#pragma unroll
                    for (int et = 0; et < 2; ++et) {
                        const LAS unsigned char* vb = (const LAS unsigned char*)Vs + vtr_off + ((32 * mt + 16 * s2) * 64 + 32 * et) * 2;
                        const v4i16_t lo = __builtin_amdgcn_ds_read_tr16_b64_v4i16((LAS v4i16_t*)vb), hh = __builtin_amdgcn_ds_read_tr16_b64_v4i16((LAS v4i16_t*)(vb + 8 * 64 * 2));
                        const bf16x8 va = (bf16x8){lo[0], lo[1], lo[2], lo[3], hh[0], hh[1], hh[2], hh[3]};
                        y[et] = __builtin_amdgcn_mfma_f32_32x32x16_bf16(va, pb, y[et], 0, 0, 0); }
                }
            }
            float sm = 0.f;
#pragma unroll
            for (int r = 0; r < 16; ++r) sm += y[0][r] + y[1][r];
            sm += __shfl_xor(sm, 32);
            const float mu = sm * (1.f / 64.f); float q = 0.f;
#pragma unroll
            for (int r = 0; r < 16; ++r) { y[0][r] -= mu; y[1][r] -= mu; q += y[0][r] * y[0][r] + y[1][r] * y[1][r]; }
            q += __shfl_xor(q, 32);
            const float rs = __builtin_amdgcn_rsqf(q * (1.f / 64.f) + EPS);
            const size_t tok = tok0 + n;
#pragma unroll
            for (int et = 0; et < 2; ++et)
#pragma unroll
                for (int g4 = 0; g4 < 4; ++g4) { const int e0 = 32 * et + 8 * g4 + 4 * hi;
                    const v2u gv = *(const GAS v2u*)(GB + tok * 512 + h * 64 + e0);
                    float o4[4];
#pragma unroll
                    for (int i = 0; i < 4; ++i) { const float g = bf2f((unsigned short)((i & 1) ? ((i & 2) ? gv.y : gv.x) >> 16 : ((i & 2) ? gv.y : gv.x) & 0xffff));
                        const float sg = g * __builtin_amdgcn_rcpf(1.f + __expf(-g)); o4[i] = sg * y[et][4 * g4 + i] * rs; }
                    v2u ov; ov.x = pg8::cvt_pk_bf16(o4[0], o4[1]); ov.y = pg8::cvt_pk_bf16(o4[2], o4[3]);
                    *(GAS v2u*)(Y + tok * D + 512 + h * 64 + e0) = ov; }
        }
        LDS_WAIT(); asm volatile("" ::: "memory");
    }
}

__device__ __forceinline__ void p_norm2_route(Frame& F) {
    const float* mod = (const float*)(F.ws + WS_MOD);
    LAS f32x4* RG = (LAS f32x4*)F.lds;
    LAS f32x4* RE = (LAS f32x4*)(F.lds + 16384);
    { const float* wrg = F.w_rg(); const float* wre = F.w_re();
        for (int i = F.tid; i < 1024; i += NWAVES * 64) { const int ln = (i & 255) >> 2, j = i >> 8, t = i & 3; RG[(j * 4 + t) * 64 + ln] = *(const GAS f32x4*)(wrg + (size_t)i * 4); }
        for (int i = F.tid; i < 4 * 1024 * 2; i += NWAVES * 64) { const int g = i >> 11, row = (i >> 1) & 1023, hf = i & 1, ln = (row & 255) >> 2, j = row >> 8, t = row & 3;
            RE[g * 2048 + ((j * 4 + t) * 2 + hf) * 64 + ln] = *(const GAS f32x4*)(wre + ((size_t)g * 1024 + row) * 8 + hf * 4); } }
    constexpr int RT_CAP = 300;
    LAS unsigned* RC = (LAS unsigned*)(F.lds + 147456);
    LAS unsigned* REC = RC + 65;
    static_assert(147456 + (65 + 3 * RT_CAP) * 4 <= RING_BYTES + AUX_BYTES, "router LDS map");
    for (int i = F.tid; i < 65; i += NWAVES * 64) RC[i] = 0u;
    __syncthreads();
    const int gw = F.vcu * NWAVES + F.wave, NGW = F.G * NWAVES;
    const float* X = F.x(); const bf16* MIX = (const bf16*)(F.ws + WS_MIX); bf16* H2 = (bf16*)(F.ws + WS_H2);
    unsigned* ltok = (unsigned*)(F.ws + WS_ROUTE); float* lw = (float*)(F.ws + WS_ROUTE + 4 * MiB);
    f32x4 nv[4]; v2u nm[4];
#define N2_LOAD(mm) do { const GAS f32x4* xr = (const GAS f32x4*)(X + (size_t)(mm) * D) + F.lane; \
        _Pragma("unroll") for (int j = 0; j < 4; ++j) { nv[j] = xr[64 * j]; nm[j] = *(const GAS v2u*)(MIX + (size_t)(mm) * D + 4 * F.lane + 256 * j); } } while (0)
    if (gw < M) N2_LOAD(gw);
    for (int m = gw; m < M; m += NGW) {
        const int b = m >> 13;
        f32x4 v[4]; float s = 0.f;
#pragma unroll
        for (int j = 0; j < 4; ++j) { v[j] = nv[j]; v[j].x += bf2f((unsigned short)(nm[j].x & 0xffff)); v[j].y += bf2f((unsigned short)(nm[j].x >> 16)); v[j].z += bf2f((unsigned short)(nm[j].y & 0xffff)); v[j].w += bf2f((unsigned short)(nm[j].y >> 16)); }
        if (m + NGW < M) N2_LOAD(m + NGW);
#pragma unroll
        for (int j = 0; j < 4; ++j) s += (v[j].x * v[j].x + v[j].y * v[j].y) + (v[j].z * v[j].z + v[j].w * v[j].w);
        const float r = 1.f / sqrtf(wave_sum(s) * (1.f / D) + EPS);
        GAS unsigned long long* o8 = (GAS unsigned long long*)(H2 + (size_t)m * D) + F.lane;
        f32x4 lg = {0.f, 0.f, 0.f, 0.f};
#pragma unroll
        for (int j = 0; j < 4; ++j) { const int col = 4 * F.lane + 256 * j;
            const f32x4 g = *(const GAS f32x4*)(F.g_ffn() + col) * (*(const GAS f32x4*)(mod + b * 6144 + 4096 + col) + 1.f), sh = *(const GAS f32x4*)(mod + b * 6144 + 3072 + col);
            v[j] = v[j] * r * g + sh;
            o8[64 * j] = (unsigned long long)pk2(v[j].x, v[j].y) | ((unsigned long long)pk2(v[j].z, v[j].w) << 32);
            const LAS f32x4* wg = RG + (j * 4) * 64 + F.lane;
            lg += wg[0] * v[j].x; lg += wg[64] * v[j].y; lg += wg[128] * v[j].z; lg += wg[192] * v[j].w; }
        lg.x = wave_sum(lg.x); lg.y = wave_sum(lg.y); lg.z = wave_sum(lg.z); lg.w = wave_sum(lg.w);
        int grp = 0; float mx = lg.x;
        if (lg.y > mx) { mx = lg.y; grp = 1; } if (lg.z > mx) { mx = lg.z; grp = 2; } if (lg.w > mx) { mx = lg.w; grp = 3; }
        const float pgrp = 1.f / (expf(lg.x - mx) + expf(lg.y - mx) + expf(lg.z - mx) + expf(lg.w - mx));
        f32x4 f0 = {0.f, 0.f, 0.f, 0.f}, f1 = f0;
        const LAS f32x4* reg = RE + grp * 2048 + F.lane;
#pragma unroll
        for (int j = 0; j < 4; ++j) { const LAS f32x4* we = reg + (j * 8) * 64;
            f0 += we[0] * v[j].x; f1 += we[64] * v[j].x; f0 += we[128] * v[j].y; f1 += we[192] * v[j].y; f0 += we[256] * v[j].z; f1 += we[320] * v[j].z; f0 += we[384] * v[j].w; f1 += we[448] * v[j].w; }
        float fe[8];
        fe[0] = wave_sum(f0.x); fe[1] = wave_sum(f0.y); fe[2] = wave_sum(f0.z); fe[3] = wave_sum(f0.w); fe[4] = wave_sum(f1.x); fe[5] = wave_sum(f1.y); fe[6] = wave_sum(f1.z); fe[7] = wave_sum(f1.w);
        int i1 = 0; float m1 = fe[0];
#pragma unroll
        for (int e = 1; e < 8; ++e) if (fe[e] > m1) { m1 = fe[e]; i1 = e; }
        int i2 = -1; float m2 = -INFINITY;
#pragma unroll
        for (int e = 0; e < 8; ++e) if (e != i1 && fe[e] > m2) { m2 = fe[e]; i2 = e; }
        const float e2 = expf(m2 - m1); const float w1 = pgrp / (1.f + e2), w2 = pgrp * e2 / (1.f + e2);
        if (F.lane < 2) { const int e = grp * 8 + (F.lane ? i2 : i1); const float w = F.lane ? w2 : w1;
            const unsigned slot = __hip_atomic_fetch_add(RC + 64, 1u, __ATOMIC_RELAXED, __HIP_MEMORY_SCOPE_WORKGROUP);
            if (slot < (unsigned)RT_CAP) { const unsigned lp = __hip_atomic_fetch_add(RC + e, 1u, __ATOMIC_RELAXED, __HIP_MEMORY_SCOPE_WORKGROUP);
                REC[slot] = ((unsigned)e << 16) | lp; REC[RT_CAP + slot] = (unsigned)m | ((unsigned)F.lane << 31); REC[2 * RT_CAP + slot] = __float_as_uint(w); }
            else { const unsigned p = __hip_atomic_fetch_add((unsigned*)(F.ctl + CW_ECNT + 64 * e), 1u, RLX_AGENT);
                ltok[(size_t)e * M + p] = (unsigned)m | ((unsigned)F.lane << 31); lw[(size_t)e * M + p] = w; } }
    }
    __syncthreads();
    if (F.tid < NEXP) { const unsigned c = RC[F.tid]; RC[32 + F.tid] = c ? __hip_atomic_fetch_add((unsigned*)(F.ctl + CW_ECNT + 64 * F.tid), c, RLX_AGENT) : 0u; }
    __syncthreads();
    { const unsigned nrec = RC[64] < (unsigned)RT_CAP ? RC[64] : (unsigned)RT_CAP;
        for (unsigned r = F.tid; r < nrec; r += NWAVES * 64) { const unsigned ep = REC[r], e = ep >> 16, p = RC[32 + e] + (ep & 0xffffu);
            ltok[(size_t)e * M + p] = REC[RT_CAP + r]; lw[(size_t)e * M + p] = __uint_as_float(REC[2 * RT_CAP + r]); } }
    __syncthreads();
}
__device__ __forceinline__ void p_expert_convert(Frame& F, int part, int nparts) {
    const int gw = F.vcu * NWAVES + F.wave, NGW = F.G * NWAVES;
    int ln = F.lane; asm volatile("" : "+v"(ln));
    LAS unsigned* T = (LAS unsigned*)(F.lds + F.wave * 16384);
    bf16* wgu = (bf16*)(F.ws + WS_WGU); bf16* wd = (bf16*)(F.ws + WS_WD);
    constexpr int I_GU = NEXP * 16 * 16, I_D = NEXP * 16 * 8;
    int k = 0;
    for (int it = gw; it < I_GU + I_D; it += NGW, ++k) {
        if (k % nparts != part) continue;
        if (it < I_GU) { const int e = it >> 8, r = it & 255, nt = r >> 4, kt = r & 15;
            tr_tile_gu(F.w_gate() + (size_t)e * D * DEXP, F.w_up() + (size_t)e * D * DEXP, wgu + (size_t)e * 1024 * 1024, nt * 64, kt * 64, T, ln); }
        else { const int q = it - I_GU, e = q >> 7, r = q & 127, nt = r >> 3, kt = r & 7;
            tr_tile_d(F.w_down() + (size_t)e * DEXP * D, wd + (size_t)e * 1024 * 512, nt * 64, kt * 64, T, ln); }
    }
}

constexpr int MOE_MAXU = 5;
struct MoeSched {
    int G, c, nunits; LAS int* blkstart; LAS unsigned* tok; bool gather;
    __device__ __forceinline__ bool next(int i, pg8::Unit& u) const {
        const int L = i * G + c; if (L >= nunits || i >= MOE_MAXU) return false;
        const int blk = L >> 2, pnl = L & 3; int e = 0;
#pragma unroll 1
        for (int k = 1; k < NEXP; ++k) if (blkstart[k] <= blk) e = k;
        u.pm = i | (blk << 8); u.pn = e * 4 + pnl; return true;
    }
    __device__ __forceinline__ int arow(const pg8::Unit& u, int rt) const {
        if (gather) { const unsigned t = tok[(u.pm & 255) * 256 + rt]; return (int)(t == 0xffffffffu ? 0u : (t & 0x7fffffffu)); }
        return (u.pm >> 8) * 256 + rt;
    }
    __device__ __forceinline__ int brow0(const pg8::Unit& u) const { return u.pn * 256; }
};
__device__ __forceinline__ int moe_tables(Frame& F, LAS int* blkstart, LAS unsigned* tok, LAS float* wts) {
    if (F.tid == 0) { int acc = 0; for (int e = 0; e < NEXP; ++e) { blkstart[e] = acc; const unsigned cnt = __hip_atomic_load((unsigned*)(F.ctl + CW_ECNT + 64 * e), RLX_AGENT); acc += (int)((cnt + 255u) >> 8); } blkstart[NEXP] = acc; }
    __syncthreads();
    const int nunits = blkstart[NEXP] * 4;
    const unsigned* ltok = (const unsigned*)(F.ws + WS_ROUTE); const float* lw = (const float*)(F.ws + WS_ROUTE + 4 * MiB);
    for (int i = 0; i < MOE_MAXU; ++i) { const int L = i * F.G + F.vcu; if (L >= nunits) break;
        const int blk = L >> 2; int e = 0;
        for (int k = 1; k < NEXP; ++k) if (blkstart[k] <= blk) e = k;
        const unsigned cnt = __hip_atomic_load((unsigned*)(F.ctl + CW_ECNT + 64 * e), RLX_AGENT);
        for (int r = F.tid; r < 256; r += NWAVES * 64) { const unsigned p = (unsigned)(blk - blkstart[e]) * 256u + (unsigned)r;
            tok[i * 256 + r] = p < cnt ? ltok[(size_t)e * M + p] : 0xffffffffu; wts[i * 256 + r] = p < cnt ? lw[(size_t)e * M + p] : 0.f; } }
    __syncthreads();
    return nunits;
}
struct EpiMoe1 {
    static constexpr bool PERM = true;
    bf16* act;
    __device__ __forceinline__ void operator()(f32x4 (&acc)[2][2][4][2], const pg8::Unit& u, int wr, int wc, int fr, int fq) const {
        const int blk = u.pm >> 8, pnl = u.pn & 3; const int row0 = blk * 256 + wr * 64 + fr;
#pragma unroll
        for (int bj = 0; bj < 2; ++bj) { const int ac = pnl * 128 + (bj * 128 + wc * 32 + 8 * fq) / 2;
#pragma unroll
            for (int ai = 0; ai < 2; ++ai)
#pragma unroll
                for (int m = 0; m < 4; ++m) { const f32x4 v0 = acc[ai][bj][m][0], v1 = acc[ai][bj][m][1];
                    const float a0 = v0[0] / (1.f + __expf(-v0[0])) * v0[1], a1 = v0[2] / (1.f + __expf(-v0[2])) * v0[3];
                    const float a2 = v1[0] / (1.f + __expf(-v1[0])) * v1[1], a3 = v1[2] / (1.f + __expf(-v1[2])) * v1[3];
                    v2u w; w.x = pg8::cvt_pk_bf16(a0, a1); w.y = pg8::cvt_pk_bf16(a2, a3);
                    *(GAS v2u*)(act + (size_t)(row0 + ai * 128 + m * 16) * DEXP + ac) = w; } }
    }
};
struct EpiMoe2 {
    static constexpr bool PERM = true;
    bf16* c0; bf16* c1; LAS unsigned* tok; LAS float* wts;
    __device__ __forceinline__ void operator()(f32x4 (&acc)[2][2][4][2], const pg8::Unit& u, int wr, int wc, int fr, int fq) const {
        const int li = u.pm & 255, pnl = u.pn & 3;
#pragma unroll
        for (int ai = 0; ai < 2; ++ai)
#pragma unroll
            for (int m = 0; m < 4; ++m) { const int rt = ai * 128 + wr * 64 + m * 16 + fr; const unsigned en = tok[li * 256 + rt]; const float w = wts[li * 256 + rt];
                if (en != 0xffffffffu) { bf16* dst = ((en >> 31) ? c1 : c0) + (size_t)(en & 0x7fffffffu) * D + pnl * 256 + wc * 32 + 8 * fq;
#pragma unroll
                    for (int bj = 0; bj < 2; ++bj) { const f32x4 v0 = acc[ai][bj][m][0] * w, v1 = acc[ai][bj][m][1] * w; v4u o;
                        o.x = pg8::cvt_pk_bf16(v0[0], v0[1]); o.y = pg8::cvt_pk_bf16(v0[2], v0[3]); o.z = pg8::cvt_pk_bf16(v1[0], v1[1]); o.w = pg8::cvt_pk_bf16(v1[2], v1[3]);
                        *(GAS v4u*)(dst + bj * 128) = o; } } }
    }
};

typedef _Float16 h16x2 __attribute__((ext_vector_type(2)));
__device__ __forceinline__ unsigned pk_f16_rtz(float a, float b) { return __builtin_bit_cast(unsigned, __builtin_amdgcn_cvt_pkrtz(a, b)); }
__device__ __forceinline__ unsigned sortable16x2(unsigned x) { const unsigned m = ((x >> 15) & 0x00010001u) * 0xFFFFu; return x ^ (m | 0x80008000u); }
constexpr int IDX_HS = 257;
constexpr int IDX_WT_OFF = 68 * 1024, IDX_RH_OFF = 72 * 1024, IDX_P2_OFF = IDX_RH_OFF + 32 * IDX_HS * 4, IDX_P2_BYTES = 4480;
static_assert(IDX_P2_OFF + 8 * IDX_P2_BYTES <= RING_BYTES + AUX_BYTES, "indexer LDS map");
template <int NC>
__device__ __forceinline__ void hist_find(LAS unsigned* H, int lane, unsigned K, unsigned& bsel, unsigned& above, unsigned& atb) {
    unsigned t[4];
#pragma unroll
    for (int q = 0; q < 4; ++q) { unsigned a = 0;
#pragma unroll
        for (int c = 0; c < NC; ++c) a += H[c * IDX_HS + 4 * lane + q];
        t[q] = a; }
    const unsigned ls = (t[0] + t[1]) + (t[2] + t[3]);
    unsigned suf = ls;
#pragma unroll
    for (int o = 1; o < 64; o <<= 1) { const unsigned v = __shfl_down(suf, o); if (lane + o < 64) suf += v; }
    unsigned ab = suf - ls; bool found = false; unsigned fb = 0, fa = 0, ft = 0;
#pragma unroll
    for (int q = 3; q >= 0; --q) { if (!found && ab < K && ab + t[q] >= K) { found = true; fb = 4 * lane + q; fa = ab; ft = t[q]; } ab += t[q]; }
    const unsigned long long bal = __ballot(found);
    const int src = bal ? (int)__builtin_ctzll(bal) : 0;
    bsel = __shfl(fb, src); above = __shfl(fa, src); atb = __shfl(ft, src);
}
__device__ __forceinline__ void sel_load(v4u (&ch)[16], const unsigned short* srow, int n, int lane) {
    const int nchunks = n >> 3;
#pragma unroll
    for (int j = 0; j < 16; ++j) { const int c = lane + 64 * j;
        unsigned off = (unsigned)c * 16u; asm volatile("" : "+v"(off));
        if (c < nchunks) ch[j] = *(const GAS v4u*)((const char*)srow + off); else ch[j] = (v4u){0u, 0u, 0u, 0u}; }
}
__device__ __forceinline__ unsigned pk_max_u16(unsigned a, unsigned b) { unsigned r; asm("v_pk_max_u16 %0, %1, %2" : "=v"(r) : "v"(a), "v"(b)); return r; }
__device__ __forceinline__ unsigned pk_min_u16(unsigned a, unsigned b) { unsigned r; asm("v_pk_min_u16 %0, %1, %2" : "=v"(r) : "v"(a), "v"(b)); return r; }
__device__ __forceinline__ void sel_compute(const v4u (&ch)[16], const unsigned short* srow, int n, unsigned char* mrow, LAS unsigned* RH, LAS unsigned* P2, int lane) {
    const int nchunks = n >> 3;
    if (n <= 256) {
#pragma unroll 1
        for (int j = 0; j < 16; ++j) { const int c = lane + 64 * j; mrow[c] = (c < nchunks) ? (unsigned char)0xFF : (unsigned char)0; }
        return;
    }
    unsigned b1, above1, at1; hist_find<1>(RH, lane, 256u, b1, above1, at1);
    for (int i = lane; i < 4 * IDX_HS; i += 64) P2[i] = 0u;
    LAS unsigned* hb = P2 + (lane & 3) * IDX_HS;
    unsigned pat = (b1 << 8) | (b1 << 24), c256 = 0x01000100u, c1 = 0x00010001u;
    asm volatile("" : "+v"(pat), "+v"(c256), "+v"(c1));
#pragma unroll
    for (int j = 0; j < 16; ++j) { if (64 * j < nchunks) {
#pragma unroll
        for (int i = 0; i < 4; ++i) { const unsigned w = ch[j][i]; const unsigned m = pk_min_u16(w ^ pat, c256);
            __hip_atomic_fetch_add(hb + (w & 0xffu), ((m >> 8) & 1u) ^ 1u, __ATOMIC_RELAXED, __HIP_MEMORY_SCOPE_WORKGROUP);
            __hip_atomic_fetch_add(hb + ((w >> 16) & 0xffu), (m >> 24) ^ 1u, __ATOMIC_RELAXED, __HIP_MEMORY_SCOPE_WORKGROUP); } } __builtin_amdgcn_sched_barrier(0); }
    unsigned b2, above2, teq; hist_find<4>(P2, lane, 256u - above1, b2, above2, teq);
    const unsigned tau = (b1 << 8) | b2; const unsigned r = 256u - above1 - above2;
    if (r >= teq) {
        unsigned tt = tau | (tau << 16); asm volatile("" : "+v"(tt));
#pragma unroll
        for (int j = 0; j < 16; ++j) { const int c = lane + 64 * j; unsigned acc = 0u;
#pragma unroll
            for (int i = 0; i < 4; ++i) { const unsigned w = ch[j][i]; const unsigned ns = pk_min_u16(pk_max_u16(w, tt) ^ w, c1);
                acc |= ns << (2 * i); }
            const unsigned bits = ~(acc | (acc >> 15)) & 0xffu;
            { unsigned off = (unsigned)c; asm volatile("" : "+v"(off)); mrow[off] = (unsigned char)bits; } __builtin_amdgcn_sched_barrier(0); }
    } else {
        unsigned running = 0u;
#pragma unroll 1
        for (int j = 0; j < 16; ++j) { const int c = lane + 64 * j;
            v4u x = {0u, 0u, 0u, 0u};
            if (c < nchunks) x = *(const GAS v4u*)(srow + (size_t)c * 8);
            unsigned gt = 0u, eq = 0u;
#pragma unroll
            for (int i = 0; i < 4; ++i) { const unsigned w = x[i], k0 = w & 0xffffu, k1 = w >> 16;
                gt |= (k0 > tau ? 1u : 0u) << (2 * i); gt |= (k1 > tau ? 1u : 0u) << (2 * i + 1); eq |= (k0 == tau ? 1u : 0u) << (2 * i); eq |= (k1 == tau ? 1u : 0u) << (2 * i + 1); }
            const unsigned tc = (unsigned)__builtin_popcount(eq); unsigned inc = tc;
#pragma unroll
            for (int o = 1; o < 64; o <<= 1) { const unsigned v = __shfl_up(inc, o); if (lane >= o) inc += v; }
            const unsigned base = running + inc - tc;
            int take = (int)r - (int)base; take = take < 0 ? 0 : (take > 8 ? 8 : take);
            unsigned e2 = eq, kept = 0u;
#pragma unroll
            for (int t = 0; t < 8; ++t) { const unsigned low = e2 & (0u - e2); if (t < take) kept |= low; e2 &= e2 - 1u; }
            running += __shfl(inc, 63);
            mrow[c] = (unsigned char)(gt | kept); }
    }
}
__device__ __forceinline__ void p_indexer(Frame& F) {
    const bf16* QI = (const bf16*)(F.ws + WS_QI); const bf16* KI = (const bf16*)(F.ws + WS_KI); const float* WI = (const float*)(F.ws + WS_WI);
    unsigned short* scr = (unsigned short*)(F.ws + WS_SCR) + (size_t)blockIdx.x * 32 * 8192;
    unsigned char* MASK = (unsigned char*)(F.ws + WS_MASK);
    const int tid = F.tid, lane = F.lane, wave = F.wave, r32 = lane & 31, hi = lane >> 5;
    LAS unsigned char* lds = F.lds;
    const int b = F.vcu >> 6, wq = F.vcu & 63;
#pragma unroll 1
    for (int ui = 0; ui < 4; ++ui) {
        const int qb32 = (ui == 0) ? wq : (ui == 1) ? 127 - wq : (ui == 2) ? 128 + wq : 255 - wq;
        const int n = 64 * ((qb32 >> 1) + 1), ntiles = n >> 5;
        const size_t tokb = (size_t)b * SEQ, tok0 = tokb + (size_t)qb32 * 32;
#pragma unroll
        for (int i = 0; i < 8; ++i) { const int f = wave + 8 * i, hh = f >> 2, ks = f & 3;
            const v4u v = *(const GAS v4u*)(QI + (tok0 + r32) * 1024 + hh * 64 + 16 * ks + 8 * hi); *(LAS v4u*)(lds + f * 1024 + lane * 16) = v; }
        { LAS float* wt = (LAS float*)(lds + IDX_WT_OFF);
            const int q = tid & 31, hh = tid >> 5; wt[hh * 32 + q] = WI[(tok0 + q) * 16 + hh] * 0.125f;
            LAS unsigned* rh = (LAS unsigned*)(lds + IDX_RH_OFF); for (int i = tid; i < 32 * IDX_HS; i += NWAVES * 64) rh[i] = 0u; }
        { const int q = tid & 31, dg = tid >> 5; f32x4 a = {0.f, 0.f, 0.f, 0.f};
#pragma unroll
            for (int hh = 0; hh < 16; ++hh) { const float wv = WI[(tok0 + q) * 16 + hh] * 0.125f; const v2u qv = *(const GAS v2u*)(QI + (tok0 + q) * 1024 + hh * 64 + 4 * dg);
                a.x += wv * bf2f((unsigned short)(qv.x & 0xffff)); a.y += wv * bf2f((unsigned short)(qv.x >> 16)); a.z += wv * bf2f((unsigned short)(qv.y & 0xffff)); a.w += wv * bf2f((unsigned short)(qv.y >> 16)); }
            v2u o; o.x = pk2(a.x, a.y); o.y = pk2(a.z, a.w);
            *(LAS v2u*)(lds + (64 + (dg >> 2)) * 1024 + (q + 32 * ((dg >> 1) & 1)) * 16 + (dg & 1) * 8) = o; }
        __syncthreads();
        LAS unsigned* hrow = (LAS unsigned*)(lds + IDX_RH_OFF) + r32 * IDX_HS;
        bf16x8 kf[2][4];
#define IDX_KLOAD(TT) do { _Pragma("unroll") for (int j = 0; j < 2; ++j) { const int T = ((TT) + j < ntiles) ? (TT) + j : ntiles - 1; \
            _Pragma("unroll") for (int ks = 0; ks < 4; ++ks) kf[j][ks] = *(const GAS bf16x8*)(KI + (tokb + (size_t)T * 32 + r32) * 64 + 16 * ks + 8 * hi); } } while (0)
#define IDX_FMA4(S, P, B, W) do { asm volatile("v_fma_f32 %0, |%4|, %8, %0\n\tv_fma_f32 %1, |%5|, %8, %1\n\tv_fma_f32 %2, |%6|, %8, %2\n\tv_fma_f32 %3, |%7|, %8, %3" \
                : "+v"(S[B]), "+v"(S[B + 1]), "+v"(S[B + 2]), "+v"(S[B + 3]) : "v"(P[B]), "v"(P[B + 1]), "v"(P[B + 2]), "v"(P[B + 3]), "v"(W)); __builtin_amdgcn_sched_barrier(0); } while (0)
#define IDX_QF(base, ks) (*(const LAS bf16x8*)((base) + (ks) * 1024))
#define IDX_MF(N, K, Q, C) N = __builtin_amdgcn_mfma_f32_32x32x16_bf16(K, Q, C, 0, 0, 0); __builtin_amdgcn_sched_barrier(0)
#define IDX_PSTEP(N0, N1, P0, P1, W, CUR, NXT) do { \
                IDX_MF(N0, kf[0][0], qa, f32x16{}); IDX_FMA4(sc[0], P0, 0, W); \
                IDX_MF(N1, kf[1][0], qa, f32x16{}); IDX_FMA4(sc[0], P0, 4, W); qa = IDX_QF(CUR, 2); \
                IDX_MF(N0, kf[0][1], qb, N0); IDX_FMA4(sc[0], P0, 8, W); \
                IDX_MF(N1, kf[1][1], qb, N1); IDX_FMA4(sc[0], P0, 12, W); qb = IDX_QF(CUR, 3); \
                IDX_MF(N0, kf[0][2], qa, N0); IDX_FMA4(sc[1], P1, 0, W); \
                IDX_MF(N1, kf[1][2], qa, N1); IDX_FMA4(sc[1], P1, 4, W); qa = IDX_QF(NXT, 0); \
                IDX_MF(N0, kf[0][3], qb, N0); IDX_FMA4(sc[1], P1, 8, W); \
                IDX_MF(N1, kf[1][3], qb, N1); IDX_FMA4(sc[1], P1, 12, W); qb = IDX_QF(NXT, 1); } while (0)
        if (wave * 2 < ntiles) IDX_KLOAD(wave * 2);
#pragma unroll 1
        for (int T0 = wave * 2; T0 < ntiles; T0 += 16) {
            f32x16 sc[2];
            sc[0] = f32x16{}; sc[1] = f32x16{};
#pragma unroll
            for (int ks = 0; ks < 4; ++ks) { const bf16x8 qf = *(const LAS bf16x8*)(lds + (64 + ks) * 1024 + lane * 16);
                sc[0] = __builtin_amdgcn_mfma_f32_32x32x16_bf16(kf[0][ks], qf, sc[0], 0, 0, 0); sc[1] = __builtin_amdgcn_mfma_f32_32x32x16_bf16(kf[1][ks], qf, sc[1], 0, 0, 0); }
            {
                f32x16 dA0 = f32x16{}, dA1 = f32x16{}, dB0 = f32x16{}, dB1 = f32x16{};
                float wprev = 0.f;
                const LAS unsigned char* qbase = lds + lane * 16;
                const LAS unsigned char* wbase = lds + IDX_WT_OFF + r32 * 4;
                bf16x8 qa = IDX_QF(qbase, 0), qb = IDX_QF(qbase, 1);
#pragma unroll 1
                for (int hh = 0; hh < 16; hh += 2) {
                    const float wh0 = *(const LAS float*)(wbase + hh * 128), wh1 = *(const LAS float*)(wbase + hh * 128 + 128);
                    IDX_PSTEP(dA0, dA1, dB0, dB1, wprev, qbase, qbase + 4096);
                    IDX_PSTEP(dB0, dB1, dA0, dA1, wh0, qbase + 4096, qbase + 8192);
                    wprev = wh1; qbase += 8192;
                }
                asm volatile("s_nop 15\n\ts_nop 7" ::: "memory");
#pragma unroll
                for (int r = 0; r < 16; r += 4) { IDX_FMA4(sc[0], dB0, r, wprev); }
#pragma unroll
                for (int r = 0; r < 16; r += 4) { IDX_FMA4(sc[1], dB1, r, wprev); }
            }
            if (T0 + 16 < ntiles) IDX_KLOAD(T0 + 16);
#pragma unroll
            for (int j = 0; j < 2; ++j) { if (T0 + j < ntiles) { unsigned short* dst = scr + (size_t)r32 * 8192 + (size_t)(T0 + j) * 32 + 4 * hi;
#pragma unroll
                for (int g = 0; g < 4; ++g) { v2u o; o.x = sortable16x2(pk_f16_rtz(sc[j][4 * g], sc[j][4 * g + 1])); o.y = sortable16x2(pk_f16_rtz(sc[j][4 * g + 2], sc[j][4 * g + 3])); *(GAS v2u*)(dst + 8 * g) = o;
                    __hip_atomic_fetch_add(hrow + ((o.x >> 8) & 255u), 1u, __ATOMIC_RELAXED, __HIP_MEMORY_SCOPE_WORKGROUP); __hip_atomic_fetch_add(hrow + (o.x >> 24), 1u, __ATOMIC_RELAXED, __HIP_MEMORY_SCOPE_WORKGROUP);
                    __hip_atomic_fetch_add(hrow + ((o.y >> 8) & 255u), 1u, __ATOMIC_RELAXED, __HIP_MEMORY_SCOPE_WORKGROUP); __hip_atomic_fetch_add(hrow + (o.y >> 24), 1u, __ATOMIC_RELAXED, __HIP_MEMORY_SCOPE_WORKGROUP); } } }
        }
#undef IDX_QF
#undef IDX_MF
#undef IDX_PSTEP
#undef IDX_FMA4
        VM_WAIT(); __syncthreads();
        __builtin_amdgcn_fence(__ATOMIC_ACQUIRE, "workgroup");
        { LAS unsigned* P2 = (LAS unsigned*)(lds + IDX_P2_OFF + wave * IDX_P2_BYTES); LAS unsigned* RH = (LAS unsigned*)(lds + IDX_RH_OFF) + wave * 4 * IDX_HS;
            const unsigned short* sr = scr + (size_t)wave * 4 * 8192; unsigned char* mr = MASK + (tok0 + wave * 4) * 1024;
#pragma unroll 1
            for (int rp3 = 0; rp3 < SUBREPS(16); ++rp3) {
            { int ls = lane; asm volatile("" : "+v"(ls));
                v4u chA[16], chB[16];
                sel_load(chA, sr, n, ls); sel_load(chB, sr + 8192, n, ls);
                sel_compute(chA, sr, n, mr, RH, P2, ls);
                sel_load(chA, sr + 2 * 8192, n, ls);
                sel_compute(chB, sr + 8192, n, mr + 1024, RH + IDX_HS, P2, ls);
                sel_load(chB, sr + 3 * 8192, n, ls);
                sel_compute(chA, sr + 2 * 8192, n, mr + 2 * 1024, RH + 2 * IDX_HS, P2, ls);
                sel_compute(chB, sr + 3 * 8192, n, mr + 3 * 1024, RH + 3 * IDX_HS, P2, ls); } } }
        __syncthreads();
    }
}

template <bool WITH_MOE>
__device__ __forceinline__ void p_final(Frame& F) {
    const int gw = F.vcu * NWAVES + F.wave, NGW = F.G * NWAVES;
    const float* X = F.x(); const bf16* MIX = (const bf16*)(F.ws + WS_MIX); const float* mod = (const float*)(F.ws + WS_MOD);
    const bf16* C0 = (const bf16*)(F.ws + WS_C0); const bf16* C1 = (const bf16*)(F.ws + WS_C1);
    f32x4 nv[4]; v2u nm[4], na[4], nc[4];
#define FIN_LOAD(mm) do { const GAS f32x4* xr = (const GAS f32x4*)(X + (size_t)(mm) * D) + F.lane; \
        _Pragma("unroll") for (int j = 0; j < 4; ++j) { nv[j] = xr[64 * j]; nm[j] = *(const GAS v2u*)(MIX + (size_t)(mm) * D + 4 * F.lane + 256 * j); if (WITH_MOE) { const int col = 4 * F.lane + 256 * j; na[j] = *(const GAS v2u*)(C0 + (size_t)(mm) * D + col); nc[j] = *(const GAS v2u*)(C1 + (size_t)(mm) * D + col); } } } while (0)
    if (gw < M) FIN_LOAD(gw);
    for (int m = gw; m < M; m += NGW) {
        const int b = m >> 13;
        f32x4 v[4]; v2u ca[4], cc[4]; float s = 0.f;
#pragma unroll
        for (int j = 0; j < 4; ++j) { v[j] = nv[j]; ca[j] = na[j]; cc[j] = nc[j];
            v[j].x += bf2f((unsigned short)(nm[j].x & 0xffff)); v[j].y += bf2f((unsigned short)(nm[j].x >> 16)); v[j].z += bf2f((unsigned short)(nm[j].y & 0xffff)); v[j].w += bf2f((unsigned short)(nm[j].y >> 16)); }
        if (m + NGW < M) FIN_LOAD(m + NGW);
#pragma unroll
        for (int j = 0; j < 4; ++j) {
            if (WITH_MOE) { const int col = 4 * F.lane + 256 * j; const f32x4 gt = *(const GAS f32x4*)(mod + b * 6144 + 5120 + col);
                const v2u a = ca[j], c = cc[j];
                f32x4 mo; mo.x = bf2f((unsigned short)(a.x & 0xffff)) + bf2f((unsigned short)(c.x & 0xffff)); mo.y = bf2f((unsigned short)(a.x >> 16)) + bf2f((unsigned short)(c.x >> 16));
                mo.z = bf2f((unsigned short)(a.y & 0xffff)) + bf2f((unsigned short)(c.y & 0xffff)); mo.w = bf2f((unsigned short)(a.y >> 16)) + bf2f((unsigned short)(c.y >> 16));
                v[j] = v[j] + gt * mo; }
            s += (v[j].x * v[j].x + v[j].y * v[j].y) + (v[j].z * v[j].z + v[j].w * v[j].w); }
        const float r = 1.f / sqrtf(wave_sum(s) * (1.f / D) + EPS);
        GAS f32x4* o = (GAS f32x4*)(F.out() + (size_t)m * D) + F.lane;
#pragma unroll
        for (int j = 0; j < 4; ++j) { const f32x4 g = *(const GAS f32x4*)(F.g_fin() + 4 * F.lane + 256 * j); o[64 * j] = v[j] * r * g; }
    }
}

constexpr int N_PHASES = 16;
__global__ void __launch_bounds__(NWAVES * 64, 2) mk_fwd(Args args) {
    extern __shared__ __attribute__((aligned(16))) unsigned char lds[];
    Frame F;
    F.lds = (LAS unsigned char*)lds;
    F.tid = threadIdx.x; F.lane = F.tid & 63; F.wave = __builtin_amdgcn_readfirstlane(F.tid >> 6);
    F.G = gridDim.x; { const int bx = blockIdx.x; F.vcu = (F.G % 8 == 0) ? (bx % 8) * (F.G / 8) + bx / 8 : bx; }
    F.ws = args.ws; F.ctl = (gu32*)(args.ws + WS_CTL);
    F.ka = (const CAS Args*)__builtin_amdgcn_kernarg_segment_ptr();
    volatile LAS unsigned* LCTL = (volatile LAS unsigned*)(F.lds + LDSCTL_OFF);
    for (int u = F.tid; u < 64; u += NWAVES * 64) LCTL[u] = 0u;
    __syncthreads();
    const bool multi = (args.ph_hi - args.ph_lo) > 1;
    XcdBarrier bar; bar.bar = (unsigned*)(F.ctl + CW_BAR); bar.x = 0; bar.st = nullptr;
    if (multi) bar = xcd_barrier_post((unsigned*)(F.ctl + CW_BAR), LCTL + 8);
    const int lo = args.ph_lo, hi = args.ph_hi;
#ifndef PH_MASK
#define PH_MASK 0xffffffffu
#endif
#define IN(k) (((PH_MASK >> (k)) & 1u) && lo <= (k) && (k) < hi)
#define REPS(k) (1 + (int)((REP_MASK >> (k)) & 1u))
#define SEAM(k) do { if (IN(k) && IN((k) + 1)) xcd_barrier(bar); } while (0)

    if (IN(0)) _Pragma("unroll") for (int rp_ = 0; rp_ < REPS(0); ++rp_) { p0_prologue(F); } SEAM(0);
    if (multi && ((REP_MASK >> 21) & 1u)) { for (int q = 0; q < 8; ++q) xcd_barrier(bar); }
    if (IN(1)) _Pragma("unroll") for (int rp_ = 0; rp_ < REPS(1); ++rp_) { p1_norm(F); } SEAM(1);
    if (IN(2)) _Pragma("unroll") for (int rp_ = 0; rp_ < REPS(2); ++rp_) {
        pg8::Gemm g{(const bf16*)(F.ws + WS_H), (const bf16*)(F.ws + WS_WIN), D}; pg8::StaticOrder S; S.init(M, NPAD, F.G, (int)blockIdx.x);
        EpiInProj E{F.ws};
        pg8::gemm_phase<EpiInProj, pg8::StaticOrder, true>(F.lds, g, S, E);
    } SEAM(2);
    if (IN(3)) _Pragma("unroll") for (int rp_ = 0; rp_ < REPS(3); ++rp_) { ra_states(F); } SEAM(3);
    if (IN(4)) _Pragma("unroll") for (int rp_ = 0; rp_ < REPS(4); ++rp_) { rb_carry(F); } SEAM(4);
    if (IN(5)) _Pragma("unroll") for (int rp_ = 0; rp_ < REPS(5); ++rp_) { r3_out(F);
    } SEAM(5);
    if (IN(6)) _Pragma("unroll") for (int rp_ = 0; rp_ < REPS(6); ++rp_) { p_indexer(F); } SEAM(6);
    if (IN(7)) _Pragma("unroll") for (int rp_ = 0; rp_ < REPS(7); ++rp_) {
        const attn_body::AttnTensors AT{(const bf16*)(F.ws + WS_QA), (const bf16*)(F.ws + WS_KA), (const bf16*)(F.ws + WS_VA), (bf16*)(F.ws + WS_Y), (const unsigned char*)(F.ws + WS_MASK)};
        const attn_body::StaticOrder S((int)F.G, (int)blockIdx.x);
        { attn_body::AttnUnit u;
            for (int i = 0; S.next(i, u); ++i) { attn_body::attn_unit<8>(u.bh / attn_body::NHEAD, u.bh % attn_body::NHEAD, u.qb, AT.Q, AT.K, AT.V, AT.O, AT.MK, (char*)lds);
                p_expert_convert(F, i, 4); __syncthreads(); } }
    } SEAM(7);
    if (IN(8)) _Pragma("unroll") for (int rp_ = 0; rp_ < REPS(8); ++rp_) {
        pg8::Gemm g{(const bf16*)(F.ws + WS_Y), (const bf16*)(F.ws + WS_WO), D}; pg8::StaticOrder S; S.init(M, D, F.G, (int)blockIdx.x);
        EpiOutProj E{(bf16*)(F.ws + WS_MIX), (const float*)(F.ws + WS_MOD)};
        pg8::gemm_phase<EpiOutProj, pg8::StaticOrder, true>(F.lds, g, S, E);
    } SEAM(8);
    if (IN(9)) _Pragma("unroll") for (int rp_ = 0; rp_ < REPS(9); ++rp_) { p_norm2_route(F); } SEAM(9);
    if (IN(10)) _Pragma("unroll") for (int rp_ = 0; rp_ < REPS(10); ++rp_) {
        LAS int* blkstart = (LAS int*)(F.lds + AUX_OFF); LAS unsigned* tok = (LAS unsigned*)(F.lds + AUX_OFF + 256); LAS float* wts = (LAS float*)(F.lds + AUX_OFF + 256 + MOE_MAXU * 1024);
        const int nunits = moe_tables(F, blkstart, tok, wts);
        pg8::Gemm g{(const bf16*)(F.ws + WS_H2), (const bf16*)(F.ws + WS_WGU), D}; MoeSched S{F.G, F.vcu, nunits, blkstart, tok, true};
        EpiMoe1 E{(bf16*)(F.ws + WS_ACT)};
        pg8::gemm_phase<EpiMoe1, MoeSched, true>(F.lds, g, S, E);
    } SEAM(10);
    if (IN(11)) _Pragma("unroll") for (int rp_ = 0; rp_ < REPS(11); ++rp_) {
        LAS int* blkstart = (LAS int*)(F.lds + AUX_OFF); LAS unsigned* tok = (LAS unsigned*)(F.lds + AUX_OFF + 256); LAS float* wts = (LAS float*)(F.lds + AUX_OFF + 256 + MOE_MAXU * 1024);
        const int nunits = moe_tables(F, blkstart, tok, wts);
        pg8::Gemm g{(const bf16*)(F.ws + WS_ACT), (const bf16*)(F.ws + WS_WD), DEXP}; MoeSched S{F.G, F.vcu, nunits, blkstart, tok, false};
        EpiMoe2 E{(bf16*)(F.ws + WS_C0), (bf16*)(F.ws + WS_C1), tok, wts};
        pg8::gemm_phase<EpiMoe2, MoeSched, true>(F.lds, g, S, E);
    } SEAM(11);
    if (IN(12)) _Pragma("unroll") for (int rp_ = 0; rp_ < REPS(12); ++rp_) { p_final<true>(F); }
#undef IN
#undef SEAM
}

extern "C" void kernel_launch(void* const* d_in, const int* in_sizes, int n_in, void* d_out, int out_size, void* d_ws, size_t ws_size, hipStream_t stream) {
    static int grid = 0;
    if (grid == 0) {
        if (n_in != 15 || out_size != M * D || ws_size < WS_END) { fprintf(stderr, "kernel_launch: unexpected shapes (n_in %d out %d ws %zu)\n", n_in, out_size, ws_size); grid = -1; return; }
        int dev = 0, cus = 0, per_cu = 0;
        if (hipGetDevice(&dev) != hipSuccess || hipDeviceGetAttribute(&cus, hipDeviceAttributeMultiprocessorCount, dev) != hipSuccess) { grid = -1; return; }
        if (hipFuncSetAttribute((const void*)mk_fwd, hipFuncAttributeMaxDynamicSharedMemorySize, LDS_BYTES) != hipSuccess) { fprintf(stderr, "kernel_launch: hipFuncSetAttribute failed\n"); grid = -1; return; }
        if (hipOccupancyMaxActiveBlocksPerMultiprocessor(&per_cu, (const void*)mk_fwd, NWAVES * 64, LDS_BYTES) != hipSuccess || per_cu < 1) { fprintf(stderr, "kernel_launch: occupancy query says %d\n", per_cu); }
        (void)hipGetLastError();
        grid = cus;
    }
    if (grid < 0) return;
    (void)hipMemsetAsync((char*)d_ws + WS_CTL, 0, CTL_ZERO_BYTES, stream);
    Args a{};
    for (int i = 0; i < 15; ++i) a.in[i] = d_in[i];
    a.out = (float*)d_out; a.ws = (unsigned char*)d_ws;
#if MK_N_LAUNCHES == 1
    a.ph_lo = 0; a.ph_hi = N_PHASES;
    hipLaunchKernelGGL(mk_fwd, dim3(grid), dim3(NWAVES * 64), LDS_BYTES, stream, a);
#else
    for (int p = 0; p < N_PHASES; ++p) { a.ph_lo = p; a.ph_hi = p + 1; hipLaunchKernelGGL(mk_fwd, dim3(grid), dim3(NWAVES * 64), LDS_BYTES, stream, a); }
#endif
}
```

```cpp
#include <hip/hip_runtime.h>
#include <cstdio>
#include <cstdint>

#ifndef REP_MASK
#define REP_MASK 0u
#endif
#define SUBREPS(k) (1 + (int)((REP_MASK >> (k)) & 1u))
#ifndef MK_N_LAUNCHES
#define MK_N_LAUNCHES 1
#endif

#define GAS __attribute__((address_space(1)))
#define LAS __attribute__((address_space(3)))
typedef unsigned short bf16;
typedef unsigned v4u __attribute__((ext_vector_type(4)));
typedef unsigned v2u __attribute__((ext_vector_type(2)));
typedef float f32x4 __attribute__((ext_vector_type(4)));
typedef float f32x16 __attribute__((ext_vector_type(16)));
typedef short bf16x8 __attribute__((ext_vector_type(8)));
typedef GAS unsigned gu32;
#define RLX_AGENT __ATOMIC_RELAXED, __HIP_MEMORY_SCOPE_AGENT
#define LDS_WAIT() asm volatile("s_waitcnt lgkmcnt(0)" ::: "memory")
#define VM_WAIT() asm volatile("s_waitcnt vmcnt(0)" ::: "memory")

constexpr int NB = 4, SEQ = 8192, M = NB * SEQ, D = 1024;
constexpr int DIN = 4688, NPAD = 4864;
constexpr int NEXP = 32, DEXP = 512;
constexpr float EPS = 1e-6f;
constexpr float C2 = 0.125f * 1.4426950408889634f;

constexpr size_t MiB = 1u << 20;
constexpr size_t WS_CTL = 0, CTL_ZERO_BYTES = 1 * MiB;
constexpr size_t WS_MODP = 1 * MiB;
constexpr size_t WS_MOD = 3 * MiB;
constexpr size_t WS_WIN = 4 * MiB;
constexpr size_t WS_WO = 14 * MiB;
constexpr size_t WS_H = 16 * MiB;
constexpr size_t WS_ST = 16 * MiB;
constexpr size_t WS_MIX = 16 * MiB;
constexpr size_t WS_QA = 80 * MiB, WS_KA = 112 * MiB, WS_VA = 144 * MiB;
constexpr size_t WS_ROUTE = 144 * MiB;
constexpr size_t WS_QI = 176 * MiB;
constexpr size_t WS_H2 = 176 * MiB;
constexpr size_t WS_C0 = 176 * MiB;
constexpr size_t WS_KI = 240 * MiB;
constexpr size_t WS_WI = 244 * MiB;
constexpr size_t WS_QB = 248 * MiB, WS_KB = 280 * MiB, WS_VB = 312 * MiB, WS_GB = 344 * MiB;
constexpr size_t WS_SCR = 248 * MiB;
constexpr size_t WS_WGU = 248 * MiB;
constexpr size_t WS_C1 = 248 * MiB;
constexpr size_t WS_WD = 312 * MiB;
constexpr size_t WS_Y = 376 * MiB;
constexpr size_t WS_ACT = 376 * MiB;
constexpr size_t WS_MASK = 440 * MiB;
constexpr size_t WS_ROPE1 = 474 * MiB;
constexpr size_t WS_ROPE2 = 476 * MiB;
constexpr size_t WS_END = 512 * MiB;

constexpr int CW_BAR = 4096;
constexpr int CW_ECNT = 16384;

constexpr int NWAVES = 8;
constexpr int RING_BYTES = 131072;
constexpr int AUX_OFF = RING_BYTES, AUX_BYTES = 20480;
constexpr int LDSCTL_OFF = AUX_OFF + AUX_BYTES;
constexpr int LDS_BYTES = LDSCTL_OFF + 256;

__device__ __forceinline__ unsigned f2bf(float f) { unsigned u = __builtin_bit_cast(unsigned, f); return (u + 0x7fffu + ((u >> 16) & 1u)) >> 16; }
__device__ __forceinline__ unsigned pk2(float lo, float hi) { return f2bf(lo) | (f2bf(hi) << 16); }
__device__ __forceinline__ float bf2f(unsigned short b) { return __builtin_bit_cast(float, (unsigned)b << 16); }
__device__ __forceinline__ float wave_sum(float v) {
#define WS_SHR(x, k) __builtin_bit_cast(float, __builtin_amdgcn_update_dpp(0, __builtin_bit_cast(int, x), 0x110 + (k), 0xf, 0xf, true))
    v += WS_SHR(v, 1); v += WS_SHR(v, 2); v += WS_SHR(v, 4); v += WS_SHR(v, 8);
#undef WS_SHR
    const int b = __builtin_bit_cast(int, v);
    const float t0 = __builtin_bit_cast(float, __builtin_amdgcn_readlane(b, 15)), t1 = __builtin_bit_cast(float, __builtin_amdgcn_readlane(b, 31));
    const float t2 = __builtin_bit_cast(float, __builtin_amdgcn_readlane(b, 47)), t3 = __builtin_bit_cast(float, __builtin_amdgcn_readlane(b, 63));
    return (t0 + t1) + (t2 + t3);
}

#define XB_TMO      128
#define XB_XCNT(j)  (256  + 64 * (j))
#define XB_XSUB(j)  (1280 + 64 * (j))
#define XB_XGEN(j)  (2304 + 64 * (j))
#define XB_TOP      3328
#define XB_TOPGEN   3392
#define XCD_BAR_WORDS 3456
#define XB_SPIN_CAP (1u << 18)
__device__ __forceinline__ unsigned xb_ld(unsigned* p)              { return __hip_atomic_load(p, __ATOMIC_RELAXED, __HIP_MEMORY_SCOPE_AGENT); }
__device__ __forceinline__ unsigned xb_add(unsigned* p, unsigned v) { return __hip_atomic_fetch_add(p, v, __ATOMIC_RELAXED, __HIP_MEMORY_SCOPE_AGENT); }
__device__ __forceinline__ unsigned xb_xcc_id() { return (unsigned)__builtin_amdgcn_s_getreg((3 << 11) | 20) & 0xFu; }
#define XB_SPIN(cond, bar) do { unsigned _sp = 0; while (cond) { __builtin_amdgcn_s_sleep(1); \
    if ((++_sp & 255u) == 0u) { if (xb_ld(&(bar)[XB_TMO])) break; if (_sp > XB_SPIN_CAP) { atomicAdd(&(bar)[XB_TMO], 1u); break; } } } } while (0)
struct XcdBarrier { unsigned* bar; unsigned x; volatile LAS unsigned* st; };
__device__ __forceinline__ XcdBarrier xcd_barrier_post(unsigned* bar, volatile LAS unsigned* st) {
    XcdBarrier b; b.bar = bar; b.x = xb_xcc_id(); b.st = st;
    if (threadIdx.x == 0) (void)xb_add(&bar[XB_XCNT(b.x)], 1u);
    return b;
}
__device__ __forceinline__ void xcd_barrier_complete(unsigned* bar, unsigned x, unsigned& nloc, unsigned& nx) {
    const unsigned G = gridDim.x * gridDim.y * gridDim.z;
    unsigned sum, cnt, mine, sp = 0u;
    for (;;) {
        sum = 0u; cnt = 0u; mine = 0u;
#pragma unroll
        for (unsigned j = 0; j < 16; ++j) { const unsigned c = xb_ld(&bar[XB_XCNT(j)]); sum += c; cnt += (c > 0u) ? 1u : 0u; mine = (j == x) ? c : mine; }
        if (sum == G) break;
        __builtin_amdgcn_s_sleep(1);
        if ((++sp & 255u) == 0u) { if (xb_ld(&bar[XB_TMO])) break; if (sp > XB_SPIN_CAP) { atomicAdd(&bar[XB_TMO], 1u); break; } }
    }
    nloc = mine > 0u ? mine : 1u; nx = cnt > 0u ? cnt : 1u;
}
__device__ __forceinline__ void xcd_barrier(const XcdBarrier& b) {
    asm volatile("s_waitcnt vmcnt(0)" ::: "memory");
    __syncthreads();
    if (threadIdx.x == 0) {
        unsigned* bar = b.bar;
        __builtin_amdgcn_s_waitcnt(0);
        unsigned nloc = b.st[0], nx = b.st[1];
        if (nloc == 0u) { xcd_barrier_complete(bar, b.x, nloc, nx); b.st[0] = nloc; b.st[1] = nx; }
        const unsigned old = xb_add(&bar[XB_XSUB(b.x)], 1u);
        const unsigned gen = old / nloc;
        if (old + 1u == (gen + 1u) * nloc) {
            __builtin_amdgcn_fence(__ATOMIC_RELEASE, "agent");
            asm volatile("s_waitcnt vmcnt(0)" ::: "memory");
            const unsigned og = xb_add(&bar[XB_TOP], 1u);
            const unsigned tg = og / nx;
            if (og + 1u == (tg + 1u) * nx) xb_add(&bar[XB_TOPGEN], 1u);
            else XB_SPIN(xb_ld(&bar[XB_TOPGEN]) == tg, bar);
            __builtin_amdgcn_fence(__ATOMIC_ACQUIRE, "agent");
            xb_add(&bar[XB_XGEN(b.x)], 1u);
            asm volatile("s_waitcnt vmcnt(0)" ::: "memory");
        } else {
            XB_SPIN(xb_ld(&bar[XB_XGEN(b.x)]) == gen, bar);
            __builtin_amdgcn_fence(__ATOMIC_ACQUIRE, "agent");
            asm volatile("s_waitcnt vmcnt(0)" ::: "memory");
        }
    }
    __syncthreads();
}

namespace pg8 {
typedef unsigned short bf16_t;
constexpr int BM = 256, BK = 64, HALF = 128, HTB = HALF * BK * 2, STAGE_BYTES = 8 * HTB;
__host__ __device__ __forceinline__ int lds_byte(int r, int c) { const int st = (r >> 4) * 2 + (c >> 5), rr = r & 15, cc = c & 31, ob = rr * 64 + cc * 2; return st * 1024 + (ob ^ (((ob >> 9) & 1) << 5)); }
__host__ __device__ __forceinline__ void stage_rc(int b, int& R, int& C) { const int st = b / 1024, sb = b % 1024, swz = sb ^ (((sb >> 9) & 1) << 5); R = (st >> 1) * 16 + swz / 64; C = (st & 1) * 32 + (swz % 64) / 2; }
__host__ __device__ __forceinline__ int perm32(int rho) { const int n = rho >> 4, i = rho & 15; return 8 * (i >> 2) + 4 * n + (i & 3); }
struct Unit { int pm, pn; };
struct Gemm { const bf16_t* A; const bf16_t* Bt; int K; };
__device__ __forceinline__ unsigned cvt_pk_bf16(float lo, float hi) { unsigned r; asm volatile("v_cvt_pk_bf16_f32 %0, %1, %2" : "=v"(r) : "v"(lo), "v"(hi)); return r; }

template <class Epi, class Sched, bool ALIGN_EPI>
__device__ __forceinline__ void gemm_phase(LAS unsigned char* lds, const Gemm g, const Sched& S, const Epi& E) {
    const int tid = threadIdx.x, wid = __builtin_amdgcn_readfirstlane(tid >> 6), lane = tid & 63, wr = wid >> 2, wc = wid & 3, fr = lane & 15, fq = lane >> 4;
    const int K = g.K, nt = K / BK;
    int Rs[2], Cs[2]; unsigned voffB[2];
#pragma unroll
    for (int i = 0; i < 2; ++i) { int R, C; stage_rc(tid * 16 + i * 8192, R, C); const int Rb = Epi::PERM ? ((R & ~31) + perm32(R & 31)) : R;
        Rs[i] = R; Cs[i] = C * 2; voffB[i] = (unsigned)(Rb * K + C) * 2u; }
    const size_t kstep = (size_t)(BK * 2);
    const size_t hstep = (size_t)HALF * K * 2;
    const unsigned ldsw = (unsigned)wid * 1024u;
    const int aoff = lds_byte(wr * 64 + fr, fq * 8), boff = lds_byte(wc * 32 + fr, fq * 8);
#define PG8_SA(b, h) (((b) * 2 + (h)) * HTB)
#define PG8_SB(b, h) ((4 + (b) * 2 + (h)) * HTB)
#define PG8_STAGE(bufoff, gbase, v0, v1) do { \
        __builtin_amdgcn_global_load_lds((const unsigned*)((const char*)(gbase) + (v0)), (LAS unsigned*)(lds + (bufoff) + ldsw), 16, 0, 0); \
        __builtin_amdgcn_global_load_lds((const unsigned*)((const char*)(gbase) + (v1)), (LAS unsigned*)(lds + (bufoff) + ldsw + 8192), 16, 0, 0); } while (0)
#define PG8_STAGEB(bufoff, gbase) PG8_STAGE(bufoff, gbase, voffB[0], voffB[1])
#define PG8_LDA(dst, b, h) do { _Pragma("unroll") for (int m = 0; m < 4; ++m) _Pragma("unroll") for (int k = 0; k < 2; ++k) dst[m][k] = *(const LAS bf16x8*)(lds + PG8_SA(b, h) + aoff + m * 2048 + k * 1024); } while (0)
#define PG8_LDB(dst, b, h) do { _Pragma("unroll") for (int n = 0; n < 2; ++n) _Pragma("unroll") for (int k = 0; k < 2; ++k) dst[n][k] = *(const LAS bf16x8*)(lds + PG8_SB(b, h) + boff + n * 2048 + k * 1024); } while (0)
#define PG8_MMA(ai, bj, At, Bt) do { __builtin_amdgcn_s_setprio(1); _Pragma("unroll") for (int m = 0; m < 4; ++m) _Pragma("unroll") for (int n = 0; n < 2; ++n) _Pragma("unroll") for (int k = 0; k < 2; ++k) \
        acc[ai][bj][m][n] = __builtin_amdgcn_mfma_f32_16x16x32_bf16(Bt[n][k], At[m][k], acc[ai][bj][m][n], 0, 0, 0); __builtin_amdgcn_s_setprio(0); } while (0)
#define PG8_WAIT_V(n) asm volatile("s_waitcnt vmcnt(" #n ")" ::: "memory")
#define PG8_WAIT_L(n) asm volatile("s_waitcnt lgkmcnt(" #n ")" ::: "memory")
#define PG8_BAR __builtin_amdgcn_s_barrier()
#define PG8_SCHED __builtin_amdgcn_sched_barrier(0)
    Unit cur, nxt; int ui = 0;
    if (!S.next(0, cur)) return;
    f32x4 acc[2][2][4][2];
#pragma unroll
    for (int a = 0; a < 2; ++a)
#pragma unroll
        for (int b = 0; b < 2; ++b)
#pragma unroll
            for (int m = 0; m < 4; ++m)
#pragma unroll
                for (int n = 0; n < 2; ++n) acc[a][b][m][n] = (f32x4){0.f, 0.f, 0.f, 0.f};
    bf16x8 At[4][2], B0[2][2], B1[2][2];
    unsigned vc[2][2], vn[2][2];
#pragma unroll
    for (int h = 0; h < 2; ++h)
#pragma unroll
        for (int i = 0; i < 2; ++i) vc[h][i] = (unsigned)S.arow(cur, h * HALF + Rs[i]) * (unsigned)(K * 2) + (unsigned)Cs[i];
    const char* cA = (const char*)g.A;
    const char* cB = (const char*)g.Bt + (size_t)S.brow0(cur) * K * 2;
    PG8_STAGEB(PG8_SB(0, 0), cB); PG8_STAGEB(PG8_SB(0, 1), cB + hstep); PG8_STAGE(PG8_SA(0, 0), cA, vc[0][0], vc[0][1]); PG8_STAGE(PG8_SA(0, 1), cA, vc[1][0], vc[1][1]);
    if (wr == 1) PG8_BAR;
    PG8_WAIT_V(2); PG8_BAR;
    PG8_STAGEB(PG8_SB(1, 0), cB + kstep); PG8_STAGE(PG8_SA(1, 0), cA + kstep, vc[0][0], vc[0][1]); PG8_STAGEB(PG8_SB(1, 1), cB + hstep + kstep);
    PG8_WAIT_V(6); PG8_BAR;
    for (;;) {
        const bool has_next = S.next(ui + 1, nxt);
        const char* nB = cB;
        if (has_next) {
            nB = (const char*)g.Bt + (size_t)S.brow0(nxt) * K * 2;
#pragma unroll
            for (int h = 0; h < 2; ++h)
#pragma unroll
                for (int i = 0; i < 2; ++i) vn[h][i] = (unsigned)S.arow(nxt, h * HALF + Rs[i]) * (unsigned)(K * 2) + (unsigned)Cs[i];
        } else {
#pragma unroll
            for (int h = 0; h < 2; ++h)
#pragma unroll
                for (int i = 0; i < 2; ++i) vn[h][i] = vc[h][i];
        }
        for (int t = 0; t < nt; t += 2) {
            const bool last = (t == nt - 2);
            const char* a1 = cA + (size_t)(t + 1) * kstep;
            const char* a2 = last ? cA : cA + (size_t)(t + 2) * kstep; const char* b2 = last ? nB : cB + (size_t)(t + 2) * kstep;
            const char* a3 = a2 + kstep; const char* b3 = b2 + kstep;
            const unsigned w00 = last ? vn[0][0] : vc[0][0], w01 = last ? vn[0][1] : vc[0][1], w10 = last ? vn[1][0] : vc[1][0], w11 = last ? vn[1][1] : vc[1][1];
            PG8_LDB(B0, 0, 0); PG8_LDB(B1, 0, 1); PG8_SCHED; PG8_LDA(At, 0, 0); PG8_STAGE(PG8_SA(1, 1), a1, vc[1][0], vc[1][1]);
            PG8_WAIT_V(8); PG8_WAIT_L(0); PG8_BAR; PG8_MMA(0, 0, At, B0); PG8_MMA(0, 1, At, B1); PG8_BAR; PG8_SCHED;
            PG8_LDA(At, 0, 1); PG8_STAGEB(PG8_SB(0, 0), b2); PG8_STAGEB(PG8_SB(0, 1), b2 + hstep); PG8_STAGE(PG8_SA(0, 0), a2, w00, w01);
            PG8_WAIT_V(8); PG8_WAIT_L(0); PG8_BAR; PG8_MMA(1, 0, At, B0); PG8_MMA(1, 1, At, B1); PG8_BAR; PG8_SCHED;
            PG8_LDB(B0, 1, 0); PG8_LDB(B1, 1, 1); PG8_SCHED; PG8_LDA(At, 1, 0); PG8_STAGE(PG8_SA(0, 1), a2, w10, w11);
            PG8_WAIT_V(8); PG8_WAIT_L(0); PG8_BAR; PG8_MMA(0, 0, At, B0); PG8_MMA(0, 1, At, B1); PG8_BAR; PG8_SCHED;
            PG8_LDA(At, 1, 1); PG8_STAGEB(PG8_SB(1, 0), b3); PG8_STAGEB(PG8_SB(1, 1), b3 + hstep); PG8_STAGE(PG8_SA(1, 0), a3, w00, w01);
            PG8_WAIT_V(8); PG8_WAIT_L(0); PG8_BAR; PG8_MMA(1, 0, At, B0); PG8_MMA(1, 1, At, B1); PG8_BAR; PG8_SCHED;
        }
        if constexpr (ALIGN_EPI) { if (wr == 0) PG8_BAR; }
        E(acc, cur, wr, wc, fr, fq);
        if (!has_next) break;
#pragma unroll
        for (int a = 0; a < 2; ++a)
#pragma unroll
            for (int b = 0; b < 2; ++b)
#pragma unroll
                for (int m = 0; m < 4; ++m)
#pragma unroll
                    for (int n = 0; n < 2; ++n) acc[a][b][m][n] = (f32x4){0.f, 0.f, 0.f, 0.f};
        cur = nxt; cB = nB; ++ui;
#pragma unroll
        for (int h = 0; h < 2; ++h)
#pragma unroll
            for (int i = 0; i < 2; ++i) vc[h][i] = vn[h][i];
        if constexpr (ALIGN_EPI) { if (wr == 1) PG8_BAR; }
    }
    PG8_WAIT_V(0);
    if constexpr (!ALIGN_EPI) { if (wr == 0) PG8_BAR; }
    PG8_BAR;
#undef PG8_SA
#undef PG8_SB
#undef PG8_STAGE
#undef PG8_STAGEB
#undef PG8_LDA
#undef PG8_LDB
#undef PG8_MMA
#undef PG8_WAIT_V
#undef PG8_WAIT_L
#undef PG8_BAR
#undef PG8_SCHED
}

struct StaticOrder {
    int nM, nN, nwg, G, c;
    __device__ void init(int Mrows, int N, int G_, int c_) { nM = Mrows / BM; nN = N / BM; nwg = nM * nN; G = G_; c = c_; }
    __device__ bool next(int i, Unit& u) const {
        const long L = (long)i * G + c; if (L >= nwg) return false;
        int wgid = (int)L; { const int q = nwg / 8, r = nwg % 8, xcd = wgid % 8, off = wgid / 8; wgid = (xcd < r ? xcd * (q + 1) : r * (q + 1) + (xcd - r) * q) + off; }
        const int nig = 8 * nN, gid = wgid / nig, fm = gid * 8, gsz = (nM - fm) < 8 ? (nM - fm) : 8;
        u.pm = fm + ((wgid % nig) % gsz); u.pn = (wgid % nig) / gsz; return true;
    }
    __device__ __forceinline__ int arow(const Unit& u, int rt) const { return u.pm * BM + rt; }
    __device__ __forceinline__ int brow0(const Unit& u) const { return u.pn * BM; }
};
}

#include <cmath>
namespace attn_body {
using bf16=unsigned short;
using bf16x8=__attribute__((ext_vector_type(8)))short;
using s16x4=__attribute__((ext_vector_type(4)))short;
using f32x16=__attribute__((ext_vector_type(16)))float;
using u32x4=__attribute__((ext_vector_type(4)))unsigned;
using u32x2=__attribute__((ext_vector_type(2)))unsigned;
constexpr int BATCH=4,NHEAD=8,SEQ=8192,D=64,DM=NHEAD*D,OPITCH=1024,MPITCH=1024;
constexpr int NW=8,QBLK=32,QB=QBLK*NW,KVBLK=64,NQB=SEQ/QB;
constexpr int ATTN_PITCH=DM, ATTN_UNIT_ROWS=QB;
__device__ __forceinline__ int crow(int r,int hi){return (r&3)+8*(r>>2)+4*hi;}
#define SBAR() __builtin_amdgcn_sched_barrier(0)
constexpr int NSLOT=3, SLOTB=8192;
constexpr int LDS_K=0, LDS_V=NSLOT*SLOTB, LDS_WS=2*NSLOT*SLOTB, LDS_OST=LDS_WS+NW*64*4, LDS_MK=LDS_OST+NW*4096, LDS_BYTES=LDS_MK+NW*1024;
__device__ __forceinline__ void glds16(const void*gsrc,unsigned lds_dst){unsigned keep;
  asm volatile("s_mov_b32 %0, m0\n\ts_mov_b32 m0, %2\n\ts_nop 0\n\tglobal_load_lds_dwordx4 %1, off\n\ts_mov_b32 m0, %0":"=&s"(keep):"v"(gsrc),"s"(lds_dst):"memory");}
__device__ __forceinline__ void glds4(const void*gsrc,unsigned lds_dst){unsigned keep;
  asm volatile("s_mov_b32 %0, m0\n\ts_mov_b32 m0, %2\n\ts_nop 0\n\tglobal_load_lds_dword %1, off\n\ts_mov_b32 m0, %0":"=&s"(keep):"v"(gsrc),"s"(lds_dst):"memory");}
__device__ __forceinline__ float mskf(float x,unsigned w,int pos){ unsigned m; asm("v_bfe_i32 %0, %1, %2, 1":"=v"(m):"v"(w),"n"(pos)); return __uint_as_float(__float_as_uint(x) & m); }
__device__ __forceinline__ float max3f(float a,float b,float c){float r;asm("v_max3_f32 %0, %1, %2, %3":"=v"(r):"v"(a),"v"(b),"v"(c));return r;}
__device__ __forceinline__ float max2f(float a,float b){float r;asm("v_max_f32_e32 %0, %1, %2":"=v"(r):"v"(a),"v"(b));return r;}
__device__ __forceinline__ float fadd_s(float a,float b){float r;asm("v_add_f32_e32 %0, %1, %2":"=v"(r):"v"(a),"v"(b));return r;}
__device__ __forceinline__ float fsub_s(float a,float b){float r;asm("v_sub_f32_e32 %0, %1, %2":"=v"(r):"v"(a),"v"(b));return r;}
typedef float f32x2_t __attribute__((ext_vector_type(2))); typedef __bf16 bf16x2_t __attribute__((ext_vector_type(2)));
__device__ __forceinline__ unsigned cvtpk_s(float lo,float hi){f32x2_t v={lo,hi};bf16x2_t b=__builtin_convertvector(v,bf16x2_t);return __builtin_bit_cast(unsigned,b);}
#define WAIT_BAR(N) asm volatile("s_waitcnt vmcnt(" #N ") lgkmcnt(0)\n\ts_barrier":::"memory")

__device__ __forceinline__ void qkt(f32x16&p0,f32x16&p1,const char*Kslot,const bf16x8*qr,const f32x16&negm,int r32,int hi){
  const char*kb=Kslot+hi*1024+r32*16;
  #pragma unroll
  for(int d0=0;d0<4;++d0){
    const bf16x8 b0=*reinterpret_cast<const bf16x8*>(kb+d0*2048);
    const bf16x8 b1=*reinterpret_cast<const bf16x8*>(kb+d0*2048+512);
    if(d0==0){p0=__builtin_amdgcn_mfma_f32_32x32x16_bf16(b0,qr[0],negm,0,0,0);p1=__builtin_amdgcn_mfma_f32_32x32x16_bf16(b1,qr[0],negm,0,0,0);}
    else{p0=__builtin_amdgcn_mfma_f32_32x32x16_bf16(b0,qr[d0],p0,0,0,0);p1=__builtin_amdgcn_mfma_f32_32x32x16_bf16(b1,qr[d0],p1,0,0,0);}}
}
typedef __attribute__((address_space(3))) const char* lds_cptr;
typedef short v4i16_t __attribute__((ext_vector_type(4)));
__device__ __forceinline__ void kload8(bf16x8*kf,lds_cptr kp){
  kf[0]=*(const __attribute__((address_space(3))) bf16x8*)(kp);      kf[1]=*(const __attribute__((address_space(3))) bf16x8*)(kp+512);
  kf[2]=*(const __attribute__((address_space(3))) bf16x8*)(kp+2048); kf[3]=*(const __attribute__((address_space(3))) bf16x8*)(kp+2560);
  kf[4]=*(const __attribute__((address_space(3))) bf16x8*)(kp+4096); kf[5]=*(const __attribute__((address_space(3))) bf16x8*)(kp+4608);
  kf[6]=*(const __attribute__((address_space(3))) bf16x8*)(kp+6144); kf[7]=*(const __attribute__((address_space(3))) bf16x8*)(kp+6656);
}
__device__ __forceinline__ void kload2(bf16x8*kf,lds_cptr kp,int j){ kf[2*j]=*(const __attribute__((address_space(3))) bf16x8*)(kp+j*2048); kf[2*j+1]=*(const __attribute__((address_space(3))) bf16x8*)(kp+j*2048+512); }
__device__ __forceinline__ s16x4 vtr(lds_cptr p){ return __builtin_bit_cast(s16x4,__builtin_amdgcn_ds_read_tr16_b64_v4i16((__attribute__((address_space(3))) v4i16_t*)p)); }
__device__ __forceinline__ float rowmax(const f32x16&p0,const f32x16&p1){
  float a=max3f(p0[0],p0[1],p1[0]),b=max3f(p0[2],p0[3],p1[1]);a=max3f(a,p1[2],p1[3]);
  #pragma unroll
  for(int r=4;r<16;r+=4){a=max3f(a,p0[r],p0[r+1]);b=max3f(b,p0[r+2],p0[r+3]);a=max3f(a,p1[r],p1[r+1]);b=max3f(b,p1[r+2],p1[r+3]);}
  const float m=max2f(a,b);
  auto rr=__builtin_amdgcn_permlane32_swap(__float_as_uint(m),__float_as_uint(m),false,false);
  return max2f(__uint_as_float(rr[0]),__uint_as_float(rr[1]));
}
__device__ __forceinline__ void pv(f32x16*o,int vb,bf16x8 pa0,bf16x8 pa1,bf16x8 pa2,bf16x8 pa3){
  #pragma unroll
  for(int d0=0;d0<2;++d0){s16x4 lo[4],hi[4];
    #pragma unroll
    for(int ks=0;ks<4;++ks){
      asm volatile("ds_read_b64_tr_b16 %0,%1 offset:%c2":"=&v"(lo[ks]):"v"(vb),"i"(d0*4096+ks*1024):"memory");
      asm volatile("ds_read_b64_tr_b16 %0,%1 offset:%c2":"=&v"(hi[ks]):"v"(vb),"i"(d0*4096+ks*1024+512):"memory");}
    asm volatile("s_waitcnt lgkmcnt(0)":::"memory");SBAR();
    #define PK(k) (bf16x8){lo[k][0],lo[k][1],lo[k][2],lo[k][3],hi[k][0],hi[k][1],hi[k][2],hi[k][3]}
    o[d0]=__builtin_amdgcn_mfma_f32_32x32x16_bf16(pa0,PK(0),o[d0],0,0,0);
    o[d0]=__builtin_amdgcn_mfma_f32_32x32x16_bf16(pa1,PK(1),o[d0],0,0,0);
    o[d0]=__builtin_amdgcn_mfma_f32_32x32x16_bf16(pa2,PK(2),o[d0],0,0,0);
    o[d0]=__builtin_amdgcn_mfma_f32_32x32x16_bf16(pa3,PK(3),o[d0],0,0,0);
    #undef PK
  }
}

#ifndef ATTN_STORE16
#define ATTN_STORE16(p,v) (*(u32x4*)(p)=(v))
#endif
template<int THRL> __device__ __forceinline__ void attn_unit(int b,int h,int qb,const bf16*Q,const bf16*__restrict__ K,const bf16*__restrict__ V,bf16*O,const unsigned char*__restrict__ MK,char*shm){
  const int tid=threadIdx.x,lane=tid&63,r32=lane&31,hi=lane>>5; const int wid=__builtin_amdgcn_readfirstlane(tid>>6);
  const long rowbase=(long)b*SEQ; const int q0=qb*QB;
  const bf16*Qw=Q+(rowbase+q0+wid*QBLK)*DM+h*D;
  const bf16*Kh=K+rowbase*DM+h*D,*Vh=V+rowbase*DM+h*D;
  const unsigned lds0=(unsigned)(uintptr_t)shm;
  float*wsf=(float*)(shm+LDS_WS)+wid*64;
  const bf16*ksrc=Kh+(long)lane*DM+wid*8;
  const bf16*vsrc=Vh+(long)(16*(wid&3)+(lane>>2))*DM+(wid>>2)*32+(lane&3)*8;
  const unsigned kdst=lds0+LDS_K+wid*1024, vdst=lds0+LDS_V+wid*1024;
  #define DMA_K(t,slot) glds16(ksrc+(long)(t)*KVBLK*DM,(unsigned)__builtin_amdgcn_readfirstlane(kdst+(slot)))
  #define DMA_V(t,slot) glds16(vsrc+(long)(t)*KVBLK*DM,(unsigned)__builtin_amdgcn_readfirstlane(vdst+(slot)))
  const unsigned char*msrc=MK+(rowbase+q0+wid*QBLK+(lane>>1))*(long)MPITCH+4*(lane&1);
  const unsigned mdst=lds0+LDS_MK+wid*1024;
  #define DMA_M(t) glds4(msrc+8*(long)(t),(unsigned)__builtin_amdgcn_readfirstlane(mdst+(((t)&3)<<8)))
  const lds_cptr mp0=(lds_cptr)shm+LDS_MK+wid*1024+r32*8;
  #define MLOAD(t) do{ const u32x2 mw_=*(const __attribute__((address_space(3))) u32x2*)(mp0+(((t)&3)<<8)); ml=mw_[0]>>(4*hi); mh=mw_[1]>>(4*hi); }while(0)
  const int vb0=(int)(lds0+LDS_V)+((lane>>4)&1)*32+(lane&3)*8+(4*hi+((lane&15)>>2))*64;
  const char*Kbase=shm+LDS_K; bf16x8 kf[8];
  const lds_cptr shm3=(lds_cptr)shm; const lds_cptr kp0=shm3+LDS_K+hi*1024+r32*16; const lds_cptr vp0=shm3+LDS_V+((lane>>4)&1)*32+(lane&3)*8+(4*hi+((lane&15)>>2))*64;
  const int NT=(q0+QB)/KVBLK;
  DMA_K(0,0);DMA_M(0);DMA_V(0,0);DMA_K(1,SLOTB);
  bf16x8 qr[4];
  #pragma unroll
  for(int d0=0;d0<4;++d0)qr[d0]=*reinterpret_cast<const bf16x8*>(&Qw[(long)r32*DM+d0*16+hi*8]);
  float mhat=0.f,l_reg=0.f;f32x16 o[2];o[0]=f32x16{};o[1]=f32x16{};f32x16 negm=f32x16{};asm volatile("":"+v"(negm));
  const int qrel=wid*QBLK+r32;
  #define CMASK(P0,P1,t) do{}while(0)
  unsigned ml=0u,mh=0u;
  bool resc=false;
  #define START(P0,P1) do{ const float rm=rowmax(P0,P1); resc=false; \
    { const float dl=rm; mhat=fadd_s(mhat,dl); \
      _Pragma("unroll") for(int r=0;r<16;++r){P0[r]=fsub_s(P0[r],dl);P1[r]=fsub_s(P1[r],dl);} \
      _Pragma("unroll") for(int r=0;r<16;++r)negm[r]=-mhat; asm volatile("":"+v"(negm)); } \
    _Pragma("unroll") for(int r=0;r<16;++r)P0[r]=__builtin_amdgcn_exp2f(P0[r]); }while(0)
  #define RESC() do{ if(resc){ asm volatile("s_waitcnt lgkmcnt(0)":::"memory"); \
      _Pragma("unroll") for(int d_=0;d_<2;++d_) _Pragma("unroll") for(int r=0;r<16;++r)o[d_][r]*=wsf[crow(r,hi)]; } }while(0)
  f32x16 pA0,pA1,pB0,pB1;
  int sl_prev=0,sl_cur=0,sl_next=SLOTB;
  #define ROT() do{sl_prev=sl_cur;sl_cur=sl_next;sl_next=(sl_next==(NSLOT-1)*SLOTB)?0:sl_next+SLOTB;}while(0)
  DMA_K(2,2*SLOTB);DMA_M(1);
  WAIT_BAR(4);
  qkt(pA0,pA1,Kbase,qr,negm,r32,hi);asm volatile("s_nop 15\n\ts_nop 7":"+v"(pA0),"+v"(pA1));CMASK(pA0,pA1,0);
  START(pA0,pA1);
  _Pragma("unroll") for(int r=0;r<16;++r)pA1[r]=__builtin_amdgcn_exp2f(pA1[r]);
  MLOAD(0);
  _Pragma("unroll") for(int r=0;r<16;++r){pA0[r]=mskf(pA0[r],ml,(r&3)+8*(r>>2));pA1[r]=mskf(pA1[r],mh,(r&3)+8*(r>>2));}
  WAIT_BAR(0);
  DMA_K(3,0);DMA_V(1,SLOTB);DMA_M(2);
  ROT();
  kload8(kf,kp0+sl_cur);
  WAIT_BAR(3);
  s16x4 vlo[8],vhi[8]; u32x4 pw0,pw1,pw2,pw3;
  #define PKW(P,B) cvtpk_s(P[B],P[B+1])
  #define PAF(k) __builtin_bit_cast(bf16x8,pw##k)
  #define VFR(i) (bf16x8){vlo[i][0],vlo[i][1],vlo[i][2],vlo[i][3],vhi[i][0],vhi[i][1],vhi[i][2],vhi[i][3]}
  #define PIN(x) asm volatile("":"+v"(x))
  #define MX3(a,b,c) __builtin_fmaxf(__builtin_fmaxf((a),(b)),(c))
  #define GAPA(MF,A0,A1,A2,A3,W0,W1,PW) do{ MF; sacc+=A0; sacc+=A1; sacc+=A2; sacc+=A3; PIN(sacc); W0; W1; PIN(PW); SBAR(); }while(0)
  #define EX(v) __builtin_amdgcn_exp2f(v)
  #define GAPB(MF,X,B,W) do{ MF; X[B]=mskf(EX(X[B]),W,2*(B)); X[B+1]=mskf(EX(X[B+1]),W,2*(B)+1); X[B+2]=mskf(EX(X[B+2]),W,2*(B)+2); X[B+3]=mskf(EX(X[B+3]),W,2*(B)+3); PIN(X); SBAR(); }while(0)
  #define VRD(i) do{ vlo[i]=vtr(vp_+(((i)>>2)*4096+((i)&3)*1024)); vhi[i]=vtr(vp_+(((i)>>2)*4096+((i)&3)*1024+512)); }while(0)
  #define KRD(G,j) do{ if(G){ kload2(kf,kp0+sl_next,j); SBAR(); } }while(0)
  #define STEP(C0,C1,P0,P1,t,GK,GV,GL,GM) do{ SBAR(); \
    const lds_cptr vp_=vp0+sl_prev; \
    VRD(0); SBAR(); float sacc=(P0[0]+P0[1]); \
    GAPA(C0=__builtin_amdgcn_mfma_f32_32x32x16_bf16(kf[0],qr[0],negm,0,0,0), P0[2],P0[3],P0[4],P0[5],     pw0[0]=PKW(P0,0), pw0[1]=PKW(P0,2), pw0); \
    VRD(4); SBAR(); GAPA(C1=__builtin_amdgcn_mfma_f32_32x32x16_bf16(kf[1],qr[0],negm,0,0,0), P0[6],P0[7],P0[8],P0[9],     pw0[2]=PKW(P0,4), pw0[3]=PKW(P0,6), pw0); \
    VRD(1); SBAR(); GAPA(C0=__builtin_amdgcn_mfma_f32_32x32x16_bf16(kf[2],qr[1],C0,0,0,0),   P0[10],P0[11],P0[12],P0[13], pw1[0]=PKW(P0,8), pw1[1]=PKW(P0,10), pw1); \
    VRD(5); SBAR(); GAPA(C1=__builtin_amdgcn_mfma_f32_32x32x16_bf16(kf[3],qr[1],C1,0,0,0),   P0[14],P0[15],P1[0],P1[1],   pw1[2]=PKW(P0,12),pw1[3]=PKW(P0,14), pw1); \
    VRD(2); SBAR(); GAPA(C0=__builtin_amdgcn_mfma_f32_32x32x16_bf16(kf[4],qr[2],C0,0,0,0),   P1[2],P1[3],P1[4],P1[5],     pw2[0]=PKW(P1,0), pw2[1]=PKW(P1,2), pw2); \
    VRD(6); SBAR(); GAPA(C1=__builtin_amdgcn_mfma_f32_32x32x16_bf16(kf[5],qr[2],C1,0,0,0),   P1[6],P1[7],P1[8],P1[9],     pw2[2]=PKW(P1,4), pw2[3]=PKW(P1,6), pw2); \
    VRD(3); SBAR(); GAPA(C0=__builtin_amdgcn_mfma_f32_32x32x16_bf16(kf[6],qr[3],C0,0,0,0),   P1[10],P1[11],P1[12],P1[13], pw3[0]=PKW(P1,8), pw3[1]=PKW(P1,10), pw3); \
    VRD(7); SBAR(); GAPA(C1=__builtin_amdgcn_mfma_f32_32x32x16_bf16(kf[7],qr[3],C1,0,0,0),   P1[14],P1[15],0.f,0.f,       pw3[2]=PKW(P1,12),pw3[3]=PKW(P1,14), pw3); \
    l_reg+=sacc; \
    if(GK){DMA_K((t)+3,sl_cur);} if(GV){DMA_V((t)+1,sl_next);} if(GM){DMA_M((t)+2);} \
    CMASK(C0,C1,t); \
    { float a=MX3(C0[0],C0[1],C1[0]),b=MX3(C0[2],C0[3],C1[1]); a=MX3(a,C1[2],C1[3]); \
      _Pragma("unroll") for(int r=4;r<16;r+=4){a=MX3(a,C0[r],C0[r+1]);b=MX3(b,C0[r+2],C0[r+3]);a=MX3(a,C1[r],C1[r+1]);b=MX3(b,C1[r+2],C1[r+3]);} \
      float rm=__builtin_fmaxf(a,b); { auto rr=__builtin_amdgcn_permlane32_swap(__float_as_uint(rm),__float_as_uint(rm),false,false); rm=__builtin_fmaxf(__uint_as_float(rr[0]),__uint_as_float(rr[1])); } \
      resc=false; \
      if(__builtin_expect(__any(rm>(float)THRL),0)){ const float dl=__builtin_fmaxf(rm,0.f); mhat+=dl; \
        _Pragma("unroll") for(int r=0;r<16;++r){C0[r]-=dl;C1[r]-=dl;} \
        _Pragma("unroll") for(int r=0;r<16;++r)negm[r]=-mhat; asm volatile("":"+v"(negm)); \
        const float f=__builtin_amdgcn_exp2f(-dl); l_reg*=f; if(hi==0)wsf[r32]=f; resc=true; } } \
    MLOAD(t); SBAR(); \
    GAPB(o[0]=__builtin_amdgcn_mfma_f32_32x32x16_bf16(PAF(0),VFR(0),o[0],0,0,0), C0,0,ml); \
    GAPB(o[1]=__builtin_amdgcn_mfma_f32_32x32x16_bf16(PAF(0),VFR(4),o[1],0,0,0), C0,4,ml); \
    KRD(GL,0); GAPB(o[0]=__builtin_amdgcn_mfma_f32_32x32x16_bf16(PAF(1),VFR(1),o[0],0,0,0), C0,8,ml); \
    KRD(GL,1); GAPB(o[1]=__builtin_amdgcn_mfma_f32_32x32x16_bf16(PAF(1),VFR(5),o[1],0,0,0), C0,12,ml); \
    KRD(GL,2); GAPB(o[0]=__builtin_amdgcn_mfma_f32_32x32x16_bf16(PAF(2),VFR(2),o[0],0,0,0), C1,0,mh); \
    KRD(GL,3); GAPB(o[1]=__builtin_amdgcn_mfma_f32_32x32x16_bf16(PAF(2),VFR(6),o[1],0,0,0), C1,4,mh); \
    GAPB(o[0]=__builtin_amdgcn_mfma_f32_32x32x16_bf16(PAF(3),VFR(3),o[0],0,0,0), C1,8,mh); \
    GAPB(o[1]=__builtin_amdgcn_mfma_f32_32x32x16_bf16(PAF(3),VFR(7),o[1],0,0,0), C1,12,mh); \
    }while(0)
  int t=1;
  #undef CMASK
  #define CMASK(P0,P1,t) do{}while(0)
  for(;t+5<NT;t+=2){
    STEP(pB0,pB1,pA0,pA1,t,true,true,true,true);     WAIT_BAR(3); RESC(); ROT();
    STEP(pA0,pA1,pB0,pB1,t+1,true,true,true,true);   WAIT_BAR(3); RESC(); ROT();
  }
  #undef CMASK
  #define CMASK(P0,P1,t) do{}while(0)
  #define ENDW(tt) do{ if((tt)+3<NT){WAIT_BAR(3);} else if((tt)+2<NT){WAIT_BAR(2);} else {WAIT_BAR(0);} }while(0)
  for(;t+1<NT;t+=2){
    STEP(pB0,pB1,pA0,pA1,t,(t+3<NT),(t+1<NT),(t+1<NT),(t+2<NT));       ENDW(t);   RESC(); ROT();
    STEP(pA0,pA1,pB0,pB1,t+1,(t+4<NT),(t+2<NT),(t+2<NT),(t+3<NT));     ENDW(t+1); RESC(); ROT();
  }
  STEP(pB0,pB1,pA0,pA1,NT-1,false,false,false,false); RESC();
  { float sacc=pB0[0]+pB0[1]; _Pragma("unroll") for(int r=2;r<16;++r)sacc+=pB0[r]; _Pragma("unroll") for(int r=0;r<16;++r)sacc+=pB1[r]; l_reg+=sacc;
    pw0=(u32x4){PKW(pB0,0),PKW(pB0,2),PKW(pB0,4),PKW(pB0,6)};pw1=(u32x4){PKW(pB0,8),PKW(pB0,10),PKW(pB0,12),PKW(pB0,14)};pw2=(u32x4){PKW(pB1,0),PKW(pB1,2),PKW(pB1,4),PKW(pB1,6)};pw3=(u32x4){PKW(pB1,8),PKW(pB1,10),PKW(pB1,12),PKW(pB1,14)};
    SBAR(); pv(o,vb0+sl_cur,PAF(0),PAF(1),PAF(2),PAF(3)); }
  #undef PKW
  #undef PAF
  #undef VFR
  #undef PIN
  #undef MX3
  #undef GAPA
  #undef GAPB
  #undef EX
  #undef VRD
  #undef KRD
  #undef STEP
  #undef ENDW
  {auto rr=__builtin_amdgcn_permlane32_swap(__float_as_uint(l_reg),__float_as_uint(l_reg),false,false);l_reg=__uint_as_float(rr[0])+__uint_as_float(rr[1]);}
  if(hi==0)wsf[32+r32]=l_reg;asm volatile("s_waitcnt lgkmcnt(0)":::"memory");
  float rli[16];
  #pragma unroll
  for(int r=0;r<16;++r)rli[r]=__builtin_amdgcn_rcpf(wsf[32+crow(r,hi)]);
  bf16*Ow=O+(rowbase+q0+wid*QBLK)*OPITCH+h*D;
  { bf16*stg=(bf16*)(shm+LDS_OST)+wid*2048;
    #pragma unroll
    for(int r=0;r<16;++r){const int orow=crow(r,hi);
      #pragma unroll
      for(int d0=0;d0<2;++d0)stg[orow*64+d0*32+r32]=(bf16)f2bf(o[d0][r]*rli[r]);}
    asm volatile("s_waitcnt lgkmcnt(0)":::"memory");
    #pragma unroll
    for(int i=0;i<4;++i){const int row=i*8+(lane>>3),ch=lane&7; const u32x4 v=*(const u32x4*)(stg+row*64+ch*8); ATTN_STORE16(Ow+(long)row*OPITCH+ch*8,v);} }
  asm volatile("s_waitcnt lgkmcnt(0)\n\ts_barrier":::"memory");
  #undef DMA_K
  #undef DMA_V
  #undef DMA_M
  #undef MLOAD
  #undef CMASK
  #undef START
  #undef RESC
  #undef ROT
}
constexpr int ATTN_LDS_BYTES=LDS_BYTES;
struct AttnTensors { const bf16* Q; const bf16* K; const bf16* V; bf16* O; const unsigned char* MK; };
struct AttnUnit { int bh; int qb; };
struct StaticOrder {
  int vcu;
  __device__ __forceinline__ explicit StaticOrder(int grid,int block):vcu((block%8)*(grid/8)+block/8){}
  __device__ __forceinline__ bool next(int i,AttnUnit&u)const{ if(i>=4)return false; const int s=vcu&7; u.bh=vcu>>3; u.qb=(i==0)?s:(i==1)?15-s:(i==2)?16+s:31-s; return true; }
  __device__ __forceinline__ void a_ready(const AttnUnit&)const{}
  __device__ __forceinline__ void done(const AttnUnit&)const{}
};
template<class Sched,int THRL=8> __device__ __forceinline__ void attn_phase(char*lds,const AttnTensors&T,const Sched&S){
  AttnUnit u;
  for(int i=0;S.next(i,u);++i){ S.a_ready(u); attn_unit<THRL>(u.bh/NHEAD,u.bh%NHEAD,u.qb,T.Q,T.K,T.V,T.O,T.MK,lds); S.done(u); }
}
#undef SBAR
#undef WAIT_BAR
}

struct Args { const void* in[15]; float* out; unsigned char* ws; int ph_lo, ph_hi; };
#define CAS __attribute__((address_space(4)))
struct Frame {
    LAS unsigned char* lds;
    gu32* ctl;
    unsigned char* ws;
    int tid, lane, wave;
    int vcu, G;
    const CAS Args* ka;
    __device__ __forceinline__ const float* inp(int k) const { return (const float*)ka->in[k]; }
#define FDEF(name, k) __device__ __forceinline__ const float* name() const { return inp(k); }
    FDEF(x, 0) FDEF(c, 1) FDEF(w_ada, 3) FDEF(b_ada, 4) FDEF(g_mix, 5) FDEF(w_in, 6) FDEF(w_o, 7) FDEF(g_ffn, 8) FDEF(w_rg, 9) FDEF(w_re, 10) FDEF(w_up, 11) FDEF(w_gate, 12) FDEF(w_down, 13) FDEF(g_fin, 14)
#undef FDEF
    __device__ __forceinline__ const int* pos() const { return (const int*)ka->in[2]; }
    __device__ __forceinline__ float* out() const { return ka->out; }
};

__device__ __forceinline__ void tr_put(LAS unsigned* T, int nb, int ns, int p, const f32x4 a, const f32x4 b) {
    T[(nb) * 33 + p] = pg8::cvt_pk_bf16(a.x, b.x); T[(nb + ns) * 33 + p] = pg8::cvt_pk_bf16(a.y, b.y);
    T[(nb + 2 * ns) * 33 + p] = pg8::cvt_pk_bf16(a.z, b.z); T[(nb + 3 * ns) * 33 + p] = pg8::cvt_pk_bf16(a.w, b.w);
}
__device__ __forceinline__ void tr_store(LAS unsigned* T, bf16* WT, int K, int n0, int k0, int lane) {
    LDS_WAIT(); asm volatile("" ::: "memory");
#pragma unroll
    for (int i = 0; i < 8; ++i) { const int n = (lane >> 3) + 8 * i, kc = lane & 7; const LAS unsigned* t = T + n * 33 + 4 * kc;
        v4u o; o.x = t[0]; o.y = t[1]; o.z = t[2]; o.w = t[3];
        *(GAS v4u*)(WT + (size_t)(n0 + n) * K + k0 + 8 * kc) = o; }
    LDS_WAIT(); asm volatile("" ::: "memory");
}
__device__ __forceinline__ void tr_tile_gu(const float* gate, const float* up, bf16* WT, int n0, int k0, LAS unsigned* T, int lane) {
    const int pq = lane >> 3, cq = lane & 7, c0 = n0 >> 1;
    f32x4 g0[4], g1[4], u0[4], u1[4];
#pragma unroll
    for (int i = 0; i < 4; ++i) { const int p = pq + 8 * i; const size_t o = (size_t)(k0 + 2 * p) * DEXP + c0 + 4 * cq;
        g0[i] = *(const GAS f32x4*)(gate + o); g1[i] = *(const GAS f32x4*)(gate + o + DEXP); u0[i] = *(const GAS f32x4*)(up + o); u1[i] = *(const GAS f32x4*)(up + o + DEXP); }
#pragma unroll
    for (int i = 0; i < 4; ++i) { const int p = pq + 8 * i; tr_put(T, 8 * cq, 2, p, g0[i], g1[i]); tr_put(T, 8 * cq + 1, 2, p, u0[i], u1[i]); }
    tr_store(T, WT, 1024, n0, k0, lane);
}
__device__ __forceinline__ void tr_tile_d(const float* wd, bf16* WT, int n0, int k0, LAS unsigned* T, int lane) {
    const int pq = lane >> 4, cq = lane & 15;
    f32x4 a[8], b[8];
#pragma unroll
    for (int i = 0; i < 8; ++i) { const int p = pq + 4 * i; const size_t o = (size_t)(k0 + 2 * p) * D + n0 + 4 * cq; a[i] = *(const GAS f32x4*)(wd + o); b[i] = *(const GAS f32x4*)(wd + o + D); }
#pragma unroll
    for (int i = 0; i < 8; ++i) { const int p = pq + 4 * i; tr_put(T, 4 * cq, 1, p, a[i], b[i]); }
    tr_store(T, WT, 512, n0, k0, lane);
}

template <class SrcFn>
__device__ __forceinline__ void tr_tile_gen(const SrcFn& src, int ldw, bf16* WT, int K, int n0, int k0, LAS unsigned* T, int lane) {
    const int pq = lane >> 4, cq = lane & 15; const float* sp = src(n0 + 4 * cq);
    f32x4 a[8], b[8];
#pragma unroll
    for (int i = 0; i < 8; ++i) { const int p = pq + 4 * i;
        if (sp) { a[i] = *(const GAS f32x4*)(sp + (size_t)(k0 + 2 * p) * ldw); b[i] = *(const GAS f32x4*)(sp + (size_t)(k0 + 2 * p + 1) * ldw); }
        else { a[i] = (f32x4){0.f, 0.f, 0.f, 0.f}; b[i] = a[i]; } }
#pragma unroll
    for (int i = 0; i < 8; ++i) { const int p = pq + 4 * i; tr_put(T, 4 * cq, 1, p, a[i], b[i]); }
    tr_store(T, WT, K, n0, k0, lane);
}

__device__ __forceinline__ int prope_dim(int p) { return p < 16 ? 8 * ((p >> 2) & 1) + 4 * (p >> 3) + (p & 3) : p; }
__device__ __forceinline__ int rrope_dim(int p) { return 32 * ((p >> 2) & 1) + 4 * (p >> 3) + (p & 3); }
__device__ __forceinline__ int win_src_col(int n) {
    if (n < 1024) return (n & ~63) + prope_dim(n & 63);
    if (n < 1536) return n;
    if (n < 2560) return (n & ~63) + prope_dim(n & 63);
    if (n < 3584) { const int q = n - 2560, sec = q >> 9, hd = (q >> 6) & 7; return (sec ? 3152 : 2640) + hd * 64 + rrope_dim(q & 63); }
    if (n < 4096) return 3664 + (n - 3584);
    if (n < 4608) return 4176 + (n - 4096);
    if (n < 4672) return 2560 + prope_dim(n - 4608);
    if (n < 4688) return 2624 + (n - 4672);
    return -1;
}

__device__ __forceinline__ void p0_prologue(Frame& F) {
    const int gw = F.vcu * NWAVES + F.wave, NGW = F.G * NWAVES;
    float* modp = (float*)(F.ws + WS_MODP);
    for (int rp2 = 0; rp2 < SUBREPS(20); ++rp2)
    for (int task = gw; task < 24 * 16; task += NGW) {
        const int cg = task % 24, ks = task / 24, j0 = cg * 256 + F.lane * 4;
        f32x4 a0 = {0, 0, 0, 0}, a1 = a0, a2 = a0, a3 = a0;
#pragma unroll 8
        for (int kk = 0; kk < 64; ++kk) { const int k = ks * 64 + kk; const f32x4 w = *(const GAS f32x4*)(F.w_ada() + (size_t)k * 6144 + j0);
            a0 += w * F.c()[0 * D + k]; a1 += w * F.c()[1 * D + k]; a2 += w * F.c()[2 * D + k]; a3 += w * F.c()[3 * D + k]; }
        *(GAS f32x4*)(modp + ((size_t)(ks * 4 + 0) * 6144 + j0)) = a0; *(GAS f32x4*)(modp + ((size_t)(ks * 4 + 1) * 6144 + j0)) = a1;
        *(GAS f32x4*)(modp + ((size_t)(ks * 4 + 2) * 6144 + j0)) = a2; *(GAS f32x4*)(modp + ((size_t)(ks * 4 + 3) * 6144 + j0)) = a3;
    }
    {
        float* c1 = (float*)(F.ws + WS_ROPE1); float* s1 = c1 + (size_t)M * 8;
        float* c2 = (float*)(F.ws + WS_ROPE2); float* s2 = c2 + (size_t)M * 32;
        const int gt = (F.vcu * NWAVES + F.wave) * 64 + F.lane, NGT = NGW * 64;
        for (int rp2 = 0; rp2 < SUBREPS(18); ++rp2)
        for (int i = gt; i < M * 40; i += NGT) {
            const int m = i / 40, j = i % 40; const float p = (float)F.pos()[m];
            if (j < 8) { const float inv = powf(500000.0f, -(float)j / 8.0f); float sn, cs; sincosf(p * inv, &sn, &cs); c1[m * 8 + j] = cs; s1[m * 8 + j] = sn; }
            else { const int jj = j - 8; const float inv = powf(10000.0f, -(float)jj / 32.0f); float sn, cs; sincosf(p * inv, &sn, &cs); c2[m * 32 + jj] = cs; s2[m * 32 + jj] = sn; }
        }
    }
    {
        constexpr int I_IN = (NPAD / 64) * (D / 64), I_O = (D / 64) * (D / 64);
        bf16* wint = (bf16*)(F.ws + WS_WIN); bf16* wot = (bf16*)(F.ws + WS_WO);
        const float* w_in = F.w_in(); const float* w_o = F.w_o();
        LAS unsigned* T = (LAS unsigned*)(F.lds + F.wave * 16384);
        for (int rp2 = 0; rp2 < SUBREPS(19); ++rp2)
        for (int it = gw; it < I_IN + I_O; it += NGW) {
            if (it < I_IN) { const int nb = it / 16, kb = it % 16;
                tr_tile_gen([&](int n) -> const float* { const int sc = win_src_col(n); return sc < 0 ? nullptr : w_in + sc; }, DIN, wint, D, nb * 64, kb * 64, T, F.lane); }
            else { const int r = it - I_IN, nb = r / 16, kb = r % 16;
                tr_tile_gen([&](int n) -> const float* { return w_o + n; }, D, wot, D, nb * 64, kb * 64, T, F.lane); }
        }
    }
}

__device__ __forceinline__ float mod_value(const float* modp, const float* b_ada, int b, int j) {
    float s = 0.f;
#pragma unroll
    for (int ks = 0; ks < 16; ++ks) s += modp[(size_t)(ks * 4 + b) * 6144 + j];
    return s + b_ada[j];
}
__device__ __forceinline__ void p1_norm(Frame& F) {
    const float* modp = (const float*)(F.ws + WS_MODP);
    LAS float* G1 = (LAS float*)F.lds;
    LAS float* S1 = G1 + 4 * D;
    for (int i = F.tid; i < 4 * D; i += NWAVES * 64) { const int b = i >> 10, col = i & 1023;
        const float sh = mod_value(modp, F.b_ada(), b, col), sc = mod_value(modp, F.b_ada(), b, 1024 + col);
        G1[i] = F.g_mix()[col] * (1.f + sc); S1[i] = sh; }
    if (blockIdx.x < 4) { float* mod = (float*)(F.ws + WS_MOD); const int b = blockIdx.x;
        for (int j = F.tid; j < 6144; j += NWAVES * 64) mod[b * 6144 + j] = mod_value(modp, F.b_ada(), b, j); }
    __syncthreads();
    const int gw = F.vcu * NWAVES + F.wave, NGW = F.G * NWAVES;
    bf16* H = (bf16*)(F.ws + WS_H);
    f32x4 nv[4];
    if (gw < M) { const GAS f32x4* xr = (const GAS f32x4*)(F.x() + (size_t)gw * D) + F.lane;
#pragma unroll
        for (int j = 0; j < 4; ++j) nv[j] = xr[64 * j]; }
    for (int m = gw; m < M; m += NGW) {
        const int b = m >> 13;
        f32x4 v[4]; float s = 0.f;
#pragma unroll
        for (int j = 0; j < 4; ++j) v[j] = nv[j];
        if (m + NGW < M) { const GAS f32x4* xr = (const GAS f32x4*)(F.x() + (size_t)(m + NGW) * D) + F.lane;
#pragma unroll
            for (int j = 0; j < 4; ++j) nv[j] = xr[64 * j]; }
#pragma unroll
        for (int j = 0; j < 4; ++j) s += (v[j].x * v[j].x + v[j].y * v[j].y) + (v[j].z * v[j].z + v[j].w * v[j].w);
        const float r = 1.f / sqrtf(wave_sum(s) * (1.f / D) + EPS);
        GAS unsigned long long* o8 = (GAS unsigned long long*)(H + (size_t)m * D) + F.lane;
#pragma unroll
        for (int j = 0; j < 4; ++j) { const int col = 4 * F.lane + 256 * j; const f32x4 g = *(const LAS f32x4*)(G1 + b * D + col), sh = *(const LAS f32x4*)(S1 + b * D + col);
            const f32x4 h = v[j] * r * g + sh;
            o8[64 * j] = (unsigned long long)pk2(h.x, h.y) | ((unsigned long long)pk2(h.z, h.w) << 32); }
    }
    __syncthreads();
}

struct EpiInProj {
    static constexpr bool PERM = true;
    unsigned char* ws;
    __device__ __forceinline__ void operator()(f32x4 (&acc)[2][2][4][2], const pg8::Unit& u, int wr, int wc, int fr, int fq) const {
        const int pn = u.pn; const int row0 = u.pm * 256 + wr * 64 + fr;
        const bool prope = (pn < 4) || (pn >= 6 && pn < 10) || (pn == 18);
        const bool rrope = (pn >= 10 && pn < 14);
        const bool roped = rrope || (prope && (wc & 1) == 0 && !(pn == 18 && wc != 0));
        const int g = 4 * (wc & 1) + fq;
        const bool act = rrope || (fq < 2);
        const int tl = rrope ? 32 : 8;
        const float* ct = (const float*)(ws + (rrope ? WS_ROPE2 : WS_ROPE1)) + 4 * (act ? g : 0); const float* stb = ct + (size_t)M * tl;
        bf16* base; int ld, colt; float sc = 1.f;
        if (pn < 2) { base = (bf16*)(ws + WS_QA); ld = 512; colt = pn * 256; sc = C2; }
        else if (pn < 4) { base = (bf16*)(ws + WS_KA); ld = 512; colt = (pn - 2) * 256; }
        else if (pn < 6) { base = (bf16*)(ws + WS_VA); ld = 512; colt = (pn - 4) * 256; }
        else if (pn < 10) { base = (bf16*)(ws + WS_QI); ld = 1024; colt = (pn - 6) * 256; }
        else if (pn < 12) { base = (bf16*)(ws + WS_QB); ld = 512; colt = (pn - 10) * 256; }
        else if (pn < 14) { base = (bf16*)(ws + WS_KB); ld = 512; colt = (pn - 12) * 256; sc = 0.125f; }
        else if (pn < 16) { base = (bf16*)(ws + WS_VB); ld = 512; colt = (pn - 14) * 256; }
        else if (pn < 18) { base = (bf16*)(ws + WS_GB); ld = 512; colt = (pn - 16) * 256; }
        else { base = (bf16*)(ws + WS_KI); ld = 64; colt = 0; }
        int colA[2], colB[2];
#pragma unroll
        for (int bj = 0; bj < 2; ++bj) { const int col = bj * 128 + wc * 32 + 8 * fq, hb = col & ~63;
            if (rrope) { colA[bj] = hb + 4 * g; colB[bj] = hb + 32 + 4 * g; }
            else if (prope && (wc & 1) == 0 && fq < 2 && !(pn == 18 && wc != 0)) { colA[bj] = hb + 4 * g; colB[bj] = hb + 8 + 4 * g; }
            else { colA[bj] = col; colB[bj] = col + 4; } }
        float* wi = (float*)(ws + WS_WI);
        f32x4 cnx = {0.f, 0.f, 0.f, 0.f}, snx = cnx;
        if (roped) { cnx = *(const GAS f32x4*)(ct + (size_t)row0 * tl); snx = *(const GAS f32x4*)(stb + (size_t)row0 * tl); }
#pragma unroll
        for (int ai = 0; ai < 2; ++ai)
#pragma unroll
            for (int m = 0; m < 4; ++m) { const int row = row0 + ai * 128 + m * 16;
                if (roped) {
                    const f32x4 cs = cnx, sn = snx;
                    if (!(ai == 1 && m == 3)) { const int rn = row0 + ((m == 3) ? 128 : ai * 128 + (m + 1) * 16);
                        cnx = *(const GAS f32x4*)(ct + (size_t)rn * tl); snx = *(const GAS f32x4*)(stb + (size_t)rn * tl); }
#pragma unroll
                    for (int bj = 0; bj < 2; ++bj) { const f32x4 x1 = acc[ai][bj][m][0], x2 = acc[ai][bj][m][1];
                        if (act) { acc[ai][bj][m][0] = x1 * cs - x2 * sn; acc[ai][bj][m][1] = x2 * cs + x1 * sn; } }
                }
                if (pn < 18) {
#pragma unroll
                    for (int bj = 0; bj < 2; ++bj) {
                        const f32x4 v0 = acc[ai][bj][m][0] * sc, v1 = acc[ai][bj][m][1] * sc; v2u wa, wb;
                        wa.x = pg8::cvt_pk_bf16(v0[0], v0[1]); wa.y = pg8::cvt_pk_bf16(v0[2], v0[3]); wb.x = pg8::cvt_pk_bf16(v1[0], v1[1]); wb.y = pg8::cvt_pk_bf16(v1[2], v1[3]);
                        bf16* rp = base + (size_t)row * ld + colt;
                        *(GAS v2u*)(rp + colA[bj]) = wa; *(GAS v2u*)(rp + colB[bj]) = wb; }
                } else {
                    const int col = wc * 32 + 8 * fq;
                    const f32x4 v0 = acc[ai][0][m][0], v1 = acc[ai][0][m][1];
                    if (col < 64) { v2u wa, wb; wa.x = pg8::cvt_pk_bf16(v0[0], v0[1]); wa.y = pg8::cvt_pk_bf16(v0[2], v0[3]); wb.x = pg8::cvt_pk_bf16(v1[0], v1[1]); wb.y = pg8::cvt_pk_bf16(v1[2], v1[3]);
                        *(GAS v2u*)(base + (size_t)row * 64 + colA[0]) = wa; *(GAS v2u*)(base + (size_t)row * 64 + colB[0]) = wb; }
                    else if (col < 80) { *(GAS f32x4*)(wi + (size_t)row * 16 + (col - 64)) = v0 * 0.25f; *(GAS f32x4*)(wi + (size_t)row * 16 + (col - 64) + 4) = v1 * 0.25f; }
                }
                asm volatile("" ::: "memory");
            }
    }
};

struct EpiOutProj {
    static constexpr bool PERM = true;
    bf16* mix; const float* mod;
    __device__ __forceinline__ void operator()(f32x4 (&acc)[2][2][4][2], const pg8::Unit& u, int wr, int wc, int fr, int fq) const {
        const int row0 = u.pm * 256 + wr * 64 + fr; const int b = (u.pm * 256) >> 13;
#pragma unroll
        for (int bj = 0; bj < 2; ++bj) { const int col = u.pn * 256 + bj * 128 + wc * 32 + 8 * fq;
            const f32x4 g0 = *(const GAS f32x4*)(mod + b * 6144 + 2048 + col), g1 = *(const GAS f32x4*)(mod + b * 6144 + 2048 + col + 4);
#pragma unroll
            for (int ai = 0; ai < 2; ++ai)
#pragma unroll
                for (int m = 0; m < 4; ++m) { const f32x4 v0 = acc[ai][bj][m][0] * g0, v1 = acc[ai][bj][m][1] * g1; v4u w;
                    w.x = pg8::cvt_pk_bf16(v0[0], v0[1]); w.y = pg8::cvt_pk_bf16(v0[2], v0[3]); w.z = pg8::cvt_pk_bf16(v1[0], v1[1]); w.w = pg8::cvt_pk_bf16(v1[2], v1[3]);
                    *(GAS v4u*)(mix + (size_t)(row0 + ai * 128 + m * 16) * D + col) = w; } }
    }
};

__device__ __forceinline__ float ret_log_gamma(int h) { return log1pf(-exp2f(-5.0f - (float)h)); }
__device__ __forceinline__ int crow(int r, int hi) { return (r & 3) + 8 * (r >> 2) + 4 * hi; }

typedef short v4i16_t __attribute__((ext_vector_type(4)));
constexpr size_t WS_TOT = WS_MASK;
constexpr size_t WS_CARRY = WS_MASK + 8 * MiB;
__device__ __forceinline__ void ra_states(Frame& F) {
    const bf16* KB = (const bf16*)(F.ws + WS_KB); const bf16* VB = (const bf16*)(F.ws + WS_VB);
    float* ST = (float*)(F.ws + WS_ST); float* TOT = (float*)(F.ws + WS_TOT);
    const int lane = F.lane, r32 = lane & 31, hi = lane >> 5, gi = lane & 15, gg = lane >> 4, wave = F.wave;
    const int half = wave >> 2, et = (wave >> 1) & 1, dt = wave & 1, ht = F.tid & 255;
    for (int unit = F.vcu; unit < 256; unit += F.G) {
        const int bh = unit >> 3, h = bh & 7, b = bh >> 3, c0 = (unit & 7) * 16 + half * 8;
        const float lg = ret_log_gamma(h), g = __expf(64.f * lg);
        f32x16 acc = f32x16{};
        const int offA = (((gi >> 2) + 8 * hi) * 64 + 32 * et + 16 * (gg & 1) + 4 * (gi & 3)) * 2;
        const int offB = (((gi >> 2) + 8 * hi) * 64 + 32 * dt + 16 * (gg & 1) + 4 * (gi & 3)) * 2;
        v4u nk[2], nvv[2];
#define RA_LOAD(cc) do { const size_t t0_ = (size_t)b * SEQ + (size_t)(cc) * 64; _Pragma("unroll") for (int p = 0; p < 2; ++p) { const int idx = ht + 256 * p, row = idx >> 3, q = idx & 7; \
            nk[p] = *(const GAS v4u*)(KB + (t0_ + row) * 512 + h * 64 + q * 8); nvv[p] = *(const GAS v4u*)(VB + (t0_ + row) * 512 + h * 64 + q * 8); } } while (0)
        RA_LOAD(c0);
#pragma unroll 1
        for (int i = 0; i < 8; ++i) {
            const int c = c0 + i;
            LAS unsigned short* Ks = (LAS unsigned short*)(F.lds + (half * 2 + (i & 1)) * 16384);
            LAS unsigned short* Vs = Ks + 4096;
#pragma unroll
            for (int p = 0; p < 2; ++p) { const int idx = ht + 256 * p, row = idx >> 3, q = idx & 7;
                v4u kk = nk[p]; const float z = __expf((63.f - (float)row) * lg); unsigned* kw = (unsigned*)&kk;
#pragma unroll
                for (int e = 0; e < 4; ++e) kw[e] = pg8::cvt_pk_bf16(bf2f((unsigned short)(kw[e] & 0xffff)) * z, bf2f((unsigned short)(kw[e] >> 16)) * z);
                *(LAS v4u*)(Ks + row * 64 + q * 8) = kk; *(LAS v4u*)(Vs + row * 64 + q * 8) = nvv[p]; }
            if (i < 7) RA_LOAD(c + 1);
            { float* st = ST + ((size_t)bh * 128 + c) * 4096;
#pragma unroll
                for (int r = 0; r < 16; ++r) st[(32 * et + crow(r, hi)) * 64 + 32 * dt + r32] = acc[r]; }
#pragma unroll
            for (int r = 0; r < 16; ++r) acc[r] *= g;
            __syncthreads();
#pragma unroll
            for (int ks = 0; ks < 4; ++ks) {
                const LAS unsigned char* va = (const LAS unsigned char*)Vs + offA + ks * 16 * 64 * 2; const LAS unsigned char* kb = (const LAS unsigned char*)Ks + offB + ks * 16 * 64 * 2;
                const v4i16_t a0 = __builtin_amdgcn_ds_read_tr16_b64_v4i16((LAS v4i16_t*)va), a1 = __builtin_amdgcn_ds_read_tr16_b64_v4i16((LAS v4i16_t*)(va + 4 * 64 * 2));
                const v4i16_t b0 = __builtin_amdgcn_ds_read_tr16_b64_v4i16((LAS v4i16_t*)kb), b1 = __builtin_amdgcn_ds_read_tr16_b64_v4i16((LAS v4i16_t*)(kb + 4 * 64 * 2));
                acc = __builtin_amdgcn_mfma_f32_32x32x16_bf16((bf16x8){a0[0], a0[1], a0[2], a0[3], a1[0], a1[1], a1[2], a1[3]}, (bf16x8){b0[0], b0[1], b0[2], b0[3], b1[0], b1[1], b1[2], b1[3]}, acc, 0, 0, 0); }
        }
#undef RA_LOAD
        { float* tt = TOT + ((size_t)bh * 16 + (unit & 7) * 2 + half) * 4096;
#pragma unroll
            for (int r = 0; r < 16; ++r) tt[(32 * et + crow(r, hi)) * 64 + 32 * dt + r32] = acc[r]; }
        __syncthreads();
    }
}
__device__ __forceinline__ void rb_carry(Frame& F) {
    const float* TOT = (const float*)(F.ws + WS_TOT); float* CAR = (float*)(F.ws + WS_CARRY);
    const int gt = (F.vcu * NWAVES + F.wave) * 64 + F.lane, NGT = F.G * NWAVES * 64;
    for (int i = gt; i < 32 * 4096; i += NGT) {
        const int bh = i >> 12, el = i & 4095, h = bh & 7;
        const float g8 = __expf(512.f * ret_log_gamma(h));
        const float* p = TOT + (size_t)bh * 16 * 4096 + el; float* q = CAR + (size_t)bh * 16 * 4096 + el; float run = 0.f;
#pragma unroll
        for (int gI = 0; gI < 16; ++gI) { const float t = p[(size_t)gI * 4096]; q[(size_t)gI * 4096] = run; run = run * g8 + t; }
    }
}
__device__ __forceinline__ void r3_out(Frame& F) {
    const int gw = F.vcu * NWAVES + F.wave, NGW = F.G * NWAVES;
    LAS unsigned short* Vs = (LAS unsigned short*)(F.lds + F.wave * 8192);
    const bf16* QB = (const bf16*)(F.ws + WS_QB); const bf16* KB = (const bf16*)(F.ws + WS_KB); const bf16* VB = (const bf16*)(F.ws + WS_VB); const bf16* GB = (const bf16*)(F.ws + WS_GB);
    const float* ST = (const float*)(F.ws + WS_ST); const float* CAR = (const float*)(F.ws + WS_CARRY); bf16* Y = (bf16*)(F.ws + WS_Y);
    const int lane = F.lane, r32 = lane & 31, hi = lane >> 5, gi = lane & 15, gg = lane >> 4;
    const bool lcar = (F.G == 256);
    LAS float* CL = (LAS float*)(F.lds + 65536);
    if (lcar) { const float* TOT = (const float*)(F.ws + WS_TOT); const int grp = F.vcu & 15;
#pragma unroll 1
        for (int it = 0; it < 2; ++it) { const int bh = (F.vcu >> 4) + 16 * it; const float g8 = __expf(512.f * ret_log_gamma(bh & 7));
            f32x4 r0 = {0.f, 0.f, 0.f, 0.f}, r1 = r0; const float* tp = TOT + (size_t)bh * 16 * 4096 + F.tid * 8;
#pragma unroll 1
            for (int g2 = 0; g2 < grp; ++g2) { r0 = r0 * g8 + *(const GAS f32x4*)(tp + (size_t)g2 * 4096); r1 = r1 * g8 + *(const GAS f32x4*)(tp + (size_t)g2 * 4096 + 4); }
            *(LAS f32x4*)(CL + it * 4096 + F.tid * 8) = r0; *(LAS f32x4*)(CL + it * 4096 + F.tid * 8 + 4) = r1; }
        __syncthreads(); }
    int pass = 0;
    const int vtr_off = (((gi >> 2) + 4 * hi) * 64 + 16 * (gg & 1) + 4 * (gi & 3)) * 2;
    for (int u = gw; u < NB * 8 * 128; u += NGW) {
        const int c = u & 127, h = (u >> 7) & 7, b = u >> 10;
        const float lg = ret_log_gamma(h), gpc = __expf(64.f * (float)(c & 7) * lg);
        const size_t tok0 = (size_t)b * SEQ + (size_t)c * 64;
        { const GAS v4u* vp = (const GAS v4u*)(VB + (tok0 + lane) * 512 + h * 64);
#pragma unroll
            for (int q = 0; q < 8; ++q) *(LAS v4u*)(Vs + lane * 64 + q * 8) = vp[q]; }
        bf16x8 qf[2][4], pf[2][4];
#pragma unroll
        for (int t = 0; t < 2; ++t)
#pragma unroll
            for (int ks = 0; ks < 4; ++ks) {
                qf[t][ks] = *(const GAS bf16x8*)(QB + (tok0 + 32 * t + r32) * 512 + h * 64 + 16 * ks + 8 * hi);
                const float* sp = ST + (size_t)u * 4096 + (32 * t + r32) * 64 + 16 * ks + 8 * hi;
                const int co = (32 * t + r32) * 64 + 16 * ks + 8 * hi; f32x4 c0, c1;
                if (lcar) { c0 = *(const LAS f32x4*)(CL + pass * 4096 + co); c1 = *(const LAS f32x4*)(CL + pass * 4096 + co + 4); }
                else { const float* cp = CAR + ((size_t)(u >> 7) * 16 + (c >> 3)) * 4096 + co; c0 = *(const GAS f32x4*)cp; c1 = *(const GAS f32x4*)(cp + 4); }
                const f32x4 s0 = *(const GAS f32x4*)sp + c0 * gpc, s1 = *(const GAS f32x4*)(sp + 4) + c1 * gpc;
                v4u w; w.x = pg8::cvt_pk_bf16(s0.x, s0.y); w.y = pg8::cvt_pk_bf16(s0.z, s0.w); w.z = pg8::cvt_pk_bf16(s1.x, s1.y); w.w = pg8::cvt_pk_bf16(s1.z, s1.w);
                pf[t][ks] = __builtin_bit_cast(bf16x8, w); }
        float emr[16];
#pragma unroll
        for (int r = 0; r < 16; ++r) emr[r] = __expf(-(float)crow(r, hi) * lg);
        const float em32 = __expf(-32.f * lg);
        LDS_WAIT(); asm volatile("" ::: "memory");
#pragma unroll
        for (int nt = 0; nt < 2; ++nt) {
            const int n = 32 * nt + r32;
            const float en = __expf((float)n * lg), xi = __expf((float)(n + 1) * lg);
            f32x16 y[2]; y[0] = f32x16{}; y[1] = f32x16{};
#pragma unroll
            for (int et = 0; et < 2; ++et)
#pragma unroll
                for (int ks = 0; ks < 4; ++ks) y[et] = __builtin_amdgcn_mfma_f32_32x32x16_bf16(pf[et][ks], qf[nt][ks], y[et], 0, 0, 0);
#pragma unroll
            for (int r = 0; r < 16; ++r) { y[0][r] *= xi; y[1][r] *= xi; }
#pragma unroll
            for (int mt = 0; mt <= nt; ++mt) {
                f32x16 st = f32x16{};
#pragma unroll
                for (int ks = 0; ks < 4; ++ks) { const bf16x8 kf = *(const GAS bf16x8*)(KB + (tok0 + 32 * mt + r32) * 512 + h * 64 + 16 * ks + 8 * hi);
                    st = __builtin_amdgcn_mfma_f32_32x32x16_bf16(kf, qf[nt][ks], st, 0, 0, 0); }
                const float enm = mt ? en * em32 : en;
#pragma unroll
                for (int r = 0; r < 16; ++r) { const int m = 32 * mt + crow(r, hi); st[r] = (n >= m) ? st[r] * (enm * emr[r]) : 0.f; }
#pragma unroll
                for (int s2 = 0; s2 < 2; ++s2) {
                    v4u pw; pw.x = pg8::cvt_pk_bf16(st[8 * s2 + 0], st[8 * s2 + 1]); pw.y = pg8::cvt_pk_bf16(st[8 * s2 + 2], st[8 * s2 + 3]); pw.z = pg8::cvt_pk_bf16(st[8 * s2 + 4], st[8 * s2 + 5]); pw.w = pg8::cvt_pk_bf16(st[8 * s2 + 6], st[8 * s2 + 7]);
                    const bf16x8 pb = __builtin_bit_cast(bf16x8, pw);
#pragma unroll
                    for (int et = 0; et < 2; ++et) {
                        const LAS unsigned char* vb = (const LAS unsigned char*)Vs + vtr_off + ((32 * mt + 16 * s2) * 64 + 32 * et) * 2;
                        const v4i16_t lo = __builtin_amdgcn_ds_read_tr16_b64_v4i16((LAS v4i16_t*)vb), hh = __builtin_amdgcn_ds_read_tr16_b64_v4i16((LAS v4i16_t*)(vb + 8 * 64 * 2));
                        const bf16x8 va = (bf16x8){lo[0], lo[1], lo[2], lo[3], hh[0], hh[1], hh[2], hh[3]};
                        y[et] = __builtin_amdgcn_mfma_f32_32x32x16_bf16(va, pb, y[et], 0, 0, 0); }
                }
            }
            float sm = 0.f;
#pragma unroll
            for (int r = 0; r < 16; ++r) sm += y[0][r] + y[1][r];
            sm += __shfl_xor(sm, 32);
            const float mu = sm * (1.f / 64.f); float q = 0.f;
#pragma unroll
            for (int r = 0; r < 16; ++r) { y[0][r] -= mu; y[1][r] -= mu; q += y[0][r] * y[0][r] + y[1][r] * y[1][r]; }
            q += __shfl_xor(q, 32);
            const float rs = __builtin_amdgcn_rsqf(q * (1.f / 64.f) + EPS);
            const size_t tok = tok0 + n;
#pragma unroll
            for (int et = 0; et < 2; ++et)
#pragma unroll
                for (int g4 = 0; g4 < 4; ++g4) { const int e0 = 32 * et + 8 * g4 + 4 * hi;
                    const v2u gv = *(const GAS v2u*)(GB + tok * 512 + h * 64 + e0);
                    float o4[4];
#pragma unroll
                    for (int i = 0; i < 4; ++i) { const float g = bf2f((unsigned short)((i & 1) ? ((i & 2) ? gv.y : gv.x) >> 16 : ((i & 2) ? gv.y : gv.x) & 0xffff));
                        const float sg = g * __builtin_amdgcn_rcpf(1.f + __expf(-g)); o4[i] = sg * y[et][4 * g4 + i] * rs; }
                    v2u ov; ov.x = pg8::cvt_pk_bf16(o4[0], o4[1]); ov.y = pg8::cvt_pk_bf16(o4[2], o4[3]);
                    *(GAS v2u*)(Y + tok * D + 512 + h * 64 + e0) = ov; }
        }
        LDS_WAIT(); asm volatile("" ::: "memory");
        ++pass;
    }
}

__device__ __forceinline__ void p_norm2_route(Frame& F) {
    const float* mod = (const float*)(F.ws + WS_MOD);
    LAS f32x4* RG = (LAS f32x4*)F.lds;
    LAS f32x4* RE = (LAS f32x4*)(F.lds + 16384);
    { const float* wrg = F.w_rg(); const float* wre = F.w_re();
        for (int i = F.tid; i < 1024; i += NWAVES * 64) { const int ln = (i & 255) >> 2, j = i >> 8, t = i & 3; RG[(j * 4 + t) * 64 + ln] = *(const GAS f32x4*)(wrg + (size_t)i * 4); }
        for (int i = F.tid; i < 4 * 1024 * 2; i += NWAVES * 64) { const int g = i >> 11, row = (i >> 1) & 1023, hf = i & 1, ln = (row & 255) >> 2, j = row >> 8, t = row & 3;
            RE[g * 2048 + ((j * 4 + t) * 2 + hf) * 64 + ln] = *(const GAS f32x4*)(wre + ((size_t)g * 1024 + row) * 8 + hf * 4); } }
    constexpr int RT_CAP = 300;
    LAS unsigned* RC = (LAS unsigned*)(F.lds + 147456);
    LAS unsigned* REC = RC + 65;
    static_assert(147456 + (65 + 3 * RT_CAP) * 4 <= RING_BYTES + AUX_BYTES, "router LDS map");
    for (int i = F.tid; i < 65; i += NWAVES * 64) RC[i] = 0u;
    __syncthreads();
    const int gw = F.vcu * NWAVES + F.wave, NGW = F.G * NWAVES;
    const float* X = F.x(); const bf16* MIX = (const bf16*)(F.ws + WS_MIX); bf16* H2 = (bf16*)(F.ws + WS_H2);
    unsigned* ltok = (unsigned*)(F.ws + WS_ROUTE); float* lw = (float*)(F.ws + WS_ROUTE + 4 * MiB);
    f32x4 nv[4]; v2u nm[4];
#define N2_LOAD(mm) do { const GAS f32x4* xr = (const GAS f32x4*)(X + (size_t)(mm) * D) + F.lane; \
        _Pragma("unroll") for (int j = 0; j < 4; ++j) { nv[j] = xr[64 * j]; nm[j] = *(const GAS v2u*)(MIX + (size_t)(mm) * D + 4 * F.lane + 256 * j); } } while (0)
    if (gw < M) N2_LOAD(gw);
    for (int m = gw; m < M; m += NGW) {
        const int b = m >> 13;
        f32x4 v[4]; float s = 0.f;
#pragma unroll
        for (int j = 0; j < 4; ++j) { v[j] = nv[j]; v[j].x += bf2f((unsigned short)(nm[j].x & 0xffff)); v[j].y += bf2f((unsigned short)(nm[j].x >> 16)); v[j].z += bf2f((unsigned short)(nm[j].y & 0xffff)); v[j].w += bf2f((unsigned short)(nm[j].y >> 16)); }
        if (m + NGW < M) N2_LOAD(m + NGW);
#pragma unroll
        for (int j = 0; j < 4; ++j) s += (v[j].x * v[j].x + v[j].y * v[j].y) + (v[j].z * v[j].z + v[j].w * v[j].w);
        const float r = 1.f / sqrtf(wave_sum(s) * (1.f / D) + EPS);
        GAS unsigned long long* o8 = (GAS unsigned long long*)(H2 + (size_t)m * D) + F.lane;
        f32x4 lg = {0.f, 0.f, 0.f, 0.f};
#pragma unroll
        for (int j = 0; j < 4; ++j) { const int col = 4 * F.lane + 256 * j;
            const f32x4 g = *(const GAS f32x4*)(F.g_ffn() + col) * (*(const GAS f32x4*)(mod + b * 6144 + 4096 + col) + 1.f), sh = *(const GAS f32x4*)(mod + b * 6144 + 3072 + col);
            v[j] = v[j] * r * g + sh;
            o8[64 * j] = (unsigned long long)pk2(v[j].x, v[j].y) | ((unsigned long long)pk2(v[j].z, v[j].w) << 32);
            const LAS f32x4* wg = RG + (j * 4) * 64 + F.lane;
            lg += wg[0] * v[j].x; lg += wg[64] * v[j].y; lg += wg[128] * v[j].z; lg += wg[192] * v[j].w; }
        lg.x = wave_sum(lg.x); lg.y = wave_sum(lg.y); lg.z = wave_sum(lg.z); lg.w = wave_sum(lg.w);
        int grp = 0; float mx = lg.x;
        if (lg.y > mx) { mx = lg.y; grp = 1; } if (lg.z > mx) { mx = lg.z; grp = 2; } if (lg.w > mx) { mx = lg.w; grp = 3; }
        const float pgrp = 1.f / (expf(lg.x - mx) + expf(lg.y - mx) + expf(lg.z - mx) + expf(lg.w - mx));
        f32x4 f0 = {0.f, 0.f, 0.f, 0.f}, f1 = f0;
        const LAS f32x4* reg = RE + grp * 2048 + F.lane;
#pragma unroll
        for (int j = 0; j < 4; ++j) { const LAS f32x4* we = reg + (j * 8) * 64;
            f0 += we[0] * v[j].x; f1 += we[64] * v[j].x; f0 += we[128] * v[j].y; f1 += we[192] * v[j].y; f0 += we[256] * v[j].z; f1 += we[320] * v[j].z; f0 += we[384] * v[j].w; f1 += we[448] * v[j].w; }
        float fe[8];
        fe[0] = wave_sum(f0.x); fe[1] = wave_sum(f0.y); fe[2] = wave_sum(f0.z); fe[3] = wave_sum(f0.w); fe[4] = wave_sum(f1.x); fe[5] = wave_sum(f1.y); fe[6] = wave_sum(f1.z); fe[7] = wave_sum(f1.w);
        int i1 = 0; float m1 = fe[0];
#pragma unroll
        for (int e = 1; e < 8; ++e) if (fe[e] > m1) { m1 = fe[e]; i1 = e; }
        int i2 = -1; float m2 = -INFINITY;
#pragma unroll
        for (int e = 0; e < 8; ++e) if (e != i1 && fe[e] > m2) { m2 = fe[e]; i2 = e; }
        const float e2 = expf(m2 - m1); const float w1 = pgrp / (1.f + e2), w2 = pgrp * e2 / (1.f + e2);
        if (F.lane < 2) { const int e = grp * 8 + (F.lane ? i2 : i1); const float w = F.lane ? w2 : w1;
            const unsigned slot = __hip_atomic_fetch_add(RC + 64, 1u, __ATOMIC_RELAXED, __HIP_MEMORY_SCOPE_WORKGROUP);
            if (slot < (unsigned)RT_CAP) { const unsigned lp = __hip_atomic_fetch_add(RC + e, 1u, __ATOMIC_RELAXED, __HIP_MEMORY_SCOPE_WORKGROUP);
                REC[slot] = ((unsigned)e << 16) | lp; REC[RT_CAP + slot] = (unsigned)m | ((unsigned)F.lane << 31); REC[2 * RT_CAP + slot] = __float_as_uint(w); }
            else { const unsigned p = __hip_atomic_fetch_add((unsigned*)(F.ctl + CW_ECNT + 64 * e), 1u, RLX_AGENT);
                ltok[(size_t)e * M + p] = (unsigned)m | ((unsigned)F.lane << 31); lw[(size_t)e * M + p] = w; } }
    }
    __syncthreads();
    if (F.tid < NEXP) { const unsigned c = RC[F.tid]; RC[32 + F.tid] = c ? __hip_atomic_fetch_add((unsigned*)(F.ctl + CW_ECNT + 64 * F.tid), c, RLX_AGENT) : 0u; }
    __syncthreads();
    { const unsigned nrec = RC[64] < (unsigned)RT_CAP ? RC[64] : (unsigned)RT_CAP;
        for (unsigned r = F.tid; r < nrec; r += NWAVES * 64) { const unsigned ep = REC[r], e = ep >> 16, p = RC[32 + e] + (ep & 0xffffu);
            ltok[(size_t)e * M + p] = REC[RT_CAP + r]; lw[(size_t)e * M + p] = __uint_as_float(REC[2 * RT_CAP + r]); } }
    __syncthreads();
}
__device__ __forceinline__ void p_expert_convert(Frame& F, int part, int nparts) {
    const int gw = F.vcu * NWAVES + F.wave, NGW = F.G * NWAVES;
    int ln = F.lane; asm volatile("" : "+v"(ln));
    LAS unsigned* T = (LAS unsigned*)(F.lds + F.wave * 16384);
    bf16* wgu = (bf16*)(F.ws + WS_WGU); bf16* wd = (bf16*)(F.ws + WS_WD);
    constexpr int I_GU = NEXP * 16 * 16, I_D = NEXP * 16 * 8;
    int k = 0;
    for (int it = gw; it < I_GU + I_D; it += NGW, ++k) {
        if (k % nparts != part) continue;
        if (it < I_GU) { const int e = it >> 8, r = it & 255, nt = r >> 4, kt = r & 15;
            tr_tile_gu(F.w_gate() + (size_t)e * D * DEXP, F.w_up() + (size_t)e * D * DEXP, wgu + (size_t)e * 1024 * 1024, nt * 64, kt * 64, T, ln); }
        else { const int q = it - I_GU, e = q >> 7, r = q & 127, nt = r >> 3, kt = r & 7;
            tr_tile_d(F.w_down() + (size_t)e * DEXP * D, wd + (size_t)e * 1024 * 512, nt * 64, kt * 64, T, ln); }
    }
}

constexpr int MOE_MAXU = 5;
struct MoeSched {
    int G, c, nunits; LAS int* blkstart; LAS unsigned* tok; bool gather;
    __device__ __forceinline__ bool next(int i, pg8::Unit& u) const {
        const int L = i * G + c; if (L >= nunits || i >= MOE_MAXU) return false;
        const int blk = L >> 2, pnl = L & 3; int e = 0;
#pragma unroll 1
        for (int k = 1; k < NEXP; ++k) if (blkstart[k] <= blk) e = k;
        u.pm = i | (blk << 8); u.pn = e * 4 + pnl; return true;
    }
    __device__ __forceinline__ int arow(const pg8::Unit& u, int rt) const {
        if (gather) { const unsigned t = tok[(u.pm & 255) * 256 + rt]; return (int)(t == 0xffffffffu ? 0u : (t & 0x7fffffffu)); }
        return (u.pm >> 8) * 256 + rt;
    }
    __device__ __forceinline__ int brow0(const pg8::Unit& u) const { return u.pn * 256; }
};
__device__ __forceinline__ int moe_tables(Frame& F, LAS int* blkstart, LAS unsigned* tok, LAS float* wts) {
    if (F.tid == 0) { int acc = 0; for (int e = 0; e < NEXP; ++e) { blkstart[e] = acc; const unsigned cnt = __hip_atomic_load((unsigned*)(F.ctl + CW_ECNT + 64 * e), RLX_AGENT); acc += (int)((cnt + 255u) >> 8); } blkstart[NEXP] = acc; }
    __syncthreads();
    const int nunits = blkstart[NEXP] * 4;
    const unsigned* ltok = (const unsigned*)(F.ws + WS_ROUTE); const float* lw = (const float*)(F.ws + WS_ROUTE + 4 * MiB);
    for (int i = 0; i < MOE_MAXU; ++i) { const int L = i * F.G + F.vcu; if (L >= nunits) break;
        const int blk = L >> 2; int e = 0;
        for (int k = 1; k < NEXP; ++k) if (blkstart[k] <= blk) e = k;
        const unsigned cnt = __hip_atomic_load((unsigned*)(F.ctl + CW_ECNT + 64 * e), RLX_AGENT);
        for (int r = F.tid; r < 256; r += NWAVES * 64) { const unsigned p = (unsigned)(blk - blkstart[e]) * 256u + (unsigned)r;
            tok[i * 256 + r] = p < cnt ? ltok[(size_t)e * M + p] : 0xffffffffu; wts[i * 256 + r] = p < cnt ? lw[(size_t)e * M + p] : 0.f; } }
    __syncthreads();
    return nunits;
}
struct EpiMoe1 {
    static constexpr bool PERM = true;
    bf16* act;
    __device__ __forceinline__ void operator()(f32x4 (&acc)[2][2][4][2], const pg8::Unit& u, int wr, int wc, int fr, int fq) const {
        const int blk = u.pm >> 8, pnl = u.pn & 3; const int row0 = blk * 256 + wr * 64 + fr;
#pragma unroll
        for (int bj = 0; bj < 2; ++bj) { const int ac = pnl * 128 + (bj * 128 + wc * 32 + 8 * fq) / 2;
#pragma unroll
            for (int ai = 0; ai < 2; ++ai)
#pragma unroll
                for (int m = 0; m < 4; ++m) { const f32x4 v0 = acc[ai][bj][m][0], v1 = acc[ai][bj][m][1];
                    const float a0 = v0[0] / (1.f + __expf(-v0[0])) * v0[1], a1 = v0[2] / (1.f + __expf(-v0[2])) * v0[3];
                    const float a2 = v1[0] / (1.f + __expf(-v1[0])) * v1[1], a3 = v1[2] / (1.f + __expf(-v1[2])) * v1[3];
                    v2u w; w.x = pg8::cvt_pk_bf16(a0, a1); w.y = pg8::cvt_pk_bf16(a2, a3);
                    *(GAS v2u*)(act + (size_t)(row0 + ai * 128 + m * 16) * DEXP + ac) = w; } }
    }
};
struct EpiMoe2 {
    static constexpr bool PERM = true;
    bf16* c0; bf16* c1; LAS unsigned* tok; LAS float* wts;
    __device__ __forceinline__ void operator()(f32x4 (&acc)[2][2][4][2], const pg8::Unit& u, int wr, int wc, int fr, int fq) const {
        const int li = u.pm & 255, pnl = u.pn & 3;
#pragma unroll
        for (int ai = 0; ai < 2; ++ai)
#pragma unroll
            for (int m = 0; m < 4; ++m) { const int rt = ai * 128 + wr * 64 + m * 16 + fr; const unsigned en = tok[li * 256 + rt]; const float w = wts[li * 256 + rt];
                if (en != 0xffffffffu) { bf16* dst = ((en >> 31) ? c1 : c0) + (size_t)(en & 0x7fffffffu) * D + pnl * 256 + wc * 32 + 8 * fq;
#pragma unroll
                    for (int bj = 0; bj < 2; ++bj) { const f32x4 v0 = acc[ai][bj][m][0] * w, v1 = acc[ai][bj][m][1] * w; v4u o;
                        o.x = pg8::cvt_pk_bf16(v0[0], v0[1]); o.y = pg8::cvt_pk_bf16(v0[2], v0[3]); o.z = pg8::cvt_pk_bf16(v1[0], v1[1]); o.w = pg8::cvt_pk_bf16(v1[2], v1[3]);
                        *(GAS v4u*)(dst + bj * 128) = o; } } }
    }
};

typedef _Float16 h16x2 __attribute__((ext_vector_type(2)));
__device__ __forceinline__ unsigned pk_f16_rtz(float a, float b) { return __builtin_bit_cast(unsigned, __builtin_amdgcn_cvt_pkrtz(a, b)); }
__device__ __forceinline__ unsigned sortable16x2(unsigned x) { const unsigned m = ((x >> 15) & 0x00010001u) * 0xFFFFu; return x ^ (m | 0x80008000u); }
constexpr int IDX_HS = 257;
constexpr int IDX_WT_OFF = 68 * 1024, IDX_RH_OFF = 72 * 1024, IDX_P2_OFF = IDX_RH_OFF + 32 * IDX_HS * 4, IDX_P2_BYTES = 4480;
static_assert(IDX_P2_OFF + 8 * IDX_P2_BYTES <= RING_BYTES + AUX_BYTES, "indexer LDS map");
template <int NC>
__device__ __forceinline__ void hist_find(LAS unsigned* H, int lane, unsigned K, unsigned& bsel, unsigned& above, unsigned& atb) {
    unsigned t[4];
#pragma unroll
    for (int q = 0; q < 4; ++q) { unsigned a = 0;
#pragma unroll
        for (int c = 0; c < NC; ++c) a += H[c * IDX_HS + 4 * lane + q];
        t[q] = a; }
    const unsigned ls = (t[0] + t[1]) + (t[2] + t[3]);
    unsigned suf = ls;
#pragma unroll
    for (int o = 1; o < 64; o <<= 1) { const unsigned v = __shfl_down(suf, o); if (lane + o < 64) suf += v; }
    unsigned ab = suf - ls; bool found = false; unsigned fb = 0, fa = 0, ft = 0;
#pragma unroll
    for (int q = 3; q >= 0; --q) { if (!found && ab < K && ab + t[q] >= K) { found = true; fb = 4 * lane + q; fa = ab; ft = t[q]; } ab += t[q]; }
    const unsigned long long bal = __ballot(found);
    const int src = bal ? (int)__builtin_ctzll(bal) : 0;
    bsel = __shfl(fb, src); above = __shfl(fa, src); atb = __shfl(ft, src);
}
__device__ __forceinline__ void sel_load(v4u (&ch)[16], const unsigned short* srow, int n, int lane) {
    const int nchunks = n >> 3;
#pragma unroll
    for (int j = 0; j < 16; ++j) { const int c = lane + 64 * j;
        unsigned off = (unsigned)c * 16u; asm volatile("" : "+v"(off));
        if (c < nchunks) ch[j] = *(const GAS v4u*)((const char*)srow + off); else ch[j] = (v4u){0u, 0u, 0u, 0u}; }
}
__device__ __forceinline__ unsigned pk_max_u16(unsigned a, unsigned b) { unsigned r; asm("v_pk_max_u16 %0, %1, %2" : "=v"(r) : "v"(a), "v"(b)); return r; }
__device__ __forceinline__ unsigned pk_min_u16(unsigned a, unsigned b) { unsigned r; asm("v_pk_min_u16 %0, %1, %2" : "=v"(r) : "v"(a), "v"(b)); return r; }
__device__ __forceinline__ void sel_compute(const v4u (&ch)[16], const unsigned short* srow, int n, unsigned char* mrow, LAS unsigned* RH, LAS unsigned* P2, int lane) {
    const int nchunks = n >> 3;
    if (n <= 256) {
#pragma unroll 1
        for (int j = 0; j < 16; ++j) { const int c = lane + 64 * j; mrow[c] = (c < nchunks) ? (unsigned char)0xFF : (unsigned char)0; }
        return;
    }
    unsigned b1, above1, at1; hist_find<1>(RH, lane, 256u, b1, above1, at1);
    for (int i = lane; i < 4 * IDX_HS; i += 64) P2[i] = 0u;
    LAS unsigned* hb = P2 + (lane & 3) * IDX_HS;
    unsigned pat = (b1 << 8) | (b1 << 24), c256 = 0x01000100u, c1 = 0x00010001u;
    asm volatile("" : "+v"(pat), "+v"(c256), "+v"(c1));
#pragma unroll
    for (int j = 0; j < 16; ++j) { if (64 * j < nchunks) {
#pragma unroll
        for (int i = 0; i < 4; ++i) { const unsigned w = ch[j][i]; const unsigned m = pk_min_u16(w ^ pat, c256);
            __hip_atomic_fetch_add(hb + (w & 0xffu), ((m >> 8) & 1u) ^ 1u, __ATOMIC_RELAXED, __HIP_MEMORY_SCOPE_WORKGROUP);
            __hip_atomic_fetch_add(hb + ((w >> 16) & 0xffu), (m >> 24) ^ 1u, __ATOMIC_RELAXED, __HIP_MEMORY_SCOPE_WORKGROUP); } } __builtin_amdgcn_sched_barrier(0); }
    unsigned b2, above2, teq; hist_find<4>(P2, lane, 256u - above1, b2, above2, teq);
    const unsigned tau = (b1 << 8) | b2; const unsigned r = 256u - above1 - above2;
    if (r >= teq) {
        unsigned tt = tau | (tau << 16); asm volatile("" : "+v"(tt));
#pragma unroll
        for (int j = 0; j < 16; ++j) { const int c = lane + 64 * j; unsigned acc = 0u;
#pragma unroll
            for (int i = 0; i < 4; ++i) { const unsigned w = ch[j][i]; const unsigned ns = pk_min_u16(pk_max_u16(w, tt) ^ w, c1);
                acc |= ns << (2 * i); }
            const unsigned bits = ~(acc | (acc >> 15)) & 0xffu;
            { unsigned off = (unsigned)c; asm volatile("" : "+v"(off)); mrow[off] = (unsigned char)bits; } __builtin_amdgcn_sched_barrier(0); }
    } else {
        unsigned running = 0u;
#pragma unroll 1
        for (int j = 0; j < 16; ++j) { const int c = lane + 64 * j;
            v4u x = {0u, 0u, 0u, 0u};
            if (c < nchunks) x = *(const GAS v4u*)(srow + (size_t)c * 8);
            unsigned gt = 0u, eq = 0u;
#pragma unroll
            for (int i = 0; i < 4; ++i) { const unsigned w = x[i], k0 = w & 0xffffu, k1 = w >> 16;
                gt |= (k0 > tau ? 1u : 0u) << (2 * i); gt |= (k1 > tau ? 1u : 0u) << (2 * i + 1); eq |= (k0 == tau ? 1u : 0u) << (2 * i); eq |= (k1 == tau ? 1u : 0u) << (2 * i + 1); }
            const unsigned tc = (unsigned)__builtin_popcount(eq); unsigned inc = tc;
#pragma unroll
            for (int o = 1; o < 64; o <<= 1) { const unsigned v = __shfl_up(inc, o); if (lane >= o) inc += v; }
            const unsigned base = running + inc - tc;
            int take = (int)r - (int)base; take = take < 0 ? 0 : (take > 8 ? 8 : take);
            unsigned e2 = eq, kept = 0u;
#pragma unroll
            for (int t = 0; t < 8; ++t) { const unsigned low = e2 & (0u - e2); if (t < take) kept |= low; e2 &= e2 - 1u; }
            running += __shfl(inc, 63);
            mrow[c] = (unsigned char)(gt | kept); }
    }
}
__device__ __forceinline__ void p_indexer(Frame& F) {
    const bf16* QI = (const bf16*)(F.ws + WS_QI); const bf16* KI = (const bf16*)(F.ws + WS_KI); const float* WI = (const float*)(F.ws + WS_WI);
    unsigned short* scr = (unsigned short*)(F.ws + WS_SCR) + (size_t)blockIdx.x * 32 * 8192;
    unsigned char* MASK = (unsigned char*)(F.ws + WS_MASK);
    const int tid = F.tid, lane = F.lane, wave = F.wave, r32 = lane & 31, hi = lane >> 5;
    LAS unsigned char* lds = F.lds;
    const int b = F.vcu >> 6, wq = F.vcu & 63;
#pragma unroll 1
    for (int ui = 0; ui < 4; ++ui) {
        const int qb32 = (ui == 0) ? wq : (ui == 1) ? 127 - wq : (ui == 2) ? 128 + wq : 255 - wq;
        const int n = 64 * ((qb32 >> 1) + 1), ntiles = n >> 5;
        const size_t tokb = (size_t)b * SEQ, tok0 = tokb + (size_t)qb32 * 32;
#pragma unroll
        for (int i = 0; i < 8; ++i) { const int f = wave + 8 * i, hh = f >> 2, ks = f & 3;
            const v4u v = *(const GAS v4u*)(QI + (tok0 + r32) * 1024 + hh * 64 + 16 * ks + 8 * hi); *(LAS v4u*)(lds + f * 1024 + lane * 16) = v; }
        { LAS float* wt = (LAS float*)(lds + IDX_WT_OFF);
            const int q = tid & 31, hh = tid >> 5; wt[hh * 32 + q] = WI[(tok0 + q) * 16 + hh] * 0.125f;
            LAS unsigned* rh = (LAS unsigned*)(lds + IDX_RH_OFF); for (int i = tid; i < 32 * IDX_HS; i += NWAVES * 64) rh[i] = 0u; }
        { const int q = tid & 31, dg = tid >> 5; f32x4 a = {0.f, 0.f, 0.f, 0.f};
#pragma unroll
            for (int hh = 0; hh < 16; ++hh) { const float wv = WI[(tok0 + q) * 16 + hh] * 0.125f; const v2u qv = *(const GAS v2u*)(QI + (tok0 + q) * 1024 + hh * 64 + 4 * dg);
                a.x += wv * bf2f((unsigned short)(qv.x & 0xffff)); a.y += wv * bf2f((unsigned short)(qv.x >> 16)); a.z += wv * bf2f((unsigned short)(qv.y & 0xffff)); a.w += wv * bf2f((unsigned short)(qv.y >> 16)); }
            v2u o; o.x = pk2(a.x, a.y); o.y = pk2(a.z, a.w);
            *(LAS v2u*)(lds + (64 + (dg >> 2)) * 1024 + (q + 32 * ((dg >> 1) & 1)) * 16 + (dg & 1) * 8) = o; }
        __syncthreads();
        LAS unsigned* hrow = (LAS unsigned*)(lds + IDX_RH_OFF) + r32 * IDX_HS;
        bf16x8 kf[2][4];
#define IDX_KLOAD(TT) do { _Pragma("unroll") for (int j = 0; j < 2; ++j) { const int T = ((TT) + j < ntiles) ? (TT) + j : ntiles - 1; \
            _Pragma("unroll") for (int ks = 0; ks < 4; ++ks) kf[j][ks] = *(const GAS bf16x8*)(KI + (tokb + (size_t)T * 32 + r32) * 64 + 16 * ks + 8 * hi); } } while (0)
#define IDX_FMA4(S, P, B, W) do { asm volatile("v_fma_f32 %0, |%4|, %8, %0\n\tv_fma_f32 %1, |%5|, %8, %1\n\tv_fma_f32 %2, |%6|, %8, %2\n\tv_fma_f32 %3, |%7|, %8, %3" \
                : "+v"(S[B]), "+v"(S[B + 1]), "+v"(S[B + 2]), "+v"(S[B + 3]) : "v"(P[B]), "v"(P[B + 1]), "v"(P[B + 2]), "v"(P[B + 3]), "v"(W)); __builtin_amdgcn_sched_barrier(0); } while (0)
#define IDX_QF(base, ks) (*(const LAS bf16x8*)((base) + (ks) * 1024))
#define IDX_MF(N, K, Q, C) N = __builtin_amdgcn_mfma_f32_32x32x16_bf16(K, Q, C, 0, 0, 0); __builtin_amdgcn_sched_barrier(0)
#define IDX_PSTEP(N0, N1, P0, P1, W, CUR, NXT) do { \
                IDX_MF(N0, kf[0][0], qa, f32x16{}); IDX_FMA4(sc[0], P0, 0, W); \
                IDX_MF(N1, kf[1][0], qa, f32x16{}); IDX_FMA4(sc[0], P0, 4, W); qa = IDX_QF(CUR, 2); \
                IDX_MF(N0, kf[0][1], qb, N0); IDX_FMA4(sc[0], P0, 8, W); \
                IDX_MF(N1, kf[1][1], qb, N1); IDX_FMA4(sc[0], P0, 12, W); qb = IDX_QF(CUR, 3); \
                IDX_MF(N0, kf[0][2], qa, N0); IDX_FMA4(sc[1], P1, 0, W); \
                IDX_MF(N1, kf[1][2], qa, N1); IDX_FMA4(sc[1], P1, 4, W); qa = IDX_QF(NXT, 0); \
                IDX_MF(N0, kf[0][3], qb, N0); IDX_FMA4(sc[1], P1, 8, W); \
                IDX_MF(N1, kf[1][3], qb, N1); IDX_FMA4(sc[1], P1, 12, W); qb = IDX_QF(NXT, 1); } while (0)
        if (wave * 2 < ntiles) IDX_KLOAD(wave * 2);
#pragma unroll 1
        for (int T0 = wave * 2; T0 < ntiles; T0 += 16) {
            f32x16 sc[2];
            sc[0] = f32x16{}; sc[1] = f32x16{};
#pragma unroll
            for (int ks = 0; ks < 4; ++ks) { const bf16x8 qf = *(const LAS bf16x8*)(lds + (64 + ks) * 1024 + lane * 16);
                sc[0] = __builtin_amdgcn_mfma_f32_32x32x16_bf16(kf[0][ks], qf, sc[0], 0, 0, 0); sc[1] = __builtin_amdgcn_mfma_f32_32x32x16_bf16(kf[1][ks], qf, sc[1], 0, 0, 0); }
            {
                f32x16 dA0 = f32x16{}, dA1 = f32x16{}, dB0 = f32x16{}, dB1 = f32x16{};
                float wprev = 0.f;
                const LAS unsigned char* qbase = lds + lane * 16;
                const LAS unsigned char* wbase = lds + IDX_WT_OFF + r32 * 4;
                bf16x8 qa = IDX_QF(qbase, 0), qb = IDX_QF(qbase, 1);
#pragma unroll 1
                for (int hh = 0; hh < 16; hh += 2) {
                    const float wh0 = *(const LAS float*)(wbase + hh * 128), wh1 = *(const LAS float*)(wbase + hh * 128 + 128);
                    IDX_PSTEP(dA0, dA1, dB0, dB1, wprev, qbase, qbase + 4096);
                    IDX_PSTEP(dB0, dB1, dA0, dA1, wh0, qbase + 4096, qbase + 8192);
                    wprev = wh1; qbase += 8192;
                }
                asm volatile("s_nop 15\n\ts_nop 7" ::: "memory");
#pragma unroll
                for (int r = 0; r < 16; r += 4) { IDX_FMA4(sc[0], dB0, r, wprev); }
#pragma unroll
                for (int r = 0; r < 16; r += 4) { IDX_FMA4(sc[1], dB1, r, wprev); }
            }
            if (T0 + 16 < ntiles) IDX_KLOAD(T0 + 16);
#pragma unroll
            for (int j = 0; j < 2; ++j) { if (T0 + j < ntiles) { unsigned short* dst = scr + (size_t)r32 * 8192 + (size_t)(T0 + j) * 32 + 4 * hi;
#pragma unroll
                for (int g = 0; g < 4; ++g) { v2u o; o.x = sortable16x2(pk_f16_rtz(sc[j][4 * g], sc[j][4 * g + 1])); o.y = sortable16x2(pk_f16_rtz(sc[j][4 * g + 2], sc[j][4 * g + 3])); *(GAS v2u*)(dst + 8 * g) = o;
                    __hip_atomic_fetch_add(hrow + ((o.x >> 8) & 255u), 1u, __ATOMIC_RELAXED, __HIP_MEMORY_SCOPE_WORKGROUP); __hip_atomic_fetch_add(hrow + (o.x >> 24), 1u, __ATOMIC_RELAXED, __HIP_MEMORY_SCOPE_WORKGROUP);
                    __hip_atomic_fetch_add(hrow + ((o.y >> 8) & 255u), 1u, __ATOMIC_RELAXED, __HIP_MEMORY_SCOPE_WORKGROUP); __hip_atomic_fetch_add(hrow + (o.y >> 24), 1u, __ATOMIC_RELAXED, __HIP_MEMORY_SCOPE_WORKGROUP); } } }
        }
#undef IDX_QF
#undef IDX_MF
#undef IDX_PSTEP
#undef IDX_FMA4
        VM_WAIT(); __syncthreads();
        __builtin_amdgcn_fence(__ATOMIC_ACQUIRE, "workgroup");
        { LAS unsigned* P2 = (LAS unsigned*)(lds + IDX_P2_OFF + wave * IDX_P2_BYTES); LAS unsigned* RH = (LAS unsigned*)(lds + IDX_RH_OFF) + wave * 4 * IDX_HS;
            const unsigned short* sr = scr + (size_t)wave * 4 * 8192; unsigned char* mr = MASK + (tok0 + wave * 4) * 1024;
#pragma unroll 1
            for (int rp3 = 0; rp3 < SUBREPS(16); ++rp3) {
            { int ls = lane; asm volatile("" : "+v"(ls));
                v4u chA[16], chB[16];
                sel_load(chA, sr, n, ls); sel_load(chB, sr + 8192, n, ls);
                sel_compute(chA, sr, n, mr, RH, P2, ls);
                sel_load(chA, sr + 2 * 8192, n, ls);
                sel_compute(chB, sr + 8192, n, mr + 1024, RH + IDX_HS, P2, ls);
                sel_load(chB, sr + 3 * 8192, n, ls);
                sel_compute(chA, sr + 2 * 8192, n, mr + 2 * 1024, RH + 2 * IDX_HS, P2, ls);
                sel_compute(chB, sr + 3 * 8192, n, mr + 3 * 1024, RH + 3 * IDX_HS, P2, ls); } } }
        __syncthreads();
    }
}

template <bool WITH_MOE>
__device__ __forceinline__ void p_final(Frame& F) {
    const int gw = F.vcu * NWAVES + F.wave, NGW = F.G * NWAVES;
    const float* X = F.x(); const bf16* MIX = (const bf16*)(F.ws + WS_MIX); const float* mod = (const float*)(F.ws + WS_MOD);
    const bf16* C0 = (const bf16*)(F.ws + WS_C0); const bf16* C1 = (const bf16*)(F.ws + WS_C1);
    f32x4 nv[4]; v2u nm[4], na[4], nc[4];
#define FIN_LOAD(mm) do { const GAS f32x4* xr = (const GAS f32x4*)(X + (size_t)(mm) * D) + F.lane; \
        _Pragma("unroll") for (int j = 0; j < 4; ++j) { nv[j] = xr[64 * j]; nm[j] = *(const GAS v2u*)(MIX + (size_t)(mm) * D + 4 * F.lane + 256 * j); if (WITH_MOE) { const int col = 4 * F.lane + 256 * j; na[j] = *(const GAS v2u*)(C0 + (size_t)(mm) * D + col); nc[j] = *(const GAS v2u*)(C1 + (size_t)(mm) * D + col); } } } while (0)
    if (gw < M) FIN_LOAD(gw);
    for (int m = gw; m < M; m += NGW) {
        const int b = m >> 13;
        f32x4 v[4]; v2u ca[4], cc[4]; float s = 0.f;
#pragma unroll
        for (int j = 0; j < 4; ++j) { v[j] = nv[j]; ca[j] = na[j]; cc[j] = nc[j];
            v[j].x += bf2f((unsigned short)(nm[j].x & 0xffff)); v[j].y += bf2f((unsigned short)(nm[j].x >> 16)); v[j].z += bf2f((unsigned short)(nm[j].y & 0xffff)); v[j].w += bf2f((unsigned short)(nm[j].y >> 16)); }
        if (m + NGW < M) FIN_LOAD(m + NGW);
#pragma unroll
        for (int j = 0; j < 4; ++j) {
            if (WITH_MOE) { const int col = 4 * F.lane + 256 * j; const f32x4 gt = *(const GAS f32x4*)(mod + b * 6144 + 5120 + col);
                const v2u a = ca[j], c = cc[j];
                f32x4 mo; mo.x = bf2f((unsigned short)(a.x & 0xffff)) + bf2f((unsigned short)(c.x & 0xffff)); mo.y = bf2f((unsigned short)(a.x >> 16)) + bf2f((unsigned short)(c.x >> 16));
                mo.z = bf2f((unsigned short)(a.y & 0xffff)) + bf2f((unsigned short)(c.y & 0xffff)); mo.w = bf2f((unsigned short)(a.y >> 16)) + bf2f((unsigned short)(c.y >> 16));
                v[j] = v[j] + gt * mo; }
            s += (v[j].x * v[j].x + v[j].y * v[j].y) + (v[j].z * v[j].z + v[j].w * v[j].w); }
        const float r = 1.f / sqrtf(wave_sum(s) * (1.f / D) + EPS);
        GAS f32x4* o = (GAS f32x4*)(F.out() + (size_t)m * D) + F.lane;
#pragma unroll
        for (int j = 0; j < 4; ++j) { const f32x4 g = *(const GAS f32x4*)(F.g_fin() + 4 * F.lane + 256 * j); o[64 * j] = v[j] * r * g; }
    }
}

constexpr int N_PHASES = 16;
__global__ void __launch_bounds__(NWAVES * 64, 2) mk_fwd(Args args) {
    extern __shared__ __attribute__((aligned(16))) unsigned char lds[];
    Frame F;
    F.lds = (LAS unsigned char*)lds;
    F.tid = threadIdx.x; F.lane = F.tid & 63; F.wave = __builtin_amdgcn_readfirstlane(F.tid >> 6);
    F.G = gridDim.x; { const int bx = blockIdx.x; F.vcu = (F.G % 8 == 0) ? (bx % 8) * (F.G / 8) + bx / 8 : bx; }
    F.ws = args.ws; F.ctl = (gu32*)(args.ws + WS_CTL);
    F.ka = (const CAS Args*)__builtin_amdgcn_kernarg_segment_ptr();
    volatile LAS unsigned* LCTL = (volatile LAS unsigned*)(F.lds + LDSCTL_OFF);
    for (int u = F.tid; u < 64; u += NWAVES * 64) LCTL[u] = 0u;
    __syncthreads();
    const bool multi = (args.ph_hi - args.ph_lo) > 1;
    XcdBarrier bar; bar.bar = (unsigned*)(F.ctl + CW_BAR); bar.x = 0; bar.st = nullptr;
    if (multi) bar = xcd_barrier_post((unsigned*)(F.ctl + CW_BAR), LCTL + 8);
    const int lo = args.ph_lo, hi = args.ph_hi;
#ifndef PH_MASK
#define PH_MASK 0xffffffffu
#endif
#define IN(k) (((PH_MASK >> (k)) & 1u) && lo <= (k) && (k) < hi)
#define REPS(k) (1 + (int)((REP_MASK >> (k)) & 1u))
#define SEAM(k) do { if (IN(k) && IN((k) + 1)) xcd_barrier(bar); } while (0)

    if (IN(0)) _Pragma("unroll") for (int rp_ = 0; rp_ < REPS(0); ++rp_) { p0_prologue(F); } SEAM(0);
    if (multi && ((REP_MASK >> 21) & 1u)) { for (int q = 0; q < 8; ++q) xcd_barrier(bar); }
    if (IN(1)) _Pragma("unroll") for (int rp_ = 0; rp_ < REPS(1); ++rp_) { p1_norm(F); } SEAM(1);
    if (IN(2)) _Pragma("unroll") for (int rp_ = 0; rp_ < REPS(2); ++rp_) {
        pg8::Gemm g{(const bf16*)(F.ws + WS_H), (const bf16*)(F.ws + WS_WIN), D}; pg8::StaticOrder S; S.init(M, NPAD, F.G, (int)blockIdx.x);
        EpiInProj E{F.ws};
        pg8::gemm_phase<EpiInProj, pg8::StaticOrder, true>(F.lds, g, S, E);
    } SEAM(2);
    if (IN(3)) _Pragma("unroll") for (int rp_ = 0; rp_ < REPS(3); ++rp_) { ra_states(F); } SEAM(3);
    if (IN(4)) { if (F.G != 256) { rb_carry(F); if (multi) xcd_barrier(bar); } }
    if (IN(5)) _Pragma("unroll") for (int rp_ = 0; rp_ < REPS(5); ++rp_) { r3_out(F);
    } SEAM(5);
    if (IN(6)) _Pragma("unroll") for (int rp_ = 0; rp_ < REPS(6); ++rp_) { p_indexer(F); } SEAM(6);
    if (IN(7)) _Pragma("unroll") for (int rp_ = 0; rp_ < REPS(7); ++rp_) {
        const attn_body::AttnTensors AT{(const bf16*)(F.ws + WS_QA), (const bf16*)(F.ws + WS_KA), (const bf16*)(F.ws + WS_VA), (bf16*)(F.ws + WS_Y), (const unsigned char*)(F.ws + WS_MASK)};
        const attn_body::StaticOrder S((int)F.G, (int)blockIdx.x);
        { attn_body::AttnUnit u;
            for (int i = 0; S.next(i, u); ++i) { attn_body::attn_unit<8>(u.bh / attn_body::NHEAD, u.bh % attn_body::NHEAD, u.qb, AT.Q, AT.K, AT.V, AT.O, AT.MK, (char*)lds);
                p_expert_convert(F, i, 4); __syncthreads(); } }
    } SEAM(7);
    if (IN(8)) _Pragma("unroll") for (int rp_ = 0; rp_ < REPS(8); ++rp_) {
        pg8::Gemm g{(const bf16*)(F.ws + WS_Y), (const bf16*)(F.ws + WS_WO), D}; pg8::StaticOrder S; S.init(M, D, F.G, (int)blockIdx.x);
        EpiOutProj E{(bf16*)(F.ws + WS_MIX), (const float*)(F.ws + WS_MOD)};
        pg8::gemm_phase<EpiOutProj, pg8::StaticOrder, true>(F.lds, g, S, E);
    } SEAM(8);
    if (IN(9)) _Pragma("unroll") for (int rp_ = 0; rp_ < REPS(9); ++rp_) { p_norm2_route(F); } SEAM(9);
    if (IN(10)) _Pragma("unroll") for (int rp_ = 0; rp_ < REPS(10); ++rp_) {
        LAS int* blkstart = (LAS int*)(F.lds + AUX_OFF); LAS unsigned* tok = (LAS unsigned*)(F.lds + AUX_OFF + 256); LAS float* wts = (LAS float*)(F.lds + AUX_OFF + 256 + MOE_MAXU * 1024);
        const int nunits = moe_tables(F, blkstart, tok, wts);
        pg8::Gemm g{(const bf16*)(F.ws + WS_H2), (const bf16*)(F.ws + WS_WGU), D}; MoeSched S{F.G, F.vcu, nunits, blkstart, tok, true};
        EpiMoe1 E{(bf16*)(F.ws + WS_ACT)};
        pg8::gemm_phase<EpiMoe1, MoeSched, true>(F.lds, g, S, E);
    } SEAM(10);
    if (IN(11)) _Pragma("unroll") for (int rp_ = 0; rp_ < REPS(11); ++rp_) {
        LAS int* blkstart = (LAS int*)(F.lds + AUX_OFF); LAS unsigned* tok = (LAS unsigned*)(F.lds + AUX_OFF + 256); LAS float* wts = (LAS float*)(F.lds + AUX_OFF + 256 + MOE_MAXU * 1024);
        const int nunits = moe_tables(F, blkstart, tok, wts);
        pg8::Gemm g{(const bf16*)(F.ws + WS_ACT), (const bf16*)(F.ws + WS_WD), DEXP}; MoeSched S{F.G, F.vcu, nunits, blkstart, tok, false};
        EpiMoe2 E{(bf16*)(F.ws + WS_C0), (bf16*)(F.ws + WS_C1), tok, wts};
        pg8::gemm_phase<EpiMoe2, MoeSched, true>(F.lds, g, S, E);
    } SEAM(11);
    if (IN(12)) _Pragma("unroll") for (int rp_ = 0; rp_ < REPS(12); ++rp_) { p_final<true>(F); }
#undef IN
#undef SEAM
}

extern "C" void kernel_launch(void* const* d_in, const int* in_sizes, int n_in, void* d_out, int out_size, void* d_ws, size_t ws_size, hipStream_t stream) {
    static int grid = 0;
    if (grid == 0) {
        if (n_in != 15 || out_size != M * D || ws_size < WS_END) { fprintf(stderr, "kernel_launch: unexpected shapes (n_in %d out %d ws %zu)\n", n_in, out_size, ws_size); grid = -1; return; }
        int dev = 0, cus = 0, per_cu = 0;
        if (hipGetDevice(&dev) != hipSuccess || hipDeviceGetAttribute(&cus, hipDeviceAttributeMultiprocessorCount, dev) != hipSuccess) { grid = -1; return; }
        if (hipFuncSetAttribute((const void*)mk_fwd, hipFuncAttributeMaxDynamicSharedMemorySize, LDS_BYTES) != hipSuccess) { fprintf(stderr, "kernel_launch: hipFuncSetAttribute failed\n"); grid = -1; return; }
        if (hipOccupancyMaxActiveBlocksPerMultiprocessor(&per_cu, (const void*)mk_fwd, NWAVES * 64, LDS_BYTES) != hipSuccess || per_cu < 1) { fprintf(stderr, "kernel_launch: occupancy query says %d\n", per_cu); }
        (void)hipGetLastError();
        grid = cus;
    }
    if (grid < 0) return;
    (void)hipMemsetAsync((char*)d_ws + WS_CTL, 0, CTL_ZERO_BYTES, stream);
    Args a{};
    for (int i = 0; i < 15; ++i) a.in[i] = d_in[i];
    a.out = (float*)d_out; a.ws = (unsigned char*)d_ws;
#if MK_N_LAUNCHES == 1
    a.ph_lo = 0; a.ph_hi = N_PHASES;
    hipLaunchKernelGGL(mk_fwd, dim3(grid), dim3(NWAVES * 64), LDS_BYTES, stream, a);
#else
    for (int p = 0; p < N_PHASES; ++p) { a.ph_lo = p; a.ph_hi = p + 1; hipLaunchKernelGGL(mk_fwd, dim3(grid), dim3(NWAVES * 64), LDS_BYTES, stream, a); }
#endif
}
```

```cpp
#include <hip/hip_runtime.h>
#include <cstdio>
#include <cstdint>

#ifndef REP_MASK
#define REP_MASK 0u
#endif
#define SUBREPS(k) (1 + (int)((REP_MASK >> (k)) & 1u))
#ifndef MK_N_LAUNCHES
#define MK_N_LAUNCHES 1
#endif

#define GAS __attribute__((address_space(1)))
#define LAS __attribute__((address_space(3)))
typedef unsigned short bf16;
typedef unsigned v4u __attribute__((ext_vector_type(4)));
typedef unsigned v2u __attribute__((ext_vector_type(2)));
typedef float f32x4 __attribute__((ext_vector_type(4)));
typedef float f32x16 __attribute__((ext_vector_type(16)));
typedef short bf16x8 __attribute__((ext_vector_type(8)));
typedef GAS unsigned gu32;
#define RLX_AGENT __ATOMIC_RELAXED, __HIP_MEMORY_SCOPE_AGENT
#define LDS_WAIT() asm volatile("s_waitcnt lgkmcnt(0)" ::: "memory")
#define VM_WAIT() asm volatile("s_waitcnt vmcnt(0)" ::: "memory")

constexpr int NB = 4, SEQ = 8192, M = NB * SEQ, D = 1024;
constexpr int DIN = 4688, NPAD = 4864;
constexpr int NEXP = 32, DEXP = 512;
constexpr float EPS = 1e-6f;
constexpr float C2 = 0.125f * 1.4426950408889634f;

constexpr size_t MiB = 1u << 20;
constexpr size_t WS_CTL = 0, CTL_ZERO_BYTES = 1 * MiB;
constexpr size_t WS_MODP = 1 * MiB;
constexpr size_t WS_MOD = 3 * MiB;
constexpr size_t WS_WIN = 4 * MiB;
constexpr size_t WS_WO = 14 * MiB;
constexpr size_t WS_H = 16 * MiB;
constexpr size_t WS_ST = 16 * MiB;
constexpr size_t WS_MIX = 16 * MiB;
constexpr size_t WS_QA = 80 * MiB, WS_KA = 112 * MiB, WS_VA = 144 * MiB;
constexpr size_t WS_ROUTE = 144 * MiB;
constexpr size_t WS_QI = 176 * MiB;
constexpr size_t WS_H2 = 176 * MiB;
constexpr size_t WS_C0 = 176 * MiB;
constexpr size_t WS_KI = 240 * MiB;
constexpr size_t WS_WI = 244 * MiB;
constexpr size_t WS_QB = 248 * MiB, WS_KB = 280 * MiB, WS_VB = 312 * MiB, WS_GB = 344 * MiB;
constexpr size_t WS_SCR = 248 * MiB;
constexpr size_t WS_WGU = 248 * MiB;
constexpr size_t WS_C1 = 248 * MiB;
constexpr size_t WS_WD = 312 * MiB;
constexpr size_t WS_Y = 376 * MiB;
constexpr size_t WS_ACT = 376 * MiB;
constexpr size_t WS_MASK = 440 * MiB;
constexpr size_t WS_ROPE1 = 474 * MiB;
constexpr size_t WS_ROPE2 = 476 * MiB;
constexpr size_t WS_END = 512 * MiB;

constexpr int CW_BAR = 4096;
constexpr int CW_ECNT = 16384;

constexpr int NWAVES = 8;
constexpr int RING_BYTES = 131072;
constexpr int AUX_OFF = RING_BYTES, AUX_BYTES = 20480;
constexpr int LDSCTL_OFF = AUX_OFF + AUX_BYTES;
constexpr int LDS_BYTES = LDSCTL_OFF + 256;

__device__ __forceinline__ unsigned f2bf(float f) { unsigned u = __builtin_bit_cast(unsigned, f); return (u + 0x7fffu + ((u >> 16) & 1u)) >> 16; }
__device__ __forceinline__ unsigned pk2(float lo, float hi) { return f2bf(lo) | (f2bf(hi) << 16); }
__device__ __forceinline__ float bf2f(unsigned short b) { return __builtin_bit_cast(float, (unsigned)b << 16); }
__device__ __forceinline__ unsigned wave_prefix_incl(unsigned v, int lane) {
#define DPP_SHR(x, k) ((unsigned)__builtin_amdgcn_update_dpp(0, (int)(x), 0x110 + (k), 0xf, 0xf, true))
    v += DPP_SHR(v, 1); v += DPP_SHR(v, 2); v += DPP_SHR(v, 4); v += DPP_SHR(v, 8);
#undef DPP_SHR
    const unsigned t0 = (unsigned)__builtin_amdgcn_readlane((int)v, 15), t1 = (unsigned)__builtin_amdgcn_readlane((int)v, 31), t2 = (unsigned)__builtin_amdgcn_readlane((int)v, 47);
    const int row = lane >> 4;
    return v + (row >= 1 ? t0 : 0u) + (row >= 2 ? t1 : 0u) + (row >= 3 ? t2 : 0u);
}
__device__ __forceinline__ float wave_sum(float v) {
#define WS_SHR(x, k) __builtin_bit_cast(float, __builtin_amdgcn_update_dpp(0, __builtin_bit_cast(int, x), 0x110 + (k), 0xf, 0xf, true))
    v += WS_SHR(v, 1); v += WS_SHR(v, 2); v += WS_SHR(v, 4); v += WS_SHR(v, 8);
#undef WS_SHR
    const int b = __builtin_bit_cast(int, v);
    const float t0 = __builtin_bit_cast(float, __builtin_amdgcn_readlane(b, 15)), t1 = __builtin_bit_cast(float, __builtin_amdgcn_readlane(b, 31));
    const float t2 = __builtin_bit_cast(float, __builtin_amdgcn_readlane(b, 47)), t3 = __builtin_bit_cast(float, __builtin_amdgcn_readlane(b, 63));
    return (t0 + t1) + (t2 + t3);
}

#define XB_TMO      128
#define XB_XCNT(j)  (256  + 64 * (j))
#define XB_XSUB(j)  (1280 + 64 * (j))
#define XB_XGEN(j)  (2304 + 64 * (j))
#define XB_TOP      3328
#define XB_TOPGEN   3392
#define XCD_BAR_WORDS 3456
#define XB_SPIN_CAP (1u << 18)
__device__ __forceinline__ unsigned xb_ld(unsigned* p)              { return __hip_atomic_load(p, __ATOMIC_RELAXED, __HIP_MEMORY_SCOPE_AGENT); }
__device__ __forceinline__ unsigned xb_add(unsigned* p, unsigned v) { return __hip_atomic_fetch_add(p, v, __ATOMIC_RELAXED, __HIP_MEMORY_SCOPE_AGENT); }
__device__ __forceinline__ unsigned xb_xcc_id() { return (unsigned)__builtin_amdgcn_s_getreg((3 << 11) | 20) & 0xFu; }
#define XB_SPIN(cond, bar) do { unsigned _sp = 0; while (cond) { __builtin_amdgcn_s_sleep(1); \
    if ((++_sp & 255u) == 0u) { if (xb_ld(&(bar)[XB_TMO])) break; if (_sp > XB_SPIN_CAP) { atomicAdd(&(bar)[XB_TMO], 1u); break; } } } } while (0)
struct XcdBarrier { unsigned* bar; unsigned x; volatile LAS unsigned* st; };
__device__ __forceinline__ XcdBarrier xcd_barrier_post(unsigned* bar, volatile LAS unsigned* st) {
    XcdBarrier b; b.bar = bar; b.x = xb_xcc_id(); b.st = st;
    if (threadIdx.x == 0) (void)xb_add(&bar[XB_XCNT(b.x)], 1u);
    return b;
}
__device__ __forceinline__ void xcd_barrier_complete(unsigned* bar, unsigned x, unsigned& nloc, unsigned& nx) {
    const unsigned G = gridDim.x * gridDim.y * gridDim.z;
    unsigned sum, cnt, mine, sp = 0u;
    for (;;) {
        sum = 0u; cnt = 0u; mine = 0u;
#pragma unroll
        for (unsigned j = 0; j < 16; ++j) { const unsigned c = xb_ld(&bar[XB_XCNT(j)]); sum += c; cnt += (c > 0u) ? 1u : 0u; mine = (j == x) ? c : mine; }
        if (sum == G) break;
        __builtin_amdgcn_s_sleep(1);
        if ((++sp & 255u) == 0u) { if (xb_ld(&bar[XB_TMO])) break; if (sp > XB_SPIN_CAP) { atomicAdd(&bar[XB_TMO], 1u); break; } }
    }
    nloc = mine > 0u ? mine : 1u; nx = cnt > 0u ? cnt : 1u;
}
__device__ __forceinline__ void xcd_barrier(const XcdBarrier& b) {
    asm volatile("s_waitcnt vmcnt(0)" ::: "memory");
    __syncthreads();
    if (threadIdx.x == 0) {
        unsigned* bar = b.bar;
        __builtin_amdgcn_s_waitcnt(0);
        unsigned nloc = b.st[0], nx = b.st[1];
        if (nloc == 0u) { xcd_barrier_complete(bar, b.x, nloc, nx); b.st[0] = nloc; b.st[1] = nx; }
        const unsigned old = xb_add(&bar[XB_XSUB(b.x)], 1u);
        const unsigned gen = old / nloc;
        if (old + 1u == (gen + 1u) * nloc) {
            __builtin_amdgcn_fence(__ATOMIC_RELEASE, "agent");
            asm volatile("s_waitcnt vmcnt(0)" ::: "memory");
            const unsigned og = xb_add(&bar[XB_TOP], 1u);
            const unsigned tg = og / nx;
            if (og + 1u == (tg + 1u) * nx) xb_add(&bar[XB_TOPGEN], 1u);
            else XB_SPIN(xb_ld(&bar[XB_TOPGEN]) == tg, bar);
            __builtin_amdgcn_fence(__ATOMIC_ACQUIRE, "agent");
            xb_add(&bar[XB_XGEN(b.x)], 1u);
            asm volatile("s_waitcnt vmcnt(0)" ::: "memory");
        } else {
            XB_SPIN(xb_ld(&bar[XB_XGEN(b.x)]) == gen, bar);
            __builtin_amdgcn_fence(__ATOMIC_ACQUIRE, "agent");
            asm volatile("s_waitcnt vmcnt(0)" ::: "memory");
        }
    }
    __syncthreads();
}

namespace pg8 {
typedef unsigned short bf16_t;
constexpr int BM = 256, BK = 64, HALF = 128, HTB = HALF * BK * 2, STAGE_BYTES = 8 * HTB;
__host__ __device__ __forceinline__ int lds_byte(int r, int c) { const int st = (r >> 4) * 2 + (c >> 5), rr = r & 15, cc = c & 31, ob = rr * 64 + cc * 2; return st * 1024 + (ob ^ (((ob >> 9) & 1) << 5)); }
__host__ __device__ __forceinline__ void stage_rc(int b, int& R, int& C) { const int st = b / 1024, sb = b % 1024, swz = sb ^ (((sb >> 9) & 1) << 5); R = (st >> 1) * 16 + swz / 64; C = (st & 1) * 32 + (swz % 64) / 2; }
__host__ __device__ __forceinline__ int perm32(int rho) { const int n = rho >> 4, i = rho & 15; return 8 * (i >> 2) + 4 * n + (i & 3); }
struct Unit { int pm, pn; };
struct Gemm { const bf16_t* A; const bf16_t* Bt; int K; };
__device__ __forceinline__ unsigned cvt_pk_bf16(float lo, float hi) { unsigned r; asm volatile("v_cvt_pk_bf16_f32 %0, %1, %2" : "=v"(r) : "v"(lo), "v"(hi)); return r; }

template <class Epi, class Sched, bool ALIGN_EPI>
__device__ __forceinline__ void gemm_phase(LAS unsigned char* lds, const Gemm g, const Sched& S, const Epi& E) {
    const int tid = threadIdx.x, wid = __builtin_amdgcn_readfirstlane(tid >> 6), lane = tid & 63, wr = wid >> 2, wc = wid & 3, fr = lane & 15, fq = lane >> 4;
    const int K = g.K, nt = K / BK;
    int Rs[2], Cs[2]; unsigned voffB[2];
#pragma unroll
    for (int i = 0; i < 2; ++i) { int R, C; stage_rc(tid * 16 + i * 8192, R, C); const int Rb = Epi::PERM ? ((R & ~31) + perm32(R & 31)) : R;
        Rs[i] = R; Cs[i] = C * 2; voffB[i] = (unsigned)(Rb * K + C) * 2u; }
    const size_t kstep = (size_t)(BK * 2);
    const size_t hstep = (size_t)HALF * K * 2;
    const unsigned ldsw = (unsigned)wid * 1024u;
    const int aoff = lds_byte(wr * 64 + fr, fq * 8), boff = lds_byte(wc * 32 + fr, fq * 8);
#define PG8_SA(b, h) (((b) * 2 + (h)) * HTB)
#define PG8_SB(b, h) ((4 + (b) * 2 + (h)) * HTB)
#define PG8_STAGE(bufoff, gbase, v0, v1) do { \
        __builtin_amdgcn_global_load_lds((const unsigned*)((const char*)(gbase) + (v0)), (LAS unsigned*)(lds + (bufoff) + ldsw), 16, 0, 0); \
        __builtin_amdgcn_global_load_lds((const unsigned*)((const char*)(gbase) + (v1)), (LAS unsigned*)(lds + (bufoff) + ldsw + 8192), 16, 0, 0); } while (0)
#define PG8_STAGEB(bufoff, gbase) PG8_STAGE(bufoff, gbase, voffB[0], voffB[1])
#define PG8_LDA(dst, b, h) do { _Pragma("unroll") for (int m = 0; m < 4; ++m) _Pragma("unroll") for (int k = 0; k < 2; ++k) dst[m][k] = *(const LAS bf16x8*)(lds + PG8_SA(b, h) + aoff + m * 2048 + k * 1024); } while (0)
#define PG8_LDB(dst, b, h) do { _Pragma("unroll") for (int n = 0; n < 2; ++n) _Pragma("unroll") for (int k = 0; k < 2; ++k) dst[n][k] = *(const LAS bf16x8*)(lds + PG8_SB(b, h) + boff + n * 2048 + k * 1024); } while (0)
#define PG8_MMA(ai, bj, At, Bt) do { __builtin_amdgcn_s_setprio(1); _Pragma("unroll") for (int m = 0; m < 4; ++m) _Pragma("unroll") for (int n = 0; n < 2; ++n) _Pragma("unroll") for (int k = 0; k < 2; ++k) \
        acc[ai][bj][m][n] = __builtin_amdgcn_mfma_f32_16x16x32_bf16(Bt[n][k], At[m][k], acc[ai][bj][m][n], 0, 0, 0); __builtin_amdgcn_s_setprio(0); } while (0)
#define PG8_WAIT_V(n) asm volatile("s_waitcnt vmcnt(" #n ")" ::: "memory")
#define PG8_WAIT_L(n) asm volatile("s_waitcnt lgkmcnt(" #n ")" ::: "memory")
#define PG8_BAR __builtin_amdgcn_s_barrier()
#define PG8_SCHED __builtin_amdgcn_sched_barrier(0)
    Unit cur, nxt; int ui = 0;
    if (!S.next(0, cur)) return;
    f32x4 acc[2][2][4][2];
#pragma unroll
    for (int a = 0; a < 2; ++a)
#pragma unroll
        for (int b = 0; b < 2; ++b)
#pragma unroll
            for (int m = 0; m < 4; ++m)
#pragma unroll
                for (int n = 0; n < 2; ++n) acc[a][b][m][n] = (f32x4){0.f, 0.f, 0.f, 0.f};
    bf16x8 At[4][2], B0[2][2], B1[2][2];
    unsigned vc[2][2], vn[2][2];
#pragma unroll
    for (int h = 0; h < 2; ++h)
#pragma unroll
        for (int i = 0; i < 2; ++i) vc[h][i] = (unsigned)S.arow(cur, h * HALF + Rs[i]) * (unsigned)(K * 2) + (unsigned)Cs[i];
    const char* cA = (const char*)g.A;
    const char* cB = (const char*)g.Bt + (size_t)S.brow0(cur) * K * 2;
    PG8_STAGEB(PG8_SB(0, 0), cB); PG8_STAGEB(PG8_SB(0, 1), cB + hstep); PG8_STAGE(PG8_SA(0, 0), cA, vc[0][0], vc[0][1]); PG8_STAGE(PG8_SA(0, 1), cA, vc[1][0], vc[1][1]);
    if (wr == 1) PG8_BAR;
    PG8_WAIT_V(2); PG8_BAR;
    PG8_STAGEB(PG8_SB(1, 0), cB + kstep); PG8_STAGE(PG8_SA(1, 0), cA + kstep, vc[0][0], vc[0][1]); PG8_STAGEB(PG8_SB(1, 1), cB + hstep + kstep);
    PG8_WAIT_V(6); PG8_BAR;
    for (;;) {
        const bool has_next = S.next(ui + 1, nxt);
        const char* nB = cB;
        if (has_next) {
            nB = (const char*)g.Bt + (size_t)S.brow0(nxt) * K * 2;
#pragma unroll
            for (int h = 0; h < 2; ++h)
#pragma unroll
                for (int i = 0; i < 2; ++i) vn[h][i] = (unsigned)S.arow(nxt, h * HALF + Rs[i]) * (unsigned)(K * 2) + (unsigned)Cs[i];
        } else {
#pragma unroll
            for (int h = 0; h < 2; ++h)
#pragma unroll
                for (int i = 0; i < 2; ++i) vn[h][i] = vc[h][i];
        }
        for (int t = 0; t < nt; t += 2) {
            const bool last = (t == nt - 2);
            const char* a1 = cA + (size_t)(t + 1) * kstep;
            const char* a2 = last ? cA : cA + (size_t)(t + 2) * kstep; const char* b2 = last ? nB : cB + (size_t)(t + 2) * kstep;
            const char* a3 = a2 + kstep; const char* b3 = b2 + kstep;
            const unsigned w00 = last ? vn[0][0] : vc[0][0], w01 = last ? vn[0][1] : vc[0][1], w10 = last ? vn[1][0] : vc[1][0], w11 = last ? vn[1][1] : vc[1][1];
            PG8_LDB(B0, 0, 0); PG8_LDB(B1, 0, 1); PG8_SCHED; PG8_LDA(At, 0, 0); PG8_STAGE(PG8_SA(1, 1), a1, vc[1][0], vc[1][1]);
            PG8_WAIT_V(8); PG8_WAIT_L(0); PG8_BAR; PG8_MMA(0, 0, At, B0); PG8_MMA(0, 1, At, B1); PG8_BAR; PG8_SCHED;
            PG8_LDA(At, 0, 1); PG8_STAGEB(PG8_SB(0, 0), b2); PG8_STAGEB(PG8_SB(0, 1), b2 + hstep); PG8_STAGE(PG8_SA(0, 0), a2, w00, w01);
            PG8_WAIT_V(8); PG8_WAIT_L(0); PG8_BAR; PG8_MMA(1, 0, At, B0); PG8_MMA(1, 1, At, B1); PG8_BAR; PG8_SCHED;
            PG8_LDB(B0, 1, 0); PG8_LDB(B1, 1, 1); PG8_SCHED; PG8_LDA(At, 1, 0); PG8_STAGE(PG8_SA(0, 1), a2, w10, w11);
            PG8_WAIT_V(8); PG8_WAIT_L(0); PG8_BAR; PG8_MMA(0, 0, At, B0); PG8_MMA(0, 1, At, B1); PG8_BAR; PG8_SCHED;
            PG8_LDA(At, 1, 1); PG8_STAGEB(PG8_SB(1, 0), b3); PG8_STAGEB(PG8_SB(1, 1), b3 + hstep); PG8_STAGE(PG8_SA(1, 0), a3, w00, w01);
            PG8_WAIT_V(8); PG8_WAIT_L(0); PG8_BAR; PG8_MMA(1, 0, At, B0); PG8_MMA(1, 1, At, B1); PG8_BAR; PG8_SCHED;
        }
        if constexpr (ALIGN_EPI) { if (wr == 0) PG8_BAR; }
        E(acc, cur, wr, wc, fr, fq);
        if (!has_next) break;
#pragma unroll
        for (int a = 0; a < 2; ++a)
#pragma unroll
            for (int b = 0; b < 2; ++b)
#pragma unroll
                for (int m = 0; m < 4; ++m)
#pragma unroll
                    for (int n = 0; n < 2; ++n) acc[a][b][m][n] = (f32x4){0.f, 0.f, 0.f, 0.f};
        cur = nxt; cB = nB; ++ui;
#pragma unroll
        for (int h = 0; h < 2; ++h)
#pragma unroll
            for (int i = 0; i < 2; ++i) vc[h][i] = vn[h][i];
        if constexpr (ALIGN_EPI) { if (wr == 1) PG8_BAR; }
    }
    PG8_WAIT_V(0);
    if constexpr (!ALIGN_EPI) { if (wr == 0) PG8_BAR; }
    PG8_BAR;
#undef PG8_SA
#undef PG8_SB
#undef PG8_STAGE
#undef PG8_STAGEB
#undef PG8_LDA
#undef PG8_LDB
#undef PG8_MMA
#undef PG8_WAIT_V
#undef PG8_WAIT_L
#undef PG8_BAR
#undef PG8_SCHED
}

struct StaticOrder {
    int nM, nN, nwg, G, c;
    __device__ void init(int Mrows, int N, int G_, int c_) { nM = Mrows / BM; nN = N / BM; nwg = nM * nN; G = G_; c = c_; }
    __device__ bool next(int i, Unit& u) const {
        const long L = (long)i * G + c; if (L >= nwg) return false;
        int wgid = (int)L; { const int q = nwg / 8, r = nwg % 8, xcd = wgid % 8, off = wgid / 8; wgid = (xcd < r ? xcd * (q + 1) : r * (q + 1) + (xcd - r) * q) + off; }
        const int nig = 8 * nN, gid = wgid / nig, fm = gid * 8, gsz = (nM - fm) < 8 ? (nM - fm) : 8;
        u.pm = fm + ((wgid % nig) % gsz); u.pn = (wgid % nig) / gsz; return true;
    }
    __device__ __forceinline__ int arow(const Unit& u, int rt) const { return u.pm * BM + rt; }
    __device__ __forceinline__ int brow0(const Unit& u) const { return u.pn * BM; }
};
}

#include <cmath>
namespace attn_body {
using bf16=unsigned short;
using bf16x8=__attribute__((ext_vector_type(8)))short;
using s16x4=__attribute__((ext_vector_type(4)))short;
using f32x16=__attribute__((ext_vector_type(16)))float;
using u32x4=__attribute__((ext_vector_type(4)))unsigned;
using u32x2=__attribute__((ext_vector_type(2)))unsigned;
constexpr int BATCH=4,NHEAD=8,SEQ=8192,D=64,DM=NHEAD*D,OPITCH=1024,MPITCH=1024;
constexpr int NW=8,QBLK=32,QB=QBLK*NW,KVBLK=64,NQB=SEQ/QB;
constexpr int ATTN_PITCH=DM, ATTN_UNIT_ROWS=QB;
__device__ __forceinline__ int crow(int r,int hi){return (r&3)+8*(r>>2)+4*hi;}
#define SBAR() __builtin_amdgcn_sched_barrier(0)
constexpr int NSLOT=3, SLOTB=8192;
constexpr int LDS_K=0, LDS_V=NSLOT*SLOTB, LDS_WS=2*NSLOT*SLOTB, LDS_OST=LDS_WS+NW*64*4, LDS_MK=LDS_OST+NW*4096, LDS_BYTES=LDS_MK+NW*1024;
__device__ __forceinline__ void glds16(const void*gsrc,unsigned lds_dst){unsigned keep;
  asm volatile("s_mov_b32 %0, m0\n\ts_mov_b32 m0, %2\n\ts_nop 0\n\tglobal_load_lds_dwordx4 %1, off\n\ts_mov_b32 m0, %0":"=&s"(keep):"v"(gsrc),"s"(lds_dst):"memory");}
__device__ __forceinline__ void glds4(const void*gsrc,unsigned lds_dst){unsigned keep;
  asm volatile("s_mov_b32 %0, m0\n\ts_mov_b32 m0, %2\n\ts_nop 0\n\tglobal_load_lds_dword %1, off\n\ts_mov_b32 m0, %0":"=&s"(keep):"v"(gsrc),"s"(lds_dst):"memory");}
__device__ __forceinline__ float mskf(float x,unsigned w,int pos){ unsigned m; asm("v_bfe_i32 %0, %1, %2, 1":"=v"(m):"v"(w),"n"(pos)); return __uint_as_float(__float_as_uint(x) & m); }
__device__ __forceinline__ float max3f(float a,float b,float c){float r;asm("v_max3_f32 %0, %1, %2, %3":"=v"(r):"v"(a),"v"(b),"v"(c));return r;}
__device__ __forceinline__ float max2f(float a,float b){float r;asm("v_max_f32_e32 %0, %1, %2":"=v"(r):"v"(a),"v"(b));return r;}
__device__ __forceinline__ float fadd_s(float a,float b){float r;asm("v_add_f32_e32 %0, %1, %2":"=v"(r):"v"(a),"v"(b));return r;}
__device__ __forceinline__ float fsub_s(float a,float b){float r;asm("v_sub_f32_e32 %0, %1, %2":"=v"(r):"v"(a),"v"(b));return r;}
typedef float f32x2_t __attribute__((ext_vector_type(2))); typedef __bf16 bf16x2_t __attribute__((ext_vector_type(2)));
__device__ __forceinline__ unsigned cvtpk_s(float lo,float hi){f32x2_t v={lo,hi};bf16x2_t b=__builtin_convertvector(v,bf16x2_t);return __builtin_bit_cast(unsigned,b);}
#define WAIT_BAR(N) asm volatile("s_waitcnt vmcnt(" #N ") lgkmcnt(0)\n\ts_barrier":::"memory")

__device__ __forceinline__ void qkt(f32x16&p0,f32x16&p1,const char*Kslot,const bf16x8*qr,const f32x16&negm,int r32,int hi){
  const char*kb=Kslot+hi*1024+r32*16;
  #pragma unroll
  for(int d0=0;d0<4;++d0){
    const bf16x8 b0=*reinterpret_cast<const bf16x8*>(kb+d0*2048);
    const bf16x8 b1=*reinterpret_cast<const bf16x8*>(kb+d0*2048+512);
    if(d0==0){p0=__builtin_amdgcn_mfma_f32_32x32x16_bf16(b0,qr[0],negm,0,0,0);p1=__builtin_amdgcn_mfma_f32_32x32x16_bf16(b1,qr[0],negm,0,0,0);}
    else{p0=__builtin_amdgcn_mfma_f32_32x32x16_bf16(b0,qr[d0],p0,0,0,0);p1=__builtin_amdgcn_mfma_f32_32x32x16_bf16(b1,qr[d0],p1,0,0,0);}}
}
typedef __attribute__((address_space(3))) const char* lds_cptr;
typedef short v4i16_t __attribute__((ext_vector_type(4)));
__device__ __forceinline__ void kload8(bf16x8*kf,lds_cptr kp){
  kf[0]=*(const __attribute__((address_space(3))) bf16x8*)(kp);      kf[1]=*(const __attribute__((address_space(3))) bf16x8*)(kp+512);
  kf[2]=*(const __attribute__((address_space(3))) bf16x8*)(kp+2048); kf[3]=*(const __attribute__((address_space(3))) bf16x8*)(kp+2560);
  kf[4]=*(const __attribute__((address_space(3))) bf16x8*)(kp+4096); kf[5]=*(const __attribute__((address_space(3))) bf16x8*)(kp+4608);
  kf[6]=*(const __attribute__((address_space(3))) bf16x8*)(kp+6144); kf[7]=*(const __attribute__((address_space(3))) bf16x8*)(kp+6656);
}
__device__ __forceinline__ void kload2(bf16x8*kf,lds_cptr kp,int j){ kf[2*j]=*(const __attribute__((address_space(3))) bf16x8*)(kp+j*2048); kf[2*j+1]=*(const __attribute__((address_space(3))) bf16x8*)(kp+j*2048+512); }
__device__ __forceinline__ s16x4 vtr(lds_cptr p){ return __builtin_bit_cast(s16x4,__builtin_amdgcn_ds_read_tr16_b64_v4i16((__attribute__((address_space(3))) v4i16_t*)p)); }
__device__ __forceinline__ float rowmax(const f32x16&p0,const f32x16&p1){
  float a=max3f(p0[0],p0[1],p1[0]),b=max3f(p0[2],p0[3],p1[1]);a=max3f(a,p1[2],p1[3]);
  #pragma unroll
  for(int r=4;r<16;r+=4){a=max3f(a,p0[r],p0[r+1]);b=max3f(b,p0[r+2],p0[r+3]);a=max3f(a,p1[r],p1[r+1]);b=max3f(b,p1[r+2],p1[r+3]);}
  const float m=max2f(a,b);
  auto rr=__builtin_amdgcn_permlane32_swap(__float_as_uint(m),__float_as_uint(m),false,false);
  return max2f(__uint_as_float(rr[0]),__uint_as_float(rr[1]));
}
__device__ __forceinline__ void pv(f32x16*o,int vb,bf16x8 pa0,bf16x8 pa1,bf16x8 pa2,bf16x8 pa3){
  #pragma unroll
  for(int d0=0;d0<2;++d0){s16x4 lo[4],hi[4];
    #pragma unroll
    for(int ks=0;ks<4;++ks){
      asm volatile("ds_read_b64_tr_b16 %0,%1 offset:%c2":"=&v"(lo[ks]):"v"(vb),"i"(d0*4096+ks*1024):"memory");
      asm volatile("ds_read_b64_tr_b16 %0,%1 offset:%c2":"=&v"(hi[ks]):"v"(vb),"i"(d0*4096+ks*1024+512):"memory");}
    asm volatile("s_waitcnt lgkmcnt(0)":::"memory");SBAR();
    #define PK(k) (bf16x8){lo[k][0],lo[k][1],lo[k][2],lo[k][3],hi[k][0],hi[k][1],hi[k][2],hi[k][3]}
    o[d0]=__builtin_amdgcn_mfma_f32_32x32x16_bf16(pa0,PK(0),o[d0],0,0,0);
    o[d0]=__builtin_amdgcn_mfma_f32_32x32x16_bf16(pa1,PK(1),o[d0],0,0,0);
    o[d0]=__builtin_amdgcn_mfma_f32_32x32x16_bf16(pa2,PK(2),o[d0],0,0,0);
    o[d0]=__builtin_amdgcn_mfma_f32_32x32x16_bf16(pa3,PK(3),o[d0],0,0,0);
    #undef PK
  }
}

#ifndef ATTN_STORE16
#define ATTN_STORE16(p,v) (*(u32x4*)(p)=(v))
#endif
template<int THRL> __device__ __forceinline__ void attn_unit(int b,int h,int qb,const bf16*Q,const bf16*__restrict__ K,const bf16*__restrict__ V,bf16*O,const unsigned char*__restrict__ MK,char*shm){
  const int tid=threadIdx.x,lane=tid&63,r32=lane&31,hi=lane>>5; const int wid=__builtin_amdgcn_readfirstlane(tid>>6);
  const long rowbase=(long)b*SEQ; const int q0=qb*QB;
  const bf16*Qw=Q+(rowbase+q0+wid*QBLK)*DM+h*D;
  const bf16*Kh=K+rowbase*DM+h*D,*Vh=V+rowbase*DM+h*D;
  const unsigned lds0=(unsigned)(uintptr_t)shm;
  float*wsf=(float*)(shm+LDS_WS)+wid*64;
  const bf16*ksrc=Kh+(long)lane*DM+wid*8;
  const bf16*vsrc=Vh+(long)(16*(wid&3)+(lane>>2))*DM+(wid>>2)*32+(lane&3)*8;
  const unsigned kdst=lds0+LDS_K+wid*1024, vdst=lds0+LDS_V+wid*1024;
  #define DMA_K(t,slot) glds16(ksrc+(long)(t)*KVBLK*DM,(unsigned)__builtin_amdgcn_readfirstlane(kdst+(slot)))
  #define DMA_V(t,slot) glds16(vsrc+(long)(t)*KVBLK*DM,(unsigned)__builtin_amdgcn_readfirstlane(vdst+(slot)))
  const unsigned char*msrc=MK+(rowbase+q0+wid*QBLK+(lane>>1))*(long)MPITCH+4*(lane&1);
  const unsigned mdst=lds0+LDS_MK+wid*1024;
  #define DMA_M(t) glds4(msrc+8*(long)(t),(unsigned)__builtin_amdgcn_readfirstlane(mdst+(((t)&3)<<8)))
  const lds_cptr mp0=(lds_cptr)shm+LDS_MK+wid*1024+r32*8;
  #define MLOAD(t) do{ const u32x2 mw_=*(const __attribute__((address_space(3))) u32x2*)(mp0+(((t)&3)<<8)); ml=mw_[0]>>(4*hi); mh=mw_[1]>>(4*hi); }while(0)
  const int vb0=(int)(lds0+LDS_V)+((lane>>4)&1)*32+(lane&3)*8+(4*hi+((lane&15)>>2))*64;
  const char*Kbase=shm+LDS_K; bf16x8 kf[8];
  const lds_cptr shm3=(lds_cptr)shm; const lds_cptr kp0=shm3+LDS_K+hi*1024+r32*16; const lds_cptr vp0=shm3+LDS_V+((lane>>4)&1)*32+(lane&3)*8+(4*hi+((lane&15)>>2))*64;
  const int NT=(q0+QB)/KVBLK;
  DMA_K(0,0);DMA_M(0);DMA_V(0,0);DMA_K(1,SLOTB);
  bf16x8 qr[4];
  #pragma unroll
  for(int d0=0;d0<4;++d0)qr[d0]=*reinterpret_cast<const bf16x8*>(&Qw[(long)r32*DM+d0*16+hi*8]);
  float mhat=0.f,l_reg=0.f;f32x16 o[2];o[0]=f32x16{};o[1]=f32x16{};f32x16 negm=f32x16{};asm volatile("":"+v"(negm));
  const int qrel=wid*QBLK+r32;
  #define CMASK(P0,P1,t) do{}while(0)
  unsigned ml=0u,mh=0u;
  bool resc=false;
  #define START(P0,P1) do{ const float rm=rowmax(P0,P1); resc=false; \
    { const float dl=rm; mhat=fadd_s(mhat,dl); \
      _Pragma("unroll") for(int r=0;r<16;++r){P0[r]=fsub_s(P0[r],dl);P1[r]=fsub_s(P1[r],dl);} \
      _Pragma("unroll") for(int r=0;r<16;++r)negm[r]=-mhat; asm volatile("":"+v"(negm)); } \
    _Pragma("unroll") for(int r=0;r<16;++r)P0[r]=__builtin_amdgcn_exp2f(P0[r]); }while(0)
  #define RESC() do{ if(resc){ asm volatile("s_waitcnt lgkmcnt(0)":::"memory"); \
      _Pragma("unroll") for(int d_=0;d_<2;++d_) _Pragma("unroll") for(int r=0;r<16;++r)o[d_][r]*=wsf[crow(r,hi)]; } }while(0)
  f32x16 pA0,pA1,pB0,pB1;
  int sl_prev=0,sl_cur=0,sl_next=SLOTB;
  #define ROT() do{sl_prev=sl_cur;sl_cur=sl_next;sl_next=(sl_next==(NSLOT-1)*SLOTB)?0:sl_next+SLOTB;}while(0)
  DMA_K(2,2*SLOTB);DMA_M(1);
  WAIT_BAR(4);
  qkt(pA0,pA1,Kbase,qr,negm,r32,hi);asm volatile("s_nop 15\n\ts_nop 7":"+v"(pA0),"+v"(pA1));CMASK(pA0,pA1,0);
  START(pA0,pA1);
  _Pragma("unroll") for(int r=0;r<16;++r)pA1[r]=__builtin_amdgcn_exp2f(pA1[r]);
  MLOAD(0);
  _Pragma("unroll") for(int r=0;r<16;++r){pA0[r]=mskf(pA0[r],ml,(r&3)+8*(r>>2));pA1[r]=mskf(pA1[r],mh,(r&3)+8*(r>>2));}
  WAIT_BAR(0);
  DMA_K(3,0);DMA_V(1,SLOTB);DMA_M(2);
  ROT();
  kload8(kf,kp0+sl_cur);
  WAIT_BAR(3);
  s16x4 vlo[8],vhi[8]; u32x4 pw0,pw1,pw2,pw3;
  #define PKW(P,B) cvtpk_s(P[B],P[B+1])
  #define PAF(k) __builtin_bit_cast(bf16x8,pw##k)
  #define VFR(i) (bf16x8){vlo[i][0],vlo[i][1],vlo[i][2],vlo[i][3],vhi[i][0],vhi[i][1],vhi[i][2],vhi[i][3]}
  #define PIN(x) asm volatile("":"+v"(x))
  #define MX3(a,b,c) __builtin_fmaxf(__builtin_fmaxf((a),(b)),(c))
  #define GAPA(MF,A0,A1,A2,A3,W0,W1,PW) do{ MF; sacc+=A0; sacc+=A1; sacc+=A2; sacc+=A3; PIN(sacc); W0; W1; PIN(PW); SBAR(); }while(0)
  #define EX(v) __builtin_amdgcn_exp2f(v)
  #define GAPB(MF,X,B,W) do{ MF; X[B]=mskf(EX(X[B]),W,2*(B)); X[B+1]=mskf(EX(X[B+1]),W,2*(B)+1); X[B+2]=mskf(EX(X[B+2]),W,2*(B)+2); X[B+3]=mskf(EX(X[B+3]),W,2*(B)+3); PIN(X); SBAR(); }while(0)
  #define VRD(i) do{ vlo[i]=vtr(vp_+(((i)>>2)*4096+((i)&3)*1024)); vhi[i]=vtr(vp_+(((i)>>2)*4096+((i)&3)*1024+512)); }while(0)
  #define KRD(G,j) do{ if(G){ kload2(kf,kp0+sl_next,j); SBAR(); } }while(0)
  #define STEP(C0,C1,P0,P1,t,GK,GV,GL,GM) do{ SBAR(); \
    const lds_cptr vp_=vp0+sl_prev; \
    VRD(0); SBAR(); float sacc=(P0[0]+P0[1]); \
    GAPA(C0=__builtin_amdgcn_mfma_f32_32x32x16_bf16(kf[0],qr[0],negm,0,0,0), P0[2],P0[3],P0[4],P0[5],     pw0[0]=PKW(P0,0), pw0[1]=PKW(P0,2), pw0); \
    VRD(4); SBAR(); GAPA(C1=__builtin_amdgcn_mfma_f32_32x32x16_bf16(kf[1],qr[0],negm,0,0,0), P0[6],P0[7],P0[8],P0[9],     pw0[2]=PKW(P0,4), pw0[3]=PKW(P0,6), pw0); \
    VRD(1); SBAR(); GAPA(C0=__builtin_amdgcn_mfma_f32_32x32x16_bf16(kf[2],qr[1],C0,0,0,0),   P0[10],P0[11],P0[12],P0[13], pw1[0]=PKW(P0,8), pw1[1]=PKW(P0,10), pw1); \
    VRD(5); SBAR(); GAPA(C1=__builtin_amdgcn_mfma_f32_32x32x16_bf16(kf[3],qr[1],C1,0,0,0),   P0[14],P0[15],P1[0],P1[1],   pw1[2]=PKW(P0,12),pw1[3]=PKW(P0,14), pw1); \
    VRD(2); SBAR(); GAPA(C0=__builtin_amdgcn_mfma_f32_32x32x16_bf16(kf[4],qr[2],C0,0,0,0),   P1[2],P1[3],P1[4],P1[5],     pw2[0]=PKW(P1,0), pw2[1]=PKW(P1,2), pw2); \
    VRD(6); SBAR(); GAPA(C1=__builtin_amdgcn_mfma_f32_32x32x16_bf16(kf[5],qr[2],C1,0,0,0),   P1[6],P1[7],P1[8],P1[9],     pw2[2]=PKW(P1,4), pw2[3]=PKW(P1,6), pw2); \
    VRD(3); SBAR(); GAPA(C0=__builtin_amdgcn_mfma_f32_32x32x16_bf16(kf[6],qr[3],C0,0,0,0),   P1[10],P1[11],P1[12],P1[13], pw3[0]=PKW(P1,8), pw3[1]=PKW(P1,10), pw3); \
    VRD(7); SBAR(); GAPA(C1=__builtin_amdgcn_mfma_f32_32x32x16_bf16(kf[7],qr[3],C1,0,0,0),   P1[14],P1[15],0.f,0.f,       pw3[2]=PKW(P1,12),pw3[3]=PKW(P1,14), pw3); \
    l_reg+=sacc; \
    if(GK){DMA_K((t)+3,sl_cur);} if(GV){DMA_V((t)+1,sl_next);} if(GM){DMA_M((t)+2);} \
    CMASK(C0,C1,t); \
    { float a=MX3(C0[0],C0[1],C1[0]),b=MX3(C0[2],C0[3],C1[1]); a=MX3(a,C1[2],C1[3]); \
      _Pragma("unroll") for(int r=4;r<16;r+=4){a=MX3(a,C0[r],C0[r+1]);b=MX3(b,C0[r+2],C0[r+3]);a=MX3(a,C1[r],C1[r+1]);b=MX3(b,C1[r+2],C1[r+3]);} \
      float rm=__builtin_fmaxf(a,b); { auto rr=__builtin_amdgcn_permlane32_swap(__float_as_uint(rm),__float_as_uint(rm),false,false); rm=__builtin_fmaxf(__uint_as_float(rr[0]),__uint_as_float(rr[1])); } \
      resc=false; \
      if(__builtin_expect(__any(rm>(float)THRL),0)){ const float dl=__builtin_fmaxf(rm,0.f); mhat+=dl; \
        _Pragma("unroll") for(int r=0;r<16;++r){C0[r]-=dl;C1[r]-=dl;} \
        _Pragma("unroll") for(int r=0;r<16;++r)negm[r]=-mhat; asm volatile("":"+v"(negm)); \
        const float f=__builtin_amdgcn_exp2f(-dl); l_reg*=f; if(hi==0)wsf[r32]=f; resc=true; } } \
    MLOAD(t); SBAR(); \
    GAPB(o[0]=__builtin_amdgcn_mfma_f32_32x32x16_bf16(PAF(0),VFR(0),o[0],0,0,0), C0,0,ml); \
    GAPB(o[1]=__builtin_amdgcn_mfma_f32_32x32x16_bf16(PAF(0),VFR(4),o[1],0,0,0), C0,4,ml); \
    KRD(GL,0); GAPB(o[0]=__builtin_amdgcn_mfma_f32_32x32x16_bf16(PAF(1),VFR(1),o[0],0,0,0), C0,8,ml); \
    KRD(GL,1); GAPB(o[1]=__builtin_amdgcn_mfma_f32_32x32x16_bf16(PAF(1),VFR(5),o[1],0,0,0), C0,12,ml); \
    KRD(GL,2); GAPB(o[0]=__builtin_amdgcn_mfma_f32_32x32x16_bf16(PAF(2),VFR(2),o[0],0,0,0), C1,0,mh); \
    KRD(GL,3); GAPB(o[1]=__builtin_amdgcn_mfma_f32_32x32x16_bf16(PAF(2),VFR(6),o[1],0,0,0), C1,4,mh); \
    GAPB(o[0]=__builtin_amdgcn_mfma_f32_32x32x16_bf16(PAF(3),VFR(3),o[0],0,0,0), C1,8,mh); \
    GAPB(o[1]=__builtin_amdgcn_mfma_f32_32x32x16_bf16(PAF(3),VFR(7),o[1],0,0,0), C1,12,mh); \
    }while(0)
  int t=1;
  #undef CMASK
  #define CMASK(P0,P1,t) do{}while(0)
  for(;t+5<NT;t+=2){
    STEP(pB0,pB1,pA0,pA1,t,true,true,true,true);     WAIT_BAR(3); RESC(); ROT();
    STEP(pA0,pA1,pB0,pB1,t+1,true,true,true,true);   WAIT_BAR(3); RESC(); ROT();
  }
  #undef CMASK
  #define CMASK(P0,P1,t) do{}while(0)
  #define ENDW(tt) do{ if((tt)+3<NT){WAIT_BAR(3);} else if((tt)+2<NT){WAIT_BAR(2);} else {WAIT_BAR(0);} }while(0)
  for(;t+1<NT;t+=2){
    STEP(pB0,pB1,pA0,pA1,t,(t+3<NT),(t+1<NT),(t+1<NT),(t+2<NT));       ENDW(t);   RESC(); ROT();
    STEP(pA0,pA1,pB0,pB1,t+1,(t+4<NT),(t+2<NT),(t+2<NT),(t+3<NT));     ENDW(t+1); RESC(); ROT();
  }
  STEP(pB0,pB1,pA0,pA1,NT-1,false,false,false,false); RESC();
  { float sacc=pB0[0]+pB0[1]; _Pragma("unroll") for(int r=2;r<16;++r)sacc+=pB0[r]; _Pragma("unroll") for(int r=0;r<16;++r)sacc+=pB1[r]; l_reg+=sacc;
    pw0=(u32x4){PKW(pB0,0),PKW(pB0,2),PKW(pB0,4),PKW(pB0,6)};pw1=(u32x4){PKW(pB0,8),PKW(pB0,10),PKW(pB0,12),PKW(pB0,14)};pw2=(u32x4){PKW(pB1,0),PKW(pB1,2),PKW(pB1,4),PKW(pB1,6)};pw3=(u32x4){PKW(pB1,8),PKW(pB1,10),PKW(pB1,12),PKW(pB1,14)};
    SBAR(); pv(o,vb0+sl_cur,PAF(0),PAF(1),PAF(2),PAF(3)); }
  #undef PKW
  #undef PAF
  #undef VFR
  #undef PIN
  #undef MX3
  #undef GAPA
  #undef GAPB
  #undef EX
  #undef VRD
  #undef KRD
  #undef STEP
  #undef ENDW
  {auto rr=__builtin_amdgcn_permlane32_swap(__float_as_uint(l_reg),__float_as_uint(l_reg),false,false);l_reg=__uint_as_float(rr[0])+__uint_as_float(rr[1]);}
  if(hi==0)wsf[32+r32]=l_reg;asm volatile("s_waitcnt lgkmcnt(0)":::"memory");
  float rli[16];
  #pragma unroll
  for(int r=0;r<16;++r)rli[r]=__builtin_amdgcn_rcpf(wsf[32+crow(r,hi)]);
  bf16*Ow=O+(rowbase+q0+wid*QBLK)*OPITCH+h*D;
  { bf16*stg=(bf16*)(shm+LDS_OST)+wid*2048;
    #pragma unroll
    for(int r=0;r<16;++r){const int orow=crow(r,hi);
      #pragma unroll
      for(int d0=0;d0<2;++d0)stg[orow*64+d0*32+r32]=(bf16)f2bf(o[d0][r]*rli[r]);}
    asm volatile("s_waitcnt lgkmcnt(0)":::"memory");
    #pragma unroll
    for(int i=0;i<4;++i){const int row=i*8+(lane>>3),ch=lane&7; const u32x4 v=*(const u32x4*)(stg+row*64+ch*8); ATTN_STORE16(Ow+(long)row*OPITCH+ch*8,v);} }
  asm volatile("s_waitcnt lgkmcnt(0)\n\ts_barrier":::"memory");
  #undef DMA_K
  #undef DMA_V
  #undef DMA_M
  #undef MLOAD
  #undef CMASK
  #undef START
  #undef RESC
  #undef ROT
}
constexpr int ATTN_LDS_BYTES=LDS_BYTES;
struct AttnTensors { const bf16* Q; const bf16* K; const bf16* V; bf16* O; const unsigned char* MK; };
struct AttnUnit { int bh; int qb; };
struct StaticOrder {
  int vcu;
  __device__ __forceinline__ explicit StaticOrder(int grid,int block):vcu((block%8)*(grid/8)+block/8){}
  __device__ __forceinline__ bool next(int i,AttnUnit&u)const{ if(i>=4)return false; const int s=vcu&7; u.bh=vcu>>3; u.qb=(i==0)?s:(i==1)?15-s:(i==2)?16+s:31-s; return true; }
  __device__ __forceinline__ void a_ready(const AttnUnit&)const{}
  __device__ __forceinline__ void done(const AttnUnit&)const{}
};
template<class Sched,int THRL=8> __device__ __forceinline__ void attn_phase(char*lds,const AttnTensors&T,const Sched&S){
  AttnUnit u;
  for(int i=0;S.next(i,u);++i){ S.a_ready(u); attn_unit<THRL>(u.bh/NHEAD,u.bh%NHEAD,u.qb,T.Q,T.K,T.V,T.O,T.MK,lds); S.done(u); }
}
#undef SBAR
#undef WAIT_BAR
}

struct Args { const void* in[15]; float* out; unsigned char* ws; int ph_lo, ph_hi; };
#define CAS __attribute__((address_space(4)))
struct Frame {
    LAS unsigned char* lds;
    gu32* ctl;
    unsigned char* ws;
    int tid, lane, wave;
    int vcu, G;
    const CAS Args* ka;
    __device__ __forceinline__ const float* inp(int k) const { return (const float*)ka->in[k]; }
#define FDEF(name, k) __device__ __forceinline__ const float* name() const { return inp(k); }
    FDEF(x, 0) FDEF(c, 1) FDEF(w_ada, 3) FDEF(b_ada, 4) FDEF(g_mix, 5) FDEF(w_in, 6) FDEF(w_o, 7) FDEF(g_ffn, 8) FDEF(w_rg, 9) FDEF(w_re, 10) FDEF(w_up, 11) FDEF(w_gate, 12) FDEF(w_down, 13) FDEF(g_fin, 14)
#undef FDEF
    __device__ __forceinline__ const int* pos() const { return (const int*)ka->in[2]; }
    __device__ __forceinline__ float* out() const { return ka->out; }
};

__device__ __forceinline__ void tr_put(LAS unsigned* T, int nb, int ns, int p, const f32x4 a, const f32x4 b) {
    T[(nb) * 33 + p] = pg8::cvt_pk_bf16(a.x, b.x); T[(nb + ns) * 33 + p] = pg8::cvt_pk_bf16(a.y, b.y);
    T[(nb + 2 * ns) * 33 + p] = pg8::cvt_pk_bf16(a.z, b.z); T[(nb + 3 * ns) * 33 + p] = pg8::cvt_pk_bf16(a.w, b.w);
}
__device__ __forceinline__ void tr_store(LAS unsigned* T, bf16* WT, int K, int n0, int k0, int lane) {
    LDS_WAIT(); asm volatile("" ::: "memory");
#pragma unroll
    for (int i = 0; i < 8; ++i) { const int n = (lane >> 3) + 8 * i, kc = lane & 7; const LAS unsigned* t = T + n * 33 + 4 * kc;
        v4u o; o.x = t[0]; o.y = t[1]; o.z = t[2]; o.w = t[3];
        *(GAS v4u*)(WT + (size_t)(n0 + n) * K + k0 + 8 * kc) = o; }
    LDS_WAIT(); asm volatile("" ::: "memory");
}
__device__ __forceinline__ void tr_tile_gu(const float* gate, const float* up, bf16* WT, int n0, int k0, LAS unsigned* T, int lane) {
    const int pq = lane >> 3, cq = lane & 7, c0 = n0 >> 1;
    f32x4 g0[4], g1[4], u0[4], u1[4];
#pragma unroll
    for (int i = 0; i < 4; ++i) { const int p = pq + 8 * i; const size_t o = (size_t)(k0 + 2 * p) * DEXP + c0 + 4 * cq;
        g0[i] = *(const GAS f32x4*)(gate + o); g1[i] = *(const GAS f32x4*)(gate + o + DEXP); u0[i] = *(const GAS f32x4*)(up + o); u1[i] = *(const GAS f32x4*)(up + o + DEXP); }
#pragma unroll
    for (int i = 0; i < 4; ++i) { const int p = pq + 8 * i; tr_put(T, 8 * cq, 2, p, g0[i], g1[i]); tr_put(T, 8 * cq + 1, 2, p, u0[i], u1[i]); }
    tr_store(T, WT, 1024, n0, k0, lane);
}
__device__ __forceinline__ void tr_tile_d(const float* wd, bf16* WT, int n0, int k0, LAS unsigned* T, int lane) {
    const int pq = lane >> 4, cq = lane & 15;
    f32x4 a[8], b[8];
#pragma unroll
    for (int i = 0; i < 8; ++i) { const int p = pq + 4 * i; const size_t o = (size_t)(k0 + 2 * p) * D + n0 + 4 * cq; a[i] = *(const GAS f32x4*)(wd + o); b[i] = *(const GAS f32x4*)(wd + o + D); }
#pragma unroll
    for (int i = 0; i < 8; ++i) { const int p = pq + 4 * i; tr_put(T, 4 * cq, 1, p, a[i], b[i]); }
    tr_store(T, WT, 512, n0, k0, lane);
}

template <class SrcFn>
__device__ __forceinline__ void tr_tile_gen(const SrcFn& src, int ldw, bf16* WT, int K, int n0, int k0, LAS unsigned* T, int lane) {
    const int pq = lane >> 4, cq = lane & 15; const float* sp = src(n0 + 4 * cq);
    f32x4 a[8], b[8];
#pragma unroll
    for (int i = 0; i < 8; ++i) { const int p = pq + 4 * i;
        if (sp) { a[i] = *(const GAS f32x4*)(sp + (size_t)(k0 + 2 * p) * ldw); b[i] = *(const GAS f32x4*)(sp + (size_t)(k0 + 2 * p + 1) * ldw); }
        else { a[i] = (f32x4){0.f, 0.f, 0.f, 0.f}; b[i] = a[i]; } }
#pragma unroll
    for (int i = 0; i < 8; ++i) { const int p = pq + 4 * i; tr_put(T, 4 * cq, 1, p, a[i], b[i]); }
    tr_store(T, WT, K, n0, k0, lane);
}

__device__ __forceinline__ int prope_dim(int p) { return p < 16 ? 8 * ((p >> 2) & 1) + 4 * (p >> 3) + (p & 3) : p; }
__device__ __forceinline__ int rrope_dim(int p) { return 32 * ((p >> 2) & 1) + 4 * (p >> 3) + (p & 3); }
__device__ __forceinline__ int win_src_col(int n) {
    if (n < 1024) return (n & ~63) + prope_dim(n & 63);
    if (n < 1536) return n;
    if (n < 2560) return (n & ~63) + prope_dim(n & 63);
    if (n < 3584) { const int q = n - 2560, sec = q >> 9, hd = (q >> 6) & 7; return (sec ? 3152 : 2640) + hd * 64 + rrope_dim(q & 63); }
    if (n < 4096) return 3664 + (n - 3584);
    if (n < 4608) return 4176 + (n - 4096);
    if (n < 4672) return 2560 + prope_dim(n - 4608);
    if (n < 4688) return 2624 + (n - 4672);
    return -1;
}

__device__ __forceinline__ void p0_prologue(Frame& F) {
    const int gw = F.vcu * NWAVES + F.wave, NGW = F.G * NWAVES;
    float* modp = (float*)(F.ws + WS_MODP);
    for (int rp2 = 0; rp2 < SUBREPS(20); ++rp2)
    for (int task = gw; task < 24 * 16; task += NGW) {
        const int cg = task % 24, ks = task / 24, j0 = cg * 256 + F.lane * 4;
        f32x4 a0 = {0, 0, 0, 0}, a1 = a0, a2 = a0, a3 = a0;
#pragma unroll 8
        for (int kk = 0; kk < 64; ++kk) { const int k = ks * 64 + kk; const f32x4 w = *(const GAS f32x4*)(F.w_ada() + (size_t)k * 6144 + j0);
            a0 += w * F.c()[0 * D + k]; a1 += w * F.c()[1 * D + k]; a2 += w * F.c()[2 * D + k]; a3 += w * F.c()[3 * D + k]; }
        *(GAS f32x4*)(modp + ((size_t)(ks * 4 + 0) * 6144 + j0)) = a0; *(GAS f32x4*)(modp + ((size_t)(ks * 4 + 1) * 6144 + j0)) = a1;
        *(GAS f32x4*)(modp + ((size_t)(ks * 4 + 2) * 6144 + j0)) = a2; *(GAS f32x4*)(modp + ((size_t)(ks * 4 + 3) * 6144 + j0)) = a3;
    }
    {
        float* c1 = (float*)(F.ws + WS_ROPE1); float* s1 = c1 + (size_t)M * 8;
        float* c2 = (float*)(F.ws + WS_ROPE2); float* s2 = c2 + (size_t)M * 32;
        const int gt = (F.vcu * NWAVES + F.wave) * 64 + F.lane, NGT = NGW * 64;
        for (int rp2 = 0; rp2 < SUBREPS(18); ++rp2)
        for (int i = gt; i < M * 40; i += NGT) {
            const int m = i / 40, j = i % 40; const float p = (float)F.pos()[m];
            if (j < 8) { const float inv = powf(500000.0f, -(float)j / 8.0f); float sn, cs; sincosf(p * inv, &sn, &cs); c1[m * 8 + j] = cs; s1[m * 8 + j] = sn; }
            else { const int jj = j - 8; const float inv = powf(10000.0f, -(float)jj / 32.0f); float sn, cs; sincosf(p * inv, &sn, &cs); c2[m * 32 + jj] = cs; s2[m * 32 + jj] = sn; }
        }
    }
    {
        constexpr int I_IN = (NPAD / 64) * (D / 64), I_O = (D / 64) * (D / 64);
        bf16* wint = (bf16*)(F.ws + WS_WIN); bf16* wot = (bf16*)(F.ws + WS_WO);
        const float* w_in = F.w_in(); const float* w_o = F.w_o();
        LAS unsigned* T = (LAS unsigned*)(F.lds + F.wave * 16384);
        for (int rp2 = 0; rp2 < SUBREPS(19); ++rp2)
        for (int it = gw; it < I_IN + I_O; it += NGW) {
            if (it < I_IN) { const int nb = it / 16, kb = it % 16;
                tr_tile_gen([&](int n) -> const float* { const int sc = win_src_col(n); return sc < 0 ? nullptr : w_in + sc; }, DIN, wint, D, nb * 64, kb * 64, T, F.lane); }
            else { const int r = it - I_IN, nb = r / 16, kb = r % 16;
                tr_tile_gen([&](int n) -> const float* { return w_o + n; }, D, wot, D, nb * 64, kb * 64, T, F.lane); }
        }
    }
}

__device__ __forceinline__ float mod_value(const float* modp, const float* b_ada, int b, int j) {
    float s = 0.f;
#pragma unroll
    for (int ks = 0; ks < 16; ++ks) s += modp[(size_t)(ks * 4 + b) * 6144 + j];
    return s + b_ada[j];
}
__device__ __forceinline__ void p1_norm(Frame& F) {
    const float* modp = (const float*)(F.ws + WS_MODP);
    LAS float* G1 = (LAS float*)F.lds;
    LAS float* S1 = G1 + 4 * D;
    for (int i = F.tid; i < 4 * D; i += NWAVES * 64) { const int b = i >> 10, col = i & 1023;
        const float sh = mod_value(modp, F.b_ada(), b, col), sc = mod_value(modp, F.b_ada(), b, 1024 + col);
        G1[i] = F.g_mix()[col] * (1.f + sc); S1[i] = sh; }
    if (blockIdx.x < 4) { float* mod = (float*)(F.ws + WS_MOD); const int b = blockIdx.x;
        for (int j = F.tid; j < 6144; j += NWAVES * 64) mod[b * 6144 + j] = mod_value(modp, F.b_ada(), b, j); }
    __syncthreads();
    const int gw = F.vcu * NWAVES + F.wave, NGW = F.G * NWAVES;
    bf16* H = (bf16*)(F.ws + WS_H);
    f32x4 nv[4];
    if (gw < M) { const GAS f32x4* xr = (const GAS f32x4*)(F.x() + (size_t)gw * D) + F.lane;
#pragma unroll
        for (int j = 0; j < 4; ++j) nv[j] = xr[64 * j]; }
    for (int m = gw; m < M; m += NGW) {
        const int b = m >> 13;
        f32x4 v[4]; float s = 0.f;
#pragma unroll
        for (int j = 0; j < 4; ++j) v[j] = nv[j];
        if (m + NGW < M) { const GAS f32x4* xr = (const GAS f32x4*)(F.x() + (size_t)(m + NGW) * D) + F.lane;
#pragma unroll
            for (int j = 0; j < 4; ++j) nv[j] = xr[64 * j]; }
#pragma unroll
        for (int j = 0; j < 4; ++j) s += (v[j].x * v[j].x + v[j].y * v[j].y) + (v[j].z * v[j].z + v[j].w * v[j].w);
        const float r = 1.f / sqrtf(wave_sum(s) * (1.f / D) + EPS);
        GAS unsigned long long* o8 = (GAS unsigned long long*)(H + (size_t)m * D) + F.lane;
#pragma unroll
        for (int j = 0; j < 4; ++j) { const int col = 4 * F.lane + 256 * j; const f32x4 g = *(const LAS f32x4*)(G1 + b * D + col), sh = *(const LAS f32x4*)(S1 + b * D + col);
            const f32x4 h = v[j] * r * g + sh;
            o8[64 * j] = (unsigned long long)pk2(h.x, h.y) | ((unsigned long long)pk2(h.z, h.w) << 32); }
    }
    __syncthreads();
}

struct EpiInProj {
    static constexpr bool PERM = true;
    unsigned char* ws;
    __device__ __forceinline__ void operator()(f32x4 (&acc)[2][2][4][2], const pg8::Unit& u, int wr, int wc, int fr, int fq) const {
        const int pn = u.pn; const int row0 = u.pm * 256 + wr * 64 + fr;
        const bool prope = (pn < 4) || (pn >= 6 && pn < 10) || (pn == 18);
        const bool rrope = (pn >= 10 && pn < 14);
        const bool roped = rrope || (prope && (wc & 1) == 0 && !(pn == 18 && wc != 0));
        const int g = 4 * (wc & 1) + fq;
        const bool act = rrope || (fq < 2);
        const int tl = rrope ? 32 : 8;
        const float* ct = (const float*)(ws + (rrope ? WS_ROPE2 : WS_ROPE1)) + 4 * (act ? g : 0); const float* stb = ct + (size_t)M * tl;
        bf16* base; int ld, colt; float sc = 1.f;
        if (pn < 2) { base = (bf16*)(ws + WS_QA); ld = 512; colt = pn * 256; sc = C2; }
        else if (pn < 4) { base = (bf16*)(ws + WS_KA); ld = 512; colt = (pn - 2) * 256; }
        else if (pn < 6) { base = (bf16*)(ws + WS_VA); ld = 512; colt = (pn - 4) * 256; }
        else if (pn < 10) { base = (bf16*)(ws + WS_QI); ld = 1024; colt = (pn - 6) * 256; }
        else if (pn < 12) { base = (bf16*)(ws + WS_QB); ld = 512; colt = (pn - 10) * 256; }
        else if (pn < 14) { base = (bf16*)(ws + WS_KB); ld = 512; colt = (pn - 12) * 256; sc = 0.125f; }
        else if (pn < 16) { base = (bf16*)(ws + WS_VB); ld = 512; colt = (pn - 14) * 256; }
        else if (pn < 18) { base = (bf16*)(ws + WS_GB); ld = 512; colt = (pn - 16) * 256; }
        else { base = (bf16*)(ws + WS_KI); ld = 64; colt = 0; }
        int colA[2], colB[2];
#pragma unroll
        for (int bj = 0; bj < 2; ++bj) { const int col = bj * 128 + wc * 32 + 8 * fq, hb = col & ~63;
            if (rrope) { colA[bj] = hb + 4 * g; colB[bj] = hb + 32 + 4 * g; }
            else if (prope && (wc & 1) == 0 && fq < 2 && !(pn == 18 && wc != 0)) { colA[bj] = hb + 4 * g; colB[bj] = hb + 8 + 4 * g; }
            else { colA[bj] = col; colB[bj] = col + 4; } }
        float* wi = (float*)(ws + WS_WI);
        f32x4 cnx = {0.f, 0.f, 0.f, 0.f}, snx = cnx;
        if (roped) { cnx = *(const GAS f32x4*)(ct + (size_t)row0 * tl); snx = *(const GAS f32x4*)(stb + (size_t)row0 * tl); }
#pragma unroll
        for (int ai = 0; ai < 2; ++ai)
#pragma unroll
            for (int m = 0; m < 4; ++m) { const int row = row0 + ai * 128 + m * 16;
                if (roped) {
                    const f32x4 cs = cnx, sn = snx;
                    if (!(ai == 1 && m == 3)) { const int rn = row0 + ((m == 3) ? 128 : ai * 128 + (m + 1) * 16);
                        cnx = *(const GAS f32x4*)(ct + (size_t)rn * tl); snx = *(const GAS f32x4*)(stb + (size_t)rn * tl); }
#pragma unroll
                    for (int bj = 0; bj < 2; ++bj) { const f32x4 x1 = acc[ai][bj][m][0], x2 = acc[ai][bj][m][1];
                        if (act) { acc[ai][bj][m][0] = x1 * cs - x2 * sn; acc[ai][bj][m][1] = x2 * cs + x1 * sn; } }
                }
                if (pn < 18) {
#pragma unroll
                    for (int bj = 0; bj < 2; ++bj) {
                        const f32x4 v0 = acc[ai][bj][m][0] * sc, v1 = acc[ai][bj][m][1] * sc; v2u wa, wb;
                        wa.x = pg8::cvt_pk_bf16(v0[0], v0[1]); wa.y = pg8::cvt_pk_bf16(v0[2], v0[3]); wb.x = pg8::cvt_pk_bf16(v1[0], v1[1]); wb.y = pg8::cvt_pk_bf16(v1[2], v1[3]);
                        bf16* rp = base + (size_t)row * ld + colt;
                        *(GAS v2u*)(rp + colA[bj]) = wa; *(GAS v2u*)(rp + colB[bj]) = wb; }
                } else {
                    const int col = wc * 32 + 8 * fq;
                    const f32x4 v0 = acc[ai][0][m][0], v1 = acc[ai][0][m][1];
                    if (col < 64) { v2u wa, wb; wa.x = pg8::cvt_pk_bf16(v0[0], v0[1]); wa.y = pg8::cvt_pk_bf16(v0[2], v0[3]); wb.x = pg8::cvt_pk_bf16(v1[0], v1[1]); wb.y = pg8::cvt_pk_bf16(v1[2], v1[3]);
                        *(GAS v2u*)(base + (size_t)row * 64 + colA[0]) = wa; *(GAS v2u*)(base + (size_t)row * 64 + colB[0]) = wb; }
                    else if (col < 80) { *(GAS f32x4*)(wi + (size_t)row * 16 + (col - 64)) = v0 * 0.25f; *(GAS f32x4*)(wi + (size_t)row * 16 + (col - 64) + 4) = v1 * 0.25f; }
                }
                asm volatile("" ::: "memory");
            }
    }
};

struct EpiOutProj {
    static constexpr bool PERM = true;
    bf16* mix; const float* mod;
    __device__ __forceinline__ void operator()(f32x4 (&acc)[2][2][4][2], const pg8::Unit& u, int wr, int wc, int fr, int fq) const {
        const int row0 = u.pm * 256 + wr * 64 + fr; const int b = (u.pm * 256) >> 13;
#pragma unroll
        for (int bj = 0; bj < 2; ++bj) { const int col = u.pn * 256 + bj * 128 + wc * 32 + 8 * fq;
            const f32x4 g0 = *(const GAS f32x4*)(mod + b * 6144 + 2048 + col), g1 = *(const GAS f32x4*)(mod + b * 6144 + 2048 + col + 4);
#pragma unroll
            for (int ai = 0; ai < 2; ++ai)
#pragma unroll
                for (int m = 0; m < 4; ++m) { const f32x4 v0 = acc[ai][bj][m][0] * g0, v1 = acc[ai][bj][m][1] * g1; v4u w;
                    w.x = pg8::cvt_pk_bf16(v0[0], v0[1]); w.y = pg8::cvt_pk_bf16(v0[2], v0[3]); w.z = pg8::cvt_pk_bf16(v1[0], v1[1]); w.w = pg8::cvt_pk_bf16(v1[2], v1[3]);
                    *(GAS v4u*)(mix + (size_t)(row0 + ai * 128 + m * 16) * D + col) = w; } }
    }
};

__device__ __forceinline__ float ret_log_gamma(int h) { return log1pf(-exp2f(-5.0f - (float)h)); }
__device__ __forceinline__ int crow(int r, int hi) { return (r & 3) + 8 * (r >> 2) + 4 * hi; }

typedef short v4i16_t __attribute__((ext_vector_type(4)));
constexpr size_t WS_TOT = WS_MASK;
constexpr size_t WS_CARRY = WS_MASK + 8 * MiB;
__device__ __forceinline__ void ra_states(Frame& F) {
    const bf16* KB = (const bf16*)(F.ws + WS_KB); const bf16* VB = (const bf16*)(F.ws + WS_VB);
    float* ST = (float*)(F.ws + WS_ST); float* TOT = (float*)(F.ws + WS_TOT);
    const int lane = F.lane, r32 = lane & 31, hi = lane >> 5, gi = lane & 15, gg = lane >> 4, wave = F.wave;
    const int half = wave >> 2, et = (wave >> 1) & 1, dt = wave & 1, ht = F.tid & 255;
    for (int unit = F.vcu; unit < 256; unit += F.G) {
        const int bh = unit >> 3, h = bh & 7, b = bh >> 3, c0 = (unit & 7) * 16 + half * 8;
        const float lg = ret_log_gamma(h), g = __expf(64.f * lg);
        f32x16 acc = f32x16{};
        const int offA = (((gi >> 2) + 8 * hi) * 64 + 32 * et + 16 * (gg & 1) + 4 * (gi & 3)) * 2;
        const int offB = (((gi >> 2) + 8 * hi) * 64 + 32 * dt + 16 * (gg & 1) + 4 * (gi & 3)) * 2;
        v4u nk[2], nvv[2];
#define RA_LOAD(cc) do { const size_t t0_ = (size_t)b * SEQ + (size_t)(cc) * 64; _Pragma("unroll") for (int p = 0; p < 2; ++p) { const int idx = ht + 256 * p, row = idx >> 3, q = idx & 7; \
            nk[p] = *(const GAS v4u*)(KB + (t0_ + row) * 512 + h * 64 + q * 8); nvv[p] = *(const GAS v4u*)(VB + (t0_ + row) * 512 + h * 64 + q * 8); } } while (0)
        RA_LOAD(c0);
#pragma unroll 1
        for (int i = 0; i < 8; ++i) {
            const int c = c0 + i;
            LAS unsigned short* Ks = (LAS unsigned short*)(F.lds + (half * 2 + (i & 1)) * 16384);
            LAS unsigned short* Vs = Ks + 4096;
#pragma unroll
            for (int p = 0; p < 2; ++p) { const int idx = ht + 256 * p, row = idx >> 3, q = idx & 7;
                v4u kk = nk[p]; const float z = __expf((63.f - (float)row) * lg); unsigned* kw = (unsigned*)&kk;
#pragma unroll
                for (int e = 0; e < 4; ++e) kw[e] = pg8::cvt_pk_bf16(bf2f((unsigned short)(kw[e] & 0xffff)) * z, bf2f((unsigned short)(kw[e] >> 16)) * z);
                *(LAS v4u*)(Ks + row * 64 + q * 8) = kk; *(LAS v4u*)(Vs + row * 64 + q * 8) = nvv[p]; }
            if (i < 7) RA_LOAD(c + 1);
            { float* st = ST + ((size_t)bh * 128 + c) * 4096;
#pragma unroll
                for (int r = 0; r < 16; ++r) st[(32 * et + crow(r, hi)) * 64 + 32 * dt + r32] = acc[r]; }
#pragma unroll
            for (int r = 0; r < 16; ++r) acc[r] *= g;
            __syncthreads();
#pragma unroll
            for (int ks = 0; ks < 4; ++ks) {
                const LAS unsigned char* va = (const LAS unsigned char*)Vs + offA + ks * 16 * 64 * 2; const LAS unsigned char* kb = (const LAS unsigned char*)Ks + offB + ks * 16 * 64 * 2;
                const v4i16_t a0 = __builtin_amdgcn_ds_read_tr16_b64_v4i16((LAS v4i16_t*)va), a1 = __builtin_amdgcn_ds_read_tr16_b64_v4i16((LAS v4i16_t*)(va + 4 * 64 * 2));
                const v4i16_t b0 = __builtin_amdgcn_ds_read_tr16_b64_v4i16((LAS v4i16_t*)kb), b1 = __builtin_amdgcn_ds_read_tr16_b64_v4i16((LAS v4i16_t*)(kb + 4 * 64 * 2));
                acc = __builtin_amdgcn_mfma_f32_32x32x16_bf16((bf16x8){a0[0], a0[1], a0[2], a0[3], a1[0], a1[1], a1[2], a1[3]}, (bf16x8){b0[0], b0[1], b0[2], b0[3], b1[0], b1[1], b1[2], b1[3]}, acc, 0, 0, 0); }
        }
#undef RA_LOAD
        { float* tt = TOT + ((size_t)bh * 16 + (unit & 7) * 2 + half) * 4096;
#pragma unroll
            for (int r = 0; r < 16; ++r) tt[(32 * et + crow(r, hi)) * 64 + 32 * dt + r32] = acc[r]; }
        __syncthreads();
    }
}
__device__ __forceinline__ void rb_carry(Frame& F) {
    const float* TOT = (const float*)(F.ws + WS_TOT); float* CAR = (float*)(F.ws + WS_CARRY);
    const int gt = (F.vcu * NWAVES + F.wave) * 64 + F.lane, NGT = F.G * NWAVES * 64;
    for (int i = gt; i < 32 * 4096; i += NGT) {
        const int bh = i >> 12, el = i & 4095, h = bh & 7;
        const float g8 = __expf(512.f * ret_log_gamma(h));
        const float* p = TOT + (size_t)bh * 16 * 4096 + el; float* q = CAR + (size_t)bh * 16 * 4096 + el; float run = 0.f;
#pragma unroll
        for (int gI = 0; gI < 16; ++gI) { const float t = p[(size_t)gI * 4096]; q[(size_t)gI * 4096] = run; run = run * g8 + t; }
    }
}
__device__ __forceinline__ void r3_out(Frame& F) {
    const int gw = F.vcu * NWAVES + F.wave, NGW = F.G * NWAVES;
    LAS unsigned short* Vs = (LAS unsigned short*)(F.lds + F.wave * 8192);
    const bf16* QB = (const bf16*)(F.ws + WS_QB); const bf16* KB = (const bf16*)(F.ws + WS_KB); const bf16* VB = (const bf16*)(F.ws + WS_VB); const bf16* GB = (const bf16*)(F.ws + WS_GB);
    const float* ST = (const float*)(F.ws + WS_ST); const float* CAR = (const float*)(F.ws + WS_CARRY); bf16* Y = (bf16*)(F.ws + WS_Y);
    const int lane = F.lane, r32 = lane & 31, hi = lane >> 5, gi = lane & 15, gg = lane >> 4;
    const bool lcar = (F.G == 256);
    LAS float* CL = (LAS float*)(F.lds + 65536);
    if (lcar) { const float* TOT = (const float*)(F.ws + WS_TOT); const int grp = F.vcu & 15;
#pragma unroll 1
        for (int it = 0; it < 2; ++it) { const int bh = (F.vcu >> 4) + 16 * it; const float g8 = __expf(512.f * ret_log_gamma(bh & 7));
            f32x4 r0 = {0.f, 0.f, 0.f, 0.f}, r1 = r0; const float* tp = TOT + (size_t)bh * 16 * 4096 + F.tid * 8;
#pragma unroll 1
            for (int g2 = 0; g2 < grp; ++g2) { r0 = r0 * g8 + *(const GAS f32x4*)(tp + (size_t)g2 * 4096); r1 = r1 * g8 + *(const GAS f32x4*)(tp + (size_t)g2 * 4096 + 4); }
            *(LAS f32x4*)(CL + it * 4096 + F.tid * 8) = r0; *(LAS f32x4*)(CL + it * 4096 + F.tid * 8 + 4) = r1; }
        __syncthreads(); }
    int pass = 0;
    const int vtr_off = (((gi >> 2) + 4 * hi) * 64 + 16 * (gg & 1) + 4 * (gi & 3)) * 2;
    for (int u = gw; u < NB * 8 * 128; u += NGW) {
        const int c = u & 127, h = (u >> 7) & 7, b = u >> 10;
        const float lg = ret_log_gamma(h), gpc = __expf(64.f * (float)(c & 7) * lg);
        const size_t tok0 = (size_t)b * SEQ + (size_t)c * 64;
        { const GAS v4u* vp = (const GAS v4u*)(VB + (tok0 + lane) * 512 + h * 64);
#pragma unroll
            for (int q = 0; q < 8; ++q) *(LAS v4u*)(Vs + lane * 64 + q * 8) = vp[q]; }
        bf16x8 qf[2][4], pf[2][4];
#pragma unroll
        for (int t = 0; t < 2; ++t)
#pragma unroll
            for (int ks = 0; ks < 4; ++ks) {
                qf[t][ks] = *(const GAS bf16x8*)(QB + (tok0 + 32 * t + r32) * 512 + h * 64 + 16 * ks + 8 * hi);
                const float* sp = ST + (size_t)u * 4096 + (32 * t + r32) * 64 + 16 * ks + 8 * hi;
                const int co = (32 * t + r32) * 64 + 16 * ks + 8 * hi; f32x4 c0, c1;
                if (lcar) { c0 = *(const LAS f32x4*)(CL + pass * 4096 + co); c1 = *(const LAS f32x4*)(CL + pass * 4096 + co + 4); }
                else { const float* cp = CAR + ((size_t)(u >> 7) * 16 + (c >> 3)) * 4096 + co; c0 = *(const GAS f32x4*)cp; c1 = *(const GAS f32x4*)(cp + 4); }
                const f32x4 s0 = *(const GAS f32x4*)sp + c0 * gpc, s1 = *(const GAS f32x4*)(sp + 4) + c1 * gpc;
                v4u w; w.x = pg8::cvt_pk_bf16(s0.x, s0.y); w.y = pg8::cvt_pk_bf16(s0.z, s0.w); w.z = pg8::cvt_pk_bf16(s1.x, s1.y); w.w = pg8::cvt_pk_bf16(s1.z, s1.w);
                pf[t][ks] = __builtin_bit_cast(bf16x8, w); }
        float emr[16];
#pragma unroll
        for (int r = 0; r < 16; ++r) emr[r] = __expf(-(float)crow(r, hi) * lg);
        const float em32 = __expf(-32.f * lg);
        LDS_WAIT(); asm volatile("" ::: "memory");
#pragma unroll
        for (int nt = 0; nt < 2; ++nt) {
            const int n = 32 * nt + r32;
            const float en = __expf((float)n * lg), xi = __expf((float)(n + 1) * lg);
            f32x16 y[2]; y[0] = f32x16{}; y[1] = f32x16{};
#pragma unroll
            for (int et = 0; et < 2; ++et)
#pragma unroll
                for (int ks = 0; ks < 4; ++ks) y[et] = __builtin_amdgcn_mfma_f32_32x32x16_bf16(pf[et][ks], qf[nt][ks], y[et], 0, 0, 0);
#pragma unroll
            for (int r = 0; r < 16; ++r) { y[0][r] *= xi; y[1][r] *= xi; }
#pragma unroll
            for (int mt = 0; mt <= nt; ++mt) {
                f32x16 st = f32x16{};
#pragma unroll
                for (int ks = 0; ks < 4; ++ks) { const bf16x8 kf = *(const GAS bf16x8*)(KB + (tok0 + 32 * mt + r32) * 512 + h * 64 + 16 * ks + 8 * hi);
                    st = __builtin_amdgcn_mfma_f32_32x32x16_bf16(kf, qf[nt][ks], st, 0, 0, 0); }
                const float enm = mt ? en * em32 : en;
#pragma unroll
                for (int r = 0; r < 16; ++r) { const int m = 32 * mt + crow(r, hi); st[r] = (n >= m) ? st[r] * (enm * emr[r]) : 0.f; }
#pragma unroll
                for (int s2 = 0; s2 < 2; ++s2) {
                    v4u pw; pw.x = pg8::cvt_pk_bf16(st[8 * s2 + 0], st[8 * s2 + 1]); pw.y = pg8::cvt_pk_bf16(st[8 * s2 + 2], st[8 * s2 + 3]); pw.z = pg8::cvt_pk_bf16(st[8 * s2 + 4], st[8 * s2 + 5]); pw.w = pg8::cvt_pk_bf16(st[8 * s2 + 6], st[8 * s2 + 7]);
                    const bf16x8 pb = __builtin_bit_cast(bf16x8, pw);
#pragma unroll
                    for (int et = 0; et < 2; ++et) {
                        const LAS unsigned char* vb = (const LAS unsigned char*)Vs + vtr_off + ((32 * mt + 16 * s2) * 64 + 32 * et) * 2;
                        const v4i16_t lo = __builtin_amdgcn_ds_read_tr16_b64_v4i16((LAS v4i16_t*)vb), hh = __builtin_amdgcn_ds_read_tr16_b64_v4i16((LAS v4i16_t*)(vb + 8 * 64 * 2));
                        const bf16x8 va = (bf16x8){lo[0], lo[1], lo[2], lo[3], hh[0], hh[1], hh[2], hh[3]};
                        y[et] = __builtin_amdgcn_mfma_f32_32x32x16_bf16(va, pb, y[et], 0, 0, 0); }
                }
            }
            float sm = 0.f;
#pragma unroll
            for (int r = 0; r < 16; ++r) sm += y[0][r] + y[1][r];
            sm += __shfl_xor(sm, 32);
            const float mu = sm * (1.f / 64.f); float q = 0.f;
#pragma unroll
            for (int r = 0; r < 16; ++r) { y[0][r] -= mu; y[1][r] -= mu; q += y[0][r] * y[0][r] + y[1][r] * y[1][r]; }
            q += __shfl_xor(q, 32);
            const float rs = __builtin_amdgcn_rsqf(q * (1.f / 64.f) + EPS);
            const size_t tok = tok0 + n;
#pragma unroll
            for (int et = 0; et < 2; ++et)
#pragma unroll
                for (int g4 = 0; g4 < 4; ++g4) { const int e0 = 32 * et + 8 * g4 + 4 * hi;
                    const v2u gv = *(const GAS v2u*)(GB + tok * 512 + h * 64 + e0);
                    float o4[4];
#pragma unroll
                    for (int i = 0; i < 4; ++i) { const float g = bf2f((unsigned short)((i & 1) ? ((i & 2) ? gv.y : gv.x) >> 16 : ((i & 2) ? gv.y : gv.x) & 0xffff));
                        const float sg = g * __builtin_amdgcn_rcpf(1.f + __expf(-g)); o4[i] = sg * y[et][4 * g4 + i] * rs; }
                    v2u ov; ov.x = pg8::cvt_pk_bf16(o4[0], o4[1]); ov.y = pg8::cvt_pk_bf16(o4[2], o4[3]);
                    *(GAS v2u*)(Y + tok * D + 512 + h * 64 + e0) = ov; }
        }
        LDS_WAIT(); asm volatile("" ::: "memory");
        ++pass;
    }
}

__device__ __forceinline__ void p_norm2_route(Frame& F) {
    const float* mod = (const float*)(F.ws + WS_MOD);
    LAS f32x4* RG = (LAS f32x4*)F.lds;
    LAS f32x4* RE = (LAS f32x4*)(F.lds + 16384);
    { const float* wrg = F.w_rg(); const float* wre = F.w_re();
        for (int i = F.tid; i < 1024; i += NWAVES * 64) { const int ln = (i & 255) >> 2, j = i >> 8, t = i & 3; RG[(j * 4 + t) * 64 + ln] = *(const GAS f32x4*)(wrg + (size_t)i * 4); }
        for (int i = F.tid; i < 4 * 1024 * 2; i += NWAVES * 64) { const int g = i >> 11, row = (i >> 1) & 1023, hf = i & 1, ln = (row & 255) >> 2, j = row >> 8, t = row & 3;
            RE[g * 2048 + ((j * 4 + t) * 2 + hf) * 64 + ln] = *(const GAS f32x4*)(wre + ((size_t)g * 1024 + row) * 8 + hf * 4); } }
    constexpr int RT_CAP = 300;
    LAS unsigned* RC = (LAS unsigned*)(F.lds + 147456);
    LAS unsigned* REC = RC + 65;
    static_assert(147456 + (65 + 3 * RT_CAP) * 4 <= RING_BYTES + AUX_BYTES, "router LDS map");
    for (int i = F.tid; i < 65; i += NWAVES * 64) RC[i] = 0u;
    __syncthreads();
    const int gw = F.vcu * NWAVES + F.wave, NGW = F.G * NWAVES;
    const float* X = F.x(); const bf16* MIX = (const bf16*)(F.ws + WS_MIX); bf16* H2 = (bf16*)(F.ws + WS_H2);
    unsigned* ltok = (unsigned*)(F.ws + WS_ROUTE); float* lw = (float*)(F.ws + WS_ROUTE + 4 * MiB);
    f32x4 nv[4]; v2u nm[4];
#define N2_LOAD(mm) do { const GAS f32x4* xr = (const GAS f32x4*)(X + (size_t)(mm) * D) + F.lane; \
        _Pragma("unroll") for (int j = 0; j < 4; ++j) { nv[j] = xr[64 * j]; nm[j] = *(const GAS v2u*)(MIX + (size_t)(mm) * D + 4 * F.lane + 256 * j); } } while (0)
    if (gw < M) N2_LOAD(gw);
    for (int m = gw; m < M; m += NGW) {
        const int b = m >> 13;
        f32x4 v[4]; float s = 0.f;
#pragma unroll
        for (int j = 0; j < 4; ++j) { v[j] = nv[j]; v[j].x += bf2f((unsigned short)(nm[j].x & 0xffff)); v[j].y += bf2f((unsigned short)(nm[j].x >> 16)); v[j].z += bf2f((unsigned short)(nm[j].y & 0xffff)); v[j].w += bf2f((unsigned short)(nm[j].y >> 16)); }
        if (m + NGW < M) N2_LOAD(m + NGW);
#pragma unroll
        for (int j = 0; j < 4; ++j) s += (v[j].x * v[j].x + v[j].y * v[j].y) + (v[j].z * v[j].z + v[j].w * v[j].w);
        const float r = 1.f / sqrtf(wave_sum(s) * (1.f / D) + EPS);
        GAS unsigned long long* o8 = (GAS unsigned long long*)(H2 + (size_t)m * D) + F.lane;
        f32x4 lg = {0.f, 0.f, 0.f, 0.f};
#pragma unroll
        for (int j = 0; j < 4; ++j) { const int col = 4 * F.lane + 256 * j;
            const f32x4 g = *(const GAS f32x4*)(F.g_ffn() + col) * (*(const GAS f32x4*)(mod + b * 6144 + 4096 + col) + 1.f), sh = *(const GAS f32x4*)(mod + b * 6144 + 3072 + col);
            v[j] = v[j] * r * g + sh;
            o8[64 * j] = (unsigned long long)pk2(v[j].x, v[j].y) | ((unsigned long long)pk2(v[j].z, v[j].w) << 32);
            const LAS f32x4* wg = RG + (j * 4) * 64 + F.lane;
            lg += wg[0] * v[j].x; lg += wg[64] * v[j].y; lg += wg[128] * v[j].z; lg += wg[192] * v[j].w; }
        lg.x = wave_sum(lg.x); lg.y = wave_sum(lg.y); lg.z = wave_sum(lg.z); lg.w = wave_sum(lg.w);
        int grp = 0; float mx = lg.x;
        if (lg.y > mx) { mx = lg.y; grp = 1; } if (lg.z > mx) { mx = lg.z; grp = 2; } if (lg.w > mx) { mx = lg.w; grp = 3; }
        const float pgrp = 1.f / (expf(lg.x - mx) + expf(lg.y - mx) + expf(lg.z - mx) + expf(lg.w - mx));
        f32x4 f0 = {0.f, 0.f, 0.f, 0.f}, f1 = f0;
        const LAS f32x4* reg = RE + grp * 2048 + F.lane;
#pragma unroll
        for (int j = 0; j < 4; ++j) { const LAS f32x4* we = reg + (j * 8) * 64;
            f0 += we[0] * v[j].x; f1 += we[64] * v[j].x; f0 += we[128] * v[j].y; f1 += we[192] * v[j].y; f0 += we[256] * v[j].z; f1 += we[320] * v[j].z; f0 += we[384] * v[j].w; f1 += we[448] * v[j].w; }
        float fe[8];
        fe[0] = wave_sum(f0.x); fe[1] = wave_sum(f0.y); fe[2] = wave_sum(f0.z); fe[3] = wave_sum(f0.w); fe[4] = wave_sum(f1.x); fe[5] = wave_sum(f1.y); fe[6] = wave_sum(f1.z); fe[7] = wave_sum(f1.w);
        int i1 = 0; float m1 = fe[0];
#pragma unroll
        for (int e = 1; e < 8; ++e) if (fe[e] > m1) { m1 = fe[e]; i1 = e; }
        int i2 = -1; float m2 = -INFINITY;
#pragma unroll
        for (int e = 0; e < 8; ++e) if (e != i1 && fe[e] > m2) { m2 = fe[e]; i2 = e; }
        const float e2 = expf(m2 - m1); const float w1 = pgrp / (1.f + e2), w2 = pgrp * e2 / (1.f + e2);
        if (F.lane < 2) { const int e = grp * 8 + (F.lane ? i2 : i1); const float w = F.lane ? w2 : w1;
            const unsigned slot = __hip_atomic_fetch_add(RC + 64, 1u, __ATOMIC_RELAXED, __HIP_MEMORY_SCOPE_WORKGROUP);
            if (slot < (unsigned)RT_CAP) { const unsigned lp = __hip_atomic_fetch_add(RC + e, 1u, __ATOMIC_RELAXED, __HIP_MEMORY_SCOPE_WORKGROUP);
                REC[slot] = ((unsigned)e << 16) | lp; REC[RT_CAP + slot] = (unsigned)m | ((unsigned)F.lane << 31); REC[2 * RT_CAP + slot] = __float_as_uint(w); }
            else { const unsigned p = __hip_atomic_fetch_add((unsigned*)(F.ctl + CW_ECNT + 64 * e), 1u, RLX_AGENT);
                ltok[(size_t)e * M + p] = (unsigned)m | ((unsigned)F.lane << 31); lw[(size_t)e * M + p] = w; } }
    }
    __syncthreads();
    if (F.tid < NEXP) { const unsigned c = RC[F.tid]; RC[32 + F.tid] = c ? __hip_atomic_fetch_add((unsigned*)(F.ctl + CW_ECNT + 64 * F.tid), c, RLX_AGENT) : 0u; }
    __syncthreads();
    { const unsigned nrec = RC[64] < (unsigned)RT_CAP ? RC[64] : (unsigned)RT_CAP;
        for (unsigned r = F.tid; r < nrec; r += NWAVES * 64) { const unsigned ep = REC[r], e = ep >> 16, p = RC[32 + e] + (ep & 0xffffu);
            ltok[(size_t)e * M + p] = REC[RT_CAP + r]; lw[(size_t)e * M + p] = __uint_as_float(REC[2 * RT_CAP + r]); } }
    __syncthreads();
}
__device__ __forceinline__ void p_expert_convert(Frame& F, int part, int nparts) {
    const int gw = F.vcu * NWAVES + F.wave, NGW = F.G * NWAVES;
    int ln = F.lane; asm volatile("" : "+v"(ln));
    LAS unsigned* T = (LAS unsigned*)(F.lds + F.wave * 16384);
    bf16* wgu = (bf16*)(F.ws + WS_WGU); bf16* wd = (bf16*)(F.ws + WS_WD);
    constexpr int I_GU = NEXP * 16 * 16, I_D = NEXP * 16 * 8;
    int k = 0;
    for (int it = gw; it < I_GU + I_D; it += NGW, ++k) {
        if (k % nparts != part) continue;
        if (it < I_GU) { const int e = it >> 8, r = it & 255, nt = r >> 4, kt = r & 15;
            tr_tile_gu(F.w_gate() + (size_t)e * D * DEXP, F.w_up() + (size_t)e * D * DEXP, wgu + (size_t)e * 1024 * 1024, nt * 64, kt * 64, T, ln); }
        else { const int q = it - I_GU, e = q >> 7, r = q & 127, nt = r >> 3, kt = r & 7;
            tr_tile_d(F.w_down() + (size_t)e * DEXP * D, wd + (size_t)e * 1024 * 512, nt * 64, kt * 64, T, ln); }
    }
}

constexpr int MOE_MAXU = 5;
struct MoeSched {
    int G, c, nunits; LAS int* blkstart; LAS unsigned* tok; bool gather;
    __device__ __forceinline__ bool next(int i, pg8::Unit& u) const {
        const int L = i * G + c; if (L >= nunits || i >= MOE_MAXU) return false;
        const int blk = L >> 2, pnl = L & 3; int e = 0;
#pragma unroll 1
        for (int k = 1; k < NEXP; ++k) if (blkstart[k] <= blk) e = k;
        u.pm = i | (blk << 8); u.pn = e * 4 + pnl; return true;
    }
    __device__ __forceinline__ int arow(const pg8::Unit& u, int rt) const {
        if (gather) { const unsigned t = tok[(u.pm & 255) * 256 + rt]; return (int)(t == 0xffffffffu ? 0u : (t & 0x7fffffffu)); }
        return (u.pm >> 8) * 256 + rt;
    }
    __device__ __forceinline__ int brow0(const pg8::Unit& u) const { return u.pn * 256; }
};
__device__ __forceinline__ int moe_tables(Frame& F, LAS int* blkstart, LAS unsigned* tok, LAS float* wts) {
    if (F.tid < 64) { const unsigned cnt = (F.tid < NEXP) ? __hip_atomic_load((unsigned*)(F.ctl + CW_ECNT + 64 * (F.tid & 31)), RLX_AGENT) : 0u;
        const unsigned nb = (cnt + 255u) >> 8; const unsigned inc = wave_prefix_incl(nb, F.tid);
        if (F.tid < NEXP) { blkstart[F.tid] = (int)(inc - nb); blkstart[40 + F.tid] = (int)cnt; }
        if (F.tid == NEXP - 1) blkstart[NEXP] = (int)inc; }
    __syncthreads();
    const int nunits = blkstart[NEXP] * 4;
    const unsigned* ltok = (const unsigned*)(F.ws + WS_ROUTE); const float* lw = (const float*)(F.ws + WS_ROUTE + 4 * MiB);
    for (int i = 0; i < MOE_MAXU; ++i) { const int L = i * F.G + F.vcu; if (L >= nunits) break;
        const int blk = L >> 2; int e = 0;
        for (int k = 1; k < NEXP; ++k) if (blkstart[k] <= blk) e = k;
        const unsigned cnt = (unsigned)blkstart[40 + e];
        for (int r = F.tid; r < 256; r += NWAVES * 64) { const unsigned p = (unsigned)(blk - blkstart[e]) * 256u + (unsigned)r;
            tok[i * 256 + r] = p < cnt ? ltok[(size_t)e * M + p] : 0xffffffffu; wts[i * 256 + r] = p < cnt ? lw[(size_t)e * M + p] : 0.f; } }
    __syncthreads();
    return nunits;
}
struct EpiMoe1 {
    static constexpr bool PERM = true;
    bf16* act;
    __device__ __forceinline__ void operator()(f32x4 (&acc)[2][2][4][2], const pg8::Unit& u, int wr, int wc, int fr, int fq) const {
        const int blk = u.pm >> 8, pnl = u.pn & 3; const int row0 = blk * 256 + wr * 64 + fr;
#pragma unroll
        for (int bj = 0; bj < 2; ++bj) { const int ac = pnl * 128 + (bj * 128 + wc * 32 + 8 * fq) / 2;
#pragma unroll
            for (int ai = 0; ai < 2; ++ai)
#pragma unroll
                for (int m = 0; m < 4; ++m) { const f32x4 v0 = acc[ai][bj][m][0], v1 = acc[ai][bj][m][1];
                    const float a0 = v0[0] / (1.f + __expf(-v0[0])) * v0[1], a1 = v0[2] / (1.f + __expf(-v0[2])) * v0[3];
                    const float a2 = v1[0] / (1.f + __expf(-v1[0])) * v1[1], a3 = v1[2] / (1.f + __expf(-v1[2])) * v1[3];
                    v2u w; w.x = pg8::cvt_pk_bf16(a0, a1); w.y = pg8::cvt_pk_bf16(a2, a3);
                    *(GAS v2u*)(act + (size_t)(row0 + ai * 128 + m * 16) * DEXP + ac) = w; } }
    }
};
struct EpiMoe2 {
    static constexpr bool PERM = true;
    bf16* c0; bf16* c1; LAS unsigned* tok; LAS float* wts;
    __device__ __forceinline__ void operator()(f32x4 (&acc)[2][2][4][2], const pg8::Unit& u, int wr, int wc, int fr, int fq) const {
        const int li = u.pm & 255, pnl = u.pn & 3;
#pragma unroll
        for (int ai = 0; ai < 2; ++ai)
#pragma unroll
            for (int m = 0; m < 4; ++m) { const int rt = ai * 128 + wr * 64 + m * 16 + fr; const unsigned en = tok[li * 256 + rt]; const float w = wts[li * 256 + rt];
                if (en != 0xffffffffu) { bf16* dst = ((en >> 31) ? c1 : c0) + (size_t)(en & 0x7fffffffu) * D + pnl * 256 + wc * 32 + 8 * fq;
#pragma unroll
                    for (int bj = 0; bj < 2; ++bj) { const f32x4 v0 = acc[ai][bj][m][0] * w, v1 = acc[ai][bj][m][1] * w; v4u o;
                        o.x = pg8::cvt_pk_bf16(v0[0], v0[1]); o.y = pg8::cvt_pk_bf16(v0[2], v0[3]); o.z = pg8::cvt_pk_bf16(v1[0], v1[1]); o.w = pg8::cvt_pk_bf16(v1[2], v1[3]);
                        *(GAS v4u*)(dst + bj * 128) = o; } } }
    }
};

typedef _Float16 h16x2 __attribute__((ext_vector_type(2)));
__device__ __forceinline__ unsigned pk_f16_rtz(float a, float b) { return __builtin_bit_cast(unsigned, __builtin_amdgcn_cvt_pkrtz(a, b)); }
__device__ __forceinline__ unsigned sortable16x2(unsigned x) { const unsigned m = ((x >> 15) & 0x00010001u) * 0xFFFFu; return x ^ (m | 0x80008000u); }
constexpr int IDX_HS = 257;
constexpr int IDX_WT_OFF = 68 * 1024, IDX_RH_OFF = 72 * 1024, IDX_P2_OFF = IDX_RH_OFF + 32 * IDX_HS * 4, IDX_P2_BYTES = 4480;
static_assert(IDX_P2_OFF + 8 * IDX_P2_BYTES <= RING_BYTES + AUX_BYTES, "indexer LDS map");
template <int NC>
__device__ __forceinline__ void hist_find(LAS unsigned* H, int lane, unsigned K, unsigned& bsel, unsigned& above, unsigned& atb) {
    unsigned t[4];
#pragma unroll
    for (int q = 0; q < 4; ++q) { unsigned a = 0;
#pragma unroll
        for (int c = 0; c < NC; ++c) a += H[c * IDX_HS + 4 * lane + q];
        t[q] = a; }
    const unsigned ls = (t[0] + t[1]) + (t[2] + t[3]);
    unsigned suf = ls;
#pragma unroll
    for (int o = 1; o < 64; o <<= 1) { const unsigned v = __shfl_down(suf, o); if (lane + o < 64) suf += v; }
    unsigned ab = suf - ls; bool found = false; unsigned fb = 0, fa = 0, ft = 0;
#pragma unroll
    for (int q = 3; q >= 0; --q) { if (!found && ab < K && ab + t[q] >= K) { found = true; fb = 4 * lane + q; fa = ab; ft = t[q]; } ab += t[q]; }
    const unsigned long long bal = __ballot(found);
    const int src = bal ? (int)__builtin_ctzll(bal) : 0;
    bsel = __shfl(fb, src); above = __shfl(fa, src); atb = __shfl(ft, src);
}
__device__ __forceinline__ void sel_load(v4u (&ch)[16], const unsigned short* srow, int n, int lane) {
    const int nchunks = n >> 3;
#pragma unroll
    for (int j = 0; j < 16; ++j) { const int c = lane + 64 * j;
        unsigned off = (unsigned)c * 16u; asm volatile("" : "+v"(off));
        if (c < nchunks) ch[j] = *(const GAS v4u*)((const char*)srow + off); else ch[j] = (v4u){0u, 0u, 0u, 0u}; }
}
__device__ __forceinline__ unsigned pk_max_u16(unsigned a, unsigned b) { unsigned r; asm("v_pk_max_u16 %0, %1, %2" : "=v"(r) : "v"(a), "v"(b)); return r; }
__device__ __forceinline__ unsigned pk_min_u16(unsigned a, unsigned b) { unsigned r; asm("v_pk_min_u16 %0, %1, %2" : "=v"(r) : "v"(a), "v"(b)); return r; }
__device__ __forceinline__ void sel_compute(const v4u (&ch)[16], const unsigned short* srow, int n, unsigned char* mrow, LAS unsigned* RH, LAS unsigned* P2, int lane) {
    const int nchunks = n >> 3;
    if (n <= 256) {
#pragma unroll 1
        for (int j = 0; j < 16; ++j) { const int c = lane + 64 * j; mrow[c] = (c < nchunks) ? (unsigned char)0xFF : (unsigned char)0; }
        return;
    }
    unsigned b1, above1, at1; hist_find<1>(RH, lane, 256u, b1, above1, at1);
    for (int i = lane; i < 4 * IDX_HS; i += 64) P2[i] = 0u;
    LAS unsigned* hb = P2 + (lane & 3) * IDX_HS;
    unsigned pat = (b1 << 8) | (b1 << 24), c256 = 0x01000100u, c1 = 0x00010001u;
    asm volatile("" : "+v"(pat), "+v"(c256), "+v"(c1));
#pragma unroll
    for (int j = 0; j < 16; ++j) { if (64 * j < nchunks) {
#pragma unroll
        for (int i = 0; i < 4; ++i) { const unsigned w = ch[j][i]; const unsigned m = pk_min_u16(w ^ pat, c256);
            __hip_atomic_fetch_add(hb + (w & 0xffu), ((m >> 8) & 1u) ^ 1u, __ATOMIC_RELAXED, __HIP_MEMORY_SCOPE_WORKGROUP);
            __hip_atomic_fetch_add(hb + ((w >> 16) & 0xffu), (m >> 24) ^ 1u, __ATOMIC_RELAXED, __HIP_MEMORY_SCOPE_WORKGROUP); } } __builtin_amdgcn_sched_barrier(0); }
    unsigned b2, above2, teq; hist_find<4>(P2, lane, 256u - above1, b2, above2, teq);
    const unsigned tau = (b1 << 8) | b2; const unsigned r = 256u - above1 - above2;
    if (r >= teq) {
        unsigned tt = tau | (tau << 16); asm volatile("" : "+v"(tt));
#pragma unroll
        for (int j = 0; j < 16; ++j) { const int c = lane + 64 * j; unsigned acc = 0u;
#pragma unroll
            for (int i = 0; i < 4; ++i) { const unsigned w = ch[j][i]; const unsigned ns = pk_min_u16(pk_max_u16(w, tt) ^ w, c1);
                acc |= ns << (2 * i); }
            const unsigned bits = ~(acc | (acc >> 15)) & 0xffu;
            { unsigned off = (unsigned)c; asm volatile("" : "+v"(off)); mrow[off] = (unsigned char)bits; } __builtin_amdgcn_sched_barrier(0); }
    } else {
        unsigned running = 0u;
#pragma unroll 1
        for (int j = 0; j < 16; ++j) { const int c = lane + 64 * j;
            v4u x = {0u, 0u, 0u, 0u};
            if (c < nchunks) x = *(const GAS v4u*)(srow + (size_t)c * 8);
            unsigned gt = 0u, eq = 0u;
#pragma unroll
            for (int i = 0; i < 4; ++i) { const unsigned w = x[i], k0 = w & 0xffffu, k1 = w >> 16;
                gt |= (k0 > tau ? 1u : 0u) << (2 * i); gt |= (k1 > tau ? 1u : 0u) << (2 * i + 1); eq |= (k0 == tau ? 1u : 0u) << (2 * i); eq |= (k1 == tau ? 1u : 0u) << (2 * i + 1); }
            const unsigned tc = (unsigned)__builtin_popcount(eq); unsigned inc = tc;
#pragma unroll
            for (int o = 1; o < 64; o <<= 1) { const unsigned v = __shfl_up(inc, o); if (lane >= o) inc += v; }
            const unsigned base = running + inc - tc;
            int take = (int)r - (int)base; take = take < 0 ? 0 : (take > 8 ? 8 : take);
            unsigned e2 = eq, kept = 0u;
#pragma unroll
            for (int t = 0; t < 8; ++t) { const unsigned low = e2 & (0u - e2); if (t < take) kept |= low; e2 &= e2 - 1u; }
            running += __shfl(inc, 63);
            mrow[c] = (unsigned char)(gt | kept); }
    }
}
__device__ __forceinline__ void p_indexer(Frame& F) {
    const bf16* QI = (const bf16*)(F.ws + WS_QI); const bf16* KI = (const bf16*)(F.ws + WS_KI); const float* WI = (const float*)(F.ws + WS_WI);
    unsigned short* scr = (unsigned short*)(F.ws + WS_SCR) + (size_t)blockIdx.x * 32 * 8192;
    unsigned char* MASK = (unsigned char*)(F.ws + WS_MASK);
    const int tid = F.tid, lane = F.lane, wave = F.wave, r32 = lane & 31, hi = lane >> 5;
    LAS unsigned char* lds = F.lds;
    const int b = F.vcu >> 6, wq = F.vcu & 63;
#define IDX_QB(UI) (((UI) == 0) ? wq : ((UI) == 1) ? 127 - wq : ((UI) == 2) ? 128 + wq : 255 - wq)
#define IDX_FRAG_DMA(UI) do { const size_t tq_ = (size_t)b * SEQ + (size_t)IDX_QB(UI) * 32 + r32; const unsigned l0_ = (unsigned)(uintptr_t)lds; \
        _Pragma("unroll") for (int i_ = 0; i_ < 8; ++i_) { const int f_ = wave + 8 * i_; \
            attn_body::glds16(QI + tq_ * 1024 + (f_ >> 2) * 64 + 16 * (f_ & 3) + 8 * hi, (unsigned)__builtin_amdgcn_readfirstlane(l0_ + f_ * 1024)); } } while (0)
    IDX_FRAG_DMA(0);
#pragma unroll 1
    for (int ui = 0; ui < 4; ++ui) {
        const int qb32 = IDX_QB(ui);
        const int n = 64 * ((qb32 >> 1) + 1), ntiles = n >> 5;
        const size_t tokb = (size_t)b * SEQ, tok0 = tokb + (size_t)qb32 * 32;
        { LAS float* wt = (LAS float*)(lds + IDX_WT_OFF);
            const int q = tid & 31, hh = tid >> 5; wt[hh * 32 + q] = WI[(tok0 + q) * 16 + hh] * 0.125f;
            LAS unsigned* rh = (LAS unsigned*)(lds + IDX_RH_OFF); for (int i = tid; i < 32 * IDX_HS; i += NWAVES * 64) rh[i] = 0u; }
        { const int q = tid & 31, dg = tid >> 5; f32x4 a = {0.f, 0.f, 0.f, 0.f};
#pragma unroll
            for (int hh = 0; hh < 16; ++hh) { const float wv = WI[(tok0 + q) * 16 + hh] * 0.125f; const v2u qv = *(const GAS v2u*)(QI + (tok0 + q) * 1024 + hh * 64 + 4 * dg);
                a.x += wv * bf2f((unsigned short)(qv.x & 0xffff)); a.y += wv * bf2f((unsigned short)(qv.x >> 16)); a.z += wv * bf2f((unsigned short)(qv.y & 0xffff)); a.w += wv * bf2f((unsigned short)(qv.y >> 16)); }
            v2u o; o.x = pk2(a.x, a.y); o.y = pk2(a.z, a.w);
            *(LAS v2u*)(lds + (64 + (dg >> 2)) * 1024 + (q + 32 * ((dg >> 1) & 1)) * 16 + (dg & 1) * 8) = o; }
        VM_WAIT();
        __syncthreads();
        LAS unsigned* hrow = (LAS unsigned*)(lds + IDX_RH_OFF) + r32 * IDX_HS;
        bf16x8 kf[2][4];
#define IDX_KLOAD(TT) do { _Pragma("unroll") for (int j = 0; j < 2; ++j) { const int T = ((TT) + j < ntiles) ? (TT) + j : ntiles - 1; \
            _Pragma("unroll") for (int ks = 0; ks < 4; ++ks) kf[j][ks] = *(const GAS bf16x8*)(KI + (tokb + (size_t)T * 32 + r32) * 64 + 16 * ks + 8 * hi); } } while (0)
#define IDX_FMA4(S, P, B, W) do { asm volatile("v_fma_f32 %0, |%4|, %8, %0\n\tv_fma_f32 %1, |%5|, %8, %1\n\tv_fma_f32 %2, |%6|, %8, %2\n\tv_fma_f32 %3, |%7|, %8, %3" \
                : "+v"(S[B]), "+v"(S[B + 1]), "+v"(S[B + 2]), "+v"(S[B + 3]) : "v"(P[B]), "v"(P[B + 1]), "v"(P[B + 2]), "v"(P[B + 3]), "v"(W)); __builtin_amdgcn_sched_barrier(0); } while (0)
#define IDX_QF(base, ks) (*(const LAS bf16x8*)((base) + (ks) * 1024))
#define IDX_MF(N, K, Q, C) N = __builtin_amdgcn_mfma_f32_32x32x16_bf16(K, Q, C, 0, 0, 0); __builtin_amdgcn_sched_barrier(0)
#define IDX_PSTEP(N0, N1, P0, P1, W, CUR, NXT) do { \
                IDX_MF(N0, kf[0][0], qa, f32x16{}); IDX_FMA4(sc[0], P0, 0, W); \
                IDX_MF(N1, kf[1][0], qa, f32x16{}); IDX_FMA4(sc[0], P0, 4, W); qa = IDX_QF(CUR, 2); \
                IDX_MF(N0, kf[0][1], qb, N0); IDX_FMA4(sc[0], P0, 8, W); \
                IDX_MF(N1, kf[1][1], qb, N1); IDX_FMA4(sc[0], P0, 12, W); qb = IDX_QF(CUR, 3); \
                IDX_MF(N0, kf[0][2], qa, N0); IDX_FMA4(sc[1], P1, 0, W); \
                IDX_MF(N1, kf[1][2], qa, N1); IDX_FMA4(sc[1], P1, 4, W); qa = IDX_QF(NXT, 0); \
                IDX_MF(N0, kf[0][3], qb, N0); IDX_FMA4(sc[1], P1, 8, W); \
                IDX_MF(N1, kf[1][3], qb, N1); IDX_FMA4(sc[1], P1, 12, W); qb = IDX_QF(NXT, 1); } while (0)
        if (wave * 2 < ntiles) IDX_KLOAD(wave * 2);
#pragma unroll 1
        for (int T0 = wave * 2; T0 < ntiles; T0 += 16) {
            f32x16 sc[2];
            sc[0] = f32x16{}; sc[1] = f32x16{};
#pragma unroll
            for (int ks = 0; ks < 4; ++ks) { const bf16x8 qf = *(const LAS bf16x8*)(lds + (64 + ks) * 1024 + lane * 16);
                sc[0] = __builtin_amdgcn_mfma_f32_32x32x16_bf16(kf[0][ks], qf, sc[0], 0, 0, 0); sc[1] = __builtin_amdgcn_mfma_f32_32x32x16_bf16(kf[1][ks], qf, sc[1], 0, 0, 0); }
            {
                f32x16 dA0 = f32x16{}, dA1 = f32x16{}, dB0 = f32x16{}, dB1 = f32x16{};
                float wprev = 0.f;
                const LAS unsigned char* qbase = lds + lane * 16;
                const LAS unsigned char* wbase = lds + IDX_WT_OFF + r32 * 4;
                bf16x8 qa = IDX_QF(qbase, 0), qb = IDX_QF(qbase, 1);
#pragma unroll 1
                for (int hh = 0; hh < 16; hh += 2) {
                    const float wh0 = *(const LAS float*)(wbase + hh * 128), wh1 = *(const LAS float*)(wbase + hh * 128 + 128);
                    IDX_PSTEP(dA0, dA1, dB0, dB1, wprev, qbase, qbase + 4096);
                    IDX_PSTEP(dB0, dB1, dA0, dA1, wh0, qbase + 4096, qbase + 8192);
                    wprev = wh1; qbase += 8192;
                }
                asm volatile("s_nop 15\n\ts_nop 7" ::: "memory");
#pragma unroll
                for (int r = 0; r < 16; r += 4) { IDX_FMA4(sc[0], dB0, r, wprev); }
#pragma unroll
                for (int r = 0; r < 16; r += 4) { IDX_FMA4(sc[1], dB1, r, wprev); }
            }
            if (T0 + 16 < ntiles) IDX_KLOAD(T0 + 16);
#pragma unroll
            for (int j = 0; j < 2; ++j) { if (T0 + j < ntiles) { unsigned short* dst = scr + (size_t)r32 * 8192 + (size_t)(T0 + j) * 32 + 4 * hi;
#pragma unroll
                for (int g = 0; g < 4; ++g) { v2u o; o.x = sortable16x2(pk_f16_rtz(sc[j][4 * g], sc[j][4 * g + 1])); o.y = sortable16x2(pk_f16_rtz(sc[j][4 * g + 2], sc[j][4 * g + 3])); *(GAS v2u*)(dst + 8 * g) = o;
                    __hip_atomic_fetch_add(hrow + ((o.x >> 8) & 255u), 1u, __ATOMIC_RELAXED, __HIP_MEMORY_SCOPE_WORKGROUP); __hip_atomic_fetch_add(hrow + (o.x >> 24), 1u, __ATOMIC_RELAXED, __HIP_MEMORY_SCOPE_WORKGROUP);
                    __hip_atomic_fetch_add(hrow + ((o.y >> 8) & 255u), 1u, __ATOMIC_RELAXED, __HIP_MEMORY_SCOPE_WORKGROUP); __hip_atomic_fetch_add(hrow + (o.y >> 24), 1u, __ATOMIC_RELAXED, __HIP_MEMORY_SCOPE_WORKGROUP); } } }
        }
#undef IDX_QF
#undef IDX_MF
#undef IDX_PSTEP
#undef IDX_FMA4
        VM_WAIT(); __syncthreads();
        __builtin_amdgcn_fence(__ATOMIC_ACQUIRE, "workgroup");
        if (ui + 1 < 4) IDX_FRAG_DMA(ui + 1);
        { LAS unsigned* P2 = (LAS unsigned*)(lds + IDX_P2_OFF + wave * IDX_P2_BYTES); LAS unsigned* RH = (LAS unsigned*)(lds + IDX_RH_OFF) + wave * 4 * IDX_HS;
            const unsigned short* sr = scr + (size_t)wave * 4 * 8192; unsigned char* mr = MASK + (tok0 + wave * 4) * 1024;
#pragma unroll 1
            for (int rp3 = 0; rp3 < SUBREPS(16); ++rp3) {
            { int ls = lane; asm volatile("" : "+v"(ls));
                v4u chA[16], chB[16];
                sel_load(chA, sr, n, ls); sel_load(chB, sr + 8192, n, ls);
                sel_compute(chA, sr, n, mr, RH, P2, ls);
                sel_load(chA, sr + 2 * 8192, n, ls);
                sel_compute(chB, sr + 8192, n, mr + 1024, RH + IDX_HS, P2, ls);
                sel_load(chB, sr + 3 * 8192, n, ls);
                sel_compute(chA, sr + 2 * 8192, n, mr + 2 * 1024, RH + 2 * IDX_HS, P2, ls);
                sel_compute(chB, sr + 3 * 8192, n, mr + 3 * 1024, RH + 3 * IDX_HS, P2, ls); } } }
        __syncthreads();
    }
}

template <bool WITH_MOE>
__device__ __forceinline__ void p_final(Frame& F) {
    const int gw = F.vcu * NWAVES + F.wave, NGW = F.G * NWAVES;
    const float* X = F.x(); const bf16* MIX = (const bf16*)(F.ws + WS_MIX); const float* mod = (const float*)(F.ws + WS_MOD);
    const bf16* C0 = (const bf16*)(F.ws + WS_C0); const bf16* C1 = (const bf16*)(F.ws + WS_C1);
    f32x4 nv[4]; v2u nm[4], na[4], nc[4];
#define FIN_LOAD(mm) do { const GAS f32x4* xr = (const GAS f32x4*)(X + (size_t)(mm) * D) + F.lane; \
        _Pragma("unroll") for (int j = 0; j < 4; ++j) { nv[j] = xr[64 * j]; nm[j] = *(const GAS v2u*)(MIX + (size_t)(mm) * D + 4 * F.lane + 256 * j); if (WITH_MOE) { const int col = 4 * F.lane + 256 * j; na[j] = *(const GAS v2u*)(C0 + (size_t)(mm) * D + col); nc[j] = *(const GAS v2u*)(C1 + (size_t)(mm) * D + col); } } } while (0)
    if (gw < M) FIN_LOAD(gw);
    for (int m = gw; m < M; m += NGW) {
        const int b = m >> 13;
        f32x4 v[4]; v2u ca[4], cc[4]; float s = 0.f;
#pragma unroll
        for (int j = 0; j < 4; ++j) { v[j] = nv[j]; ca[j] = na[j]; cc[j] = nc[j];
            v[j].x += bf2f((unsigned short)(nm[j].x & 0xffff)); v[j].y += bf2f((unsigned short)(nm[j].x >> 16)); v[j].z += bf2f((unsigned short)(nm[j].y & 0xffff)); v[j].w += bf2f((unsigned short)(nm[j].y >> 16)); }
        if (m + NGW < M) FIN_LOAD(m + NGW);
#pragma unroll
        for (int j = 0; j < 4; ++j) {
            if (WITH_MOE) { const int col = 4 * F.lane + 256 * j; const f32x4 gt = *(const GAS f32x4*)(mod + b * 6144 + 5120 + col);
                const v2u a = ca[j], c = cc[j];
                f32x4 mo; mo.x = bf2f((unsigned short)(a.x & 0xffff)) + bf2f((unsigned short)(c.x & 0xffff)); mo.y = bf2f((unsigned short)(a.x >> 16)) + bf2f((unsigned short)(c.x >> 16));
                mo.z = bf2f((unsigned short)(a.y & 0xffff)) + bf2f((unsigned short)(c.y & 0xffff)); mo.w = bf2f((unsigned short)(a.y >> 16)) + bf2f((unsigned short)(c.y >> 16));
                v[j] = v[j] + gt * mo; }
            s += (v[j].x * v[j].x + v[j].y * v[j].y) + (v[j].z * v[j].z + v[j].w * v[j].w); }
        const float r = 1.f / sqrtf(wave_sum(s) * (1.f / D) + EPS);
        GAS f32x4* o = (GAS f32x4*)(F.out() + (size_t)m * D) + F.lane;
#pragma unroll
        for (int j = 0; j < 4; ++j) { const f32x4 g = *(const GAS f32x4*)(F.g_fin() + 4 * F.lane + 256 * j); o[64 * j] = v[j] * r * g; }
    }
}

constexpr int N_PHASES = 16;
__global__ void __launch_bounds__(NWAVES * 64, 2) mk_fwd(Args args) {
    extern __shared__ __attribute__((aligned(16))) unsigned char lds[];
    Frame F;
    F.lds = (LAS unsigned char*)lds;
    F.tid = threadIdx.x; F.lane = F.tid & 63; F.wave = __builtin_amdgcn_readfirstlane(F.tid >> 6);
    F.G = gridDim.x; { const int bx = blockIdx.x; F.vcu = (F.G % 8 == 0) ? (bx % 8) * (F.G / 8) + bx / 8 : bx; }
    F.ws = args.ws; F.ctl = (gu32*)(args.ws + WS_CTL);
    F.ka = (const CAS Args*)__builtin_amdgcn_kernarg_segment_ptr();
    volatile LAS unsigned* LCTL = (volatile LAS unsigned*)(F.lds + LDSCTL_OFF);
    for (int u = F.tid; u < 64; u += NWAVES * 64) LCTL[u] = 0u;
    __syncthreads();
    const bool multi = (args.ph_hi - args.ph_lo) > 1;
    XcdBarrier bar; bar.bar = (unsigned*)(F.ctl + CW_BAR); bar.x = 0; bar.st = nullptr;
    if (multi) bar = xcd_barrier_post((unsigned*)(F.ctl + CW_BAR), LCTL + 8);
    const int lo = args.ph_lo, hi = args.ph_hi;
#ifndef PH_MASK
#define PH_MASK 0xffffffffu
#endif
#define IN(k) (((PH_MASK >> (k)) & 1u) && lo <= (k) && (k) < hi)
#define REPS(k) (1 + (int)((REP_MASK >> (k)) & 1u))
#define SEAM(k) do { if (IN(k) && IN((k) + 1)) xcd_barrier(bar); } while (0)

    if (IN(0)) _Pragma("unroll") for (int rp_ = 0; rp_ < REPS(0); ++rp_) { p0_prologue(F); } SEAM(0);
    if (multi && ((REP_MASK >> 21) & 1u)) { for (int q = 0; q < 8; ++q) xcd_barrier(bar); }
    if (IN(1)) _Pragma("unroll") for (int rp_ = 0; rp_ < REPS(1); ++rp_) { p1_norm(F); } SEAM(1);
    if (IN(2)) _Pragma("unroll") for (int rp_ = 0; rp_ < REPS(2); ++rp_) {
        pg8::Gemm g{(const bf16*)(F.ws + WS_H), (const bf16*)(F.ws + WS_WIN), D}; pg8::StaticOrder S; S.init(M, NPAD, F.G, (int)blockIdx.x);
        EpiInProj E{F.ws};
        pg8::gemm_phase<EpiInProj, pg8::StaticOrder, true>(F.lds, g, S, E);
    } SEAM(2);
    if (IN(3)) _Pragma("unroll") for (int rp_ = 0; rp_ < REPS(3); ++rp_) { ra_states(F); } SEAM(3);
    if (IN(4)) { if (F.G != 256) { rb_carry(F); if (multi) xcd_barrier(bar); } }
    if (IN(5)) _Pragma("unroll") for (int rp_ = 0; rp_ < REPS(5); ++rp_) { r3_out(F);
    } SEAM(5);
    if (IN(6)) _Pragma("unroll") for (int rp_ = 0; rp_ < REPS(6); ++rp_) { p_indexer(F); } SEAM(6);
    if (IN(7)) _Pragma("unroll") for (int rp_ = 0; rp_ < REPS(7); ++rp_) {
        const attn_body::AttnTensors AT{(const bf16*)(F.ws + WS_QA), (const bf16*)(F.ws + WS_KA), (const bf16*)(F.ws + WS_VA), (bf16*)(F.ws + WS_Y), (const unsigned char*)(F.ws + WS_MASK)};
        const attn_body::StaticOrder S((int)F.G, (int)blockIdx.x);
        { attn_body::AttnUnit u;
            for (int i = 0; S.next(i, u); ++i) { attn_body::attn_unit<8>(u.bh / attn_body::NHEAD, u.bh % attn_body::NHEAD, u.qb, AT.Q, AT.K, AT.V, AT.O, AT.MK, (char*)lds);
                p_expert_convert(F, i, 4); __syncthreads(); } }
    } SEAM(7);
    if (IN(8)) _Pragma("unroll") for (int rp_ = 0; rp_ < REPS(8); ++rp_) {
        pg8::Gemm g{(const bf16*)(F.ws + WS_Y), (const bf16*)(F.ws + WS_WO), D}; pg8::StaticOrder S; S.init(M, D, F.G, (int)blockIdx.x);
        EpiOutProj E{(bf16*)(F.ws + WS_MIX), (const float*)(F.ws + WS_MOD)};
        pg8::gemm_phase<EpiOutProj, pg8::StaticOrder, true>(F.lds, g, S, E);
    } SEAM(8);
    if (IN(9)) _Pragma("unroll") for (int rp_ = 0; rp_ < REPS(9); ++rp_) { p_norm2_route(F); } SEAM(9);
    if (IN(10)) _Pragma("unroll") for (int rp_ = 0; rp_ < REPS(10); ++rp_) {
        LAS int* blkstart = (LAS int*)(F.lds + AUX_OFF); LAS unsigned* tok = (LAS unsigned*)(F.lds + AUX_OFF + 512); LAS float* wts = (LAS float*)(F.lds + AUX_OFF + 512 + MOE_MAXU * 1024);
        const int nunits = moe_tables(F, blkstart, tok, wts);
        pg8::Gemm g{(const bf16*)(F.ws + WS_H2), (const bf16*)(F.ws + WS_WGU), D}; MoeSched S{F.G, F.vcu, nunits, blkstart, tok, true};
        EpiMoe1 E{(bf16*)(F.ws + WS_ACT)};
        pg8::gemm_phase<EpiMoe1, MoeSched, true>(F.lds, g, S, E);
    } SEAM(10);
    if (IN(11)) _Pragma("unroll") for (int rp_ = 0; rp_ < REPS(11); ++rp_) {
        LAS int* blkstart = (LAS int*)(F.lds + AUX_OFF); LAS unsigned* tok = (LAS unsigned*)(F.lds + AUX_OFF + 512); LAS float* wts = (LAS float*)(F.lds + AUX_OFF + 512 + MOE_MAXU * 1024);
        const int nunits = moe_tables(F, blkstart, tok, wts);
        pg8::Gemm g{(const bf16*)(F.ws + WS_ACT), (const bf16*)(F.ws + WS_WD), DEXP}; MoeSched S{F.G, F.vcu, nunits, blkstart, tok, false};
        EpiMoe2 E{(bf16*)(F.ws + WS_C0), (bf16*)(F.ws + WS_C1), tok, wts};
        pg8::gemm_phase<EpiMoe2, MoeSched, true>(F.lds, g, S, E);
    } SEAM(11);
    if (IN(12)) _Pragma("unroll") for (int rp_ = 0; rp_ < REPS(12); ++rp_) { p_final<true>(F); }
#undef IN
#undef SEAM
}

extern "C" void kernel_launch(void* const* d_in, const int* in_sizes, int n_in, void* d_out, int out_size, void* d_ws, size_t ws_size, hipStream_t stream) {
    static int grid = 0;
    if (grid == 0) {
        if (n_in != 15 || out_size != M * D || ws_size < WS_END) { fprintf(stderr, "kernel_launch: unexpected shapes (n_in %d out %d ws %zu)\n", n_in, out_size, ws_size); grid = -1; return; }
        int dev = 0, cus = 0, per_cu = 0;
        if (hipGetDevice(&dev) != hipSuccess || hipDeviceGetAttribute(&cus, hipDeviceAttributeMultiprocessorCount, dev) != hipSuccess) { grid = -1; return; }
        if (hipFuncSetAttribute((const void*)mk_fwd, hipFuncAttributeMaxDynamicSharedMemorySize, LDS_BYTES) != hipSuccess) { fprintf(stderr, "kernel_launch: hipFuncSetAttribute failed\n"); grid = -1; return; }
        if (hipOccupancyMaxActiveBlocksPerMultiprocessor(&per_cu, (const void*)mk_fwd, NWAVES * 64, LDS_BYTES) != hipSuccess || per_cu < 1) { fprintf(stderr, "kernel_launch: occupancy query says %d\n", per_cu); }
        (void)hipGetLastError();
        grid = cus;
    }
    if (grid < 0) return;
    (void)hipMemsetAsync((char*)d_ws + WS_CTL, 0, CTL_ZERO_BYTES, stream);
    Args a{};
    for (int i = 0; i < 15; ++i) a.in[i] = d_in[i];
    a.out = (float*)d_out; a.ws = (unsigned char*)d_ws;
#if MK_N_LAUNCHES == 1
    a.ph_lo = 0; a.ph_hi = N_PHASES;
    hipLaunchKernelGGL(mk_fwd, dim3(grid), dim3(NWAVES * 64), LDS_BYTES, stream, a);
#else
    for (int p = 0; p < N_PHASES; ++p) { a.ph_lo = p; a.ph_hi = p + 1; hipLaunchKernelGGL(mk_fwd, dim3(grid), dim3(NWAVES * 64), LDS_BYTES, stream, a); }
#endif
}
```
